# Optimizing an MI355X kernel written in HIP

```python
import math
import jax, jax.numpy as jnp
from jax import lax
import numpy as np

D_MODEL = 4096
BATCH = 4
SEQ = 4096
DEPTH = 2
DEC_BATCH = 32
DEC_SEQ = 32
PAST_LEN = 4096

CHUNK = 64
N_HEADS = 32
HEAD_DIM = D_MODEL // N_HEADS
N_KV = 8
GROUP = N_HEADS // N_KV
ATTN_WIDTH = N_HEADS * HEAD_DIM
H_IDX = 32
D_IDX = 64
TOPK_MAX = 256
Q_BLOCK = 128
NUM_BUCKETS = 32
MAX_DISTANCE = 128
POOL_WINDOWS = (2, 4, 8, 16)
N_POOL_GROUPS = len(POOL_WINDOWS)
POOL_WIDTH = D_MODEL
GROUP_W = POOL_WIDTH // N_POOL_GROUPS
POOL_HIST = max(POOL_WINDOWS) - 1
EPS = 1e-6
N_ATTN_LAYERS = (DEPTH + 1) // 2
N_POOL_LAYERS = DEPTH // 2

Q_W = ATTN_WIDTH
KV_W = N_KV * HEAD_DIM
QI_W = H_IDX * D_IDX
KI_W = D_IDX
WI_W = H_IDX
ATTN_IN = Q_W + 2 * KV_W + QI_W + KI_W + WI_W + ATTN_WIDTH
ATTN_SPLITS = (Q_W, Q_W + KV_W, Q_W + 2 * KV_W, Q_W + 2 * KV_W + QI_W,
               Q_W + 2 * KV_W + QI_W + KI_W, Q_W + 2 * KV_W + QI_W + KI_W + WI_W)

kernel_name = "hybrid_dsa_pool_streaming_step"

f32 = jnp.float32


def rmsnorm(x, w):
    xf = x.astype(f32)
    y = xf * lax.rsqrt(jnp.mean(xf * xf, axis=-1, keepdims=True) + EPS)
    return (y * w.astype(f32)).astype(x.dtype)


def rel_bucket(rel):
    nb = NUM_BUCKETS // 2
    ret = jnp.where(rel > 0, nb, 0)
    n = jnp.abs(rel)
    max_exact = nb // 2
    nf = jnp.maximum(n, 1).astype(f32)
    large = max_exact + (jnp.log(nf / max_exact) / math.log(MAX_DISTANCE / max_exact)
                         * (nb - max_exact)).astype(jnp.int32)
    large = jnp.minimum(large, nb - 1)
    return ret + jnp.where(n < max_exact, n, large)


def dsa_select_attend(q, qi, wi, q_pos, k_all, v_all, ki_all, k_pos, k_sel, rel_bias):
    B, Q = q.shape[:2]
    dots = jnp.einsum('bqhd,bsd->bqhs', qi, ki_all, preferred_element_type=f32) * (D_IDX ** -0.5)
    score = jnp.einsum('bqhs,bqh->bqs', jax.nn.relu(dots), wi.astype(f32) * (H_IDX ** -0.5))
    adm = (k_pos[None, :] // CHUNK) <= (q_pos[:, None] // CHUNK)
    score = jnp.where(adm[None], score, -jnp.inf)
    _, idx = lax.top_k(score, k_sel)
    take = jax.vmap(lambda a, i: a[i])
    k_g = take(k_all, idx)
    v_g = take(v_all, idx)
    sel_pos = k_pos[idx]
    valid = (sel_pos // CHUNK) <= (q_pos[None, :, None] // CHUNK)
    bias = rel_bias[rel_bucket(sel_pos - q_pos[None, :, None])]
    bias = bias.reshape(B, Q, k_sel, N_KV, GROUP).transpose(0, 1, 3, 4, 2)
    qg = q.reshape(B, Q, N_KV, GROUP, HEAD_DIM)
    logits = jnp.einsum('bqkgd,bqjkd->bqkgj', qg, k_g, preferred_element_type=f32) * (HEAD_DIM ** -0.5)
    logits = logits + bias.astype(f32)
    logits = jnp.where(valid[:, :, None, None, :], logits, -jnp.inf)
    p = jax.nn.softmax(logits, axis=-1)
    out = jnp.einsum('bqkgj,bqjkd->bqkgd', p.astype(v_g.dtype), v_g, preferred_element_type=f32)
    return out.reshape(B, Q, ATTN_WIDTH).astype(q.dtype)


def attn_project(h, w_in):
    B, T, _ = h.shape
    proj = h @ w_in
    q, k, v, qi, ki, wi, gate = jnp.split(proj, ATTN_SPLITS, axis=-1)
    return (q.reshape(B, T, N_HEADS, HEAD_DIM), k.reshape(B, T, N_KV, HEAD_DIM),
            v.reshape(B, T, N_KV, HEAD_DIM), qi.reshape(B, T, H_IDX, D_IDX), ki, wi, gate)


def prompt_attend(q, qi, wi, k, v, ki, rel_bias):
    B, S = q.shape[:2]
    nb = S // Q_BLOCK
    pos = jnp.arange(S)
    k_sel = min(TOPK_MAX, S // 4)

    def to_blocks(a):
        return jnp.moveaxis(a.reshape((B, nb, Q_BLOCK) + a.shape[2:]), 1, 0)

    def blk(args):
        qb, qib, wib, pb = args
        return dsa_select_attend(qb, qib, wib, pb, k, v, ki, pos, k_sel, rel_bias)

    out = lax.map(blk, (to_blocks(q), to_blocks(qi), to_blocks(wi), pos.reshape(nb, Q_BLOCK)))
    return jnp.moveaxis(out, 0, 1).reshape(B, S, ATTN_WIDTH)


def sample_attend(q, qi, wi, k, v, ki, ck, cv, cki, rel_bias):
    T = q.shape[1]
    P = ck.shape[1]
    k_all = jnp.concatenate([ck.astype(k.dtype), k], axis=1)
    v_all = jnp.concatenate([cv.astype(v.dtype), v], axis=1)
    ki_all = jnp.concatenate([cki.astype(ki.dtype), ki], axis=1)
    k_pos = jnp.arange(P + T)
    q_pos = P + jnp.arange(T)
    k_sel = min(TOPK_MAX, (P + T) // 4)
    return dsa_select_attend(q, qi, wi, q_pos, k_all, v_all, ki_all, k_pos, k_sel, rel_bias)


def pool_mix(u, hist, start):
    B, T, E = u.shape
    P = POOL_HIST
    ext = jnp.concatenate([jnp.zeros((B, 1, E), f32), hist.astype(f32), u.astype(f32)], axis=1)
    c = jnp.cumsum(ext, axis=1)
    ends = c[:, P + 1:P + 1 + T]
    pos = start + jnp.arange(T)
    outs = []
    for g, w in enumerate(POOL_WINDOWS):
        lo, hi = g * GROUP_W, (g + 1) * GROUP_W
        s = ends[..., lo:hi] - c[:, P + 1 - w:P + 1 - w + T, lo:hi]
        cnt = jnp.minimum(pos + 1, w).astype(f32)
        outs.append(s / cnt[None, :, None])
    mean = jnp.concatenate(outs, axis=-1)
    return (mean - u.astype(f32)).astype(u.dtype)


def pool_layer(h, hist, start, w_in, group_w, scale, w_out):
    B, T, _ = h.shape
    proj = h @ w_in
    u, gate = proj[..., :POOL_WIDTH], proj[..., POOL_WIDTH:]
    m = pool_mix(u, hist, start)
    z = jnp.einsum('btgc,gcd->btgd', m.reshape(B, T, N_POOL_GROUPS, GROUP_W), group_w).reshape(B, T, POOL_WIDTH)
    z = z * scale
    out = (z * jax.nn.silu(gate)) @ w_out
    new_hist = jnp.concatenate([hist.astype(u.dtype), u], axis=1)[:, -POOL_HIST:]
    return out, new_hist


def setup_inputs(seed: int = 0) -> dict:
    key = jax.random.key(seed)
    ks = jax.random.split(key, 16)
    NA, NP = N_ATTN_LAYERS, N_POOL_LAYERS
    nrm = jax.random.normal
    return {
        "x_prompt": nrm(ks[0], (BATCH, SEQ, D_MODEL), f32),
        "x_sample": nrm(ks[1], (DEC_BATCH, DEC_SEQ, D_MODEL), f32),
        "cache_k": nrm(ks[2], (NA, DEC_BATCH, PAST_LEN, N_KV, HEAD_DIM), f32),
        "cache_v": nrm(ks[3], (NA, DEC_BATCH, PAST_LEN, N_KV, HEAD_DIM), f32),
        "cache_kidx": nrm(ks[4], (NA, DEC_BATCH, PAST_LEN, D_IDX), f32),
        "state_pool": nrm(ks[5], (NP, DEC_BATCH, POOL_HIST, POOL_WIDTH), f32),
        "norm_w": 1.0 + 0.02 * nrm(ks[6], (DEPTH, D_MODEL), f32),
        "final_norm_w": 1.0 + 0.02 * nrm(ks[7], (D_MODEL,), f32),
        "attn_w_in": nrm(ks[8], (NA, D_MODEL, ATTN_IN), f32) * D_MODEL ** -0.5,
        "attn_w_out": nrm(ks[9], (NA, ATTN_WIDTH, D_MODEL), f32) * ATTN_WIDTH ** -0.5,
        "rel_bias": 0.2 * nrm(ks[10], (NUM_BUCKETS, N_HEADS), f32),
        "pool_w_in": nrm(ks[11], (NP, D_MODEL, 2 * POOL_WIDTH), f32) * D_MODEL ** -0.5,
        "pool_group_w": nrm(ks[12], (NP, N_POOL_GROUPS, GROUP_W, GROUP_W), f32) * GROUP_W ** -0.5,
        "pool_scale": 1.0 + 0.05 * nrm(ks[13], (NP, POOL_WIDTH), f32),
        "pool_w_out": nrm(ks[14], (NP, POOL_WIDTH, D_MODEL), f32) * POOL_WIDTH ** -0.5,
    }


def reference(x_prompt, x_sample, cache_k, cache_v, cache_kidx, state_pool, norm_w, final_norm_w,
              attn_w_in, attn_w_out, rel_bias, pool_w_in, pool_group_w, pool_scale, pool_w_out):
    xp, xs = x_prompt, x_sample
    kp, vp, kip, poolp = [], [], [], []
    ksm, vsm, kism, poolsm = [], [], [], []
    for i in range(DEPTH):
        hp = rmsnorm(xp, norm_w[i])
        hs = rmsnorm(xs, norm_w[i])
        if i % 2 == 0:
            a = i // 2
            q, k, v, qi, ki, wi, g = attn_project(hp, attn_w_in[a])
            o = prompt_attend(q, qi, wi, k, v, ki, rel_bias)
            xp = xp + (o * jax.nn.silu(g)) @ attn_w_out[a]
            kp.append(k); vp.append(v); kip.append(ki)
            q, k, v, qi, ki, wi, g = attn_project(hs, attn_w_in[a])
            o = sample_attend(q, qi, wi, k, v, ki, cache_k[a], cache_v[a], cache_kidx[a], rel_bias)
            xs = xs + (o * jax.nn.silu(g)) @ attn_w_out[a]
            ksm.append(k); vsm.append(v); kism.append(ki)
        else:
            p = i // 2
            zero_hist = jnp.zeros((xp.shape[0], POOL_HIST, POOL_WIDTH), xp.dtype)
            out, hist = pool_layer(hp, zero_hist, 0, pool_w_in[p], pool_group_w[p], pool_scale[p], pool_w_out[p])
            xp = xp + out
            poolp.append(hist)
            out, hist = pool_layer(hs, state_pool[p], PAST_LEN, pool_w_in[p], pool_group_w[p], pool_scale[p], pool_w_out[p])
            xs = xs + out
            poolsm.append(hist)
    y_prompt = rmsnorm(xp, final_norm_w)
    y_sample = rmsnorm(xs, final_norm_w)
    return (y_prompt, y_sample, jnp.stack(kp), jnp.stack(vp), jnp.stack(kip), jnp.stack(poolp),
            jnp.stack(ksm), jnp.stack(vsm), jnp.stack(kism), jnp.stack(poolsm))
```

```cpp
#include <hip/hip_runtime.h>
#include <cstdio>
#include <cstdint>

#define LAS __attribute__((address_space(3)))
typedef unsigned short bf16_t;
typedef short bf16x8 __attribute__((ext_vector_type(8)));
typedef short s16x4 __attribute__((ext_vector_type(4)));
typedef float f32x4 __attribute__((ext_vector_type(4)));
typedef float f32x16 __attribute__((ext_vector_type(16)));
typedef unsigned u32x4 __attribute__((ext_vector_type(4)));
typedef unsigned u32x2 __attribute__((ext_vector_type(2)));
typedef unsigned long long u64;

constexpr int DM = 4096, NBATCH = 4, SEQ = 4096, DB = 32, DSQ = 32, PAST = 4096;
constexpr int MP = NBATCH * SEQ, MS = DB * DSQ, MT = MP + MS;
constexpr int KVW = 1024, QIW = 2048, DIDX = 64, HIDX = 32;
constexpr int N1 = 12544;
constexpr int SKV = 4160;
constexpr int RMS = 65;
constexpr float EPS = 1e-6f;
constexpr int NWAVES = 8, NTHREADS = 512;
constexpr int NPHASE = 11;

constexpr size_t O_YP = 0, O_YS = 67108864, O_KP = 71303168, O_VP = 88080384, O_KIP = 104857600, O_POOLP = 105906176,
                 O_KS = 106151936, O_VS = 107200512, O_KIS = 108249088, O_POOLS = 108314624, O_END = 110280704;

constexpr size_t MiB = 1u << 20;
constexpr size_t WS_CTL = 0, CTL_ZERO_BYTES = 1 * MiB;
constexpr size_t WS_WT_IN = 1 * MiB, WS_WT_OUT = 99 * MiB, WS_WT_PIN = 131 * MiB, WS_WT_GRP = 195 * MiB, WS_WT_POUT = 203 * MiB;
constexpr size_t WS_H = 235 * MiB, WS_QB = 371 * MiB, WS_KP = 507 * MiB, WS_VP = 539 * MiB, WS_KS = 571 * MiB, WS_VS = 831 * MiB;
constexpr size_t WS_QIB = 1091 * MiB, WS_KIP = 1159 * MiB, WS_KIS = 1161 * MiB, WS_WIB = 1178 * MiB, WS_SG = 1181 * MiB, WS_RM = 1317 * MiB;
constexpr size_t WS_OG = 1326 * MiB, WS_X1 = 1462 * MiB, WS_END = 1734 * MiB;
constexpr size_t WS_U = WS_QB, WS_SG2 = WS_SG, WS_MX = WS_OG, WS_ZG = WS_KS;
constexpr int CW_BAR = 4096;

constexpr int LDS_BYTES = 147456, RING_BYTES = 131072, MISC_OFF = RING_BYTES + 320;

__device__ __forceinline__ unsigned cvt_pk_bf16(float lo, float hi) { unsigned r; asm("v_cvt_pk_bf16_f32 %0, %1, %2" : "=v"(r) : "v"(lo), "v"(hi)); return r; }
__device__ __forceinline__ float bf_lo(unsigned w) { return __uint_as_float(w << 16); }
__device__ __forceinline__ float bf_hi(unsigned w) { return __uint_as_float(w & 0xffff0000u); }
__device__ __forceinline__ float silu_f(float x) { return x * __builtin_amdgcn_rcpf(1.0f + __builtin_amdgcn_exp2f(-1.4426950408889634f * x)); }
__device__ __forceinline__ float wave_sum(float v) {
#pragma unroll
    for (int o = 1; o < 64; o <<= 1) v += __shfl_xor(v, o);
    return v;
}
#define LDS_WAIT() asm volatile("s_waitcnt lgkmcnt(0)" ::: "memory")
#define VM_WAIT() asm volatile("s_waitcnt vmcnt(0)" ::: "memory")

#define XB_TMO      128
#define XB_XCNT(j)  (256  + 64 * (j))
#define XB_XSUB(j)  (1280 + 64 * (j))
#define XB_XGEN(j)  (2304 + 64 * (j))
#define XB_TOP      3328
#define XB_TOPGEN   3392
#define XCD_BAR_WORDS 3456
#define XB_SPIN_CAP (1u << 18)
__device__ __forceinline__ unsigned xb_ld(unsigned* p)              { return __hip_atomic_load(p, __ATOMIC_RELAXED, __HIP_MEMORY_SCOPE_AGENT); }
__device__ __forceinline__ unsigned xb_add(unsigned* p, unsigned v) { return __hip_atomic_fetch_add(p, v, __ATOMIC_RELAXED, __HIP_MEMORY_SCOPE_AGENT); }
__device__ __forceinline__ unsigned xb_xcc_id() { return (unsigned)__builtin_amdgcn_s_getreg((3 << 11) | 20) & 0xFu; }
#define XB_SPIN(cond, bar) do { unsigned _sp = 0; while (cond) { __builtin_amdgcn_s_sleep(1); \
    if ((++_sp & 255u) == 0u) { if (xb_ld(&(bar)[XB_TMO])) break; if (_sp > XB_SPIN_CAP) { atomicAdd(&(bar)[XB_TMO], 1u); break; } } } } while (0)
struct XcdBarrier { unsigned* bar; unsigned x; volatile LAS unsigned* st; };
__device__ __forceinline__ XcdBarrier xcd_barrier_post(unsigned* bar, volatile LAS unsigned* st) {
    XcdBarrier b; b.bar = bar; b.x = xb_xcc_id(); b.st = st;
    if (threadIdx.x == 0) (void)xb_add(&bar[XB_XCNT(b.x)], 1u);
    return b;
}
__device__ __forceinline__ void xcd_barrier_complete(unsigned* bar, unsigned x, unsigned& nloc, unsigned& nx) {
    const unsigned G = gridDim.x * gridDim.y * gridDim.z;
    unsigned sum, cnt, mine, sp = 0u;
    for (;;) {
        sum = 0u; cnt = 0u; mine = 0u;
#pragma unroll
        for (unsigned j = 0; j < 16; ++j) { const unsigned c = xb_ld(&bar[XB_XCNT(j)]); sum += c; cnt += (c > 0u) ? 1u : 0u; mine = (j == x) ? c : mine; }
        if (sum == G) break;
        __builtin_amdgcn_s_sleep(1);
        if ((++sp & 255u) == 0u) { if (xb_ld(&bar[XB_TMO])) break; if (sp > XB_SPIN_CAP) { atomicAdd(&bar[XB_TMO], 1u); break; } }
    }
    nloc = mine > 0u ? mine : 1u; nx = cnt > 0u ? cnt : 1u;
}
__device__ __forceinline__ void xcd_barrier(const XcdBarrier& b) {
    asm volatile("s_waitcnt vmcnt(0)" ::: "memory");
    __syncthreads();
    if (threadIdx.x == 0) {
        unsigned* bar = b.bar;
        __builtin_amdgcn_s_waitcnt(0);
        unsigned nloc = b.st[0], nx = b.st[1];
        if (nloc == 0u) { xcd_barrier_complete(bar, b.x, nloc, nx); b.st[0] = nloc; b.st[1] = nx; }
        const unsigned old = xb_add(&bar[XB_XSUB(b.x)], 1u);
        const unsigned gen = old / nloc;
        if (old + 1u == (gen + 1u) * nloc) {
            __builtin_amdgcn_fence(__ATOMIC_RELEASE, "agent");
            asm volatile("s_waitcnt vmcnt(0)" ::: "memory");
            const unsigned og = xb_add(&bar[XB_TOP], 1u);
            const unsigned tg = og / nx;
            if (og + 1u == (tg + 1u) * nx) xb_add(&bar[XB_TOPGEN], 1u);
            else XB_SPIN(xb_ld(&bar[XB_TOPGEN]) == tg, bar);
            __builtin_amdgcn_fence(__ATOMIC_ACQUIRE, "agent");
            xb_add(&bar[XB_XGEN(b.x)], 1u);
            asm volatile("s_waitcnt vmcnt(0)" ::: "memory");
        } else {
            XB_SPIN(xb_ld(&bar[XB_XGEN(b.x)]) == gen, bar);
            __builtin_amdgcn_fence(__ATOMIC_ACQUIRE, "agent");
            asm volatile("s_waitcnt vmcnt(0)" ::: "memory");
        }
    }
    __syncthreads();
}

namespace pg8 {
constexpr int BM = 256, BK = 64, HALF = 128, HTB = HALF * BK * 2, STAGE_BYTES = 8 * HTB, NXCD = 8, WGM = 8;
__host__ __device__ __forceinline__ int lds_byte(int r, int c) { const int st = (r >> 4) * 2 + (c >> 5), rr = r & 15, cc = c & 31, ob = rr * 64 + cc * 2; return st * 1024 + (ob ^ (((ob >> 9) & 1) << 5)); }
__host__ __device__ __forceinline__ void stage_rc(int b, int& R, int& C) { const int st = b / 1024, sb = b % 1024, swz = sb ^ (((sb >> 9) & 1) << 5); R = (st >> 1) * 16 + swz / 64; C = (st & 1) * 32 + (swz % 64) / 2; }
__host__ __device__ __forceinline__ int perm32(int rho) { const int n = rho >> 4, i = rho & 15; return 8 * (i >> 2) + 4 * n + (i & 3); }
struct Unit { int pm, pn; };
struct Gemm { const bf16_t* A; const bf16_t* Bt; int M, N, K, lda, ldb, grouped; };
struct StaticOrder {
    int nM, nN, nwg, G, c;
    __host__ __device__ void init(int M, int N, int G_, int c_) { nM = M / BM; nN = N / BM; nwg = nM * nN; G = G_; c = c_; }
    __host__ __device__ bool next(int i, Unit& u) const {
        const long L = (long)i * G + c; if (L >= nwg) return false;
        int wgid = (int)L; { const int q = nwg / NXCD, r = nwg % NXCD, xcd = wgid % NXCD, off = wgid / NXCD; wgid = (xcd < r ? xcd * (q + 1) : r * (q + 1) + (xcd - r) * q) + off; }
        const int nig = WGM * nN, gid = wgid / nig, fm = gid * WGM, gsz = (nM - fm) < WGM ? (nM - fm) : WGM;
        u.pm = fm + ((wgid % nig) % gsz); u.pn = (wgid % nig) / gsz; return true;
    }
};

template <class Epi, bool ALIGN_EPI = true>
__device__ __forceinline__ void gemm_phase(LAS unsigned char* lds, const Gemm g, const StaticOrder& S, const Epi& E) {
    const int tid = threadIdx.x, wid = __builtin_amdgcn_readfirstlane(tid >> 6), lane = tid & 63, wr = wid >> 2, wc = wid & 3, fr = lane & 15, fq = lane >> 4;
    const int K = g.K, nt = K / BK;
    unsigned voffA[2], voffB[2];
#pragma unroll
    for (int i = 0; i < 2; ++i) { int R, C; stage_rc(tid * 16 + i * 8192, R, C); const int Rb = Epi::PERM ? ((R & ~31) + perm32(R & 31)) : R;
        voffA[i] = (unsigned)(R * g.lda + C) * 2u; voffB[i] = (unsigned)(Rb * g.ldb + C) * 2u; }
    const size_t kstep = (size_t)(BK * 2);
    const size_t hstepA = (size_t)HALF * g.lda * 2, hstepB = (size_t)HALF * g.ldb * 2;
    const size_t tstepA = 2 * hstepA, tstepB = 2 * hstepB;
    const unsigned ldsw = (unsigned)wid * 1024u;
    const int aoff = lds_byte(wr * 64 + fr, fq * 8), boff = lds_byte(wc * 32 + fr, fq * 8);
#define PG8_SA(b, h) (((b) * 2 + (h)) * HTB)
#define PG8_SB(b, h) ((4 + (b) * 2 + (h)) * HTB)
#define PG8_STAGE(bufoff, gbase, voff) do { _Pragma("unroll") for (int _i = 0; _i < 2; ++_i) \
        __builtin_amdgcn_global_load_lds((const unsigned*)((const char*)(gbase) + (voff)[_i]), (LAS unsigned*)(lds + (bufoff) + ldsw + _i * 8192), 16, 0, 0); } while (0)
#define PG8_LDA(dst, b, h) do { _Pragma("unroll") for (int m = 0; m < 4; ++m) _Pragma("unroll") for (int k = 0; k < 2; ++k) dst[m][k] = *(const LAS bf16x8*)(lds + PG8_SA(b, h) + aoff + m * 2048 + k * 1024); } while (0)
#define PG8_LDB(dst, b, h) do { _Pragma("unroll") for (int n = 0; n < 2; ++n) _Pragma("unroll") for (int k = 0; k < 2; ++k) dst[n][k] = *(const LAS bf16x8*)(lds + PG8_SB(b, h) + boff + n * 2048 + k * 1024); } while (0)
#define PG8_MMA(ai, bj, At, Bt) do { __builtin_amdgcn_s_setprio(1); _Pragma("unroll") for (int m = 0; m < 4; ++m) _Pragma("unroll") for (int n = 0; n < 2; ++n) _Pragma("unroll") for (int k = 0; k < 2; ++k) \
        acc[ai][bj][m][n] = __builtin_amdgcn_mfma_f32_16x16x32_bf16(Bt[n][k], At[m][k], acc[ai][bj][m][n], 0, 0, 0); __builtin_amdgcn_s_setprio(0); } while (0)
#define PG8_WAIT_V(n) asm volatile("s_waitcnt vmcnt(" #n ")" ::: "memory")
#define PG8_WAIT_L(n) asm volatile("s_waitcnt lgkmcnt(" #n ")" ::: "memory")
#define PG8_BAR __builtin_amdgcn_s_barrier()
#define PG8_SCHED __builtin_amdgcn_sched_barrier(0)
#define PG8_APTR(u) ((const char*)g.A + (size_t)(u).pm * tstepA + (g.grouped ? (size_t)((u).pn >> 2) * (size_t)K * 2 : (size_t)0))
    Unit cur, nxt; int ui = 0;
    if (!S.next(0, cur)) return;
    f32x4 acc[2][2][4][2];
#pragma unroll
    for (int a = 0; a < 2; ++a)
#pragma unroll
        for (int b = 0; b < 2; ++b)
#pragma unroll
            for (int m = 0; m < 4; ++m)
#pragma unroll
                for (int n = 0; n < 2; ++n) acc[a][b][m][n] = (f32x4){0.f, 0.f, 0.f, 0.f};
    bf16x8 At[4][2], B0[2][2], B1[2][2];
    const char* cA = PG8_APTR(cur); const char* cB = (const char*)g.Bt + (size_t)cur.pn * tstepB;
    PG8_STAGE(PG8_SB(0, 0), cB, voffB); PG8_STAGE(PG8_SB(0, 1), cB + hstepB, voffB); PG8_STAGE(PG8_SA(0, 0), cA, voffA); PG8_STAGE(PG8_SA(0, 1), cA + hstepA, voffA);
    if (wr == 1) PG8_BAR;
    PG8_WAIT_V(2); PG8_BAR;
    PG8_STAGE(PG8_SB(1, 0), cB + kstep, voffB); PG8_STAGE(PG8_SA(1, 0), cA + kstep, voffA); PG8_STAGE(PG8_SB(1, 1), cB + hstepB + kstep, voffB);
    PG8_WAIT_V(6); PG8_BAR;
    for (;;) {
        const bool has_next = S.next(ui + 1, nxt);
        const char* nA = has_next ? PG8_APTR(nxt) : cA; const char* nB = has_next ? (const char*)g.Bt + (size_t)nxt.pn * tstepB : cB;
        for (int t = 0; t < nt; t += 2) {
            const bool last = (t == nt - 2);
            const char* a1 = cA + (size_t)(t + 1) * kstep;
            const char* a2 = last ? nA : cA + (size_t)(t + 2) * kstep; const char* b2 = last ? nB : cB + (size_t)(t + 2) * kstep;
            const char* a3 = a2 + kstep; const char* b3 = b2 + kstep;
            PG8_LDB(B0, 0, 0); PG8_LDB(B1, 0, 1); PG8_SCHED; PG8_LDA(At, 0, 0); PG8_STAGE(PG8_SA(1, 1), a1 + hstepA, voffA);
            PG8_WAIT_V(8); PG8_WAIT_L(0); PG8_BAR; PG8_MMA(0, 0, At, B0); PG8_MMA(0, 1, At, B1); PG8_BAR; PG8_SCHED;
            PG8_LDA(At, 0, 1); PG8_STAGE(PG8_SB(0, 0), b2, voffB); PG8_STAGE(PG8_SB(0, 1), b2 + hstepB, voffB); PG8_STAGE(PG8_SA(0, 0), a2, voffA);
            PG8_WAIT_V(8); PG8_WAIT_L(0); PG8_BAR; PG8_MMA(1, 0, At, B0); PG8_MMA(1, 1, At, B1); PG8_BAR; PG8_SCHED;
            PG8_LDB(B0, 1, 0); PG8_LDB(B1, 1, 1); PG8_SCHED; PG8_LDA(At, 1, 0); PG8_STAGE(PG8_SA(0, 1), a2 + hstepA, voffA);
            PG8_WAIT_V(8); PG8_WAIT_L(0); PG8_BAR; PG8_MMA(0, 0, At, B0); PG8_MMA(0, 1, At, B1); PG8_BAR; PG8_SCHED;
            PG8_LDA(At, 1, 1); PG8_STAGE(PG8_SB(1, 0), b3, voffB); PG8_STAGE(PG8_SB(1, 1), b3 + hstepB, voffB); PG8_STAGE(PG8_SA(1, 0), a3, voffA);
            PG8_WAIT_V(8); PG8_WAIT_L(0); PG8_BAR; PG8_MMA(1, 0, At, B0); PG8_MMA(1, 1, At, B1); PG8_BAR; PG8_SCHED;
        }
        if constexpr (ALIGN_EPI) { if (wr == 0) PG8_BAR; }
        E(acc, cur, wr, wc, fr, fq);
        if (!has_next) break;
#pragma unroll
        for (int a = 0; a < 2; ++a)
#pragma unroll
            for (int b = 0; b < 2; ++b)
#pragma unroll
                for (int m = 0; m < 4; ++m)
#pragma unroll
                    for (int n = 0; n < 2; ++n) acc[a][b][m][n] = (f32x4){0.f, 0.f, 0.f, 0.f};
        cur = nxt; cA = nA; cB = nB; ++ui;
        if constexpr (ALIGN_EPI) { if (wr == 1) PG8_BAR; }
    }
    PG8_WAIT_V(0);
    if constexpr (!ALIGN_EPI) { if (wr == 0) PG8_BAR; }
    PG8_BAR;
#undef PG8_SA
#undef PG8_SB
#undef PG8_STAGE
#undef PG8_LDA
#undef PG8_LDB
#undef PG8_MMA
#undef PG8_WAIT_V
#undef PG8_WAIT_L
#undef PG8_BAR
#undef PG8_SCHED
#undef PG8_APTR
}
}

struct Params {
    const float *x_prompt, *x_sample, *cache_k, *cache_v, *cache_kidx, *state_pool, *norm_w, *final_norm_w, *attn_w_in, *attn_w_out, *rel_bias,
                *pool_w_in, *pool_group_w, *pool_scale, *pool_w_out;
    float* out; unsigned char* ws; int ph_lo, ph_hi;
};

__device__ __forceinline__ u32x4 pack8(const f32x4 a, const f32x4 b) { u32x4 w; w.x = cvt_pk_bf16(a[0], a[1]); w.y = cvt_pk_bf16(a[2], a[3]); w.z = cvt_pk_bf16(b[0], b[1]); w.w = cvt_pk_bf16(b[2], b[3]); return w; }
__device__ __forceinline__ f32x4 silu4(f32x4 v) { return (f32x4){silu_f(v[0]), silu_f(v[1]), silu_f(v[2]), silu_f(v[3])}; }

__device__ __forceinline__ size_t kif_off(int s, int d0) { return ((size_t)(((s >> 5) * 4 + (d0 >> 4)) * 64 + ((d0 >> 3) & 1) * 32 + (s & 31))) * 8; }

struct Epi1 {
    static constexpr bool PERM = true;
    unsigned char* ws; float* out;
    __device__ __forceinline__ void operator()(const f32x4 (&acc)[2][2][4][2], const pg8::Unit& u, int wr, int wc, int fr, int fq) const {
        const int pn = u.pn;
#pragma unroll
        for (int ai = 0; ai < 2; ++ai)
#pragma unroll
            for (int m = 0; m < 4; ++m) {
                const int r = u.pm * 256 + ai * 128 + wr * 64 + m * 16 + fr;
                const bool samp = r >= MP; const int rs = r - MP, sb = rs >> 5, st = rs & 31;
#pragma unroll
                for (int bj = 0; bj < 2; ++bj) {
                    const int lc = bj * 128 + wc * 32 + 8 * fq;
                    const f32x4 v0 = acc[ai][bj][m][0], v1 = acc[ai][bj][m][1];
                    if (pn < 16) {
                        *(u32x4*)((bf16_t*)(ws + WS_QB) + (size_t)r * DM + pn * 256 + lc) = pack8(v0, v1);
                    } else if (pn < 24) {
                        const bool isv = pn >= 20; const int c = (pn - (isv ? 20 : 16)) * 256 + lc;
                        bf16_t* dst; float* fo;
                        if (!samp) { dst = (bf16_t*)(ws + (isv ? WS_VP : WS_KP)) + (size_t)r * KVW + c; fo = out + (isv ? O_VP : O_KP) + (size_t)r * KVW + c; }
                        else { dst = (bf16_t*)(ws + (isv ? WS_VS : WS_KS)) + ((size_t)sb * SKV + PAST + st) * KVW + c; fo = out + (isv ? O_VS : O_KS) + (size_t)rs * KVW + c; }
                        *(u32x4*)dst = pack8(v0, v1); *(f32x4*)fo = v0; *(f32x4*)(fo + 4) = v1;
                    } else if (pn < 32) {
                        *(u32x4*)((bf16_t*)(ws + WS_QIB) + (size_t)r * QIW + (pn - 24) * 256 + lc) = pack8(v0, v1);
                    } else if (pn < 48) {
                        *(u32x4*)((bf16_t*)(ws + WS_SG) + (size_t)r * DM + (pn - 32) * 256 + lc) = pack8(silu4(v0), silu4(v1));
                    } else {
                        if (lc < 64) {
                            bf16_t* dst; float* fo;
                            if (!samp) { dst = (bf16_t*)(ws + WS_KIP) + (size_t)(r >> 12) * SEQ * DIDX + kif_off(r & 4095, lc); fo = out + O_KIP + (size_t)r * DIDX + lc; }
                            else { dst = (bf16_t*)(ws + WS_KIS) + (size_t)sb * SKV * DIDX + kif_off(PAST + st, lc); fo = out + O_KIS + (size_t)rs * DIDX + lc; }
                            *(u32x4*)dst = pack8(v0, v1); *(f32x4*)fo = v0; *(f32x4*)(fo + 4) = v1;
                        } else if (lc < 96) {
                            float* fo = (float*)(ws + WS_WIB) + (size_t)r * HIDX + (lc - 64);
                            *(f32x4*)fo = v0; *(f32x4*)(fo + 4) = v1;
                        }
                    }
                }
            }
    }
};
struct EpiRes {
    static constexpr bool PERM = false;
    const float* xp; const float* xs; const float* base; float* dst;
    __device__ __forceinline__ void operator()(const f32x4 (&acc)[2][2][4][2], const pg8::Unit& u, int wr, int wc, int fr, int fq) const {
#pragma unroll
        for (int ai = 0; ai < 2; ++ai)
#pragma unroll
            for (int m = 0; m < 4; ++m) {
                const int r = u.pm * 256 + ai * 128 + wr * 64 + m * 16 + fr;
                const float* b = base ? base + (size_t)r * DM : (r < MP ? xp + (size_t)r * DM : xs + (size_t)(r - MP) * DM);
                float* d = dst + (size_t)r * DM;
#pragma unroll
                for (int bj = 0; bj < 2; ++bj)
#pragma unroll
                    for (int n = 0; n < 2; ++n) { const int c = u.pn * 256 + bj * 128 + wc * 32 + n * 16 + 4 * fq;
                        *(f32x4*)(d + c) = *(const f32x4*)(b + c) + acc[ai][bj][m][n]; }
            }
    }
};
struct Epi3 {
    static constexpr bool PERM = true;
    unsigned char* ws; float* out;
    __device__ __forceinline__ void operator()(const f32x4 (&acc)[2][2][4][2], const pg8::Unit& u, int wr, int wc, int fr, int fq) const {
        const int pn = u.pn;
#pragma unroll
        for (int ai = 0; ai < 2; ++ai)
#pragma unroll
            for (int m = 0; m < 4; ++m) {
                const int r = u.pm * 256 + ai * 128 + wr * 64 + m * 16 + fr;
                float* po = nullptr;
                if (r < MP) { const int t = r & 4095; if (t >= SEQ - 15) po = out + O_POOLP + ((size_t)(r >> 12) * 15 + (t - (SEQ - 15))) * DM; }
                else { const int rs = r - MP, t = rs & 31; if (t >= DSQ - 15) po = out + O_POOLS + ((size_t)(rs >> 5) * 15 + (t - (DSQ - 15))) * DM; }
#pragma unroll
                for (int bj = 0; bj < 2; ++bj) {
                    const int lc = bj * 128 + wc * 32 + 8 * fq;
                    const f32x4 v0 = acc[ai][bj][m][0], v1 = acc[ai][bj][m][1];
                    if (pn < 16) {
                        const int c = pn * 256 + lc;
                        *(u32x4*)((bf16_t*)(ws + WS_U) + (size_t)r * DM + c) = pack8(v0, v1);
                        if (po) { *(f32x4*)(po + c) = v0; *(f32x4*)(po + c + 4) = v1; }
                    } else {
                        *(u32x4*)((bf16_t*)(ws + WS_SG2) + (size_t)r * DM + (pn - 16) * 256 + lc) = pack8(silu4(v0), silu4(v1));
                    }
                }
            }
    }
};
struct Epi4 {
    static constexpr bool PERM = true;
    unsigned char* ws; const float* scale;
    __device__ __forceinline__ void operator()(const f32x4 (&acc)[2][2][4][2], const pg8::Unit& u, int wr, int wc, int fr, int fq) const {
#pragma unroll
        for (int bj = 0; bj < 2; ++bj) {
            const int c = u.pn * 256 + bj * 128 + wc * 32 + 8 * fq;
            const f32x4 s0 = *(const f32x4*)(scale + c), s1 = *(const f32x4*)(scale + c + 4);
#pragma unroll
            for (int ai = 0; ai < 2; ++ai)
#pragma unroll
                for (int m = 0; m < 4; ++m) {
                    const int r = u.pm * 256 + ai * 128 + wr * 64 + m * 16 + fr;
                    const u32x4 gw = *(const u32x4*)((const bf16_t*)(ws + WS_SG2) + (size_t)r * DM + c);
                    const f32x4 g0 = (f32x4){bf_lo(gw.x), bf_hi(gw.x), bf_lo(gw.y), bf_hi(gw.y)}, g1 = (f32x4){bf_lo(gw.z), bf_hi(gw.z), bf_lo(gw.w), bf_hi(gw.w)};
                    *(u32x4*)((bf16_t*)(ws + WS_ZG) + (size_t)r * DM + c) = pack8(acc[ai][bj][m][0] * s0 * g0, acc[ai][bj][m][1] * s1 * g1);
                }
        }
    }
};

__device__ __forceinline__ void transpose_item(const float* W, int N, int k0, int n0, bf16_t* WT, int K, int drow0, LAS float* scr, int lane) {
#pragma unroll 8
    for (int i = 0; i < 32; ++i) { const int kk = 2 * i + (lane >> 5); scr[kk * 33 + (lane & 31)] = W[(size_t)(k0 + kk) * N + n0 + (lane & 31)]; }
    LDS_WAIT(); asm volatile("" ::: "memory");
    const int c = lane & 7;
#pragma unroll
    for (int j = 0; j < 4; ++j) { const int n = (lane >> 3) + 8 * j; const LAS float* s = scr + (8 * c) * 33 + n;
        u32x4 o; o.x = cvt_pk_bf16(s[0 * 33], s[1 * 33]); o.y = cvt_pk_bf16(s[2 * 33], s[3 * 33]); o.z = cvt_pk_bf16(s[4 * 33], s[5 * 33]); o.w = cvt_pk_bf16(s[6 * 33], s[7 * 33]);
        *(u32x4*)(WT + (size_t)(drow0 + n) * K + k0 + 8 * c) = o; }
    LDS_WAIT(); asm volatile("" ::: "memory");
}
template <bool F32OUT>
__device__ __forceinline__ void rms_row(const float* xrow, const float* w, void* orow, int lane) {
    const f32x4* xr = (const f32x4*)xrow + lane; const f32x4* wr = (const f32x4*)w + lane;
    f32x4 v[16]; float s = 0.f;
#pragma unroll
    for (int j = 0; j < 16; ++j) { v[j] = xr[64 * j]; s += (v[j].x * v[j].x + v[j].y * v[j].y) + (v[j].z * v[j].z + v[j].w * v[j].w); }
    const float rstd = 1.0f / sqrtf(wave_sum(s) * (1.0f / DM) + EPS);
#pragma unroll
    for (int j = 0; j < 16; ++j) { const f32x4 g = wr[64 * j]; const f32x4 y = v[j] * rstd * g;
        if (F32OUT) ((f32x4*)orow + lane)[64 * j] = y;
        else { u32x2 o; o.x = cvt_pk_bf16(y.x, y.y); o.y = cvt_pk_bf16(y.z, y.w); ((u32x2*)orow + lane)[64 * j] = o; } }
}

__device__ __forceinline__ unsigned ord_key(float f) { const unsigned b = __float_as_uint(f); return (b & 0x80000000u) ? ~b : (b | 0x80000000u); }
constexpr int NVJ = 65;
__device__ __forceinline__ void select_query(const bf16_t* qi_row, const float* wi_row, const bf16_t* kif, int nt, bool last_half, u64* rm, int lane) {
    const int r32 = lane & 31, hi = lane >> 5;
    if (nt <= 4) { if (lane < nt) rm[lane] = ~0ull; return; }
    bf16x8 a[4];
#pragma unroll
    for (int ks = 0; ks < 4; ++ks) a[ks] = *(const bf16x8*)(qi_row + r32 * 64 + ks * 16 + hi * 8);
    float w[16];
#pragma unroll
    for (int r = 0; r < 16; ++r) w[r] = wi_row[(r & 3) + 8 * (r >> 2) + 4 * hi] * (0.125f * 0.17677669529663687f);
    unsigned uk[NVJ];
    typedef const __attribute__((address_space(1))) char* gcp; typedef const __attribute__((address_space(1))) bf16x8* gbp;
    gcp kbase = (gcp)kif; const unsigned loff = (unsigned)lane * 16u;
#pragma unroll
    for (int j = 0; j < NVJ; ++j) {
        uk[j] = 0u;
        if (j < nt) {
            bf16x8 b0[4], b1[4];
#pragma unroll
            for (int ks = 0; ks < 4; ++ks) b0[ks] = *(gbp)(kbase + loff + ks * 1024);
            kbase += 4096; asm volatile("" : "+s"(kbase));
#pragma unroll
            for (int ks = 0; ks < 4; ++ks) b1[ks] = *(gbp)(kbase + loff + ks * 1024);
            kbase += 4096; asm volatile("" : "+s"(kbase));
            f32x16 c0 = {}, c1 = {};
#pragma unroll
            for (int ks = 0; ks < 4; ++ks) { c0 = __builtin_amdgcn_mfma_f32_32x32x16_bf16(a[ks], b0[ks], c0, 0, 0, 0); c1 = __builtin_amdgcn_mfma_f32_32x32x16_bf16(a[ks], b1[ks], c1, 0, 0, 0); }
            float s0 = 0.f, s1 = 0.f;
#pragma unroll
            for (int r = 0; r < 16; ++r) { s0 = fmaf(w[r], fmaxf(c0[r], 0.f), s0); s1 = fmaf(w[r], fmaxf(c1[r], 0.f), s1); }
            auto rr = __builtin_amdgcn_permlane32_swap(__float_as_uint(s0), __float_as_uint(s1), false, false);
            float v = __uint_as_float(rr[0]) + __uint_as_float(rr[1]);
            if (last_half && j == nt - 1 && hi) v = -__builtin_inff();
            uk[j] = ord_key(v);
        }
    }
#define CNT_GE(cnt, thr, x) asm volatile("v_cmp_le_u32 vcc, %1, %2\n\ts_bcnt1_i32_b64 vcc_lo, vcc\n\ts_add_i32 %0, %0, vcc_lo" : "+s"(cnt) : "s"(thr), "v"(x) : "vcc", "scc")
#define CNT_GT(cnt, thr, x) asm volatile("v_cmp_lt_u32 vcc, %1, %2\n\ts_bcnt1_i32_b64 vcc_lo, vcc\n\ts_add_i32 %0, %0, vcc_lo" : "+s"(cnt) : "s"(thr), "v"(x) : "vcc", "scc")
    unsigned T = 0u;
    for (int bit = 31; bit >= 0; --bit) {
        const unsigned cand = T | (1u << bit); int cnt = 0;
#pragma unroll
        for (int j = 0; j < NVJ; ++j) CNT_GE(cnt, cand, uk[j]);
        if (cnt >= 256) T = cand;
    }
    int cge = 0;
#pragma unroll
    for (int j = 0; j < NVJ; ++j) CNT_GE(cge, T, uk[j]);
    if (cge == 256) {
#pragma unroll
        for (int j = 0; j < NVJ; ++j) { u64 mk; asm volatile("v_cmp_le_u32 %0, %1, %2" : "=s"(mk) : "s"(T), "v"(uk[j])); if (lane == 0) rm[j] = mk; }
    } else {
        int cgt = 0;
#pragma unroll
        for (int j = 0; j < NVJ; ++j) CNT_GT(cgt, T, uk[j]);
        int need = 256 - cgt;
#pragma unroll
        for (int j = 0; j < NVJ; ++j) {
            u64 gt, eq; asm volatile("v_cmp_lt_u32 %0, %1, %2" : "=s"(gt) : "s"(T), "v"(uk[j])); asm volatile("v_cmp_eq_u32 %0, %1, %2" : "=s"(eq) : "s"(T), "v"(uk[j]));
            const int below = __builtin_popcountll(eq & ((1ull << lane) - 1ull));
            const u64 take = __ballot(((eq >> lane) & 1ull) && below < need);
            need -= __builtin_popcountll(take);
            if (lane == 0) rm[j] = gt | take;
        }
    }
#undef CNT_GE
#undef CNT_GT
}

namespace att {
constexpr int D = 128, KVBLK = 64;
constexpr float SCALE = 0.088388347648318440f;
constexpr float THR = 8.f;
constexpr float NEG = -1e30f, MINIT = -1e20f;
constexpr size_t SHM_V = KVBLK * D * 2, SHM_K = KVBLK * D * 2;
constexpr size_t OFF_WS = 2 * SHM_V + 2 * SHM_K, OFF_TB = OFF_WS + 8 * 64 * 4, LDS_ATTN = OFF_TB + 4 * 256 * 4;
#define KSWZ(row, colB) ((row) * 256 + ((colB) ^ (((row) & 7) << 4)))
#define SBAR() __builtin_amdgcn_sched_barrier(0)
__device__ __forceinline__ int crow(int r, int hi) { return (r & 3) + 8 * (r >> 2) + 4 * hi; }
__device__ __forceinline__ void partialSM(f32x16& p0, f32x16& p1, float& m_reg, float& mn, float& alpha) {
    constexpr float C = SCALE * 1.4426950408889634f;
    float pmax = p0[0];
#pragma unroll
    for (int r = 1; r < 16; ++r) pmax = fmaxf(pmax, p0[r]);
#pragma unroll
    for (int r = 0; r < 16; ++r) pmax = fmaxf(pmax, p1[r]);
    { auto rr = __builtin_amdgcn_permlane32_swap(__float_as_uint(pmax), __float_as_uint(pmax), false, false);
      pmax = fmaxf(__uint_as_float(rr[0]), __uint_as_float(rr[1])); }
    if (__builtin_expect(__all(pmax - m_reg <= THR / SCALE), 1)) { mn = m_reg; alpha = 1.f; }
    else { mn = fmaxf(m_reg, pmax); alpha = __builtin_amdgcn_exp2f((m_reg - mn) * C); m_reg = mn; }
    const float mnC = -mn * C;
#pragma unroll
    for (int r = 0; r < 16; ++r) p0[r] = fmaf(p0[r], C, mnC);
#pragma unroll
    for (int r = 0; r < 16; ++r) p1[r] = fmaf(p1[r], C, mnC);
#pragma unroll
    for (int r = 0; r < 16; ++r) p0[r] = __builtin_amdgcn_exp2f(p0[r]);
}
__device__ __forceinline__ void finishSM(f32x16& p0, f32x16& p1, float alpha, float& l_reg, bf16x8& pa0, bf16x8& pa1, bf16x8& pa2, bf16x8& pa3) {
#pragma unroll
    for (int r = 0; r < 16; ++r) p1[r] = __builtin_amdgcn_exp2f(p1[r]);
    float ps = 0;
#pragma unroll
    for (int r = 0; r < 16; ++r) ps += p0[r];
#pragma unroll
    for (int r = 0; r < 16; ++r) ps += p1[r];
    { auto rr = __builtin_amdgcn_permlane32_swap(__float_as_uint(ps), __float_as_uint(ps), false, false);
      ps = __uint_as_float(rr[0]) + __uint_as_float(rr[1]); }
    l_reg = l_reg * alpha + ps;
#define PK4(P, BASE, OUT) do { unsigned a0 = cvt_pk_bf16(P[BASE + 0], P[BASE + 1]), a1 = cvt_pk_bf16(P[BASE + 2], P[BASE + 3]);   \
    unsigned b0 = cvt_pk_bf16(P[BASE + 4], P[BASE + 5]), b1 = cvt_pk_bf16(P[BASE + 6], P[BASE + 7]);                              \
    auto r0 = __builtin_amdgcn_permlane32_swap(a0, b0, false, false); auto r1 = __builtin_amdgcn_permlane32_swap(a1, b1, false, false); \
    u32x4 w = {r0[0], r1[0], r0[1], r1[1]}; OUT = *reinterpret_cast<bf16x8*>(&w); } while (0)
    PK4(p0, 0, pa0); PK4(p0, 8, pa1); PK4(p1, 0, pa2); PK4(p1, 8, pa3);
#undef PK4
}
__device__ __forceinline__ void qkt(f32x16& p0, f32x16& p1, const LAS char* Ks, const bf16x8* qr, int r32, int hi) {
    p0 = f32x16{}; p1 = f32x16{};
#pragma unroll
    for (int d0 = 0; d0 < 8; ++d0) { const int cb = (d0 * 16 + hi * 8) * 2;
        const bf16x8 b0 = *(const LAS bf16x8*)(Ks + KSWZ(r32, cb));
        const bf16x8 b1 = *(const LAS bf16x8*)(Ks + KSWZ(32 + r32, cb));
        p0 = __builtin_amdgcn_mfma_f32_32x32x16_bf16(b0, qr[d0], p0, 0, 0, 0);
        p1 = __builtin_amdgcn_mfma_f32_32x32x16_bf16(b1, qr[d0], p1, 0, 0, 0); }
}
__device__ __forceinline__ int v_st(int k, int c) { const int kk = (k & ~0xC) | ((k & 4) << 1) | ((k & 8) >> 1); return ((kk >> 3) * 4 + (c >> 5)) * 512 + ((kk & 7) * 32 + (c & 31)) * 2; }
__device__ __forceinline__ int v_rd_base(int lane) { return ((lane & 3) << 3) | (((lane >> 2) & 3) << 6) | (((lane >> 4) & 1) << 5) | (((lane >> 5) & 1) << 8); }
constexpr int v_rd_off(int d0, int ks, int half) { return d0 * 512 + ks * 4096 + half * 2048; }
template <int OFF> __device__ __forceinline__ s16x4 tr_read(int vb) {
    s16x4 r; asm volatile("ds_read_b64_tr_b16 %0, %1 offset:%2" : "=&v"(r) : "v"(vb), "i"(OFF) : "memory"); return r;
}
template <int D0> __device__ __forceinline__ void pv_one(f32x16& od, int vb, bf16x8 pa0, bf16x8 pa1, bf16x8 pa2, bf16x8 pa3) {
    const s16x4 l0 = tr_read<v_rd_off(D0, 0, 0)>(vb), h0 = tr_read<v_rd_off(D0, 0, 1)>(vb), l1 = tr_read<v_rd_off(D0, 1, 0)>(vb), h1 = tr_read<v_rd_off(D0, 1, 1)>(vb);
    const s16x4 l2 = tr_read<v_rd_off(D0, 2, 0)>(vb), h2 = tr_read<v_rd_off(D0, 2, 1)>(vb), l3 = tr_read<v_rd_off(D0, 3, 0)>(vb), h3 = tr_read<v_rd_off(D0, 3, 1)>(vb);
    asm volatile("s_waitcnt lgkmcnt(0)" ::: "memory"); SBAR();
#define PK(L, H) (bf16x8){L[0], L[1], L[2], L[3], H[0], H[1], H[2], H[3]}
    od = __builtin_amdgcn_mfma_f32_32x32x16_bf16(pa0, PK(l0, h0), od, 0, 0, 0);
    od = __builtin_amdgcn_mfma_f32_32x32x16_bf16(pa1, PK(l1, h1), od, 0, 0, 0);
    od = __builtin_amdgcn_mfma_f32_32x32x16_bf16(pa2, PK(l2, h2), od, 0, 0, 0);
    od = __builtin_amdgcn_mfma_f32_32x32x16_bf16(pa3, PK(l3, h3), od, 0, 0, 0);
#undef PK
}
__device__ __forceinline__ void pv_d0(f32x16* o, int vb, bf16x8 pa0, bf16x8 pa1, bf16x8 pa2, bf16x8 pa3) {
    pv_one<0>(o[0], vb, pa0, pa1, pa2, pa3); pv_one<1>(o[1], vb, pa0, pa1, pa2, pa3); pv_one<2>(o[2], vb, pa0, pa1, pa2, pa3); pv_one<3>(o[3], vb, pa0, pa1, pa2, pa3);
}
__device__ __forceinline__ void mask_bias(f32x16& p0, f32x16& p1, u64 mw, bool near, const LAS float* tbk, int hi) {
    if (near) {
#pragma unroll
        for (int r = 0; r < 16; ++r) { const int b = (r & 3) + 8 * (r >> 2); p0[r] += tbk[b]; p1[r] += tbk[32 + b]; }
    }
    const unsigned lo = (unsigned)mw >> (4 * hi), hh = (unsigned)(mw >> 32) >> (4 * hi);
#pragma unroll
    for (int r = 0; r < 16; ++r) { const int b = (r & 3) + 8 * (r >> 2);
        p0[r] = ((lo >> b) & 1u) ? p0[r] : NEG; p1[r] = ((hh >> b) & 1u) ? p1[r] : NEG; }
}

template <bool SAMPLE>
__device__ __forceinline__ void attn_block(const bf16_t* __restrict__ Qg, const bf16_t* __restrict__ Kh, const bf16_t* __restrict__ Vh, const u64* __restrict__ rmq,
                                           const bf16_t* __restrict__ SGg, bf16_t* __restrict__ OGg, int NT, int qpos0, int kvh, const float* __restrict__ rel_bias, LAS char* lds) {
    int tid = threadIdx.x; asm volatile("" : "+v"(tid));
    const int wid = __builtin_amdgcn_readfirstlane(tid >> 6), lane = tid & 63, r32 = lane & 31, hi = lane >> 5;
    const int hl = wid & 3, qs = SAMPLE ? 0 : (wid >> 2), head = kvh * 4 + hl;
    LAS char* V_lds = lds; LAS char* K_lds = lds + 2 * SHM_V;
    LAS float* ws = (LAS float*)(lds + OFF_WS) + wid * 64; LAS float* li_l = ws; LAS float* al_l = ws + 32;
    LAS float* tb = (LAS float*)(lds + OFF_TB);
    for (int e = tid; e < 1024; e += NTHREADS) {
        const int h = e >> 8, rel = (e & 255) - 192, n = rel < 0 ? -rel : rel;
        int bk = n < 8 ? n : (n < 12 ? 8 : n < 16 ? 9 : n < 23 ? 10 : n < 32 ? 11 : n < 46 ? 12 : n < 64 ? 13 : n < 91 ? 14 : 15);
        if (rel > 0) bk += 16;
        tb[e] = (rel_bias[bk * 32 + kvh * 4 + h] - rel_bias[15 * 32 + kvh * 4 + h]) * (1.0f / SCALE);
    }
    float m_reg = MINIT, l_reg = 0; f32x16 o[4] = {}; bf16x8 qr[8];
    const int qrow = qs * 32 + r32;
    const bf16_t* Qw = Qg + (size_t)qrow * DM + head * D + hi * 8;
#pragma unroll
    for (int d0 = 0; d0 < 8; ++d0) qr[d0] = *(const bf16x8*)(Qw + d0 * 16);
    const u64* rml = rmq + (size_t)qrow * RMS;
    const int sr = tid >> 4, sc = (tid & 15) * 8, vst0 = v_st(sr, sc), vst1 = v_st(32 + sr, sc);
    const int vb0 = (int)(uintptr_t)V_lds + v_rd_base(lane);
    const int tboff = hl * 256 + 192 - (qpos0 + qrow) + 4 * hi;
    struct { bf16x8 vs0, vs1, ks0, ks1; } sr_[1];
    constexpr int LDK = KVW;
#define TCL(t) ((t) < NT ? (t) : NT - 1)
#define SLOAD(i, t) do { const size_t k0_ = (size_t)TCL(t) * KVBLK; sr_[i].vs0 = *(const bf16x8*)&Vh[(k0_ + sr) * LDK + sc]; sr_[i].vs1 = *(const bf16x8*)&Vh[(k0_ + 32 + sr) * LDK + sc]; \
    sr_[i].ks0 = *(const bf16x8*)&Kh[(k0_ + sr) * LDK + sc]; sr_[i].ks1 = *(const bf16x8*)&Kh[(k0_ + 32 + sr) * LDK + sc]; } while (0)
#define SWRITE(b, i) do { *(LAS bf16x8*)(V_lds + (b) * SHM_V + vst0) = sr_[i].vs0; *(LAS bf16x8*)(V_lds + (b) * SHM_V + vst1) = sr_[i].vs1; const int kc = sc * 2;  \
    *(LAS bf16x8*)(K_lds + (b) * SHM_K + KSWZ(sr, kc)) = sr_[i].ks0; *(LAS bf16x8*)(K_lds + (b) * SHM_K + KSWZ(32 + sr, kc)) = sr_[i].ks1; } while (0)
#define SWAIT() asm volatile("s_waitcnt vmcnt(0)" ::: "memory")
#define RESC(a) do { if (__any((a) < 1.f)) { if (hi == 0) al_l[r32] = (a); asm volatile("s_waitcnt lgkmcnt(0)" ::: "memory"); \
    _Pragma("unroll") for (int d = 0; d < 4; ++d) _Pragma("unroll") for (int r = 0; r < 16; ++r) o[d][r] *= al_l[crow(r, hi)]; } } while (0)
#define MB(P0, P1, t) mask_bias(P0, P1, rml[t], (t) >= NT - 3, tb + tboff + (t) * KVBLK, hi)
    f32x16 pA0, pA1, pB0, pB1; float mnA, mnB, alA, alB; bf16x8 pa0, pa1, pa2, pa3;
    SLOAD(0, 0); asm volatile("s_waitcnt vmcnt(0)" ::: "memory"); SWRITE(0, 0); __syncthreads();
    qkt(pA0, pA1, K_lds, qr, r32, hi); MB(pA0, pA1, 0); partialSM(pA0, pA1, m_reg, mnA, alA);
    SLOAD(0, 1);
    SWAIT(); SWRITE(1, 0); __syncthreads();
    int j = 1;
    for (; j + 1 < NT; j += 2) {
        SBAR(); qkt(pB0, pB1, K_lds + SHM_K, qr, r32, hi);
        finishSM(pA0, pA1, alA, l_reg, pa0, pa1, pa2, pa3); SBAR();
        SLOAD(0, j + 1); SBAR();
        pv_d0(o, vb0, pa0, pa1, pa2, pa3); MB(pB0, pB1, j); partialSM(pB0, pB1, m_reg, mnB, alB);
        __syncthreads(); SWAIT(); SWRITE(0, 0);
        RESC(alB); __syncthreads();
        SBAR(); qkt(pA0, pA1, K_lds, qr, r32, hi);
        finishSM(pB0, pB1, alB, l_reg, pa0, pa1, pa2, pa3); SBAR();
        SLOAD(0, j + 2); SBAR();
        pv_d0(o, vb0 + (int)SHM_V, pa0, pa1, pa2, pa3); MB(pA0, pA1, j + 1); partialSM(pA0, pA1, m_reg, mnA, alA);
        __syncthreads(); SWAIT(); SWRITE(1, 0);
        RESC(alA); __syncthreads();
    }
    if (j < NT) {
        SBAR(); qkt(pB0, pB1, K_lds + SHM_K, qr, r32, hi);
        finishSM(pA0, pA1, alA, l_reg, pa0, pa1, pa2, pa3); SBAR();
        pv_d0(o, vb0, pa0, pa1, pa2, pa3); MB(pB0, pB1, j); partialSM(pB0, pB1, m_reg, mnB, alB);
        RESC(alB);
        finishSM(pB0, pB1, alB, l_reg, pa0, pa1, pa2, pa3); SBAR();
        pv_d0(o, vb0 + (int)SHM_V, pa0, pa1, pa2, pa3);
    } else {
        RESC(alA);
        finishSM(pA0, pA1, alA, l_reg, pa0, pa1, pa2, pa3); SBAR();
        pv_d0(o, vb0, pa0, pa1, pa2, pa3);
    }
    asm volatile("s_waitcnt vmcnt(0)" ::: "memory");
    if (hi == 0) li_l[r32] = l_reg; asm volatile("s_waitcnt lgkmcnt(0)" ::: "memory");
    if (!SAMPLE || wid < 4) {
#pragma unroll
        for (int r = 0; r < 16; ++r) { const int orow = qs * 32 + crow(r, hi); const float rl = __builtin_amdgcn_rcpf(li_l[crow(r, hi)]);
            const size_t off = (size_t)orow * DM + head * D + r32;
#pragma unroll
            for (int d0 = 0; d0 < 4; ++d0) { const float g = __uint_as_float((unsigned)SGg[off + d0 * 32] << 16);
                OGg[off + d0 * 32] = (bf16_t)(cvt_pk_bf16(o[d0][r] * rl * g, 0.f) & 0xffffu); }
            asm volatile("" ::: "memory"); }
    }
    __syncthreads();
#undef TCL
#undef SLOAD
#undef SWRITE
#undef SWAIT
#undef RESC
#undef MB
}
}

__global__ void __launch_bounds__(NTHREADS, 2) mega(Params p) {
    extern __shared__ __attribute__((aligned(16))) unsigned char lds_raw[];
    LAS unsigned char* lds = (LAS unsigned char*)lds_raw;
    volatile LAS unsigned* MISC = (volatile LAS unsigned*)(lds + MISC_OFF);
    const int G = gridDim.x; const int bx = blockIdx.x;
    const int vcu = (G % 8 == 0) ? (bx % 8) * (G / 8) + bx / 8 : bx;
    const int NGW = G * NWAVES;
#define PHASE_IDS() int tid = threadIdx.x; asm volatile("" : "+v"(tid)); const int lane = tid & 63, wave = __builtin_amdgcn_readfirstlane(tid >> 6), gw = vcu * NWAVES + wave; (void)lane; (void)gw
    unsigned char* ws = p.ws; float* out = p.out;
    const int lo = p.ph_lo, hi_ph = p.ph_hi;
    for (int u = threadIdx.x; u < (LDS_BYTES - RING_BYTES) / 4; u += NTHREADS) ((LAS unsigned*)(lds + RING_BYTES))[u] = 0u;
    __syncthreads();
    XcdBarrier bar; bar.bar = (unsigned*)(ws + WS_CTL) + CW_BAR; bar.x = 0; bar.st = nullptr;
    if (hi_ph - lo > 1) bar = xcd_barrier_post((unsigned*)(ws + WS_CTL) + CW_BAR, MISC + 8);
#ifndef PH_MASK
#define PH_MASK 0x7ff
#endif
#define IN(k) (((PH_MASK >> (k)) & 1) && lo <= (k) && (k) < hi_ph)
#define SEAM(k) do { if (IN(k) && IN((k) + 1)) xcd_barrier(bar); } while (0)

    if (IN(0)) {
        PHASE_IDS();
        LAS float* scr = (LAS float*)(lds + wave * 16384);
        constexpr int I_IN = 64 * 387, I_OUT = 64 * 128, I_PIN = 64 * 256, I_GRP = 4 * 16 * 32, I_POUT = 64 * 128;
        constexpr int NITEMS = I_IN + I_OUT + I_PIN + I_GRP + I_POUT;
        for (int it = gw; it < NITEMS; it += NGW) {
            int r = it;
            if (r < I_IN) { const int kb = r / 387, nb = r % 387, n0 = nb * 32;
                const int drow = n0 < 8192 ? n0 : (n0 < 8288 ? 12288 + (n0 - 8192) : 8192 + (n0 - 8288));
                transpose_item(p.attn_w_in, 12384, kb * 64, n0, (bf16_t*)(ws + WS_WT_IN), DM, drow, scr, lane); continue; } r -= I_IN;
            if (r < I_OUT) { transpose_item(p.attn_w_out, DM, (r / 128) * 64, (r % 128) * 32, (bf16_t*)(ws + WS_WT_OUT), DM, (r % 128) * 32, scr, lane); continue; } r -= I_OUT;
            if (r < I_PIN) { transpose_item(p.pool_w_in, 8192, (r / 256) * 64, (r % 256) * 32, (bf16_t*)(ws + WS_WT_PIN), DM, (r % 256) * 32, scr, lane); continue; } r -= I_PIN;
            if (r < I_GRP) { const int g = r / 512, q = r % 512;
                transpose_item(p.pool_group_w + (size_t)g * 1024 * 1024, 1024, (q / 32) * 64, (q % 32) * 32, (bf16_t*)(ws + WS_WT_GRP), 1024, g * 1024 + (q % 32) * 32, scr, lane); continue; } r -= I_GRP;
            transpose_item(p.pool_w_out, DM, (r / 128) * 64, (r % 128) * 32, (bf16_t*)(ws + WS_WT_POUT), DM, (r % 128) * 32, scr, lane);
        }
        {
            u32x4* z = (u32x4*)((bf16_t*)(ws + WS_WT_IN) + (size_t)12384 * DM);
            for (size_t i = (size_t)gw * 64 + lane; i < (size_t)160 * DM * 2 / 16; i += (size_t)NGW * 64) z[i] = (u32x4){0u, 0u, 0u, 0u};
        }
        for (int m = gw; m < MT; m += NGW)
            rms_row<false>(m < MP ? p.x_prompt + (size_t)m * DM : p.x_sample + (size_t)(m - MP) * DM, p.norm_w, (bf16_t*)(ws + WS_H) + (size_t)m * DM, lane);
        {
            const size_t gt = (size_t)gw * 64 + lane, GT = (size_t)NGW * 64;
            constexpr size_t NC8 = (size_t)DB * PAST * KVW / 8;
            for (size_t i = gt; i < 2 * NC8; i += GT) {
                const bool isv = i >= NC8; const size_t j = isv ? i - NC8 : i;
                const float* src = (isv ? p.cache_v : p.cache_k) + j * 8;
                const f32x4 a = *(const f32x4*)src, b = *(const f32x4*)(src + 4);
                const size_t row = j / (KVW / 8), c8 = j % (KVW / 8), bb = row / PAST, s = row % PAST;
                *(u32x4*)((bf16_t*)(ws + (isv ? WS_VS : WS_KS)) + (bb * SKV + s) * KVW + c8 * 8) = pack8(a, b);
            }
            constexpr size_t NZ8 = (size_t)DB * 32 * KVW / 8;
            for (size_t i = gt; i < 2 * NZ8; i += GT) {
                const bool isv = i >= NZ8; const size_t j = isv ? i - NZ8 : i;
                const size_t row = j / (KVW / 8), c8 = j % (KVW / 8), bb = row / 32, s = 4128 + row % 32;
                *(u32x4*)((bf16_t*)(ws + (isv ? WS_VS : WS_KS)) + (bb * SKV + s) * KVW + c8 * 8) = (u32x4){0u, 0u, 0u, 0u};
            }
            constexpr size_t NK8 = (size_t)DB * SKV * DIDX / 8;
            for (size_t i = gt; i < NK8; i += GT) {
                const size_t row = i / 8, c8 = i % 8, bb = row / SKV, s = row % SKV;
                if (s >= (size_t)PAST && s < (size_t)PAST + DSQ) continue;
                u32x4 w = (u32x4){0u, 0u, 0u, 0u};
                if (s < (size_t)PAST) { const float* src = p.cache_kidx + (bb * PAST + s) * DIDX + c8 * 8; w = pack8(*(const f32x4*)src, *(const f32x4*)(src + 4)); }
                *(u32x4*)((bf16_t*)(ws + WS_KIS) + bb * SKV * DIDX + kif_off((int)s, (int)c8 * 8)) = w;
            }
        }
    }
    SEAM(0);
    if (IN(1)) {
        pg8::Gemm g{(const bf16_t*)(ws + WS_H), (const bf16_t*)(ws + WS_WT_IN), MT, N1, DM, DM, DM, 0};
        pg8::StaticOrder S; S.init(MT, N1, G, bx);
        Epi1 E{ws, out};
        pg8::gemm_phase<Epi1>(lds, g, S, E);
    }
    SEAM(1);
    if (IN(2)) {
        PHASE_IDS();
        u64* RM = (u64*)(ws + WS_RM);
        for (int pi = gw; pi < 2048; pi += NGW) {
#pragma unroll 1
            for (int k = 0; k < 8; ++k) {
                const int b = k >> 1, t = (k & 1) ? 4095 - pi : pi, m = b * SEQ + t;
                select_query((const bf16_t*)(ws + WS_QIB) + (size_t)m * QIW, (const float*)(ws + WS_WIB) + (size_t)m * HIDX,
                             (const bf16_t*)(ws + WS_KIP) + (size_t)b * SEQ * DIDX, (t >> 6) + 1, false, RM + (size_t)m * RMS, lane);
            }
            if ((pi & 1) == 0) { const int s = pi >> 1, m = MP + s, b = s >> 5;
                select_query((const bf16_t*)(ws + WS_QIB) + (size_t)m * QIW, (const float*)(ws + WS_WIB) + (size_t)m * HIDX,
                             (const bf16_t*)(ws + WS_KIS) + (size_t)b * SKV * DIDX, 65, true, RM + (size_t)m * RMS, lane); }
        }
    }
    SEAM(2);
    if (IN(3)) {
        const u64* RM = (const u64*)(ws + WS_RM);
        const bf16_t* QB = (const bf16_t*)(ws + WS_QB); const bf16_t* SG = (const bf16_t*)(ws + WS_SG); bf16_t* OG = (bf16_t*)(ws + WS_OG);
        for (int it = vcu; it < 1280; it += G) {
            if (it < 1024) {
                const int b = it >> 8, kvh = (it >> 5) & 7, pr = it & 31;
                const bf16_t* Kh = (const bf16_t*)(ws + WS_KP) + (size_t)b * SEQ * KVW + kvh * 128; const bf16_t* Vh = (const bf16_t*)(ws + WS_VP) + (size_t)b * SEQ * KVW + kvh * 128;
#pragma unroll 1
                for (int half = 0; half < 2; ++half) {
                    const int c = half ? 63 - pr : pr; const size_t m0 = (size_t)b * SEQ + c * 64;
                    att::attn_block<false>(QB + m0 * DM, Kh, Vh, RM + m0 * RMS, SG + m0 * DM, OG + m0 * DM, c + 1, c * 64, kvh, p.rel_bias, (LAS char*)lds);
                }
            } else {
                const int s = it - 1024, b = s >> 3, kvh = s & 7; const size_t m0 = (size_t)MP + b * 32;
                const bf16_t* Kh = (const bf16_t*)(ws + WS_KS) + (size_t)b * SKV * KVW + kvh * 128; const bf16_t* Vh = (const bf16_t*)(ws + WS_VS) + (size_t)b * SKV * KVW + kvh * 128;
                att::attn_block<true>(QB + m0 * DM, Kh, Vh, RM + m0 * RMS, SG + m0 * DM, OG + m0 * DM, 65, PAST, kvh, p.rel_bias, (LAS char*)lds);
            }
        }
    }
    SEAM(3);
    if (IN(4)) {
        pg8::Gemm g{(const bf16_t*)(ws + WS_OG), (const bf16_t*)(ws + WS_WT_OUT), MT, DM, DM, DM, DM, 0};
        pg8::StaticOrder S; S.init(MT, DM, G, bx);
        EpiRes E{p.x_prompt, p.x_sample, nullptr, (float*)(ws + WS_X1)};
        pg8::gemm_phase<EpiRes>(lds, g, S, E);
    }
    SEAM(4);
    if (IN(5)) {
        PHASE_IDS();
        for (int m = gw; m < MT; m += NGW) rms_row<false>((const float*)(ws + WS_X1) + (size_t)m * DM, p.norm_w + DM, (bf16_t*)(ws + WS_H) + (size_t)m * DM, lane);
    }
    SEAM(5);
    if (IN(6)) {
        pg8::Gemm g{(const bf16_t*)(ws + WS_H), (const bf16_t*)(ws + WS_WT_PIN), MT, 8192, DM, DM, DM, 0};
        pg8::StaticOrder S; S.init(MT, 8192, G, bx);
        Epi3 E{ws, out};
        pg8::gemm_phase<Epi3>(lds, g, S, E);
    }
    SEAM(6);
    if (IN(7)) {
        PHASE_IDS();
        const bf16_t* U = (const bf16_t*)(ws + WS_U); bf16_t* MX = (bf16_t*)(ws + WS_MX);
        const size_t gt = (size_t)gw * 64 + lane, GT = (size_t)NGW * 64;
        for (size_t i = gt; i < (size_t)MT * (DM / 8); i += GT) {
            const int r = (int)(i >> 9), c8 = (int)(i & 511), c = c8 * 8, w = 2 << (c >> 10);
            int t, nin; const float* hist = nullptr; float cnt;
            if (r < MP) { t = r & 4095; nin = (t + 1 < w) ? t + 1 : w; cnt = (float)nin; }
            else { const int rs = r - MP; t = rs & 31; nin = (t + 1 < w) ? t + 1 : w; cnt = (float)w; hist = p.state_pool + (size_t)(rs >> 5) * 15 * DM + c; }
            float s[8] = {0.f, 0.f, 0.f, 0.f, 0.f, 0.f, 0.f, 0.f}; float u0[8];
            for (int k = 0; k < nin; ++k) { const u32x4 x = *(const u32x4*)(U + (size_t)(r - k) * DM + c);
                const float f[8] = {bf_lo(x.x), bf_hi(x.x), bf_lo(x.y), bf_hi(x.y), bf_lo(x.z), bf_hi(x.z), bf_lo(x.w), bf_hi(x.w)};
#pragma unroll
                for (int e = 0; e < 8; ++e) { s[e] += f[e]; if (k == 0) u0[e] = f[e]; } }
            if (hist) for (int k = nin; k < w; ++k) { const float* hp = hist + (size_t)(15 + t - k) * DM;
                const f32x4 a = *(const f32x4*)hp, b = *(const f32x4*)(hp + 4);
                s[0] += a.x; s[1] += a.y; s[2] += a.z; s[3] += a.w; s[4] += b.x; s[5] += b.y; s[6] += b.z; s[7] += b.w; }
            const float ic = 1.0f / cnt; u32x4 o;
            o.x = cvt_pk_bf16(s[0] * ic - u0[0], s[1] * ic - u0[1]); o.y = cvt_pk_bf16(s[2] * ic - u0[2], s[3] * ic - u0[3]);
            o.z = cvt_pk_bf16(s[4] * ic - u0[4], s[5] * ic - u0[5]); o.w = cvt_pk_bf16(s[6] * ic - u0[6], s[7] * ic - u0[7]);
            *(u32x4*)(MX + (size_t)r * DM + c) = o;
        }
    }
    SEAM(7);
    if (IN(8)) {
        pg8::Gemm g{(const bf16_t*)(ws + WS_MX), (const bf16_t*)(ws + WS_WT_GRP), MT, DM, 1024, DM, 1024, 1};
        pg8::StaticOrder S; S.init(MT, DM, G, bx);
        Epi4 E{ws, p.pool_scale};
        pg8::gemm_phase<Epi4>(lds, g, S, E);
    }
    SEAM(8);
    if (IN(9)) {
        pg8::Gemm g{(const bf16_t*)(ws + WS_ZG), (const bf16_t*)(ws + WS_WT_POUT), MT, DM, DM, DM, DM, 0};
        pg8::StaticOrder S; S.init(MT, DM, G, bx);
        EpiRes E{nullptr, nullptr, (const float*)(ws + WS_X1), (float*)(ws + WS_X1)};
        pg8::gemm_phase<EpiRes>(lds, g, S, E);
    }
    SEAM(9);
    if (IN(10)) {
        PHASE_IDS();
        for (int m = gw; m < MT; m += NGW) rms_row<true>((const float*)(ws + WS_X1) + (size_t)m * DM, p.final_norm_w, out + (m < MP ? O_YP + (size_t)m * DM : O_YS + (size_t)(m - MP) * DM), lane);
    }
#undef IN
#undef SEAM
}

#ifndef MK_N_LAUNCHES
#define MK_N_LAUNCHES 1
#endif
extern "C" void kernel_launch(void* const* d_in, const int* in_sizes, int n_in, void* d_out, int out_size, void* d_ws, size_t ws_size, hipStream_t stream) {
    static int grid = 0;
    if (grid == 0) {
        if (n_in != 15 || (size_t)out_size != O_END || ws_size < WS_END) { fprintf(stderr, "kernel_launch: unexpected shapes: n_in %d out %d ws %zu (need >= %zu)\n", n_in, out_size, ws_size, (size_t)WS_END); grid = -1; return; }
        int dev = 0, cus = 0, per_cu = 0;
        if (hipGetDevice(&dev) != hipSuccess || hipDeviceGetAttribute(&cus, hipDeviceAttributeMultiprocessorCount, dev) != hipSuccess) { grid = -1; return; }
        if (hipFuncSetAttribute((const void*)mega, hipFuncAttributeMaxDynamicSharedMemorySize, LDS_BYTES) != hipSuccess) { fprintf(stderr, "kernel_launch: hipFuncSetAttribute failed\n"); grid = -1; return; }
        if (hipOccupancyMaxActiveBlocksPerMultiprocessor(&per_cu, (const void*)mega, NTHREADS, LDS_BYTES) != hipSuccess || per_cu < 1) { fprintf(stderr, "kernel_launch: occupancy query says %d\n", per_cu); }
        (void)hipGetLastError();
        grid = cus;
    }
    if (grid < 0) return;
    if (hipMemsetAsync((char*)d_ws + WS_CTL, 0, CTL_ZERO_BYTES, stream) != hipSuccess) return;
    Params p{};
    p.x_prompt = (const float*)d_in[0]; p.x_sample = (const float*)d_in[1]; p.cache_k = (const float*)d_in[2]; p.cache_v = (const float*)d_in[3];
    p.cache_kidx = (const float*)d_in[4]; p.state_pool = (const float*)d_in[5]; p.norm_w = (const float*)d_in[6]; p.final_norm_w = (const float*)d_in[7];
    p.attn_w_in = (const float*)d_in[8]; p.attn_w_out = (const float*)d_in[9]; p.rel_bias = (const float*)d_in[10]; p.pool_w_in = (const float*)d_in[11];
    p.pool_group_w = (const float*)d_in[12]; p.pool_scale = (const float*)d_in[13]; p.pool_w_out = (const float*)d_in[14];
    p.out = (float*)d_out; p.ws = (unsigned char*)d_ws;
    if (MK_N_LAUNCHES == 1) { p.ph_lo = 0; p.ph_hi = NPHASE; hipLaunchKernelGGL(mega, dim3(grid), dim3(NTHREADS), LDS_BYTES, stream, p); }
    else for (int k = 0; k < NPHASE; ++k) { p.ph_lo = k; p.ph_hi = k + 1; hipLaunchKernelGGL(mega, dim3(grid), dim3(NTHREADS), LDS_BYTES, stream, p); }
    const hipError_t le = hipPeekAtLastError();
    if (le != hipSuccess) fprintf(stderr, "kernel_launch: launch failed: %s\n", hipGetErrorName(le));
}
```

```cpp
#include <hip/hip_runtime.h>
#include <cstdio>
#include <cstdint>

#define LAS __attribute__((address_space(3)))
typedef unsigned short bf16_t;
typedef short bf16x8 __attribute__((ext_vector_type(8)));
typedef short s16x4 __attribute__((ext_vector_type(4)));
typedef float f32x4 __attribute__((ext_vector_type(4)));
typedef float f32x16 __attribute__((ext_vector_type(16)));
typedef unsigned u32x4 __attribute__((ext_vector_type(4)));
typedef unsigned u32x2 __attribute__((ext_vector_type(2)));
typedef unsigned long long u64;

constexpr int DM = 4096, NBATCH = 4, SEQ = 4096, DB = 32, DSQ = 32, PAST = 4096;
constexpr int MP = NBATCH * SEQ, MS = DB * DSQ, MT = MP + MS;
constexpr int KVW = 1024, QIW = 2048, DIDX = 64, HIDX = 32;
constexpr int N1 = 12544;
constexpr int SKV = 4160;
constexpr int RMS = 65;
constexpr float EPS = 1e-6f;
constexpr int NWAVES = 8, NTHREADS = 512;
constexpr int NPHASE = 11;

constexpr size_t O_YP = 0, O_YS = 67108864, O_KP = 71303168, O_VP = 88080384, O_KIP = 104857600, O_POOLP = 105906176,
                 O_KS = 106151936, O_VS = 107200512, O_KIS = 108249088, O_POOLS = 108314624, O_END = 110280704;

constexpr size_t MiB = 1u << 20;
constexpr size_t WS_CTL = 0, CTL_ZERO_BYTES = 1 * MiB;
constexpr size_t WS_WT_IN = 1 * MiB, WS_WT_OUT = 99 * MiB, WS_WT_PIN = 131 * MiB, WS_WT_GRP = 195 * MiB, WS_WT_POUT = 203 * MiB;
constexpr size_t WS_H = 235 * MiB, WS_QB = 371 * MiB, WS_KP = 507 * MiB, WS_VP = 539 * MiB, WS_KS = 571 * MiB, WS_VS = 831 * MiB;
constexpr size_t WS_QIB = 1091 * MiB, WS_KIP = 1159 * MiB, WS_KIS = 1161 * MiB, WS_WIB = 1178 * MiB, WS_SG = 1181 * MiB, WS_RM = 1317 * MiB;
constexpr size_t WS_OG = 1326 * MiB, WS_X1 = 1462 * MiB, WS_END = 1734 * MiB;
constexpr size_t WS_U = WS_QB, WS_SG2 = WS_SG, WS_MX = WS_OG, WS_ZG = WS_KS;
constexpr int CW_BAR = 4096;

constexpr int LDS_BYTES = 147456, RING_BYTES = 131072, MISC_OFF = RING_BYTES + 320;

__device__ __forceinline__ unsigned cvt_pk_bf16(float lo, float hi) { unsigned r; asm("v_cvt_pk_bf16_f32 %0, %1, %2" : "=v"(r) : "v"(lo), "v"(hi)); return r; }
__device__ __forceinline__ float bf_lo(unsigned w) { return __uint_as_float(w << 16); }
__device__ __forceinline__ float bf_hi(unsigned w) { return __uint_as_float(w & 0xffff0000u); }
__device__ __forceinline__ float silu_f(float x) { return x * __builtin_amdgcn_rcpf(1.0f + __builtin_amdgcn_exp2f(-1.4426950408889634f * x)); }
__device__ __forceinline__ float wave_sum(float v) {
#pragma unroll
    for (int o = 1; o < 64; o <<= 1) v += __shfl_xor(v, o);
    return v;
}
#define LDS_WAIT() asm volatile("s_waitcnt lgkmcnt(0)" ::: "memory")
#define VM_WAIT() asm volatile("s_waitcnt vmcnt(0)" ::: "memory")

#define XB_TMO      128
#define XB_XCNT(j)  (256  + 64 * (j))
#define XB_XSUB(j)  (1280 + 64 * (j))
#define XB_XGEN(j)  (2304 + 64 * (j))
#define XB_TOP      3328
#define XB_TOPGEN   3392
#define XCD_BAR_WORDS 3456
#define XB_SPIN_CAP (1u << 18)
__device__ __forceinline__ unsigned xb_ld(unsigned* p)              { return __hip_atomic_load(p, __ATOMIC_RELAXED, __HIP_MEMORY_SCOPE_AGENT); }
__device__ __forceinline__ unsigned xb_add(unsigned* p, unsigned v) { return __hip_atomic_fetch_add(p, v, __ATOMIC_RELAXED, __HIP_MEMORY_SCOPE_AGENT); }
__device__ __forceinline__ unsigned xb_xcc_id() { return (unsigned)__builtin_amdgcn_s_getreg((3 << 11) | 20) & 0xFu; }
#define XB_SPIN(cond, bar) do { unsigned _sp = 0; while (cond) { __builtin_amdgcn_s_sleep(1); \
    if ((++_sp & 255u) == 0u) { if (xb_ld(&(bar)[XB_TMO])) break; if (_sp > XB_SPIN_CAP) { atomicAdd(&(bar)[XB_TMO], 1u); break; } } } } while (0)
struct XcdBarrier { unsigned* bar; unsigned x; volatile LAS unsigned* st; };
__device__ __forceinline__ XcdBarrier xcd_barrier_post(unsigned* bar, volatile LAS unsigned* st) {
    XcdBarrier b; b.bar = bar; b.x = xb_xcc_id(); b.st = st;
    if (threadIdx.x == 0) (void)xb_add(&bar[XB_XCNT(b.x)], 1u);
    return b;
}
__device__ __forceinline__ void xcd_barrier_complete(unsigned* bar, unsigned x, unsigned& nloc, unsigned& nx) {
    const unsigned G = gridDim.x * gridDim.y * gridDim.z;
    unsigned sum, cnt, mine, sp = 0u;
    for (;;) {
        sum = 0u; cnt = 0u; mine = 0u;
#pragma unroll
        for (unsigned j = 0; j < 16; ++j) { const unsigned c = xb_ld(&bar[XB_XCNT(j)]); sum += c; cnt += (c > 0u) ? 1u : 0u; mine = (j == x) ? c : mine; }
        if (sum == G) break;
        __builtin_amdgcn_s_sleep(1);
        if ((++sp & 255u) == 0u) { if (xb_ld(&bar[XB_TMO])) break; if (sp > XB_SPIN_CAP) { atomicAdd(&bar[XB_TMO], 1u); break; } }
    }
    nloc = mine > 0u ? mine : 1u; nx = cnt > 0u ? cnt : 1u;
}
__device__ __forceinline__ void xcd_barrier(const XcdBarrier& b) {
    asm volatile("s_waitcnt vmcnt(0)" ::: "memory");
    __syncthreads();
    if (threadIdx.x == 0) {
        unsigned* bar = b.bar;
        __builtin_amdgcn_s_waitcnt(0);
        unsigned nloc = b.st[0], nx = b.st[1];
        if (nloc == 0u) { xcd_barrier_complete(bar, b.x, nloc, nx); b.st[0] = nloc; b.st[1] = nx; }
        const unsigned old = xb_add(&bar[XB_XSUB(b.x)], 1u);
        const unsigned gen = old / nloc;
        if (old + 1u == (gen + 1u) * nloc) {
            __builtin_amdgcn_fence(__ATOMIC_RELEASE, "agent");
            asm volatile("s_waitcnt vmcnt(0)" ::: "memory");
            const unsigned og = xb_add(&bar[XB_TOP], 1u);
            const unsigned tg = og / nx;
            if (og + 1u == (tg + 1u) * nx) xb_add(&bar[XB_TOPGEN], 1u);
            else XB_SPIN(xb_ld(&bar[XB_TOPGEN]) == tg, bar);
            __builtin_amdgcn_fence(__ATOMIC_ACQUIRE, "agent");
            xb_add(&bar[XB_XGEN(b.x)], 1u);
            asm volatile("s_waitcnt vmcnt(0)" ::: "memory");
        } else {
            XB_SPIN(xb_ld(&bar[XB_XGEN(b.x)]) == gen, bar);
            __builtin_amdgcn_fence(__ATOMIC_ACQUIRE, "agent");
            asm volatile("s_waitcnt vmcnt(0)" ::: "memory");
        }
    }
    __syncthreads();
}

namespace pg8 {
constexpr int BM = 256, BK = 64, HALF = 128, HTB = HALF * BK * 2, STAGE_BYTES = 8 * HTB, NXCD = 8, WGM = 8;
__host__ __device__ __forceinline__ int lds_byte(int r, int c) { const int st = (r >> 4) * 2 + (c >> 5), rr = r & 15, cc = c & 31, ob = rr * 64 + cc * 2; return st * 1024 + (ob ^ (((ob >> 9) & 1) << 5)); }
__host__ __device__ __forceinline__ void stage_rc(int b, int& R, int& C) { const int st = b / 1024, sb = b % 1024, swz = sb ^ (((sb >> 9) & 1) << 5); R = (st >> 1) * 16 + swz / 64; C = (st & 1) * 32 + (swz % 64) / 2; }
__host__ __device__ __forceinline__ int perm32(int rho) { const int n = rho >> 4, i = rho & 15; return 8 * (i >> 2) + 4 * n + (i & 3); }
struct Unit { int pm, pn; };
struct Gemm { const bf16_t* A; const bf16_t* Bt; int M, N, K, lda, ldb, grouped; };
struct StaticOrder {
    int nM, nN, nwg, G, c;
    __host__ __device__ void init(int M, int N, int G_, int c_) { nM = M / BM; nN = N / BM; nwg = nM * nN; G = G_; c = c_; }
    __host__ __device__ bool next(int i, Unit& u) const {
        const long L = (long)i * G + c; if (L >= nwg) return false;
        int wgid = (int)L; { const int q = nwg / NXCD, r = nwg % NXCD, xcd = wgid % NXCD, off = wgid / NXCD; wgid = (xcd < r ? xcd * (q + 1) : r * (q + 1) + (xcd - r) * q) + off; }
        const int nig = WGM * nN, gid = wgid / nig, fm = gid * WGM, gsz = (nM - fm) < WGM ? (nM - fm) : WGM;
        u.pm = fm + ((wgid % nig) % gsz); u.pn = (wgid % nig) / gsz; return true;
    }
};

template <class Epi, bool ALIGN_EPI = true>
__device__ __forceinline__ void gemm_phase(LAS unsigned char* lds, const Gemm g, const StaticOrder& S, const Epi& E) {
    const int tid = threadIdx.x, wid = __builtin_amdgcn_readfirstlane(tid >> 6), lane = tid & 63, wr = wid >> 2, wc = wid & 3, fr = lane & 15, fq = lane >> 4;
    const int K = g.K, nt = K / BK;
    unsigned voffA[2], voffB[2];
#pragma unroll
    for (int i = 0; i < 2; ++i) { int R, C; stage_rc(tid * 16 + i * 8192, R, C); const int Rb = Epi::PERM ? ((R & ~31) + perm32(R & 31)) : R;
        voffA[i] = (unsigned)(R * g.lda + C) * 2u; voffB[i] = (unsigned)(Rb * g.ldb + C) * 2u; }
    const size_t kstep = (size_t)(BK * 2);
    const size_t hstepA = (size_t)HALF * g.lda * 2, hstepB = (size_t)HALF * g.ldb * 2;
    const size_t tstepA = 2 * hstepA, tstepB = 2 * hstepB;
    const unsigned ldsw = (unsigned)wid * 1024u;
    const int aoff = lds_byte(wr * 64 + fr, fq * 8), boff = lds_byte(wc * 32 + fr, fq * 8);
#define PG8_SA(b, h) (((b) * 2 + (h)) * HTB)
#define PG8_SB(b, h) ((4 + (b) * 2 + (h)) * HTB)
#define PG8_STAGE(bufoff, gbase, voff) do { _Pragma("unroll") for (int _i = 0; _i < 2; ++_i) \
        __builtin_amdgcn_global_load_lds((const unsigned*)((const char*)(gbase) + (voff)[_i]), (LAS unsigned*)(lds + (bufoff) + ldsw + _i * 8192), 16, 0, 0); } while (0)
#define PG8_LDA(dst, b, h) do { _Pragma("unroll") for (int m = 0; m < 4; ++m) _Pragma("unroll") for (int k = 0; k < 2; ++k) dst[m][k] = *(const LAS bf16x8*)(lds + PG8_SA(b, h) + aoff + m * 2048 + k * 1024); } while (0)
#define PG8_LDB(dst, b, h) do { _Pragma("unroll") for (int n = 0; n < 2; ++n) _Pragma("unroll") for (int k = 0; k < 2; ++k) dst[n][k] = *(const LAS bf16x8*)(lds + PG8_SB(b, h) + boff + n * 2048 + k * 1024); } while (0)
#define PG8_MMA(ai, bj, At, Bt) do { __builtin_amdgcn_s_setprio(1); _Pragma("unroll") for (int m = 0; m < 4; ++m) _Pragma("unroll") for (int n = 0; n < 2; ++n) _Pragma("unroll") for (int k = 0; k < 2; ++k) \
        acc[ai][bj][m][n] = __builtin_amdgcn_mfma_f32_16x16x32_bf16(Bt[n][k], At[m][k], acc[ai][bj][m][n], 0, 0, 0); __builtin_amdgcn_s_setprio(0); } while (0)
#define PG8_WAIT_V(n) asm volatile("s_waitcnt vmcnt(" #n ")" ::: "memory")
#define PG8_WAIT_L(n) asm volatile("s_waitcnt lgkmcnt(" #n ")" ::: "memory")
#define PG8_BAR __builtin_amdgcn_s_barrier()
#define PG8_SCHED __builtin_amdgcn_sched_barrier(0)
#define PG8_APTR(u) ((const char*)g.A + (size_t)(u).pm * tstepA + (g.grouped ? (size_t)((u).pn >> 2) * (size_t)K * 2 : (size_t)0))
    Unit cur, nxt; int ui = 0;
    if (!S.next(0, cur)) return;
    f32x4 acc[2][2][4][2];
#pragma unroll
    for (int a = 0; a < 2; ++a)
#pragma unroll
        for (int b = 0; b < 2; ++b)
#pragma unroll
            for (int m = 0; m < 4; ++m)
#pragma unroll
                for (int n = 0; n < 2; ++n) acc[a][b][m][n] = (f32x4){0.f, 0.f, 0.f, 0.f};
    bf16x8 At[4][2], B0[2][2], B1[2][2];
    const char* cA = PG8_APTR(cur); const char* cB = (const char*)g.Bt + (size_t)cur.pn * tstepB;
    PG8_STAGE(PG8_SB(0, 0), cB, voffB); PG8_STAGE(PG8_SB(0, 1), cB + hstepB, voffB); PG8_STAGE(PG8_SA(0, 0), cA, voffA); PG8_STAGE(PG8_SA(0, 1), cA + hstepA, voffA);
    if (wr == 1) PG8_BAR;
    PG8_WAIT_V(2); PG8_BAR;
    PG8_STAGE(PG8_SB(1, 0), cB + kstep, voffB); PG8_STAGE(PG8_SA(1, 0), cA + kstep, voffA); PG8_STAGE(PG8_SB(1, 1), cB + hstepB + kstep, voffB);
    PG8_WAIT_V(6); PG8_BAR;
    for (;;) {
        const bool has_next = S.next(ui + 1, nxt);
        const char* nA = has_next ? PG8_APTR(nxt) : cA; const char* nB = has_next ? (const char*)g.Bt + (size_t)nxt.pn * tstepB : cB;
        for (int t = 0; t < nt; t += 2) {
            const bool last = (t == nt - 2);
            const char* a1 = cA + (size_t)(t + 1) * kstep;
            const char* a2 = last ? nA : cA + (size_t)(t + 2) * kstep; const char* b2 = last ? nB : cB + (size_t)(t + 2) * kstep;
            const char* a3 = a2 + kstep; const char* b3 = b2 + kstep;
            PG8_LDB(B0, 0, 0); PG8_LDB(B1, 0, 1); PG8_SCHED; PG8_LDA(At, 0, 0); PG8_STAGE(PG8_SA(1, 1), a1 + hstepA, voffA);
            PG8_WAIT_V(8); PG8_WAIT_L(0); PG8_BAR; PG8_MMA(0, 0, At, B0); PG8_MMA(0, 1, At, B1); PG8_BAR; PG8_SCHED;
            PG8_LDA(At, 0, 1); PG8_STAGE(PG8_SB(0, 0), b2, voffB); PG8_STAGE(PG8_SB(0, 1), b2 + hstepB, voffB); PG8_STAGE(PG8_SA(0, 0), a2, voffA);
            PG8_WAIT_V(8); PG8_WAIT_L(0); PG8_BAR; PG8_MMA(1, 0, At, B0); PG8_MMA(1, 1, At, B1); PG8_BAR; PG8_SCHED;
            PG8_LDB(B0, 1, 0); PG8_LDB(B1, 1, 1); PG8_SCHED; PG8_LDA(At, 1, 0); PG8_STAGE(PG8_SA(0, 1), a2 + hstepA, voffA);
            PG8_WAIT_V(8); PG8_WAIT_L(0); PG8_BAR; PG8_MMA(0, 0, At, B0); PG8_MMA(0, 1, At, B1); PG8_BAR; PG8_SCHED;
            PG8_LDA(At, 1, 1); PG8_STAGE(PG8_SB(1, 0), b3, voffB); PG8_STAGE(PG8_SB(1, 1), b3 + hstepB, voffB); PG8_STAGE(PG8_SA(1, 0), a3, voffA);
            PG8_WAIT_V(8); PG8_WAIT_L(0); PG8_BAR; PG8_MMA(1, 0, At, B0); PG8_MMA(1, 1, At, B1); PG8_BAR; PG8_SCHED;
        }
        if constexpr (ALIGN_EPI) { if (wr == 0) PG8_BAR; }
        E(acc, cur, wr, wc, fr, fq);
        if (!has_next) break;
#pragma unroll
        for (int a = 0; a < 2; ++a)
#pragma unroll
            for (int b = 0; b < 2; ++b)
#pragma unroll
                for (int m = 0; m < 4; ++m)
#pragma unroll
                    for (int n = 0; n < 2; ++n) acc[a][b][m][n] = (f32x4){0.f, 0.f, 0.f, 0.f};
        cur = nxt; cA = nA; cB = nB; ++ui;
        if constexpr (ALIGN_EPI) { if (wr == 1) PG8_BAR; }
    }
    PG8_WAIT_V(0);
    if constexpr (!ALIGN_EPI) { if (wr == 0) PG8_BAR; }
    PG8_BAR;
#undef PG8_SA
#undef PG8_SB
#undef PG8_STAGE
#undef PG8_LDA
#undef PG8_LDB
#undef PG8_MMA
#undef PG8_WAIT_V
#undef PG8_WAIT_L
#undef PG8_BAR
#undef PG8_SCHED
#undef PG8_APTR
}
}

struct Params {
    const float *x_prompt, *x_sample, *cache_k, *cache_v, *cache_kidx, *state_pool, *norm_w, *final_norm_w, *attn_w_in, *attn_w_out, *rel_bias,
                *pool_w_in, *pool_group_w, *pool_scale, *pool_w_out;
    float* out; unsigned char* ws; int ph_lo, ph_hi;
};

__device__ __forceinline__ u32x4 pack8(const f32x4 a, const f32x4 b) { u32x4 w; w.x = cvt_pk_bf16(a[0], a[1]); w.y = cvt_pk_bf16(a[2], a[3]); w.z = cvt_pk_bf16(b[0], b[1]); w.w = cvt_pk_bf16(b[2], b[3]); return w; }
__device__ __forceinline__ f32x4 silu4(f32x4 v) { return (f32x4){silu_f(v[0]), silu_f(v[1]), silu_f(v[2]), silu_f(v[3])}; }

constexpr int UP_SEQ = SEQ + 16, US_SEQ = DSQ + 16, UP_ROWS = NBATCH * UP_SEQ;
__device__ __forceinline__ int u_row(int r) { return r < MP ? (r >> 12) * UP_SEQ + 16 + (r & 4095) : UP_ROWS + ((r - MP) >> 5) * US_SEQ + 16 + ((r - MP) & 31); }
__device__ __forceinline__ size_t kif_off(int s, int d0) { return ((size_t)(((s >> 5) * 4 + (d0 >> 4)) * 64 + ((d0 >> 3) & 1) * 32 + (s & 31))) * 8; }

struct Epi1 {
    static constexpr bool PERM = true;
    unsigned char* ws; float* out;
    __device__ __forceinline__ void operator()(const f32x4 (&acc)[2][2][4][2], const pg8::Unit& u, int wr, int wc, int fr, int fq) const {
        const int pn = u.pn;
#pragma unroll
        for (int ai = 0; ai < 2; ++ai)
#pragma unroll
            for (int m = 0; m < 4; ++m) {
                const int r = u.pm * 256 + ai * 128 + wr * 64 + m * 16 + fr;
                const bool samp = r >= MP; const int rs = r - MP, sb = rs >> 5, st = rs & 31;
#pragma unroll
                for (int bj = 0; bj < 2; ++bj) {
                    const int lc = bj * 128 + wc * 32 + 8 * fq;
                    const f32x4 v0 = acc[ai][bj][m][0], v1 = acc[ai][bj][m][1];
                    if (pn < 16) {
                        *(u32x4*)((bf16_t*)(ws + WS_QB) + (size_t)r * DM + pn * 256 + lc) = pack8(v0, v1);
                    } else if (pn < 24) {
                        const bool isv = pn >= 20; const int c = (pn - (isv ? 20 : 16)) * 256 + lc;
                        bf16_t* dst; float* fo;
                        if (!samp) { dst = (bf16_t*)(ws + (isv ? WS_VP : WS_KP)) + (size_t)r * KVW + c; fo = out + (isv ? O_VP : O_KP) + (size_t)r * KVW + c; }
                        else { dst = (bf16_t*)(ws + (isv ? WS_VS : WS_KS)) + ((size_t)sb * SKV + PAST + st) * KVW + c; fo = out + (isv ? O_VS : O_KS) + (size_t)rs * KVW + c; }
                        *(u32x4*)dst = pack8(v0, v1); *(f32x4*)fo = v0; *(f32x4*)(fo + 4) = v1;
                    } else if (pn < 32) {
                        *(u32x4*)((bf16_t*)(ws + WS_QIB) + (size_t)r * QIW + (pn - 24) * 256 + lc) = pack8(v0, v1);
                    } else if (pn < 48) {
                        *(u32x4*)((bf16_t*)(ws + WS_SG) + (size_t)r * DM + (pn - 32) * 256 + lc) = pack8(silu4(v0), silu4(v1));
                    } else {
                        if (lc < 64) {
                            bf16_t* dst; float* fo;
                            if (!samp) { dst = (bf16_t*)(ws + WS_KIP) + (size_t)(r >> 12) * SEQ * DIDX + kif_off(r & 4095, lc); fo = out + O_KIP + (size_t)r * DIDX + lc; }
                            else { dst = (bf16_t*)(ws + WS_KIS) + (size_t)sb * SKV * DIDX + kif_off(PAST + st, lc); fo = out + O_KIS + (size_t)rs * DIDX + lc; }
                            *(u32x4*)dst = pack8(v0, v1); *(f32x4*)fo = v0; *(f32x4*)(fo + 4) = v1;
                        } else if (lc < 96) {
                            float* fo = (float*)(ws + WS_WIB) + (size_t)r * HIDX + (lc - 64);
                            *(f32x4*)fo = v0; *(f32x4*)(fo + 4) = v1;
                        }
                    }
                }
            }
    }
};
struct EpiRes {
    static constexpr bool PERM = false;
    const float* xp; const float* xs; const float* base; float* dst;
    __device__ __forceinline__ void operator()(const f32x4 (&acc)[2][2][4][2], const pg8::Unit& u, int wr, int wc, int fr, int fq) const {
#pragma unroll
        for (int ai = 0; ai < 2; ++ai)
#pragma unroll
            for (int m = 0; m < 4; ++m) {
                const int r = u.pm * 256 + ai * 128 + wr * 64 + m * 16 + fr;
                const float* b = base ? base + (size_t)r * DM : (r < MP ? xp + (size_t)r * DM : xs + (size_t)(r - MP) * DM);
                float* d = dst + (size_t)r * DM;
#pragma unroll
                for (int bj = 0; bj < 2; ++bj)
#pragma unroll
                    for (int n = 0; n < 2; ++n) { const int c = u.pn * 256 + bj * 128 + wc * 32 + n * 16 + 4 * fq;
                        *(f32x4*)(d + c) = *(const f32x4*)(b + c) + acc[ai][bj][m][n]; }
            }
    }
};
struct Epi3 {
    static constexpr bool PERM = true;
    unsigned char* ws; float* out;
    __device__ __forceinline__ void operator()(const f32x4 (&acc)[2][2][4][2], const pg8::Unit& u, int wr, int wc, int fr, int fq) const {
        const int pn = u.pn;
#pragma unroll
        for (int ai = 0; ai < 2; ++ai)
#pragma unroll
            for (int m = 0; m < 4; ++m) {
                const int r = u.pm * 256 + ai * 128 + wr * 64 + m * 16 + fr;
                float* po = nullptr;
                if (r < MP) { const int t = r & 4095; if (t >= SEQ - 15) po = out + O_POOLP + ((size_t)(r >> 12) * 15 + (t - (SEQ - 15))) * DM; }
                else { const int rs = r - MP, t = rs & 31; if (t >= DSQ - 15) po = out + O_POOLS + ((size_t)(rs >> 5) * 15 + (t - (DSQ - 15))) * DM; }
#pragma unroll
                for (int bj = 0; bj < 2; ++bj) {
                    const int lc = bj * 128 + wc * 32 + 8 * fq;
                    const f32x4 v0 = acc[ai][bj][m][0], v1 = acc[ai][bj][m][1];
                    if (pn < 16) {
                        const int c = pn * 256 + lc;
                        *(u32x4*)((bf16_t*)(ws + WS_U) + (size_t)u_row(r) * DM + c) = pack8(v0, v1);
                        if (po) { *(f32x4*)(po + c) = v0; *(f32x4*)(po + c + 4) = v1; }
                    } else {
                        *(u32x4*)((bf16_t*)(ws + WS_SG2) + (size_t)r * DM + (pn - 16) * 256 + lc) = pack8(silu4(v0), silu4(v1));
                    }
                }
            }
    }
};
struct Epi4 {
    static constexpr bool PERM = true;
    unsigned char* ws; const float* scale;
    __device__ __forceinline__ void operator()(const f32x4 (&acc)[2][2][4][2], const pg8::Unit& u, int wr, int wc, int fr, int fq) const {
#pragma unroll
        for (int bj = 0; bj < 2; ++bj) {
            const int c = u.pn * 256 + bj * 128 + wc * 32 + 8 * fq;
            const f32x4 s0 = *(const f32x4*)(scale + c), s1 = *(const f32x4*)(scale + c + 4);
#pragma unroll
            for (int ai = 0; ai < 2; ++ai)
#pragma unroll
                for (int m = 0; m < 4; ++m) {
                    const int r = u.pm * 256 + ai * 128 + wr * 64 + m * 16 + fr;
                    const u32x4 gw = *(const u32x4*)((const bf16_t*)(ws + WS_SG2) + (size_t)r * DM + c);
                    const f32x4 g0 = (f32x4){bf_lo(gw.x), bf_hi(gw.x), bf_lo(gw.y), bf_hi(gw.y)}, g1 = (f32x4){bf_lo(gw.z), bf_hi(gw.z), bf_lo(gw.w), bf_hi(gw.w)};
                    *(u32x4*)((bf16_t*)(ws + WS_ZG) + (size_t)r * DM + c) = pack8(acc[ai][bj][m][0] * s0 * g0, acc[ai][bj][m][1] * s1 * g1);
                }
        }
    }
};

__device__ __forceinline__ void transpose_item(const float* W, int N, int k0, int n0, bf16_t* WT, int K, int drow0, LAS float* scr, int lane) {
#pragma unroll 8
    for (int i = 0; i < 32; ++i) { const int kk = 2 * i + (lane >> 5); scr[kk * 33 + (lane & 31)] = W[(size_t)(k0 + kk) * N + n0 + (lane & 31)]; }
    LDS_WAIT(); asm volatile("" ::: "memory");
    const int c = lane & 7;
#pragma unroll
    for (int j = 0; j < 4; ++j) { const int n = (lane >> 3) + 8 * j; const LAS float* s = scr + (8 * c) * 33 + n;
        u32x4 o; o.x = cvt_pk_bf16(s[0 * 33], s[1 * 33]); o.y = cvt_pk_bf16(s[2 * 33], s[3 * 33]); o.z = cvt_pk_bf16(s[4 * 33], s[5 * 33]); o.w = cvt_pk_bf16(s[6 * 33], s[7 * 33]);
        *(u32x4*)(WT + (size_t)(drow0 + n) * K + k0 + 8 * c) = o; }
    LDS_WAIT(); asm volatile("" ::: "memory");
}
template <bool F32OUT>
__device__ __forceinline__ void rms_row(const float* xrow, const float* w, void* orow, int lane) {
    const f32x4* xr = (const f32x4*)xrow + lane; const f32x4* wr = (const f32x4*)w + lane;
    f32x4 v[16]; float s = 0.f;
#pragma unroll
    for (int j = 0; j < 16; ++j) { v[j] = xr[64 * j]; s += (v[j].x * v[j].x + v[j].y * v[j].y) + (v[j].z * v[j].z + v[j].w * v[j].w); }
    const float rstd = 1.0f / sqrtf(wave_sum(s) * (1.0f / DM) + EPS);
#pragma unroll
    for (int j = 0; j < 16; ++j) { const f32x4 g = wr[64 * j]; const f32x4 y = v[j] * rstd * g;
        if (F32OUT) ((f32x4*)orow + lane)[64 * j] = y;
        else { u32x2 o; o.x = cvt_pk_bf16(y.x, y.y); o.y = cvt_pk_bf16(y.z, y.w); ((u32x2*)orow + lane)[64 * j] = o; } }
}

__device__ __forceinline__ unsigned ord_key(float f) { const unsigned b = __float_as_uint(f); return (b & 0x80000000u) ? ~b : (b | 0x80000000u); }
constexpr int NVJ = 65;
__device__ __forceinline__ void select_query(const bf16_t* qi_row, const float* wi_row, const bf16_t* kif, int nt, bool last_half, u64* rm, int lane) {
    const int r32 = lane & 31, hi = lane >> 5;
    if (nt <= 4) { if (lane < nt) rm[lane] = ~0ull; return; }
    bf16x8 a[4];
#pragma unroll
    for (int ks = 0; ks < 4; ++ks) a[ks] = *(const bf16x8*)(qi_row + r32 * 64 + ks * 16 + hi * 8);
    float w[16];
#pragma unroll
    for (int r = 0; r < 16; ++r) w[r] = wi_row[(r & 3) + 8 * (r >> 2) + 4 * hi] * (0.125f * 0.17677669529663687f);
    unsigned uk[NVJ];
    typedef const __attribute__((address_space(1))) char* gcp; typedef const __attribute__((address_space(1))) bf16x8* gbp;
    gcp kbase = (gcp)kif; const unsigned loff = (unsigned)lane * 16u;
#pragma unroll
    for (int j = 0; j < NVJ; ++j) {
        uk[j] = 0u;
        if (j < nt) {
            bf16x8 b0[4], b1[4];
#pragma unroll
            for (int ks = 0; ks < 4; ++ks) b0[ks] = *(gbp)(kbase + loff + ks * 1024);
            kbase += 4096; asm volatile("" : "+s"(kbase));
#pragma unroll
            for (int ks = 0; ks < 4; ++ks) b1[ks] = *(gbp)(kbase + loff + ks * 1024);
            kbase += 4096; asm volatile("" : "+s"(kbase));
            f32x16 c0 = {}, c1 = {};
#pragma unroll
            for (int ks = 0; ks < 4; ++ks) { c0 = __builtin_amdgcn_mfma_f32_32x32x16_bf16(a[ks], b0[ks], c0, 0, 0, 0); c1 = __builtin_amdgcn_mfma_f32_32x32x16_bf16(a[ks], b1[ks], c1, 0, 0, 0); }
            float s0 = 0.f, s1 = 0.f;
#pragma unroll
            for (int r = 0; r < 16; ++r) { s0 = fmaf(w[r], fmaxf(c0[r], 0.f), s0); s1 = fmaf(w[r], fmaxf(c1[r], 0.f), s1); }
            auto rr = __builtin_amdgcn_permlane32_swap(__float_as_uint(s0), __float_as_uint(s1), false, false);
            float v = __uint_as_float(rr[0]) + __uint_as_float(rr[1]);
            if (last_half && j == nt - 1 && hi) v = -__builtin_inff();
            uk[j] = ord_key(v);
        }
    }
#define CNT_GE(cnt, thr, x) asm volatile("v_cmp_le_u32 vcc, %1, %2\n\ts_bcnt1_i32_b64 vcc_lo, vcc\n\ts_add_i32 %0, %0, vcc_lo" : "+s"(cnt) : "s"(thr), "v"(x) : "vcc", "scc")
#define CNT_GT(cnt, thr, x) asm volatile("v_cmp_lt_u32 vcc, %1, %2\n\ts_bcnt1_i32_b64 vcc_lo, vcc\n\ts_add_i32 %0, %0, vcc_lo" : "+s"(cnt) : "s"(thr), "v"(x) : "vcc", "scc")
    unsigned T = 0u;
    for (int bit = 31; bit >= 0; --bit) {
        const unsigned cand = T | (1u << bit); int cnt = 0;
#pragma unroll
        for (int j = 0; j < NVJ; ++j) CNT_GE(cnt, cand, uk[j]);
        if (cnt >= 256) T = cand;
    }
    int cge = 0;
#pragma unroll
    for (int j = 0; j < NVJ; ++j) CNT_GE(cge, T, uk[j]);
    if (cge == 256) {
#pragma unroll
        for (int j = 0; j < NVJ; ++j) { u64 mk; asm volatile("v_cmp_le_u32 %0, %1, %2" : "=s"(mk) : "s"(T), "v"(uk[j])); if (lane == 0) rm[j] = mk; }
    } else {
        int cgt = 0;
#pragma unroll
        for (int j = 0; j < NVJ; ++j) CNT_GT(cgt, T, uk[j]);
        int need = 256 - cgt;
#pragma unroll
        for (int j = 0; j < NVJ; ++j) {
            u64 gt, eq; asm volatile("v_cmp_lt_u32 %0, %1, %2" : "=s"(gt) : "s"(T), "v"(uk[j])); asm volatile("v_cmp_eq_u32 %0, %1, %2" : "=s"(eq) : "s"(T), "v"(uk[j]));
            const int below = __builtin_popcountll(eq & ((1ull << lane) - 1ull));
            const u64 take = __ballot(((eq >> lane) & 1ull) && below < need);
            need -= __builtin_popcountll(take);
            if (lane == 0) rm[j] = gt | take;
        }
    }
#undef CNT_GE
#undef CNT_GT
}

namespace att {
constexpr int D = 128, KVBLK = 64;
constexpr float SCALE = 0.088388347648318440f;
constexpr float THR = 8.f;
constexpr float NEG = -1e30f, MINIT = -1e20f;
constexpr size_t SHM_V = KVBLK * D * 2, SHM_K = KVBLK * D * 2;
constexpr size_t OFF_WS = 2 * SHM_V + 2 * SHM_K, OFF_TB = OFF_WS + 8 * 64 * 4, OFF_MK = OFF_TB + 4 * 256 * 4, LDS_ATTN = OFF_MK + 64 * 65 * 8;
static_assert(LDS_ATTN <= 131072, "attention LDS");
#define KSWZ(row, colB) ((row) * 256 + ((colB) ^ (((row) & 7) << 4)))
#define SBAR() __builtin_amdgcn_sched_barrier(0)
__device__ __forceinline__ int crow(int r, int hi) { return (r & 3) + 8 * (r >> 2) + 4 * hi; }
__device__ __forceinline__ void partialSM(f32x16& p0, f32x16& p1, float& m_reg, float& mn, float& alpha) {
    constexpr float C = SCALE * 1.4426950408889634f;
    float pmax = p0[0];
#pragma unroll
    for (int r = 1; r < 16; ++r) pmax = fmaxf(pmax, p0[r]);
#pragma unroll
    for (int r = 0; r < 16; ++r) pmax = fmaxf(pmax, p1[r]);
    { auto rr = __builtin_amdgcn_permlane32_swap(__float_as_uint(pmax), __float_as_uint(pmax), false, false);
      pmax = fmaxf(__uint_as_float(rr[0]), __uint_as_float(rr[1])); }
    if (__builtin_expect(__all(pmax - m_reg <= THR / SCALE), 1)) { mn = m_reg; alpha = 1.f; }
    else { mn = fmaxf(m_reg, pmax); alpha = __builtin_amdgcn_exp2f((m_reg - mn) * C); m_reg = mn; }
    const float mnC = -mn * C;
#pragma unroll
    for (int r = 0; r < 16; ++r) p0[r] = fmaf(p0[r], C, mnC);
#pragma unroll
    for (int r = 0; r < 16; ++r) p1[r] = fmaf(p1[r], C, mnC);
#pragma unroll
    for (int r = 0; r < 16; ++r) p0[r] = __builtin_amdgcn_exp2f(p0[r]);
}
__device__ __forceinline__ void finishSM(f32x16& p0, f32x16& p1, float alpha, float& l_reg, bf16x8& pa0, bf16x8& pa1, bf16x8& pa2, bf16x8& pa3) {
#pragma unroll
    for (int r = 0; r < 16; ++r) p1[r] = __builtin_amdgcn_exp2f(p1[r]);
    float ps = 0;
#pragma unroll
    for (int r = 0; r < 16; ++r) ps += p0[r];
#pragma unroll
    for (int r = 0; r < 16; ++r) ps += p1[r];
    { auto rr = __builtin_amdgcn_permlane32_swap(__float_as_uint(ps), __float_as_uint(ps), false, false);
      ps = __uint_as_float(rr[0]) + __uint_as_float(rr[1]); }
    l_reg = l_reg * alpha + ps;
#define PK4(P, BASE, OUT) do { unsigned a0 = cvt_pk_bf16(P[BASE + 0], P[BASE + 1]), a1 = cvt_pk_bf16(P[BASE + 2], P[BASE + 3]);   \
    unsigned b0 = cvt_pk_bf16(P[BASE + 4], P[BASE + 5]), b1 = cvt_pk_bf16(P[BASE + 6], P[BASE + 7]);                              \
    auto r0 = __builtin_amdgcn_permlane32_swap(a0, b0, false, false); auto r1 = __builtin_amdgcn_permlane32_swap(a1, b1, false, false); \
    u32x4 w = {r0[0], r1[0], r0[1], r1[1]}; OUT = *reinterpret_cast<bf16x8*>(&w); } while (0)
    PK4(p0, 0, pa0); PK4(p0, 8, pa1); PK4(p1, 0, pa2); PK4(p1, 8, pa3);
#undef PK4
}
__device__ __forceinline__ void qkt(f32x16& p0, f32x16& p1, const LAS char* Ks, const bf16x8* qr, int r32, int hi) {
    p0 = f32x16{}; p1 = f32x16{};
#pragma unroll
    for (int d0 = 0; d0 < 8; ++d0) { const int cb = (d0 * 16 + hi * 8) * 2;
        const bf16x8 b0 = *(const LAS bf16x8*)(Ks + KSWZ(r32, cb));
        const bf16x8 b1 = *(const LAS bf16x8*)(Ks + KSWZ(32 + r32, cb));
        p0 = __builtin_amdgcn_mfma_f32_32x32x16_bf16(b0, qr[d0], p0, 0, 0, 0);
        p1 = __builtin_amdgcn_mfma_f32_32x32x16_bf16(b1, qr[d0], p1, 0, 0, 0); }
}
__device__ __forceinline__ int v_st(int k, int c) { const int kk = (k & ~0xC) | ((k & 4) << 1) | ((k & 8) >> 1); return ((kk >> 3) * 4 + (c >> 5)) * 512 + ((kk & 7) * 32 + (c & 31)) * 2; }
__device__ __forceinline__ int v_rd_base(int lane) { return ((lane & 3) << 3) | (((lane >> 2) & 3) << 6) | (((lane >> 4) & 1) << 5) | (((lane >> 5) & 1) << 8); }
constexpr int v_rd_off(int d0, int ks, int half) { return d0 * 512 + ks * 4096 + half * 2048; }
template <int OFF> __device__ __forceinline__ s16x4 tr_read(int vb) {
    s16x4 r; asm volatile("ds_read_b64_tr_b16 %0, %1 offset:%2" : "=&v"(r) : "v"(vb), "i"(OFF) : "memory"); return r;
}
template <int D0> __device__ __forceinline__ void pv_one(f32x16& od, int vb, bf16x8 pa0, bf16x8 pa1, bf16x8 pa2, bf16x8 pa3) {
    const s16x4 l0 = tr_read<v_rd_off(D0, 0, 0)>(vb), h0 = tr_read<v_rd_off(D0, 0, 1)>(vb), l1 = tr_read<v_rd_off(D0, 1, 0)>(vb), h1 = tr_read<v_rd_off(D0, 1, 1)>(vb);
    const s16x4 l2 = tr_read<v_rd_off(D0, 2, 0)>(vb), h2 = tr_read<v_rd_off(D0, 2, 1)>(vb), l3 = tr_read<v_rd_off(D0, 3, 0)>(vb), h3 = tr_read<v_rd_off(D0, 3, 1)>(vb);
    asm volatile("s_waitcnt lgkmcnt(0)" ::: "memory"); SBAR();
#define PK(L, H) (bf16x8){L[0], L[1], L[2], L[3], H[0], H[1], H[2], H[3]}
    od = __builtin_amdgcn_mfma_f32_32x32x16_bf16(pa0, PK(l0, h0), od, 0, 0, 0);
    od = __builtin_amdgcn_mfma_f32_32x32x16_bf16(pa1, PK(l1, h1), od, 0, 0, 0);
    od = __builtin_amdgcn_mfma_f32_32x32x16_bf16(pa2, PK(l2, h2), od, 0, 0, 0);
    od = __builtin_amdgcn_mfma_f32_32x32x16_bf16(pa3, PK(l3, h3), od, 0, 0, 0);
#undef PK
}
__device__ __forceinline__ void pv_d0(f32x16* o, int vb, bf16x8 pa0, bf16x8 pa1, bf16x8 pa2, bf16x8 pa3) {
    pv_one<0>(o[0], vb, pa0, pa1, pa2, pa3); pv_one<1>(o[1], vb, pa0, pa1, pa2, pa3); pv_one<2>(o[2], vb, pa0, pa1, pa2, pa3); pv_one<3>(o[3], vb, pa0, pa1, pa2, pa3);
}
__device__ __forceinline__ void mask_bias(f32x16& p0, f32x16& p1, u64 mw, bool near, const LAS float* tbk, int hi) {
    if (near) {
#pragma unroll
        for (int r = 0; r < 16; ++r) { const int b = (r & 3) + 8 * (r >> 2); p0[r] += tbk[b]; p1[r] += tbk[32 + b]; }
    }
    const unsigned lo = (unsigned)mw >> (4 * hi), hh = (unsigned)(mw >> 32) >> (4 * hi);
#pragma unroll
    for (int r = 0; r < 16; ++r) { const int b = (r & 3) + 8 * (r >> 2);
        p0[r] = ((lo >> b) & 1u) ? p0[r] : NEG; p1[r] = ((hh >> b) & 1u) ? p1[r] : NEG; }
}

template <bool SAMPLE>
__device__ __forceinline__ void attn_block(const bf16_t* __restrict__ Qg, const bf16_t* __restrict__ Kh, const bf16_t* __restrict__ Vh, const u64* __restrict__ rmq,
                                           const bf16_t* __restrict__ SGg, bf16_t* __restrict__ OGg, int NT, int qpos0, int kvh, const float* __restrict__ rel_bias, LAS char* lds) {
    int tid = threadIdx.x; asm volatile("" : "+v"(tid));
    const int wid = __builtin_amdgcn_readfirstlane(tid >> 6), lane = tid & 63, r32 = lane & 31, hi = lane >> 5;
    const int hl = wid & 3, qs = SAMPLE ? 0 : (wid >> 2), head = kvh * 4 + hl;
    LAS char* V_lds = lds; LAS char* K_lds = lds + 2 * SHM_V;
    LAS float* ws = (LAS float*)(lds + OFF_WS) + wid * 64; LAS float* li_l = ws; LAS float* al_l = ws + 32;
    LAS float* tb = (LAS float*)(lds + OFF_TB);
    for (int e = tid; e < 1024; e += NTHREADS) {
        const int h = e >> 8, rel = (e & 255) - 192, n = rel < 0 ? -rel : rel;
        int bk = n < 8 ? n : (n < 12 ? 8 : n < 16 ? 9 : n < 23 ? 10 : n < 32 ? 11 : n < 46 ? 12 : n < 64 ? 13 : n < 91 ? 14 : 15);
        if (rel > 0) bk += 16;
        tb[e] = (rel_bias[bk * 32 + kvh * 4 + h] - rel_bias[15 * 32 + kvh * 4 + h]) * (1.0f / SCALE);
    }
    {
        const u32x4* src = (const u32x4*)rmq; LAS u32x4* dst = (LAS u32x4*)(lds + OFF_MK);
        constexpr int NCH = (SAMPLE ? 32 : 64) * RMS * 8 / 16;
        for (int e = tid; e < NCH; e += NTHREADS) dst[e] = src[e];
    }
    float m_reg = MINIT, l_reg = 0; f32x16 o[4] = {}; bf16x8 qr[8];
    const int qrow = qs * 32 + r32;
    const bf16_t* Qw = Qg + (size_t)qrow * DM + head * D + hi * 8;
#pragma unroll
    for (int d0 = 0; d0 < 8; ++d0) qr[d0] = *(const bf16x8*)(Qw + d0 * 16);
    const LAS u64* rml = (const LAS u64*)(lds + OFF_MK) + qrow * RMS;
    const int sr = tid >> 4, sc = (tid & 15) * 8, vst0 = v_st(sr, sc), vst1 = v_st(32 + sr, sc);
    const int vb0 = (int)(uintptr_t)V_lds + v_rd_base(lane);
    const int tboff = hl * 256 + 192 - (qpos0 + qrow) + 4 * hi;
    struct { bf16x8 vs0, vs1, ks0, ks1; } sr_[1];
    constexpr int LDK = KVW;
#define TCL(t) ((t) < NT ? (t) : NT - 1)
#define SLOAD(i, t) do { const size_t k0_ = (size_t)TCL(t) * KVBLK; sr_[i].vs0 = *(const bf16x8*)&Vh[(k0_ + sr) * LDK + sc]; sr_[i].vs1 = *(const bf16x8*)&Vh[(k0_ + 32 + sr) * LDK + sc]; \
    sr_[i].ks0 = *(const bf16x8*)&Kh[(k0_ + sr) * LDK + sc]; sr_[i].ks1 = *(const bf16x8*)&Kh[(k0_ + 32 + sr) * LDK + sc]; } while (0)
#define SWRITE(b, i) do { *(LAS bf16x8*)(V_lds + (b) * SHM_V + vst0) = sr_[i].vs0; *(LAS bf16x8*)(V_lds + (b) * SHM_V + vst1) = sr_[i].vs1; const int kc = sc * 2;  \
    *(LAS bf16x8*)(K_lds + (b) * SHM_K + KSWZ(sr, kc)) = sr_[i].ks0; *(LAS bf16x8*)(K_lds + (b) * SHM_K + KSWZ(32 + sr, kc)) = sr_[i].ks1; } while (0)
#define SWAIT() asm volatile("s_waitcnt vmcnt(0)" ::: "memory")
#define RESC(a) do { if (__any((a) < 1.f)) { if (hi == 0) al_l[r32] = (a); asm volatile("s_waitcnt lgkmcnt(0)" ::: "memory"); \
    _Pragma("unroll") for (int d = 0; d < 4; ++d) _Pragma("unroll") for (int r = 0; r < 16; ++r) o[d][r] *= al_l[crow(r, hi)]; } } while (0)
#define MB(P0, P1, t) mask_bias(P0, P1, rml[t], (t) >= NT - 3, tb + tboff + (t) * KVBLK, hi)
    f32x16 pA0, pA1, pB0, pB1; float mnA, mnB, alA, alB; bf16x8 pa0, pa1, pa2, pa3;
    SLOAD(0, 0); asm volatile("s_waitcnt vmcnt(0)" ::: "memory"); SWRITE(0, 0); __syncthreads();
    qkt(pA0, pA1, K_lds, qr, r32, hi); MB(pA0, pA1, 0); partialSM(pA0, pA1, m_reg, mnA, alA);
    SLOAD(0, 1);
    SWAIT(); SWRITE(1, 0); __syncthreads();
    int j = 1;
    for (; j + 1 < NT; j += 2) {
        SBAR(); qkt(pB0, pB1, K_lds + SHM_K, qr, r32, hi);
        finishSM(pA0, pA1, alA, l_reg, pa0, pa1, pa2, pa3); SBAR();
        SLOAD(0, j + 1); SBAR();
        pv_d0(o, vb0, pa0, pa1, pa2, pa3); MB(pB0, pB1, j); partialSM(pB0, pB1, m_reg, mnB, alB);
        __syncthreads(); SWAIT(); SWRITE(0, 0);
        RESC(alB); __syncthreads();
        SBAR(); qkt(pA0, pA1, K_lds, qr, r32, hi);
        finishSM(pB0, pB1, alB, l_reg, pa0, pa1, pa2, pa3); SBAR();
        SLOAD(0, j + 2); SBAR();
        pv_d0(o, vb0 + (int)SHM_V, pa0, pa1, pa2, pa3); MB(pA0, pA1, j + 1); partialSM(pA0, pA1, m_reg, mnA, alA);
        __syncthreads(); SWAIT(); SWRITE(1, 0);
        RESC(alA); __syncthreads();
    }
    if (j < NT) {
        SBAR(); qkt(pB0, pB1, K_lds + SHM_K, qr, r32, hi);
        finishSM(pA0, pA1, alA, l_reg, pa0, pa1, pa2, pa3); SBAR();
        pv_d0(o, vb0, pa0, pa1, pa2, pa3); MB(pB0, pB1, j); partialSM(pB0, pB1, m_reg, mnB, alB);
        RESC(alB);
        finishSM(pB0, pB1, alB, l_reg, pa0, pa1, pa2, pa3); SBAR();
        pv_d0(o, vb0 + (int)SHM_V, pa0, pa1, pa2, pa3);
    } else {
        RESC(alA);
        finishSM(pA0, pA1, alA, l_reg, pa0, pa1, pa2, pa3); SBAR();
        pv_d0(o, vb0, pa0, pa1, pa2, pa3);
    }
    asm volatile("s_waitcnt vmcnt(0)" ::: "memory");
    if (hi == 0) li_l[r32] = l_reg; asm volatile("s_waitcnt lgkmcnt(0)" ::: "memory");
    if (!SAMPLE || wid < 4) {
#pragma unroll
        for (int r = 0; r < 16; ++r) { const int orow = qs * 32 + crow(r, hi); const float rl = __builtin_amdgcn_rcpf(li_l[crow(r, hi)]);
            const size_t off = (size_t)orow * DM + head * D + r32;
#pragma unroll
            for (int d0 = 0; d0 < 4; ++d0) { const float g = __uint_as_float((unsigned)SGg[off + d0 * 32] << 16);
                OGg[off + d0 * 32] = (bf16_t)(cvt_pk_bf16(o[d0][r] * rl * g, 0.f) & 0xffffu); }
            asm volatile("" ::: "memory"); }
    }
    __syncthreads();
#undef TCL
#undef SLOAD
#undef SWRITE
#undef SWAIT
#undef RESC
#undef MB
}
}

__global__ void __launch_bounds__(NTHREADS, 2) mega(Params p) {
    extern __shared__ __attribute__((aligned(16))) unsigned char lds_raw[];
    LAS unsigned char* lds = (LAS unsigned char*)lds_raw;
    volatile LAS unsigned* MISC = (volatile LAS unsigned*)(lds + MISC_OFF);
    const int G = gridDim.x; const int bx = blockIdx.x;
    const int vcu = (G % 8 == 0) ? (bx % 8) * (G / 8) + bx / 8 : bx;
    const int NGW = G * NWAVES;
#define PHASE_IDS() int tid = threadIdx.x; asm volatile("" : "+v"(tid)); const int lane = tid & 63, wave = __builtin_amdgcn_readfirstlane(tid >> 6), gw = vcu * NWAVES + wave; (void)lane; (void)gw
    unsigned char* ws = p.ws; float* out = p.out;
    const int lo = p.ph_lo, hi_ph = p.ph_hi;
    for (int u = threadIdx.x; u < (LDS_BYTES - RING_BYTES) / 4; u += NTHREADS) ((LAS unsigned*)(lds + RING_BYTES))[u] = 0u;
    __syncthreads();
    XcdBarrier bar; bar.bar = (unsigned*)(ws + WS_CTL) + CW_BAR; bar.x = 0; bar.st = nullptr;
    if (hi_ph - lo > 1) bar = xcd_barrier_post((unsigned*)(ws + WS_CTL) + CW_BAR, MISC + 8);
#ifndef PH_MASK
#define PH_MASK 0x7ff
#endif
#define IN(k) (((PH_MASK >> (k)) & 1) && lo <= (k) && (k) < hi_ph)
#define SEAM(k) do { if (IN(k) && IN((k) + 1)) xcd_barrier(bar); } while (0)

    if (IN(0)) {
        PHASE_IDS();
        LAS float* scr = (LAS float*)(lds + wave * 16384);
        constexpr int I_IN = 64 * 387, I_OUT = 64 * 128, I_PIN = 64 * 256, I_GRP = 4 * 16 * 32, I_POUT = 64 * 128;
        constexpr int NITEMS = I_IN + I_OUT + I_PIN + I_GRP + I_POUT;
        for (int it = gw; it < NITEMS; it += NGW) {
            int r = it;
            if (r < I_IN) { const int kb = r / 387, nb = r % 387, n0 = nb * 32;
                const int drow = n0 < 8192 ? n0 : (n0 < 8288 ? 12288 + (n0 - 8192) : 8192 + (n0 - 8288));
                transpose_item(p.attn_w_in, 12384, kb * 64, n0, (bf16_t*)(ws + WS_WT_IN), DM, drow, scr, lane); continue; } r -= I_IN;
            if (r < I_OUT) { transpose_item(p.attn_w_out, DM, (r / 128) * 64, (r % 128) * 32, (bf16_t*)(ws + WS_WT_OUT), DM, (r % 128) * 32, scr, lane); continue; } r -= I_OUT;
            if (r < I_PIN) { transpose_item(p.pool_w_in, 8192, (r / 256) * 64, (r % 256) * 32, (bf16_t*)(ws + WS_WT_PIN), DM, (r % 256) * 32, scr, lane); continue; } r -= I_PIN;
            if (r < I_GRP) { const int g = r / 512, q = r % 512;
                transpose_item(p.pool_group_w + (size_t)g * 1024 * 1024, 1024, (q / 32) * 64, (q % 32) * 32, (bf16_t*)(ws + WS_WT_GRP), 1024, g * 1024 + (q % 32) * 32, scr, lane); continue; } r -= I_GRP;
            transpose_item(p.pool_w_out, DM, (r / 128) * 64, (r % 128) * 32, (bf16_t*)(ws + WS_WT_POUT), DM, (r % 128) * 32, scr, lane);
        }
        {
            u32x4* z = (u32x4*)((bf16_t*)(ws + WS_WT_IN) + (size_t)12384 * DM);
            for (size_t i = (size_t)gw * 64 + lane; i < (size_t)160 * DM * 2 / 16; i += (size_t)NGW * 64) z[i] = (u32x4){0u, 0u, 0u, 0u};
        }
        for (int m = gw; m < MT; m += NGW)
            rms_row<false>(m < MP ? p.x_prompt + (size_t)m * DM : p.x_sample + (size_t)(m - MP) * DM, p.norm_w, (bf16_t*)(ws + WS_H) + (size_t)m * DM, lane);
        {
            const size_t gt = (size_t)gw * 64 + lane, GT = (size_t)NGW * 64;
            constexpr size_t NC8 = (size_t)DB * PAST * KVW / 8;
            for (size_t i = gt; i < 2 * NC8; i += GT) {
                const bool isv = i >= NC8; const size_t j = isv ? i - NC8 : i;
                const float* src = (isv ? p.cache_v : p.cache_k) + j * 8;
                const f32x4 a = *(const f32x4*)src, b = *(const f32x4*)(src + 4);
                const size_t row = j / (KVW / 8), c8 = j % (KVW / 8), bb = row / PAST, s = row % PAST;
                *(u32x4*)((bf16_t*)(ws + (isv ? WS_VS : WS_KS)) + (bb * SKV + s) * KVW + c8 * 8) = pack8(a, b);
            }
            constexpr size_t NZ8 = (size_t)DB * 32 * KVW / 8;
            for (size_t i = gt; i < 2 * NZ8; i += GT) {
                const bool isv = i >= NZ8; const size_t j = isv ? i - NZ8 : i;
                const size_t row = j / (KVW / 8), c8 = j % (KVW / 8), bb = row / 32, s = 4128 + row % 32;
                *(u32x4*)((bf16_t*)(ws + (isv ? WS_VS : WS_KS)) + (bb * SKV + s) * KVW + c8 * 8) = (u32x4){0u, 0u, 0u, 0u};
            }
            constexpr size_t NK8 = (size_t)DB * SKV * DIDX / 8;
            for (size_t i = gt; i < NK8; i += GT) {
                const size_t row = i / 8, c8 = i % 8, bb = row / SKV, s = row % SKV;
                if (s >= (size_t)PAST && s < (size_t)PAST + DSQ) continue;
                u32x4 w = (u32x4){0u, 0u, 0u, 0u};
                if (s < (size_t)PAST) { const float* src = p.cache_kidx + (bb * PAST + s) * DIDX + c8 * 8; w = pack8(*(const f32x4*)src, *(const f32x4*)(src + 4)); }
                *(u32x4*)((bf16_t*)(ws + WS_KIS) + bb * SKV * DIDX + kif_off((int)s, (int)c8 * 8)) = w;
            }
        }
    }
    SEAM(0);
    if (IN(1)) {
        pg8::Gemm g{(const bf16_t*)(ws + WS_H), (const bf16_t*)(ws + WS_WT_IN), MT, N1, DM, DM, DM, 0};
        pg8::StaticOrder S; S.init(MT, N1, G, bx);
        Epi1 E{ws, out};
        pg8::gemm_phase<Epi1>(lds, g, S, E);
    }
    SEAM(1);
    if (IN(2)) {
        PHASE_IDS();
        u64* RM = (u64*)(ws + WS_RM);
        for (int pi = gw; pi < 2048; pi += NGW) {
#pragma unroll 1
            for (int k = 0; k < 8; ++k) {
                const int b = k >> 1, t = (k & 1) ? 4095 - pi : pi, m = b * SEQ + t;
                select_query((const bf16_t*)(ws + WS_QIB) + (size_t)m * QIW, (const float*)(ws + WS_WIB) + (size_t)m * HIDX,
                             (const bf16_t*)(ws + WS_KIP) + (size_t)b * SEQ * DIDX, (t >> 6) + 1, false, RM + (size_t)m * RMS, lane);
            }
            if ((pi & 1) == 0) { const int s = pi >> 1, m = MP + s, b = s >> 5;
                select_query((const bf16_t*)(ws + WS_QIB) + (size_t)m * QIW, (const float*)(ws + WS_WIB) + (size_t)m * HIDX,
                             (const bf16_t*)(ws + WS_KIS) + (size_t)b * SKV * DIDX, 65, true, RM + (size_t)m * RMS, lane); }
        }
    }
    SEAM(2);
    if (IN(3)) {
        const u64* RM = (const u64*)(ws + WS_RM);
        const bf16_t* QB = (const bf16_t*)(ws + WS_QB); const bf16_t* SG = (const bf16_t*)(ws + WS_SG); bf16_t* OG = (bf16_t*)(ws + WS_OG);
        for (int it = vcu; it < 1280; it += G) {
            if (it < 1024) {
                const int b = it >> 8, kvh = (it >> 5) & 7, pr = it & 31;
                const bf16_t* Kh = (const bf16_t*)(ws + WS_KP) + (size_t)b * SEQ * KVW + kvh * 128; const bf16_t* Vh = (const bf16_t*)(ws + WS_VP) + (size_t)b * SEQ * KVW + kvh * 128;
#pragma unroll 1
                for (int half = 0; half < 2; ++half) {
                    const int c = half ? 63 - pr : pr; const size_t m0 = (size_t)b * SEQ + c * 64;
                    att::attn_block<false>(QB + m0 * DM, Kh, Vh, RM + m0 * RMS, SG + m0 * DM, OG + m0 * DM, c + 1, c * 64, kvh, p.rel_bias, (LAS char*)lds);
                }
            } else {
                const int s = it - 1024, b = s >> 3, kvh = s & 7; const size_t m0 = (size_t)MP + b * 32;
                const bf16_t* Kh = (const bf16_t*)(ws + WS_KS) + (size_t)b * SKV * KVW + kvh * 128; const bf16_t* Vh = (const bf16_t*)(ws + WS_VS) + (size_t)b * SKV * KVW + kvh * 128;
                att::attn_block<true>(QB + m0 * DM, Kh, Vh, RM + m0 * RMS, SG + m0 * DM, OG + m0 * DM, 65, PAST, kvh, p.rel_bias, (LAS char*)lds);
            }
        }
    }
    SEAM(3);
    if (IN(4)) {
        pg8::Gemm g{(const bf16_t*)(ws + WS_OG), (const bf16_t*)(ws + WS_WT_OUT), MT, DM, DM, DM, DM, 0};
        pg8::StaticOrder S; S.init(MT, DM, G, bx);
        EpiRes E{p.x_prompt, p.x_sample, nullptr, (float*)(ws + WS_X1)};
        pg8::gemm_phase<EpiRes>(lds, g, S, E);
    }
    SEAM(4);
    if (IN(5)) {
        PHASE_IDS();
        for (int m = gw; m < MT; m += NGW) rms_row<false>((const float*)(ws + WS_X1) + (size_t)m * DM, p.norm_w + DM, (bf16_t*)(ws + WS_H) + (size_t)m * DM, lane);
        {
            bf16_t* U = (bf16_t*)(ws + WS_U);
            constexpr int NPAD = (NBATCH + DB) * 16 * 512;
            for (int i = gw * 64 + lane; i < NPAD; i += NGW * 64) {
                const int c = (i & 511) * 8, rr = i >> 9, sq = rr >> 4, k = rr & 15;
                u32x4 o = (u32x4){0u, 0u, 0u, 0u}; size_t row;
                if (sq < NBATCH) row = (size_t)sq * UP_SEQ + k;
                else { const int b = sq - NBATCH; row = (size_t)UP_ROWS + (size_t)b * US_SEQ + k;
                    if (k >= 1) { const float* hp = p.state_pool + ((size_t)b * 15 + (k - 1)) * DM + c; o = pack8(*(const f32x4*)hp, *(const f32x4*)(hp + 4)); } }
                *(u32x4*)(U + row * DM + c) = o;
            }
        }
    }
    SEAM(5);
    if (IN(6)) {
        pg8::Gemm g{(const bf16_t*)(ws + WS_H), (const bf16_t*)(ws + WS_WT_PIN), MT, 8192, DM, DM, DM, 0};
        pg8::StaticOrder S; S.init(MT, 8192, G, bx);
        Epi3 E{ws, out};
        pg8::gemm_phase<Epi3>(lds, g, S, E);
    }
    SEAM(6);
    if (IN(7)) {
        PHASE_IDS();
        const bf16_t* __restrict__ U = (const bf16_t*)(ws + WS_U); bf16_t* __restrict__ MX = (bf16_t*)(ws + WS_MX);
        constexpr int RUN = 32, NRUN_P = MP / RUN, NITEM = (NRUN_P + DB) * 512;
        const int gt = gw * 64 + lane, GT = NGW * 64;
#define ACC8(S, X, SGN) do { S[0] += SGN bf_lo(X.x); S[1] += SGN bf_hi(X.x); S[2] += SGN bf_lo(X.y); S[3] += SGN bf_hi(X.y); S[4] += SGN bf_lo(X.z); S[5] += SGN bf_hi(X.z); S[6] += SGN bf_lo(X.w); S[7] += SGN bf_hi(X.w); } while (0)
        for (int i = gt; i < NITEM; i += GT) {
            const int run = i >> 9, c = (i & 511) * 8, w = 2 << (c >> 10);
            const bool samp = run >= NRUN_P;
            const int m0 = samp ? MP + (run - NRUN_P) * 32 : run * RUN;
            const int t0 = samp ? 0 : (m0 & 4095);
            const bf16_t* up = U + (size_t)u_row(m0) * DM + c;
            float s[8] = {0.f, 0.f, 0.f, 0.f, 0.f, 0.f, 0.f, 0.f};
            for (int k = 1; k <= w; ++k) { const u32x4 x = *(const u32x4*)(up - (size_t)k * DM); ACC8(s, x, +); }
            const float icw = 1.0f / (float)w;
#pragma unroll 1
            for (int tb = 0; tb < RUN; tb += 8) {
                u32x4 cur[8], old[8];
#pragma unroll
                for (int q = 0; q < 8; ++q) { cur[q] = *(const u32x4*)(up + (size_t)(tb + q) * DM); old[q] = *(const u32x4*)(up + ((ptrdiff_t)(tb + q) - w) * DM); }
#pragma unroll
                for (int q = 0; q < 8; ++q) {
                    const int t = t0 + tb + q;
                    ACC8(s, cur[q], +); ACC8(s, old[q], -);
                    const float ic = (samp || t + 1 >= w) ? icw : 1.0f / (float)(t + 1);
                    const float f[8] = {bf_lo(cur[q].x), bf_hi(cur[q].x), bf_lo(cur[q].y), bf_hi(cur[q].y), bf_lo(cur[q].z), bf_hi(cur[q].z), bf_lo(cur[q].w), bf_hi(cur[q].w)};
                    u32x4 o;
                    o.x = cvt_pk_bf16(s[0] * ic - f[0], s[1] * ic - f[1]); o.y = cvt_pk_bf16(s[2] * ic - f[2], s[3] * ic - f[3]);
                    o.z = cvt_pk_bf16(s[4] * ic - f[4], s[5] * ic - f[5]); o.w = cvt_pk_bf16(s[6] * ic - f[6], s[7] * ic - f[7]);
                    *(u32x4*)(MX + (size_t)(m0 + tb + q) * DM + c) = o;
                }
            }
        }
#undef ACC8
    }
    SEAM(7);
    if (IN(8)) {
        pg8::Gemm g{(const bf16_t*)(ws + WS_MX), (const bf16_t*)(ws + WS_WT_GRP), MT, DM, 1024, DM, 1024, 1};
        pg8::StaticOrder S; S.init(MT, DM, G, bx);
        Epi4 E{ws, p.pool_scale};
        pg8::gemm_phase<Epi4>(lds, g, S, E);
    }
    SEAM(8);
    if (IN(9)) {
        pg8::Gemm g{(const bf16_t*)(ws + WS_ZG), (const bf16_t*)(ws + WS_WT_POUT), MT, DM, DM, DM, DM, 0};
        pg8::StaticOrder S; S.init(MT, DM, G, bx);
        EpiRes E{nullptr, nullptr, (const float*)(ws + WS_X1), (float*)(ws + WS_X1)};
        pg8::gemm_phase<EpiRes>(lds, g, S, E);
    }
    SEAM(9);
    if (IN(10)) {
        PHASE_IDS();
        for (int m = gw; m < MT; m += NGW) rms_row<true>((const float*)(ws + WS_X1) + (size_t)m * DM, p.final_norm_w, out + (m < MP ? O_YP + (size_t)m * DM : O_YS + (size_t)(m - MP) * DM), lane);
    }
#undef IN
#undef SEAM
}

#ifndef MK_N_LAUNCHES
#define MK_N_LAUNCHES 1
#endif
extern "C" void kernel_launch(void* const* d_in, const int* in_sizes, int n_in, void* d_out, int out_size, void* d_ws, size_t ws_size, hipStream_t stream) {
    static int grid = 0;
    if (grid == 0) {
        if (n_in != 15 || (size_t)out_size != O_END || ws_size < WS_END) { fprintf(stderr, "kernel_launch: unexpected shapes: n_in %d out %d ws %zu (need >= %zu)\n", n_in, out_size, ws_size, (size_t)WS_END); grid = -1; return; }
        int dev = 0, cus = 0, per_cu = 0;
        if (hipGetDevice(&dev) != hipSuccess || hipDeviceGetAttribute(&cus, hipDeviceAttributeMultiprocessorCount, dev) != hipSuccess) { grid = -1; return; }
        if (hipFuncSetAttribute((const void*)mega, hipFuncAttributeMaxDynamicSharedMemorySize, LDS_BYTES) != hipSuccess) { fprintf(stderr, "kernel_launch: hipFuncSetAttribute failed\n"); grid = -1; return; }
        if (hipOccupancyMaxActiveBlocksPerMultiprocessor(&per_cu, (const void*)mega, NTHREADS, LDS_BYTES) != hipSuccess || per_cu < 1) { fprintf(stderr, "kernel_launch: occupancy query says %d\n", per_cu); }
        (void)hipGetLastError();
        grid = cus;
    }
    if (grid < 0) return;
    if (hipMemsetAsync((char*)d_ws + WS_CTL, 0, CTL_ZERO_BYTES, stream) != hipSuccess) return;
    Params p{};
    p.x_prompt = (const float*)d_in[0]; p.x_sample = (const float*)d_in[1]; p.cache_k = (const float*)d_in[2]; p.cache_v = (const float*)d_in[3];
    p.cache_kidx = (const float*)d_in[4]; p.state_pool = (const float*)d_in[5]; p.norm_w = (const float*)d_in[6]; p.final_norm_w = (const float*)d_in[7];
    p.attn_w_in = (const float*)d_in[8]; p.attn_w_out = (const float*)d_in[9]; p.rel_bias = (const float*)d_in[10]; p.pool_w_in = (const float*)d_in[11];
    p.pool_group_w = (const float*)d_in[12]; p.pool_scale = (const float*)d_in[13]; p.pool_w_out = (const float*)d_in[14];
    p.out = (float*)d_out; p.ws = (unsigned char*)d_ws;
    if (MK_N_LAUNCHES == 1) { p.ph_lo = 0; p.ph_hi = NPHASE; hipLaunchKernelGGL(mega, dim3(grid), dim3(NTHREADS), LDS_BYTES, stream, p); }
    else for (int k = 0; k < NPHASE; ++k) { p.ph_lo = k; p.ph_hi = k + 1; hipLaunchKernelGGL(mega, dim3(grid), dim3(NTHREADS), LDS_BYTES, stream, p); }
#ifdef PROBE_PHASE
    { p.ph_lo = PROBE_PHASE; p.ph_hi = PROBE_PHASE + 1; hipLaunchKernelGGL(mega, dim3(grid), dim3(NTHREADS), LDS_BYTES, stream, p); }
#endif
    const hipError_t le = hipPeekAtLastError();
    if (le != hipSuccess) fprintf(stderr, "kernel_launch: launch failed: %s\n", hipGetErrorName(le));
}
```

```cpp
#include <hip/hip_runtime.h>
#include <cstdio>
#include <cstdint>

#define LAS __attribute__((address_space(3)))
typedef unsigned short bf16_t;
typedef short bf16x8 __attribute__((ext_vector_type(8)));
typedef short s16x4 __attribute__((ext_vector_type(4)));
typedef float f32x4 __attribute__((ext_vector_type(4)));
typedef float f32x16 __attribute__((ext_vector_type(16)));
typedef unsigned u32x4 __attribute__((ext_vector_type(4)));
typedef unsigned u32x2 __attribute__((ext_vector_type(2)));
typedef unsigned long long u64;
typedef int i32x4 __attribute__((ext_vector_type(4)));

constexpr int DM = 4096, NBATCH = 4, SEQ = 4096, DB = 32, DSQ = 32, PAST = 4096;
constexpr int MP = NBATCH * SEQ, MS = DB * DSQ, MT = MP + MS;
constexpr int KVW = 1024, QIW = 2048, DIDX = 64, HIDX = 32, NKVH = 8;
constexpr int N1 = 12544;
constexpr int SKV = 4160;
constexpr int RMS = 65;
constexpr float EPS = 1e-6f;
constexpr int NWAVES = 8, NTHREADS = 512;
constexpr int NPHASE = 15;

constexpr size_t O_YP = 0, O_YS = 67108864, O_KP = 71303168, O_VP = 88080384, O_KIP = 104857600, O_POOLP = 105906176,
                 O_KS = 106151936, O_VS = 107200512, O_KIS = 108249088, O_POOLS = 108314624, O_END = 110280704;

constexpr size_t MiB = 1u << 20;
constexpr size_t WS_CTL = 0, CTL_ZERO_BYTES = 1 * MiB;
constexpr size_t WS_WT_IN = 1 * MiB, WS_WT_OUT = 99 * MiB, WS_WT_PIN = 131 * MiB, WS_WT_GRP = 195 * MiB, WS_WT_POUT = 203 * MiB;
constexpr size_t WS_H = 235 * MiB, WS_QB = 371 * MiB, WS_KP = 507 * MiB, WS_VP = 539 * MiB, WS_KS = 571 * MiB, WS_VS = 831 * MiB;
constexpr size_t WS_QIB = 1091 * MiB, WS_KIP = 1159 * MiB, WS_KIS = 1161 * MiB, WS_WIB = 1178 * MiB, WS_SG = 1181 * MiB, WS_RM = 1317 * MiB;
constexpr size_t WS_OG = 1326 * MiB, WS_X1 = 1462 * MiB, WS_SC = 1734 * MiB, WS_END = 2011 * MiB;
constexpr int SCW = 4160;
constexpr size_t WS_KSN = WS_KS, WS_VSN = WS_KS + 2 * MiB;
constexpr size_t WS_U = WS_QB, WS_SG2 = WS_SG, WS_MX = WS_OG, WS_ZG = WS_VS;
constexpr size_t WS_SS1 = WS_CTL + 256 * 1024;
constexpr size_t WS_PS = 600 * MiB;
constexpr size_t WS_H8 = 664 * MiB, WS_WT8 = 131 * MiB;
constexpr size_t WS_CAMAX = WS_CTL + 384 * 1024, WS_SB = WS_CTL + 448 * 1024, WS_SA = WS_CTL + 512 * 1024;
constexpr size_t WS_WP8 = 764 * MiB;
constexpr size_t WS_CAMAX2 = WS_CTL + 640 * 1024, WS_SB2 = WS_CTL + 704 * 1024, WS_ROWF = WS_CTL + 768 * 1024;
constexpr size_t WS_WO8 = 796 * MiB, WS_WPO8 = 812 * MiB;
constexpr size_t WS_CAMAX3 = WS_CTL + 848 * 1024, WS_CAMAX4 = WS_CTL + 864 * 1024, WS_SB3 = WS_CTL + 880 * 1024, WS_SB4 = WS_CTL + 896 * 1024;
constexpr int NB16 = 2304;
constexpr int NI8 = 10240;
constexpr int CW_BAR = 4096;

constexpr int LDS_BYTES = 147456, RING_BYTES = 131072, MISC_OFF = RING_BYTES + 320;

__device__ __forceinline__ unsigned cvt_pk_bf16(float lo, float hi) { unsigned r; asm("v_cvt_pk_bf16_f32 %0, %1, %2" : "=v"(r) : "v"(lo), "v"(hi)); return r; }
__device__ __forceinline__ float bf_lo(unsigned w) { return __uint_as_float(w << 16); }
__device__ __forceinline__ float bf_hi(unsigned w) { return __uint_as_float(w & 0xffff0000u); }
__device__ __forceinline__ float fma_abs(float a, float b, float c) { float d; asm("v_fma_f32 %0, %1, |%2|, %3" : "=v"(d) : "v"(a), "v"(b), "v"(c)); return d; }
__device__ __forceinline__ float silu_f(float x) { return x * __builtin_amdgcn_rcpf(1.0f + __builtin_amdgcn_exp2f(-1.4426950408889634f * x)); }
__device__ __forceinline__ float wave_sum(float v) {
#pragma unroll
    for (int o = 1; o < 64; o <<= 1) v += __shfl_xor(v, o);
    return v;
}
#define LDS_WAIT() asm volatile("s_waitcnt lgkmcnt(0)" ::: "memory")
#define VM_WAIT() asm volatile("s_waitcnt vmcnt(0)" ::: "memory")

#define XB_TMO      128
#define XB_XCNT(j)  (256  + 64 * (j))
#define XB_XSUB(j)  (1280 + 64 * (j))
#define XB_XGEN(j)  (2304 + 64 * (j))
#define XB_TOP      3328
#define XB_TOPGEN   3392
#define XCD_BAR_WORDS 3456
#define XB_SPIN_CAP (1u << 18)
__device__ __forceinline__ unsigned xb_ld(unsigned* p)              { return __hip_atomic_load(p, __ATOMIC_RELAXED, __HIP_MEMORY_SCOPE_AGENT); }
__device__ __forceinline__ unsigned xb_add(unsigned* p, unsigned v) { return __hip_atomic_fetch_add(p, v, __ATOMIC_RELAXED, __HIP_MEMORY_SCOPE_AGENT); }
__device__ __forceinline__ unsigned xb_xcc_id() { return (unsigned)__builtin_amdgcn_s_getreg((3 << 11) | 20) & 0xFu; }
#define XB_SPIN(cond, bar) do { unsigned _sp = 0; while (cond) { __builtin_amdgcn_s_sleep(1); \
    if ((++_sp & 255u) == 0u) { if (xb_ld(&(bar)[XB_TMO])) break; if (_sp > XB_SPIN_CAP) { atomicAdd(&(bar)[XB_TMO], 1u); break; } } } } while (0)
struct XcdBarrier { unsigned* bar; unsigned x; volatile LAS unsigned* st; };
__device__ __forceinline__ XcdBarrier xcd_barrier_post(unsigned* bar, volatile LAS unsigned* st) {
    XcdBarrier b; b.bar = bar; b.x = xb_xcc_id(); b.st = st;
    if (threadIdx.x == 0) (void)xb_add(&bar[XB_XCNT(b.x)], 1u);
    return b;
}
__device__ __forceinline__ void xcd_barrier_complete(unsigned* bar, unsigned x, unsigned& nloc, unsigned& nx) {
    const unsigned G = gridDim.x * gridDim.y * gridDim.z;
    unsigned sum, cnt, mine, sp = 0u;
    for (;;) {
        sum = 0u; cnt = 0u; mine = 0u;
#pragma unroll
        for (unsigned j = 0; j < 16; ++j) { const unsigned c = xb_ld(&bar[XB_XCNT(j)]); sum += c; cnt += (c > 0u) ? 1u : 0u; mine = (j == x) ? c : mine; }
        if (sum == G) break;
        __builtin_amdgcn_s_sleep(1);
        if ((++sp & 255u) == 0u) { if (xb_ld(&bar[XB_TMO])) break; if (sp > XB_SPIN_CAP) { atomicAdd(&bar[XB_TMO], 1u); break; } }
    }
    nloc = mine > 0u ? mine : 1u; nx = cnt > 0u ? cnt : 1u;
}
__device__ __forceinline__ void xcd_barrier(const XcdBarrier& b) {
    asm volatile("s_waitcnt vmcnt(0)" ::: "memory");
    __syncthreads();
    if (threadIdx.x == 0) {
        unsigned* bar = b.bar;
        __builtin_amdgcn_s_waitcnt(0);
        unsigned nloc = b.st[0], nx = b.st[1];
        if (nloc == 0u) { xcd_barrier_complete(bar, b.x, nloc, nx); b.st[0] = nloc; b.st[1] = nx; }
        const unsigned old = xb_add(&bar[XB_XSUB(b.x)], 1u);
        const unsigned gen = old / nloc;
        if (old + 1u == (gen + 1u) * nloc) {
            __builtin_amdgcn_fence(__ATOMIC_RELEASE, "agent");
            asm volatile("s_waitcnt vmcnt(0)" ::: "memory");
            const unsigned og = xb_add(&bar[XB_TOP], 1u);
            const unsigned tg = og / nx;
            if (og + 1u == (tg + 1u) * nx) xb_add(&bar[XB_TOPGEN], 1u);
            else XB_SPIN(xb_ld(&bar[XB_TOPGEN]) == tg, bar);
            __builtin_amdgcn_fence(__ATOMIC_ACQUIRE, "agent");
            xb_add(&bar[XB_XGEN(b.x)], 1u);
            asm volatile("s_waitcnt vmcnt(0)" ::: "memory");
        } else {
            XB_SPIN(xb_ld(&bar[XB_XGEN(b.x)]) == gen, bar);
            __builtin_amdgcn_fence(__ATOMIC_ACQUIRE, "agent");
            asm volatile("s_waitcnt vmcnt(0)" ::: "memory");
        }
    }
    __syncthreads();
}

namespace pg8 {
constexpr int BM = 256, BK = 64, HALF = 128, HTB = HALF * BK * 2, STAGE_BYTES = 8 * HTB, NXCD = 8, WGM = 8;
__host__ __device__ __forceinline__ int lds_byte(int r, int c) { const int st = (r >> 4) * 2 + (c >> 5), rr = r & 15, cc = c & 31, ob = rr * 64 + cc * 2; return st * 1024 + (ob ^ (((ob >> 9) & 1) << 5)); }
__host__ __device__ __forceinline__ void stage_rc(int b, int& R, int& C) { const int st = b / 1024, sb = b % 1024, swz = sb ^ (((sb >> 9) & 1) << 5); R = (st >> 1) * 16 + swz / 64; C = (st & 1) * 32 + (swz % 64) / 2; }
__host__ __device__ __forceinline__ int perm32(int rho) { const int n = rho >> 4, i = rho & 15; return 8 * (i >> 2) + 4 * n + (i & 3); }
struct Unit { int pm, pn, kq, half; };
struct Gemm { const bf16_t* A; const bf16_t* Bt; int M, N, K, lda, ldb, grouped; };
struct Order {
    int nM, nN, nfull, ntail, mode, G, c, qf, rf;
    __device__ void init(int nM_, int nN_, int ntail_, int mode_, int G_, int c_) { nM = nM_; nN = nN_; nfull = nM * nN; ntail = ntail_; mode = mode_; G = G_; c = c_;
        qf = __builtin_amdgcn_readfirstlane(nfull / G); rf = __builtin_amdgcn_readfirstlane(nfull % G); }
    __device__ bool next(int i, Unit& u) const {
        const long L = (long)i * G + c;
        if (L < nfull) {
            int wgid = (int)L; { const int q = nfull / NXCD, r = nfull % NXCD, xcd = wgid % NXCD, off = wgid / NXCD; wgid = (xcd < r ? xcd * (q + 1) : r * (q + 1) + (xcd - r) * q) + off; }
            const int nig = WGM * nN, gid = wgid / nig, fm = gid * WGM, gsz = (nM - fm) < WGM ? (nM - fm) : WGM;
            u.pm = fm + ((wgid % nig) % gsz); u.pn = (wgid % nig) / gsz; u.kq = -1; u.half = 0; return true;
        }
        int r = rf, q = qf, gr = G - rf, cc = c, ii = i; asm volatile("" : "+s"(r), "+s"(q), "+s"(gr), "+s"(cc), "+s"(ii));
        if (cc < r || ii < q) return false;
        const int e = (ii - q) * gr + (cc - r);
        if (e >= ntail) return false;
        if (mode == 1) { u.pm = e; u.pn = nN; u.kq = -1; u.half = 1; }
        else { const int t = e >> 2; u.pm = nM + (t >> 4); u.pn = t & 15; u.kq = e & 3; u.half = 0; }
        return true;
    }
};

template <class Epi, bool HALFCAP = false, bool I8 = false, bool ALIGN_EPI = true>
__device__ __forceinline__ void gemm_phase(LAS unsigned char* lds, const Gemm g, const Order& S, const Epi& E) {
    int tid = threadIdx.x; asm volatile("" : "+v"(tid));
    const int wid = __builtin_amdgcn_readfirstlane(tid >> 6), lane = tid & 63, wr = wid >> 2, wc = wid & 3, fr = lane & 15, fq = lane >> 4;
    const int K = g.K, ntf = K / BK;
    unsigned voffA[2], voffB[2];
#pragma unroll
    for (int i = 0; i < 2; ++i) { int R, C; stage_rc(tid * 16 + i * 8192, R, C); const int Rb = Epi::PERM ? ((R & ~31) + perm32(R & 31)) : R;
        voffA[i] = (unsigned)(R * g.lda + C) * 2u; voffB[i] = (unsigned)(Rb * g.ldb + C) * 2u; }
    const size_t kstep = (size_t)(BK * 2);
    const size_t hstepA = (size_t)HALF * g.lda * 2, hstepB = (size_t)HALF * g.ldb * 2;
    const size_t tstepA = 2 * hstepA, tstepB = 2 * hstepB;
    const unsigned ldsw = (unsigned)wid * 1024u;
    const int aoff = lds_byte(wr * 64 + fr, fq * 8), boff = lds_byte(wc * 32 + fr, fq * 8);
#define PG8_SA(b, h) (((b) * 2 + (h)) * HTB)
#define PG8_SB(b, h) ((4 + (b) * 2 + (h)) * HTB)
#define PG8_STAGE(bufoff, gbase, voff) do { _Pragma("unroll") for (int _i = 0; _i < 2; ++_i) \
        __builtin_amdgcn_global_load_lds((const unsigned*)((const char*)(gbase) + (voff)[_i]), (LAS unsigned*)(lds + (bufoff) + ldsw + _i * 8192), 16, 0, 0); } while (0)
#define PG8_LDA(dst, b, h) do { _Pragma("unroll") for (int m = 0; m < 4; ++m) _Pragma("unroll") for (int k = 0; k < 2; ++k) dst[m][k] = *(const LAS bf16x8*)(lds + PG8_SA(b, h) + aoff + m * 2048 + k * 1024); } while (0)
#define PG8_LDB(dst, b, h) do { _Pragma("unroll") for (int n = 0; n < 2; ++n) _Pragma("unroll") for (int k = 0; k < 2; ++k) dst[n][k] = *(const LAS bf16x8*)(lds + PG8_SB(b, h) + boff + n * 2048 + k * 1024); } while (0)
#define PG8_MMA(ai, bj, At, Bt) do { __builtin_amdgcn_s_setprio(1); _Pragma("unroll") for (int m = 0; m < 4; ++m) _Pragma("unroll") for (int n = 0; n < 2; ++n) _Pragma("unroll") for (int k = 0; k < 2; ++k) \
        { if constexpr (I8) acc[ai][bj][m][n] = __builtin_bit_cast(f32x4, __builtin_amdgcn_mfma_i32_16x16x64_i8(__builtin_bit_cast(i32x4, Bt[n][k]), __builtin_bit_cast(i32x4, At[m][k]), __builtin_bit_cast(i32x4, acc[ai][bj][m][n]), 0, 0, 0)); \
          else acc[ai][bj][m][n] = __builtin_amdgcn_mfma_f32_16x16x32_bf16(Bt[n][k], At[m][k], acc[ai][bj][m][n], 0, 0, 0); } __builtin_amdgcn_s_setprio(0); } while (0)
#define PG8_MMA1(ai, At, Bt) do { if (!HALFCAP || full) PG8_MMA(ai, 1, At, Bt); } while (0)
#define PG8_WAIT_V(n) asm volatile("s_waitcnt vmcnt(" #n ")" ::: "memory")
#define PG8_WAIT_L(n) asm volatile("s_waitcnt lgkmcnt(" #n ")" ::: "memory")
#define PG8_BAR __builtin_amdgcn_s_barrier()
#define PG8_SCHED __builtin_amdgcn_sched_barrier(0)
#define PG8_KOFF(u) ((u).kq < 0 ? (size_t)0 : (size_t)(u).kq * (size_t)(K / 4) * 2)
#define PG8_APTR(u) ((const char*)g.A + (size_t)(u).pm * tstepA + (g.grouped ? (size_t)((u).pn >> 2) * (size_t)K * 2 : (size_t)0) + PG8_KOFF(u))
#define PG8_BPTR(u) ((const char*)g.Bt + (size_t)(u).pn * tstepB + PG8_KOFF(u))
    Unit cur, nxt; int ui = 0;
    if (!S.next(0, cur)) return;
    f32x4 acc[2][2][4][2];
#pragma unroll
    for (int a = 0; a < 2; ++a)
#pragma unroll
        for (int b = 0; b < 2; ++b)
#pragma unroll
            for (int m = 0; m < 4; ++m)
#pragma unroll
                for (int n = 0; n < 2; ++n) acc[a][b][m][n] = (f32x4){0.f, 0.f, 0.f, 0.f};
    bf16x8 At[4][2], B0[2][2], B1[2][2];
    const char* cA = PG8_APTR(cur); const char* cB = PG8_BPTR(cur);
    PG8_STAGE(PG8_SB(0, 0), cB, voffB); PG8_STAGE(PG8_SB(0, 1), cB + hstepB, voffB); PG8_STAGE(PG8_SA(0, 0), cA, voffA); PG8_STAGE(PG8_SA(0, 1), cA + hstepA, voffA);
    if (wr == 1) PG8_BAR;
    PG8_WAIT_V(2); PG8_BAR;
    PG8_STAGE(PG8_SB(1, 0), cB + kstep, voffB); PG8_STAGE(PG8_SA(1, 0), cA + kstep, voffA); PG8_STAGE(PG8_SB(1, 1), cB + hstepB + kstep, voffB);
    PG8_WAIT_V(6); PG8_BAR;
    for (;;) {
        const bool has_next = S.next(ui + 1, nxt);
        const char* nA = has_next ? PG8_APTR(nxt) : cA; const char* nB = has_next ? PG8_BPTR(nxt) : cB;
        const int nt = cur.kq < 0 ? ntf : ntf / 4; const bool full = !cur.half; (void)full;
        for (int t = 0; t < nt; t += 2) {
            const bool last = (t == nt - 2);
            const char* a1 = cA + (size_t)(t + 1) * kstep;
            const char* a2 = last ? nA : cA + (size_t)(t + 2) * kstep; const char* b2 = last ? nB : cB + (size_t)(t + 2) * kstep;
            const char* a3 = a2 + kstep; const char* b3 = b2 + kstep;
            PG8_LDB(B0, 0, 0); PG8_LDB(B1, 0, 1); PG8_SCHED; PG8_LDA(At, 0, 0); PG8_STAGE(PG8_SA(1, 1), a1 + hstepA, voffA);
            PG8_WAIT_V(8); PG8_WAIT_L(0); PG8_BAR; PG8_MMA(0, 0, At, B0); PG8_MMA1(0, At, B1); PG8_BAR; PG8_SCHED;
            PG8_LDA(At, 0, 1); PG8_STAGE(PG8_SB(0, 0), b2, voffB); PG8_STAGE(PG8_SB(0, 1), b2 + hstepB, voffB); PG8_STAGE(PG8_SA(0, 0), a2, voffA);
            PG8_WAIT_V(8); PG8_WAIT_L(0); PG8_BAR; PG8_MMA(1, 0, At, B0); PG8_MMA1(1, At, B1); PG8_BAR; PG8_SCHED;
            PG8_LDB(B0, 1, 0); PG8_LDB(B1, 1, 1); PG8_SCHED; PG8_LDA(At, 1, 0); PG8_STAGE(PG8_SA(0, 1), a2 + hstepA, voffA);
            PG8_WAIT_V(8); PG8_WAIT_L(0); PG8_BAR; PG8_MMA(0, 0, At, B0); PG8_MMA1(0, At, B1); PG8_BAR; PG8_SCHED;
            PG8_LDA(At, 1, 1); PG8_STAGE(PG8_SB(1, 0), b3, voffB); PG8_STAGE(PG8_SB(1, 1), b3 + hstepB, voffB); PG8_STAGE(PG8_SA(1, 0), a3, voffA);
            PG8_WAIT_V(8); PG8_WAIT_L(0); PG8_BAR; PG8_MMA(1, 0, At, B0); PG8_MMA1(1, At, B1); PG8_BAR; PG8_SCHED;
        }
        if constexpr (ALIGN_EPI) { if (wr == 0) PG8_BAR; }
        E(acc, cur, wr, wc, fr, fq);
        if (!has_next) break;
#pragma unroll
        for (int a = 0; a < 2; ++a)
#pragma unroll
            for (int b = 0; b < 2; ++b)
#pragma unroll
                for (int m = 0; m < 4; ++m)
#pragma unroll
                    for (int n = 0; n < 2; ++n) acc[a][b][m][n] = (f32x4){0.f, 0.f, 0.f, 0.f};
        cur = nxt; cA = nA; cB = nB; ++ui;
        if constexpr (ALIGN_EPI) { if (wr == 1) PG8_BAR; }
    }
    PG8_WAIT_V(0);
    if constexpr (!ALIGN_EPI) { if (wr == 0) PG8_BAR; }
    PG8_BAR;
#undef PG8_SA
#undef PG8_SB
#undef PG8_STAGE
#undef PG8_LDA
#undef PG8_LDB
#undef PG8_MMA
#undef PG8_MMA1
#undef PG8_WAIT_V
#undef PG8_WAIT_L
#undef PG8_BAR
#undef PG8_SCHED
#undef PG8_KOFF
#undef PG8_APTR
#undef PG8_BPTR
}
}

struct Params {
    const float *x_prompt, *x_sample, *cache_k, *cache_v, *cache_kidx, *state_pool, *norm_w, *final_norm_w, *attn_w_in, *attn_w_out, *rel_bias,
                *pool_w_in, *pool_group_w, *pool_scale, *pool_w_out;
    float* out; unsigned char* ws; int ph_lo, ph_hi;
};

__device__ __forceinline__ u32x4 pack8(const f32x4 a, const f32x4 b) { u32x4 w; w.x = cvt_pk_bf16(a[0], a[1]); w.y = cvt_pk_bf16(a[2], a[3]); w.z = cvt_pk_bf16(b[0], b[1]); w.w = cvt_pk_bf16(b[2], b[3]); return w; }
__device__ __forceinline__ f32x4 silu4(f32x4 v) { return (f32x4){silu_f(v[0]), silu_f(v[1]), silu_f(v[2]), silu_f(v[3])}; }

constexpr int UP_SEQ = SEQ + 16, US_SEQ = DSQ + 16, UP_ROWS = NBATCH * UP_SEQ;
__device__ __forceinline__ int u_row(int r) { return r < MP ? (r >> 12) * UP_SEQ + 16 + (r & 4095) : UP_ROWS + ((r - MP) >> 5) * US_SEQ + 16 + ((r - MP) & 31); }
__device__ __forceinline__ size_t kif_off(int s, int d0) { return ((size_t)(((s >> 5) * 4 + (d0 >> 4)) * 64 + ((d0 >> 3) & 1) * 32 + (s & 31))) * 8; }

struct Epi1a {
    static constexpr bool PERM = true;
    unsigned char* ws; float* out;
    __device__ __forceinline__ void operator()(const f32x4 (&acc)[2][2][4][2], const pg8::Unit& u, int wr, int wc, int fr, int fq) const {
        const int pn = u.pn; const float* SA = (const float*)(ws + WS_SA); const float* SB = (const float*)(ws + WS_SB);
#pragma unroll
        for (int bj = 0; bj < 2; ++bj) {
            const int lc = bj * 128 + wc * 32 + 8 * fq, gc = pn * 256 + lc;
            const f32x4 sb0 = *(const f32x4*)(SB + gc), sb1 = *(const f32x4*)(SB + gc + 4);
#pragma unroll
            for (int ai = 0; ai < 2; ++ai)
#pragma unroll
                for (int m = 0; m < 4; ++m) {
                    const int r = u.pm * 256 + ai * 128 + wr * 64 + m * 16 + fr; const float sa = SA[r];
                    const i32x4 i0 = __builtin_bit_cast(i32x4, acc[ai][bj][m][0]), i1 = __builtin_bit_cast(i32x4, acc[ai][bj][m][1]);
                    const f32x4 v0 = (f32x4){(float)i0[0], (float)i0[1], (float)i0[2], (float)i0[3]} * sb0 * sa, v1 = (f32x4){(float)i1[0], (float)i1[1], (float)i1[2], (float)i1[3]} * sb1 * sa;
                    if (pn < 16) *(u32x4*)((bf16_t*)(ws + WS_QB) + (size_t)r * DM + gc) = pack8(v0, v1);
                    else if (pn < 24) {
                        const bool isv = pn >= 20; const int c = (pn & 3) * 256 + lc; const bool samp = r >= MP; const int rs = r - MP;
                        bf16_t* dst; float* fo;
                        if (!samp) { dst = (bf16_t*)(ws + (isv ? WS_VP : WS_KP)) + (size_t)r * KVW + c; fo = out + (isv ? O_VP : O_KP) + (size_t)r * KVW + c; }
                        else { dst = (bf16_t*)(ws + (isv ? WS_VSN : WS_KSN)) + (size_t)rs * KVW + c; fo = out + (isv ? O_VS : O_KS) + (size_t)rs * KVW + c; }
                        *(u32x4*)dst = pack8(v0, v1); *(f32x4*)fo = v0; *(f32x4*)(fo + 4) = v1;
                    }
                    else *(u32x4*)((bf16_t*)(ws + WS_SG) + (size_t)r * DM + (gc - 6144)) = pack8(silu4(v0), silu4(v1));
                }
        }
    }
};
struct Epi1b {
    static constexpr bool PERM = true;
    unsigned char* ws; float* out;
    __device__ __forceinline__ void operator()(const f32x4 (&acc)[2][2][4][2], const pg8::Unit& u, int wr, int wc, int fr, int fq) const {
        const int pn = u.pn;
#pragma unroll
        for (int ai = 0; ai < 2; ++ai)
#pragma unroll
            for (int m = 0; m < 4; ++m) {
                const int r = u.pm * 256 + ai * 128 + wr * 64 + m * 16 + fr;
                const bool samp = r >= MP; const int rs = r - MP, sb = rs >> 5, st = rs & 31;
#pragma unroll
                for (int bj = 0; bj < 2; ++bj) {
                    const int lc = bj * 128 + wc * 32 + 8 * fq;
                    const f32x4 v0 = acc[ai][bj][m][0], v1 = acc[ai][bj][m][1];
                    if (pn < 8) {
                        const int c = pn * 256 + lc, h = c >> 6, d = c & 63;
                        *(u32x4*)((bf16_t*)(ws + WS_QIB) + ((((size_t)(r >> 5) * 32 + h) * 4 + (d >> 4)) * 2 + ((d >> 3) & 1)) * 256 + (r & 31) * 8) = pack8(v0, v1);
                    } else {
                        if (lc < 64) {
                            bf16_t* dst; float* fo;
                            if (!samp) { dst = (bf16_t*)(ws + WS_KIP) + (size_t)(r >> 12) * SEQ * DIDX + kif_off(r & 4095, lc); fo = out + O_KIP + (size_t)r * DIDX + lc; }
                            else { dst = (bf16_t*)(ws + WS_KIS) + (size_t)sb * SKV * DIDX + kif_off(PAST + st, lc); fo = out + O_KIS + (size_t)rs * DIDX + lc; }
                            *(u32x4*)dst = pack8(v0, v1); *(f32x4*)fo = v0; *(f32x4*)(fo + 4) = v1;
                        } else if (lc < 96) {
                            float* fo = (float*)(ws + WS_WIB) + (size_t)r * HIDX + (lc - 64);
                            *(f32x4*)fo = v0; *(f32x4*)(fo + 4) = v1;
                        }
                    }
                }
            }
    }
};
__device__ __forceinline__ f32x4 cvt_i32x4(const f32x4 a) { const i32x4 i = __builtin_bit_cast(i32x4, a); return (f32x4){(float)i[0], (float)i[1], (float)i[2], (float)i[3]}; }
struct EpiX1 {
    static constexpr bool PERM = false;
    const float* xp; float* X1; bf16_t* XB; float* PS; const float* SA; const float* SB;
    __device__ __forceinline__ void operator()(const f32x4 (&acc)[2][2][4][2], const pg8::Unit& u, int wr, int wc, int fr, int fq) const {
        f32x4 sb[2][2];
#pragma unroll
        for (int bj = 0; bj < 2; ++bj)
#pragma unroll
            for (int n = 0; n < 2; ++n) sb[bj][n] = *(const f32x4*)(SB + u.pn * 256 + bj * 128 + wc * 32 + n * 16 + 4 * fq);
#pragma unroll
        for (int ai = 0; ai < 2; ++ai)
#pragma unroll
            for (int m = 0; m < 4; ++m) {
                const int r = u.pm * 256 + ai * 128 + wr * 64 + m * 16 + fr; const float sa = SA[r];
                if (u.kq >= 0) {
                    float* d = PS + ((size_t)u.kq * MS + (r - MP)) * DM;
#pragma unroll
                    for (int bj = 0; bj < 2; ++bj)
#pragma unroll
                        for (int n = 0; n < 2; ++n) *(f32x4*)(d + u.pn * 256 + bj * 128 + wc * 32 + n * 16 + 4 * fq) = cvt_i32x4(acc[ai][bj][m][n]) * sb[bj][n] * sa;
                } else {
                    const float* b = xp + (size_t)r * DM; bf16_t* db = XB + (size_t)r * DM;
#pragma unroll
                    for (int bj = 0; bj < 2; ++bj)
#pragma unroll
                        for (int n = 0; n < 2; ++n) { const int c = u.pn * 256 + bj * 128 + wc * 32 + n * 16 + 4 * fq;
                            const f32x4 v = *(const f32x4*)(b + c) + cvt_i32x4(acc[ai][bj][m][n]) * sb[bj][n] * sa;
                            u32x2 w; w.x = cvt_pk_bf16(v[0], v[1]); w.y = cvt_pk_bf16(v[2], v[3]); *(u32x2*)(db + c) = w; }
                }
            }
    }
};
struct EpiX2 {
    static constexpr bool PERM = false;
    bf16_t* XB; float* PS; const float* SA; const float* SB;
    __device__ __forceinline__ void operator()(const f32x4 (&acc)[2][2][4][2], const pg8::Unit& u, int wr, int wc, int fr, int fq) const {
        f32x4 sb[2][2];
#pragma unroll
        for (int bj = 0; bj < 2; ++bj)
#pragma unroll
            for (int n = 0; n < 2; ++n) sb[bj][n] = *(const f32x4*)(SB + u.pn * 256 + bj * 128 + wc * 32 + n * 16 + 4 * fq);
#pragma unroll
        for (int ai = 0; ai < 2; ++ai)
#pragma unroll
            for (int m = 0; m < 4; ++m) {
                const int r = u.pm * 256 + ai * 128 + wr * 64 + m * 16 + fr; const float sa = SA[r];
                float* d = PS + ((size_t)(u.kq >= 0 ? u.kq : 0) * MS + (r - MP)) * DM; bf16_t* db = XB + (size_t)r * DM;
#pragma unroll
                for (int bj = 0; bj < 2; ++bj)
#pragma unroll
                    for (int n = 0; n < 2; ++n) { const int c = u.pn * 256 + bj * 128 + wc * 32 + n * 16 + 4 * fq; const f32x4 v = cvt_i32x4(acc[ai][bj][m][n]) * sb[bj][n] * sa;
                        if (u.kq >= 0) *(f32x4*)(d + c) = v;
                        else { const u32x2 x = *(const u32x2*)(db + c); u32x2 w; w.x = cvt_pk_bf16(bf_lo(x.x) + v[0], bf_hi(x.x) + v[1]); w.y = cvt_pk_bf16(bf_lo(x.y) + v[2], bf_hi(x.y) + v[3]); *(u32x2*)(db + c) = w; } }
            }
    }
};
struct Epi3 {
    static constexpr bool PERM = true;
    unsigned char* ws; float* out;
    __device__ __forceinline__ void operator()(const f32x4 (&acc)[2][2][4][2], const pg8::Unit& u, int wr, int wc, int fr, int fq) const {
        const int pn = u.pn; const float* ROWF = (const float*)(ws + WS_ROWF); const float* SB2 = (const float*)(ws + WS_SB2);
#pragma unroll
        for (int ai = 0; ai < 2; ++ai)
#pragma unroll
            for (int m = 0; m < 4; ++m) {
                const int r = u.pm * 256 + ai * 128 + wr * 64 + m * 16 + fr;
                const float rowf = ROWF[r];
                float* po = nullptr;
                if (r < MP) { const int t = r & 4095; if (t >= SEQ - 15) po = out + O_POOLP + ((size_t)(r >> 12) * 15 + (t - (SEQ - 15))) * DM; }
                else { const int rs = r - MP, t = rs & 31; if (t >= DSQ - 15) po = out + O_POOLS + ((size_t)(rs >> 5) * 15 + (t - (DSQ - 15))) * DM; }
#pragma unroll
                for (int bj = 0; bj < 2; ++bj) {
                    const int lc = bj * 128 + wc * 32 + 8 * fq;
                    const f32x4 s0 = *(const f32x4*)(SB2 + pn * 256 + lc), s1 = *(const f32x4*)(SB2 + pn * 256 + lc + 4);
                    const i32x4 i0 = __builtin_bit_cast(i32x4, acc[ai][bj][m][0]), i1 = __builtin_bit_cast(i32x4, acc[ai][bj][m][1]);
                    const f32x4 v0 = (f32x4){(float)i0[0], (float)i0[1], (float)i0[2], (float)i0[3]} * s0 * rowf, v1 = (f32x4){(float)i1[0], (float)i1[1], (float)i1[2], (float)i1[3]} * s1 * rowf;
                    if (pn < 16) {
                        const int c = pn * 256 + lc;
                        *(u32x4*)((bf16_t*)(ws + WS_U) + (size_t)u_row(r) * DM + c) = pack8(v0, v1);
                        if (po) { *(f32x4*)(po + c) = v0; *(f32x4*)(po + c + 4) = v1; }
                    } else {
                        *(u32x4*)((bf16_t*)(ws + WS_SG2) + (size_t)r * DM + (pn - 16) * 256 + lc) = pack8(silu4(v0), silu4(v1));
                    }
                }
            }
    }
};
struct Epi4 {
    static constexpr bool PERM = true;
    unsigned char* ws; const float* scale;
    __device__ __forceinline__ void operator()(const f32x4 (&acc)[2][2][4][2], const pg8::Unit& u, int wr, int wc, int fr, int fq) const {
#pragma unroll
        for (int bj = 0; bj < 2; ++bj) {
            const int c = u.pn * 256 + bj * 128 + wc * 32 + 8 * fq;
            const f32x4 s0 = *(const f32x4*)(scale + c), s1 = *(const f32x4*)(scale + c + 4);
#pragma unroll
            for (int ai = 0; ai < 2; ++ai)
#pragma unroll
                for (int m = 0; m < 4; ++m) {
                    const int r = u.pm * 256 + ai * 128 + wr * 64 + m * 16 + fr;
                    const u32x4 gw = *(const u32x4*)((const bf16_t*)(ws + WS_SG2) + (size_t)r * DM + c);
                    const f32x4 g0 = (f32x4){bf_lo(gw.x), bf_hi(gw.x), bf_lo(gw.y), bf_hi(gw.y)}, g1 = (f32x4){bf_lo(gw.z), bf_hi(gw.z), bf_lo(gw.w), bf_hi(gw.w)};
                    *(u32x4*)((bf16_t*)(ws + WS_ZG) + (size_t)r * DM + c) = pack8(acc[ai][bj][m][0] * s0 * g0, acc[ai][bj][m][1] * s1 * g1);
                }
        }
    }
};

__device__ __forceinline__ void transpose_item(const float* W, int N, int k0, int n0, bf16_t* WT, int K, int drow0, LAS float* scr, int lane, const float* kscale = nullptr) {
#pragma unroll 8
    for (int i = 0; i < 32; ++i) { const int kk = 2 * i + (lane >> 5); float v = W[(size_t)(k0 + kk) * N + n0 + (lane & 31)]; if (kscale) v *= kscale[k0 + kk]; scr[kk * 33 + (lane & 31)] = v; }
    LDS_WAIT(); asm volatile("" ::: "memory");
    const int c = lane & 7;
#pragma unroll
    for (int j = 0; j < 4; ++j) { const int n = (lane >> 3) + 8 * j; const LAS float* s = scr + (8 * c) * 33 + n;
        u32x4 o; o.x = cvt_pk_bf16(s[0 * 33], s[1 * 33]); o.y = cvt_pk_bf16(s[2 * 33], s[3 * 33]); o.z = cvt_pk_bf16(s[4 * 33], s[5 * 33]); o.w = cvt_pk_bf16(s[6 * 33], s[7 * 33]);
        *(u32x4*)(WT + (size_t)(drow0 + n) * K + k0 + 8 * c) = o; }
    LDS_WAIT(); asm volatile("" ::: "memory");
}
__device__ __forceinline__ unsigned q8(float v) { return (unsigned)(int)__builtin_rintf(v) & 0xffu; }
__device__ __forceinline__ unsigned q8x4(float a, float b, float c, float d) { return q8(a) | (q8(b) << 8) | (q8(c) << 16) | (q8(d) << 24); }
__device__ __forceinline__ void transpose_item_i8(const float* W, int N, int k0, int n0, signed char* WT, int K, int drow0, LAS float* scr, int lane, const unsigned* camax, float* sbout, const float* kscale = nullptr) {
#pragma unroll 8
    for (int i = 0; i < 32; ++i) { const int kk = 2 * i + (lane >> 5); float v = W[(size_t)(k0 + kk) * N + n0 + (lane & 31)]; if (kscale) v *= kscale[k0 + kk]; scr[kk * 33 + (lane & 31)] = v; }
    LDS_WAIT(); asm volatile("" ::: "memory");
    const int c = lane & 3;
#pragma unroll
    for (int j = 0; j < 2; ++j) { const int n = (lane >> 2) + 16 * j; const LAS float* sp = scr + (16 * c) * 33 + n;
        const float am = __uint_as_float(camax[drow0 + n]), inv = am > 0.f ? 127.0f / am : 0.f;
        u32x4 o;
        o.x = q8x4(sp[0 * 33] * inv, sp[1 * 33] * inv, sp[2 * 33] * inv, sp[3 * 33] * inv); o.y = q8x4(sp[4 * 33] * inv, sp[5 * 33] * inv, sp[6 * 33] * inv, sp[7 * 33] * inv);
        o.z = q8x4(sp[8 * 33] * inv, sp[9 * 33] * inv, sp[10 * 33] * inv, sp[11 * 33] * inv); o.w = q8x4(sp[12 * 33] * inv, sp[13 * 33] * inv, sp[14 * 33] * inv, sp[15 * 33] * inv);
        *(u32x4*)(WT + (size_t)(drow0 + n) * K + k0 + 16 * c) = o;
        if (k0 == 0 && c == 0) sbout[drow0 + n] = am * (1.0f / 127.0f); }
    LDS_WAIT(); asm volatile("" ::: "memory");
}
__device__ __forceinline__ void rms_row_q(const float* xrow, const float* w, bf16_t* orow, signed char* qrow, float* sa, int lane) {
    const f32x4* xr = (const f32x4*)xrow + lane; const f32x4* wr = (const f32x4*)w + lane;
    f32x4 v[16]; float s = 0.f;
#pragma unroll
    for (int j = 0; j < 16; ++j) { v[j] = xr[64 * j]; s += (v[j].x * v[j].x + v[j].y * v[j].y) + (v[j].z * v[j].z + v[j].w * v[j].w); }
    const float rstd = 1.0f / sqrtf(wave_sum(s) * (1.0f / DM) + EPS);
    float am = 0.f;
#pragma unroll
    for (int j = 0; j < 16; ++j) { v[j] = v[j] * rstd * wr[64 * j]; am = fmaxf(am, fmaxf(fmaxf(fabsf(v[j].x), fabsf(v[j].y)), fmaxf(fabsf(v[j].z), fabsf(v[j].w))));
        u32x2 o; o.x = cvt_pk_bf16(v[j].x, v[j].y); o.y = cvt_pk_bf16(v[j].z, v[j].w); ((u32x2*)orow + lane)[64 * j] = o; }
#pragma unroll
    for (int o = 1; o < 64; o <<= 1) am = fmaxf(am, __shfl_xor(am, o));
    const float inv = am > 0.f ? 127.0f / am : 0.f;
#pragma unroll
    for (int j = 0; j < 16; ++j) ((unsigned*)qrow + lane)[64 * j] = q8x4(v[j].x * inv, v[j].y * inv, v[j].z * inv, v[j].w * inv);
    if (lane == 0) *sa = am * (1.0f / 127.0f);
}
__device__ __forceinline__ void quant_row_bf16(const bf16_t* src, signed char* dst, float& am_out, float& ss_out, int lane) {
    const u32x4* xb = (const u32x4*)src + lane; u32x4 x[8]; float am = 0.f, ss = 0.f;
#pragma unroll
    for (int j = 0; j < 8; ++j) { x[j] = xb[64 * j];
        const float f[8] = {bf_lo(x[j].x), bf_hi(x[j].x), bf_lo(x[j].y), bf_hi(x[j].y), bf_lo(x[j].z), bf_hi(x[j].z), bf_lo(x[j].w), bf_hi(x[j].w)};
#pragma unroll
        for (int e = 0; e < 8; ++e) { am = fmaxf(am, fabsf(f[e])); ss = fmaf(f[e], f[e], ss); } }
#pragma unroll
    for (int o = 1; o < 64; o <<= 1) am = fmaxf(am, __shfl_xor(am, o));
    ss = wave_sum(ss);
    const float inv = am > 0.f ? 127.0f / am : 0.f;
    u32x2* q = (u32x2*)dst + lane;
#pragma unroll
    for (int j = 0; j < 8; ++j) { u32x2 o; o.x = q8x4(bf_lo(x[j].x) * inv, bf_hi(x[j].x) * inv, bf_lo(x[j].y) * inv, bf_hi(x[j].y) * inv);
        o.y = q8x4(bf_lo(x[j].z) * inv, bf_hi(x[j].z) * inv, bf_lo(x[j].w) * inv, bf_hi(x[j].w) * inv); q[64 * j] = o; }
    am_out = am; ss_out = ss;
}
template <bool F32OUT>
__device__ __forceinline__ void rms_row(const float* xrow, const float* w, void* orow, int lane) {
    const f32x4* xr = (const f32x4*)xrow + lane; const f32x4* wr = (const f32x4*)w + lane;
    f32x4 v[16]; float s = 0.f;
#pragma unroll
    for (int j = 0; j < 16; ++j) { v[j] = xr[64 * j]; s += (v[j].x * v[j].x + v[j].y * v[j].y) + (v[j].z * v[j].z + v[j].w * v[j].w); }
    const float rstd = 1.0f / sqrtf(wave_sum(s) * (1.0f / DM) + EPS);
#pragma unroll
    for (int j = 0; j < 16; ++j) { const f32x4 g = wr[64 * j]; const f32x4 y = v[j] * rstd * g;
        if (F32OUT) ((f32x4*)orow + lane)[64 * j] = y;
        else { u32x2 o; o.x = cvt_pk_bf16(y.x, y.y); o.y = cvt_pk_bf16(y.z, y.w); ((u32x2*)orow + lane)[64 * j] = o; } }
}

__device__ __forceinline__ unsigned ord_key(float f) { const unsigned b = __float_as_uint(f); return (b & 0x80000000u) ? ~b : (b | 0x80000000u); }
constexpr int NVJ = 65;
constexpr int SC_WT_OFF = RING_BYTES + 1024;
constexpr int SC_QB_OFF = SC_WT_OFF + 4096;
__device__ __forceinline__ void score_tiles(const bf16_t* __restrict__ qif, const float* __restrict__ wi, const bf16_t* __restrict__ kif, float* __restrict__ sc,
                                            int kt0, int step, int count, LAS unsigned char* lds) {
    int tid = threadIdx.x; asm volatile("" : "+v"(tid));
    const int wid = __builtin_amdgcn_readfirstlane(tid >> 6), lane = tid & 63, r32 = lane & 31, hi = lane >> 5;
    constexpr float WSC = 0.5f * 0.125f * 0.17677669529663687f;
    __syncthreads();
    {   const u32x4* src = (const u32x4*)qif; LAS u32x4* dst = (LAS u32x4*)lds;
        u32x4 t[16];
#pragma unroll
        for (int i = 0; i < 16; ++i) t[i] = src[tid + 512 * i];
#pragma unroll
        for (int i = 0; i < 16; ++i) dst[tid + 512 * i] = t[i];
        LAS float* wt = (LAS float*)(lds + SC_WT_OFF);
#pragma unroll
        for (int e = tid; e < 1024; e += NTHREADS) { const int h = e >> 5, hh = (e >> 4) & 1, r = e & 15, q = (r & 3) + 8 * (r >> 2) + 4 * hh;
            wt[e] = wi[q * HIDX + h] * WSC; }
    }
    __syncthreads();
    if (tid < 256) {
        const int q = tid >> 3, ch = tid & 7; float acc[8] = {0.f, 0.f, 0.f, 0.f, 0.f, 0.f, 0.f, 0.f};
        const LAS u32x4* Af = (const LAS u32x4*)lds + ch * 32 + q;
        const LAS float* wtq = (const LAS float*)(lds + SC_WT_OFF) + ((q >> 2) & 1) * 16 + (q & 3) + 4 * (q >> 3);
#pragma unroll 4
        for (int h = 0; h < 32; ++h) { const float w = wtq[h * 32]; const u32x4 x = Af[h * 256];
            acc[0] = fmaf(w, bf_lo(x.x), acc[0]); acc[1] = fmaf(w, bf_hi(x.x), acc[1]); acc[2] = fmaf(w, bf_lo(x.y), acc[2]); acc[3] = fmaf(w, bf_hi(x.y), acc[3]);
            acc[4] = fmaf(w, bf_lo(x.z), acc[4]); acc[5] = fmaf(w, bf_hi(x.z), acc[5]); acc[6] = fmaf(w, bf_lo(x.w), acc[6]); acc[7] = fmaf(w, bf_hi(x.w), acc[7]); }
        u32x4 vh, vl;
        vh.x = cvt_pk_bf16(acc[0], acc[1]); vh.y = cvt_pk_bf16(acc[2], acc[3]); vh.z = cvt_pk_bf16(acc[4], acc[5]); vh.w = cvt_pk_bf16(acc[6], acc[7]);
        vl.x = cvt_pk_bf16(acc[0] - bf_lo(vh.x), acc[1] - bf_hi(vh.x)); vl.y = cvt_pk_bf16(acc[2] - bf_lo(vh.y), acc[3] - bf_hi(vh.y));
        vl.z = cvt_pk_bf16(acc[4] - bf_lo(vh.z), acc[5] - bf_hi(vh.z)); vl.w = cvt_pk_bf16(acc[6] - bf_lo(vh.w), acc[7] - bf_hi(vh.w));
        LAS u32x4* qb = (LAS u32x4*)(lds + SC_QB_OFF);
        qb[ch * 32 + q] = vh; qb[256 + ch * 32 + q] = vl;
    }
    __syncthreads();
    const LAS bf16x8* A = (const LAS bf16x8*)lds + lane;
    const LAS bf16x8* QBF = (const LAS bf16x8*)(lds + SC_QB_OFF) + lane;
    const LAS f32x4* W4 = (const LAS f32x4*)(lds + SC_WT_OFF) + hi * 4;
#define FMA8(NOP, S, W, C, B, X) asm volatile(NOP "v_fma_f32 %0, %8, |%16|, %0\n\tv_fma_f32 %1, %9, |%17|, %1\n\tv_fma_f32 %2, %10, |%18|, %2\n\tv_fma_f32 %3, %11, |%19|, %3\n\t" \
        "v_fma_f32 %4, %12, |%20|, %4\n\tv_fma_f32 %5, %13, |%21|, %5\n\tv_fma_f32 %6, %14, |%22|, %6\n\tv_fma_f32 %7, %15, |%23|, %7" \
        : "+v"(S[B + 0]), "+v"(S[B + 1]), "+v"(S[B + 2]), "+v"(S[B + 3]), "+v"(S[B + 4]), "+v"(S[B + 5]), "+v"(S[B + 6]), "+v"(S[B + 7]) \
        : "v"(W[B + 0]), "v"(W[B + 1]), "v"(W[B + 2]), "v"(W[B + 3]), "v"(W[B + 4]), "v"(W[B + 5]), "v"(W[B + 6]), "v"(W[B + 7]), \
          "v"(C[B + 0]), "v"(C[B + 1]), "v"(C[B + 2]), "v"(C[B + 3]), "v"(C[B + 4]), "v"(C[B + 5]), "v"(C[B + 6]), "v"(C[B + 7]), "v"(X))
#define SC_LDA(dst, h) do { _Pragma("unroll") for (int ks = 0; ks < 4; ++ks) dst[ks] = A[((h) * 4 + ks) * 64]; } while (0)
#define SC_STEP(a, h) do { const f32x4 w0 = W4[(h) * 8 + 0], w1 = W4[(h) * 8 + 1], w2 = W4[(h) * 8 + 2], w3 = W4[(h) * 8 + 3]; \
        const float w[16] = {w0.x, w0.y, w0.z, w0.w, w1.x, w1.y, w1.z, w1.w, w2.x, w2.y, w2.z, w2.w, w3.x, w3.y, w3.z, w3.w}; \
        f32x16 c0 = {}, c1 = {}; \
        _Pragma("unroll") for (int ks = 0; ks < 4; ++ks) { c0 = __builtin_amdgcn_mfma_f32_32x32x16_bf16(a[ks], b0[ks], c0, 0, 0, 0); c1 = __builtin_amdgcn_mfma_f32_32x32x16_bf16(a[ks], b1[ks], c1, 0, 0, 0); } \
        FMA8("s_nop 11\n\t", s0, w, c0, 0, c1[15]); FMA8("", s0, w, c0, 8, c1[15]); FMA8("", s1, w, c1, 0, c1[15]); FMA8("", s1, w, c1, 8, c1[15]); } while (0)
    for (int idx = wid; idx < count; idx += NWAVES) {
        const int kt = kt0 + step * idx;
        const bf16x8* kb = (const bf16x8*)kif + (size_t)kt * 512 + lane;
        bf16x8 b0[4], b1[4];
#pragma unroll
        for (int ks = 0; ks < 4; ++ks) { b0[ks] = kb[ks * 64]; b1[ks] = kb[(4 + ks) * 64]; }
        f32x16 s0 = {}, s1 = {};
#pragma unroll
        for (int ks = 0; ks < 4; ++ks) { const bf16x8 qh = QBF[ks * 64], ql = QBF[256 + ks * 64];
            s0 = __builtin_amdgcn_mfma_f32_32x32x16_bf16(qh, b0[ks], s0, 0, 0, 0); s1 = __builtin_amdgcn_mfma_f32_32x32x16_bf16(qh, b1[ks], s1, 0, 0, 0);
            s0 = __builtin_amdgcn_mfma_f32_32x32x16_bf16(ql, b0[ks], s0, 0, 0, 0); s1 = __builtin_amdgcn_mfma_f32_32x32x16_bf16(ql, b1[ks], s1, 0, 0, 0); }
        bf16x8 aA[4], aB[4];
        SC_LDA(aA, 0);
#pragma unroll 1
        for (int h = 0; h < 32; h += 2) {
            SC_LDA(aB, h + 1);
            { bf16x8 (&a)[4] = aA; SC_STEP(a, h); }
            if (h + 2 < 32) SC_LDA(aA, h + 2);
            { bf16x8 (&a)[4] = aB; SC_STEP(a, h + 1); }
        }
        float* o = sc + (size_t)kt * 64 + r32;
#pragma unroll
        for (int r = 0; r < 16; ++r) { const int q = (r & 3) + 8 * (r >> 2) + 4 * hi; o[(size_t)q * SCW] = s0[r]; o[(size_t)q * SCW + 32] = s1[r]; }
    }
#undef SC_LDA
#undef SC_STEP
#undef FMA8
}
__device__ __forceinline__ void sel_load(const float* __restrict__ sc, int nt, float (&vv)[NVJ], int lane) {
    if (nt <= 4) return;
    const int ng = (nt + 3) >> 2;
#pragma unroll
    for (int g = 0; g < 16; ++g) if (g < ng) {
#pragma unroll
        for (int i = 0; i < 4; ++i) vv[4 * g + i] = sc[(4 * g + i) * 64 + lane]; }
    if (ng > 16) vv[64] = sc[64 * 64 + lane];
}
__device__ __forceinline__ void select_row(float (&vv)[NVJ], int nt, int nvalid, u64* __restrict__ rm, const float* __restrict__ sc_next, int nt_next, int lane) {
    if (nt <= 4) { if (lane < nt) rm[lane] = ~0ull; sel_load(sc_next, nt_next, vv, lane); return; }
    unsigned uk[NVJ];
    { const int ng = (nt + 3) >> 2;
#pragma unroll
      for (int j = 0; j < NVJ; ++j) uk[j] = ((j >> 2) < ng && j * 64 + lane < nvalid) ? ord_key(vv[j]) : 0u; }
    sel_load(sc_next, nt_next, vv, lane);
#define CNTV(cnt, thr, x) asm volatile("v_cmp_le_u32 vcc, %1, %2\n\tv_addc_co_u32 %0, vcc, 0, %0, vcc" : "+v"(cnt) : "v"(thr), "v"(x) : "vcc")
    const int ng = (nt + 3) >> 2;
    unsigned T = 0u; int cT = 0;
    for (int bit = 31; bit >= 0; --bit) {
        const unsigned cand = T | (1u << bit); int cl = 0;
#pragma unroll
        for (int g = 0; g < 16; ++g) if (g < ng) { CNTV(cl, cand, uk[4 * g]); CNTV(cl, cand, uk[4 * g + 1]); CNTV(cl, cand, uk[4 * g + 2]); CNTV(cl, cand, uk[4 * g + 3]); }
        if (ng > 16) CNTV(cl, cand, uk[64]);
        cl += __builtin_amdgcn_update_dpp(0, cl, 0xB1, 0xf, 0xf, false);
        cl += __builtin_amdgcn_update_dpp(0, cl, 0x4E, 0xf, 0xf, false);
        cl += __builtin_amdgcn_update_dpp(0, cl, 0x141, 0xf, 0xf, false);
        cl += __builtin_amdgcn_update_dpp(0, cl, 0x140, 0xf, 0xf, false);
        const int cnt = (__builtin_amdgcn_readlane(cl, 0) + __builtin_amdgcn_readlane(cl, 16)) + (__builtin_amdgcn_readlane(cl, 32) + __builtin_amdgcn_readlane(cl, 48));
        if (cnt >= 256) { T = cand; cT = cnt; if (cnt == 256) break; }
    }
#undef CNTV
    if (cT == 256) {
#pragma unroll
        for (int j = 0; j < NVJ; ++j) { u64 mk; asm volatile("v_cmp_le_u32 %0, %1, %2" : "=s"(mk) : "s"(T), "v"(uk[j])); if (lane == 0) rm[j] = mk; }
    } else {
        int cgt = 0;
#pragma unroll
        for (int j = 0; j < NVJ; ++j) { u64 t0_; asm volatile("v_cmp_lt_u32 %0, %1, %2" : "=&s"(t0_) : "s"(T), "v"(uk[j])); cgt += __builtin_popcountll(t0_); }
        int need = 256 - cgt;
#pragma unroll
        for (int j = 0; j < NVJ; ++j) {
            u64 gt, eq; asm volatile("v_cmp_lt_u32 %0, %1, %2" : "=s"(gt) : "s"(T), "v"(uk[j])); asm volatile("v_cmp_eq_u32 %0, %1, %2" : "=s"(eq) : "s"(T), "v"(uk[j]));
            const int below = __builtin_popcountll(eq & ((1ull << lane) - 1ull));
            const u64 take = __ballot(((eq >> lane) & 1ull) && below < need);
            need -= __builtin_popcountll(take);
            if (lane == 0) rm[j] = gt | take;
        }
    }
}

namespace att {
constexpr int D = 128, KVBLK = 64;
constexpr float SCALE = 0.088388347648318440f;
constexpr float THR = 8.f;
constexpr float NEG = -1e30f, MINIT = -1e20f;
constexpr size_t SHM_V = KVBLK * D * 2, SHM_K = KVBLK * D * 2;
constexpr size_t OFF_WS = 2 * SHM_V + 2 * SHM_K, OFF_TB = OFF_WS + 8 * 64 * 4, OFF_MK = OFF_TB + 4 * 256 * 4, LDS_ATTN = OFF_MK + 64 * 65 * 8;
static_assert(LDS_ATTN <= 131072, "attention LDS");
#define KSWZ(row, colB) ((row) * 256 + ((colB) ^ (((row) & 7) << 4)))
#define SBAR() __builtin_amdgcn_sched_barrier(0)
__device__ __forceinline__ int crow(int r, int hi) { return (r & 3) + 8 * (r >> 2) + 4 * hi; }
__device__ __forceinline__ void partialSM(f32x16& p0, f32x16& p1, float& m_reg, float& mn, float& alpha) {
    constexpr float C = SCALE * 1.4426950408889634f;
    float pmax = p0[0];
#pragma unroll
    for (int r = 1; r < 16; ++r) pmax = fmaxf(pmax, p0[r]);
#pragma unroll
    for (int r = 0; r < 16; ++r) pmax = fmaxf(pmax, p1[r]);
    { auto rr = __builtin_amdgcn_permlane32_swap(__float_as_uint(pmax), __float_as_uint(pmax), false, false);
      pmax = fmaxf(__uint_as_float(rr[0]), __uint_as_float(rr[1])); }
    if (__builtin_expect(__all(pmax - m_reg <= THR / SCALE), 1)) { mn = m_reg; alpha = 1.f; }
    else { mn = fmaxf(m_reg, pmax); alpha = __builtin_amdgcn_exp2f((m_reg - mn) * C); m_reg = mn; }
    const float mnC = -mn * C;
#pragma unroll
    for (int r = 0; r < 16; ++r) p0[r] = fmaf(p0[r], C, mnC);
#pragma unroll
    for (int r = 0; r < 16; ++r) p1[r] = fmaf(p1[r], C, mnC);
#pragma unroll
    for (int r = 0; r < 16; ++r) p0[r] = __builtin_amdgcn_exp2f(p0[r]);
}
__device__ __forceinline__ void finishSM(f32x16& p0, f32x16& p1, float alpha, float& l_reg, bf16x8& pa0, bf16x8& pa1, bf16x8& pa2, bf16x8& pa3) {
#pragma unroll
    for (int r = 0; r < 16; ++r) p1[r] = __builtin_amdgcn_exp2f(p1[r]);
    float ps = 0;
#pragma unroll
    for (int r = 0; r < 16; ++r) ps += p0[r];
#pragma unroll
    for (int r = 0; r < 16; ++r) ps += p1[r];
    { auto rr = __builtin_amdgcn_permlane32_swap(__float_as_uint(ps), __float_as_uint(ps), false, false);
      ps = __uint_as_float(rr[0]) + __uint_as_float(rr[1]); }
    l_reg = l_reg * alpha + ps;
#define PK4(P, BASE, OUT) do { unsigned a0 = cvt_pk_bf16(P[BASE + 0], P[BASE + 1]), a1 = cvt_pk_bf16(P[BASE + 2], P[BASE + 3]);   \
    unsigned b0 = cvt_pk_bf16(P[BASE + 4], P[BASE + 5]), b1 = cvt_pk_bf16(P[BASE + 6], P[BASE + 7]);                              \
    auto r0 = __builtin_amdgcn_permlane32_swap(a0, b0, false, false); auto r1 = __builtin_amdgcn_permlane32_swap(a1, b1, false, false); \
    u32x4 w = {r0[0], r1[0], r0[1], r1[1]}; OUT = *reinterpret_cast<bf16x8*>(&w); } while (0)
    PK4(p0, 0, pa0); PK4(p0, 8, pa1); PK4(p1, 0, pa2); PK4(p1, 8, pa3);
#undef PK4
}
__device__ __forceinline__ void qkt(f32x16& p0, f32x16& p1, const LAS char* Ks, const bf16x8* qr, int r32, int hi) {
    p0 = f32x16{}; p1 = f32x16{};
#pragma unroll
    for (int d0 = 0; d0 < 8; ++d0) { const int cb = (d0 * 16 + hi * 8) * 2;
        const bf16x8 b0 = *(const LAS bf16x8*)(Ks + KSWZ(r32, cb));
        const bf16x8 b1 = *(const LAS bf16x8*)(Ks + KSWZ(32 + r32, cb));
        p0 = __builtin_amdgcn_mfma_f32_32x32x16_bf16(b0, qr[d0], p0, 0, 0, 0);
        p1 = __builtin_amdgcn_mfma_f32_32x32x16_bf16(b1, qr[d0], p1, 0, 0, 0); }
}
__device__ __forceinline__ int v_st(int k, int c) { const int kk = (k & ~0xC) | ((k & 4) << 1) | ((k & 8) >> 1); return ((kk >> 3) * 4 + (c >> 5)) * 512 + ((kk & 7) * 32 + (c & 31)) * 2; }
__device__ __forceinline__ int v_rd_base(int lane) { return ((lane & 3) << 3) | (((lane >> 2) & 3) << 6) | (((lane >> 4) & 1) << 5) | (((lane >> 5) & 1) << 8); }
constexpr int v_rd_off(int d0, int ks, int half) { return d0 * 512 + ks * 4096 + half * 2048; }
template <int OFF> __device__ __forceinline__ s16x4 tr_read(int vb) {
    s16x4 r; asm volatile("ds_read_b64_tr_b16 %0, %1 offset:%2" : "=&v"(r) : "v"(vb), "i"(OFF) : "memory"); return r;
}
template <int D0> __device__ __forceinline__ void pv_one(f32x16& od, int vb, bf16x8 pa0, bf16x8 pa1, bf16x8 pa2, bf16x8 pa3) {
    const s16x4 l0 = tr_read<v_rd_off(D0, 0, 0)>(vb), h0 = tr_read<v_rd_off(D0, 0, 1)>(vb), l1 = tr_read<v_rd_off(D0, 1, 0)>(vb), h1 = tr_read<v_rd_off(D0, 1, 1)>(vb);
    const s16x4 l2 = tr_read<v_rd_off(D0, 2, 0)>(vb), h2 = tr_read<v_rd_off(D0, 2, 1)>(vb), l3 = tr_read<v_rd_off(D0, 3, 0)>(vb), h3 = tr_read<v_rd_off(D0, 3, 1)>(vb);
    asm volatile("s_waitcnt lgkmcnt(0)" ::: "memory"); SBAR();
#define PK(L, H) (bf16x8){L[0], L[1], L[2], L[3], H[0], H[1], H[2], H[3]}
    od = __builtin_amdgcn_mfma_f32_32x32x16_bf16(pa0, PK(l0, h0), od, 0, 0, 0);
    od = __builtin_amdgcn_mfma_f32_32x32x16_bf16(pa1, PK(l1, h1), od, 0, 0, 0);
    od = __builtin_amdgcn_mfma_f32_32x32x16_bf16(pa2, PK(l2, h2), od, 0, 0, 0);
    od = __builtin_amdgcn_mfma_f32_32x32x16_bf16(pa3, PK(l3, h3), od, 0, 0, 0);
#undef PK
}
__device__ __forceinline__ void pv_d0(f32x16* o, int vb, bf16x8 pa0, bf16x8 pa1, bf16x8 pa2, bf16x8 pa3) {
    pv_one<0>(o[0], vb, pa0, pa1, pa2, pa3); pv_one<1>(o[1], vb, pa0, pa1, pa2, pa3); pv_one<2>(o[2], vb, pa0, pa1, pa2, pa3); pv_one<3>(o[3], vb, pa0, pa1, pa2, pa3);
}
__device__ __forceinline__ void mask_bias(f32x16& p0, f32x16& p1, u64 mw, bool near, const LAS float* tbk, int hi) {
    if (near) {
#pragma unroll
        for (int r = 0; r < 16; ++r) { const int b = (r & 3) + 8 * (r >> 2); p0[r] += tbk[b]; p1[r] += tbk[32 + b]; }
    }
    const unsigned lo = (unsigned)mw >> (4 * hi), hh = (unsigned)(mw >> 32) >> (4 * hi);
#pragma unroll
    for (int r = 0; r < 16; ++r) { const int b = (r & 3) + 8 * (r >> 2);
        const unsigned m0 = (unsigned)__builtin_amdgcn_sbfe((int)lo, b, 1), m1 = (unsigned)__builtin_amdgcn_sbfe((int)hh, b, 1);
        p0[r] = __uint_as_float((m0 & __float_as_uint(p0[r])) | (~m0 & __float_as_uint(NEG)));
        p1[r] = __uint_as_float((m1 & __float_as_uint(p1[r])) | (~m1 & __float_as_uint(NEG))); }
}

__device__ __forceinline__ void og_store_rows(const LAS char* st, const bf16_t* __restrict__ SGg, bf16_t* __restrict__ OGg, int kvh, int nrows, int tid) {
    for (int c = tid; c < nrows * 64; c += NTHREADS) { const int row = c >> 6, ch = c & 63;
        const u32x4 ov = *(const LAS u32x4*)(st + row * 1024 + ch * 16);
        const size_t off = (size_t)row * DM + kvh * 512 + ch * 8;
        const u32x4 gv = *(const u32x4*)(SGg + off);
        u32x4 w; w.x = cvt_pk_bf16(bf_lo(ov.x) * bf_lo(gv.x), bf_hi(ov.x) * bf_hi(gv.x)); w.y = cvt_pk_bf16(bf_lo(ov.y) * bf_lo(gv.y), bf_hi(ov.y) * bf_hi(gv.y));
        w.z = cvt_pk_bf16(bf_lo(ov.z) * bf_lo(gv.z), bf_hi(ov.z) * bf_hi(gv.z)); w.w = cvt_pk_bf16(bf_lo(ov.w) * bf_lo(gv.w), bf_hi(ov.w) * bf_hi(gv.w));
        *(u32x4*)(OGg + off) = w; }
}
__device__ __forceinline__ void attn_block(const bf16_t* __restrict__ Qg, const bf16_t* __restrict__ Kh, const bf16_t* __restrict__ Vh, const u64* __restrict__ rmq,
                                           const bf16_t* __restrict__ SGg, bf16_t* __restrict__ OGg, int NT, int qpos0, int kvh, const float* __restrict__ rel_bias, LAS char* lds) {
    int tid = threadIdx.x; asm volatile("" : "+v"(tid));
    const int wid = __builtin_amdgcn_readfirstlane(tid >> 6), lane = tid & 63, r32 = lane & 31, hi = lane >> 5;
    const int hl = wid & 3, qs = wid >> 2, head = kvh * 4 + hl;
    LAS char* V_lds = lds; LAS char* K_lds = lds + 2 * SHM_V;
    LAS float* ws = (LAS float*)(lds + OFF_WS) + wid * 64; LAS float* li_l = ws; LAS float* al_l = ws + 32;
    LAS float* tb = (LAS float*)(lds + OFF_TB);
    for (int e = tid; e < 1024; e += NTHREADS) {
        const int h = e >> 8, rel = (e & 255) - 192, n = rel < 0 ? -rel : rel;
        int bk = n < 8 ? n : (n < 12 ? 8 : n < 16 ? 9 : n < 23 ? 10 : n < 32 ? 11 : n < 46 ? 12 : n < 64 ? 13 : n < 91 ? 14 : 15);
        if (rel > 0) bk += 16;
        tb[e] = (rel_bias[bk * 32 + kvh * 4 + h] - rel_bias[15 * 32 + kvh * 4 + h]) * (1.0f / SCALE);
    }
    {
        const u32x4* src = (const u32x4*)rmq; LAS u32x4* dst = (LAS u32x4*)(lds + OFF_MK);
        constexpr int NCH = 64 * RMS * 8 / 16;
        for (int e = tid; e < NCH; e += NTHREADS) dst[e] = src[e];
    }
    float m_reg = MINIT, l_reg = 0; f32x16 o[4] = {}; bf16x8 qr[8];
    const int qrow = qs * 32 + r32;
    const bf16_t* Qw = Qg + (size_t)qrow * DM + head * D + hi * 8;
#pragma unroll
    for (int d0 = 0; d0 < 8; ++d0) qr[d0] = *(const bf16x8*)(Qw + d0 * 16);
    const LAS u64* rml = (const LAS u64*)(lds + OFF_MK) + qrow * RMS;
    const int vb0 = (int)(uintptr_t)V_lds + v_rd_base(lane);
    const int tboff = hl * 256 + 192 - (qpos0 + qrow) + 4 * hi;
    constexpr int LDK = KVW;
    unsigned koff[2], voff[2];
#pragma unroll
    for (int i = 0; i < 2; ++i) { const int off = (wid * 2 + i) * 1024 + lane * 16;
        { const int row = off >> 8, cB = (off & 255) ^ ((row & 7) << 4); koff[i] = (unsigned)(row * LDK * 2 + cB); }
        { const int sub = off >> 9, kk = (sub >> 2) * 8 + ((off & 511) >> 6), k = (kk & ~0xC) | ((kk & 4) << 1) | ((kk & 8) >> 1), c = (sub & 3) * 32 + ((off & 63) >> 1); voff[i] = (unsigned)(k * LDK * 2 + c * 2); } }
#define DMA_K(t, slot) do { _Pragma("unroll") for (int i_ = 0; i_ < 2; ++i_) __builtin_amdgcn_global_load_lds((const unsigned*)((const char*)Kh + (size_t)(t) * (KVBLK * LDK * 2) + koff[i_]), \
        (LAS unsigned*)(K_lds + (slot) * SHM_K + (wid * 2 + i_) * 1024), 16, 0, 0); } while (0)
#define DMA_V(t, slot) do { _Pragma("unroll") for (int i_ = 0; i_ < 2; ++i_) __builtin_amdgcn_global_load_lds((const unsigned*)((const char*)Vh + (size_t)(t) * (KVBLK * LDK * 2) + voff[i_]), \
        (LAS unsigned*)(V_lds + (slot) * SHM_V + (wid * 2 + i_) * 1024), 16, 0, 0); } while (0)
#define STEPBAR() do { asm volatile("s_waitcnt vmcnt(0) lgkmcnt(0)" ::: "memory"); __builtin_amdgcn_s_barrier(); asm volatile("" ::: "memory"); } while (0)
#define RESC(a) do { if (__any((a) < 1.f)) { if (hi == 0) al_l[r32] = (a); asm volatile("s_waitcnt lgkmcnt(0)" ::: "memory"); \
    _Pragma("unroll") for (int d = 0; d < 4; ++d) _Pragma("unroll") for (int r = 0; r < 16; ++r) o[d][r] *= al_l[crow(r, hi)]; } } while (0)
#define MB(P0, P1, t) mask_bias(P0, P1, rml[t], (t) >= NT - 3, tb + tboff + (t) * KVBLK, hi)
    f32x16 pA0, pA1, pB0, pB1; float mnA, mnB, alA, alB; bf16x8 pa0, pa1, pa2, pa3;
    DMA_K(0, 0);
    STEPBAR();
    if (NT > 1) DMA_K(1, 1);
    DMA_V(0, 0);
    qkt(pA0, pA1, K_lds, qr, r32, hi); MB(pA0, pA1, 0); partialSM(pA0, pA1, m_reg, mnA, alA);
    int j = 1;
    for (; j + 1 < NT; j += 2) {
        STEPBAR();
        DMA_K(j + 1, 0); DMA_V(j, 1);
        SBAR(); qkt(pB0, pB1, K_lds + SHM_K, qr, r32, hi);
        finishSM(pA0, pA1, alA, l_reg, pa0, pa1, pa2, pa3); SBAR();
        pv_d0(o, vb0, pa0, pa1, pa2, pa3); MB(pB0, pB1, j); partialSM(pB0, pB1, m_reg, mnB, alB);
        RESC(alB);
        STEPBAR();
        if (j + 2 < NT) DMA_K(j + 2, 1);
        DMA_V(j + 1, 0);
        SBAR(); qkt(pA0, pA1, K_lds, qr, r32, hi);
        finishSM(pB0, pB1, alB, l_reg, pa0, pa1, pa2, pa3); SBAR();
        pv_d0(o, vb0 + (int)SHM_V, pa0, pa1, pa2, pa3); MB(pA0, pA1, j + 1); partialSM(pA0, pA1, m_reg, mnA, alA);
        RESC(alA);
    }
    if (j < NT) {
        STEPBAR();
        DMA_V(j, 1);
        SBAR(); qkt(pB0, pB1, K_lds + SHM_K, qr, r32, hi);
        finishSM(pA0, pA1, alA, l_reg, pa0, pa1, pa2, pa3); SBAR();
        pv_d0(o, vb0, pa0, pa1, pa2, pa3); MB(pB0, pB1, j); partialSM(pB0, pB1, m_reg, mnB, alB);
        RESC(alB);
        STEPBAR();
        finishSM(pB0, pB1, alB, l_reg, pa0, pa1, pa2, pa3); SBAR();
        pv_d0(o, vb0 + (int)SHM_V, pa0, pa1, pa2, pa3);
    } else {
        STEPBAR();
        finishSM(pA0, pA1, alA, l_reg, pa0, pa1, pa2, pa3); SBAR();
        pv_d0(o, vb0, pa0, pa1, pa2, pa3);
    }
    asm volatile("s_waitcnt vmcnt(0)" ::: "memory");
    if (hi == 0) li_l[r32] = l_reg;
    __syncthreads();
    {
        LAS bf16_t* st = (LAS bf16_t*)lds;
#pragma unroll
        for (int r = 0; r < 16; ++r) { const int orow = qs * 32 + crow(r, hi); const float rl = __builtin_amdgcn_rcpf(li_l[crow(r, hi)]);
#pragma unroll
            for (int d0 = 0; d0 < 4; ++d0) st[orow * 512 + hl * 128 + d0 * 32 + r32] = (bf16_t)(cvt_pk_bf16(o[d0][r] * rl, 0.f) & 0xffffu); }
    }
    __syncthreads();
    og_store_rows(lds, SGg, OGg, kvh, 64, tid);
    __syncthreads();
#undef DMA_K
#undef DMA_V
#undef STEPBAR
#undef RESC
#undef MB
}

#define WGBAR() do { asm volatile("s_waitcnt lgkmcnt(0)" ::: "memory"); __builtin_amdgcn_s_barrier(); asm volatile("" ::: "memory"); } while (0)
__device__ __forceinline__ void attn_sample_block(const bf16_t* __restrict__ Qg, const float* __restrict__ ck, const float* __restrict__ cv, const bf16_t* __restrict__ kn, const bf16_t* __restrict__ vn,
                                                  const u64* __restrict__ rmq, const bf16_t* __restrict__ SGg, bf16_t* __restrict__ OGg, int kvh, const float* __restrict__ rel_bias, LAS char* lds) {
    int tid = threadIdx.x; asm volatile("" : "+v"(tid));
    const int wid = __builtin_amdgcn_readfirstlane(tid >> 6), lane = tid & 63, r32 = lane & 31, hi = lane >> 5;
    constexpr int NT = 65;
    LAS char* V_lds = lds; LAS char* K_lds = lds + 2 * SHM_V;
    LAS float* tb = (LAS float*)(lds + OFF_TB);
    for (int e = tid; e < 1024; e += NTHREADS) {
        const int h = e >> 8, rel = (e & 255) - 192, n = rel < 0 ? -rel : rel;
        int bk = n < 8 ? n : (n < 12 ? 8 : n < 16 ? 9 : n < 23 ? 10 : n < 32 ? 11 : n < 46 ? 12 : n < 64 ? 13 : n < 91 ? 14 : 15);
        if (rel > 0) bk += 16;
        tb[e] = (rel_bias[bk * 32 + kvh * 4 + h] - rel_bias[15 * 32 + kvh * 4 + h]) * (1.0f / SCALE);
    }
    {   const u32x4* src = (const u32x4*)rmq; LAS u32x4* dst = (LAS u32x4*)(lds + OFF_MK);
        for (int e = tid; e < 32 * RMS * 8 / 16; e += NTHREADS) dst[e] = src[e]; }
    if (wid >= 4) {
        const int lt = tid - 256;
        f32x4 krA[4][2], vrA[4][2], krB[4][2], vrB[4][2];
        const int row0 = lt >> 4, c8 = (lt & 15) * 8;
#define LD_TILE(kr, vr, t) do { if ((t) < 64) { _Pragma("unroll") for (int i = 0; i < 4; ++i) { const size_t o_ = ((size_t)(t) * 64 + row0 + 16 * i) * KVW + c8; \
            kr[i][0] = *(const f32x4*)(ck + o_); kr[i][1] = *(const f32x4*)(ck + o_ + 4); vr[i][0] = *(const f32x4*)(cv + o_); vr[i][1] = *(const f32x4*)(cv + o_ + 4); } } } while (0)
#define WR_TILE(kr, vr, t, b) do { if ((t) < 64) { _Pragma("unroll") for (int i = 0; i < 4; ++i) { const int r_ = row0 + 16 * i; \
            *(LAS u32x4*)(K_lds + (b) * SHM_K + KSWZ(r_, c8 * 2)) = pack8(kr[i][0], kr[i][1]); *(LAS u32x4*)(V_lds + (b) * SHM_V + v_st(r_, c8)) = pack8(vr[i][0], vr[i][1]); } } \
        else if ((t) == 64) { _Pragma("unroll") for (int i = 0; i < 4; ++i) { const int r_ = row0 + 16 * i; u32x4 kx = (u32x4){0u, 0u, 0u, 0u}, vx = kx; \
            if (r_ < 32) { kx = *(const u32x4*)(kn + (size_t)r_ * KVW + c8); vx = *(const u32x4*)(vn + (size_t)r_ * KVW + c8); } \
            *(LAS u32x4*)(K_lds + (b) * SHM_K + KSWZ(r_, c8 * 2)) = kx; *(LAS u32x4*)(V_lds + (b) * SHM_V + v_st(r_, c8)) = vx; } } } while (0)
        LD_TILE(krA, vrA, 0); WR_TILE(krA, vrA, 0, 0); LD_TILE(krA, vrA, 1); LD_TILE(krB, vrB, 2);
        WGBAR();
        WR_TILE(krA, vrA, 1, 1); LD_TILE(krA, vrA, 3);
        WGBAR();
        for (int j = 1; j + 1 < NT; j += 2) {
            WGBAR();
            WR_TILE(krB, vrB, j + 1, 0);
            WGBAR();
            LD_TILE(krB, vrB, j + 3);
            WGBAR();
            WR_TILE(krA, vrA, j + 2, 1);
            WGBAR();
            LD_TILE(krA, vrA, j + 4);
        }
#undef LD_TILE
#undef WR_TILE
    } else {
        LAS float* ws = (LAS float*)(lds + OFF_WS) + wid * 64; LAS float* li_l = ws; LAS float* al_l = ws + 32;
        const int head = kvh * 4 + wid;
        float m_reg = MINIT, l_reg = 0; f32x16 o[4] = {}; bf16x8 qr[8];
        const bf16_t* Qw = Qg + (size_t)r32 * DM + head * D + hi * 8;
#pragma unroll
        for (int d0 = 0; d0 < 8; ++d0) qr[d0] = *(const bf16x8*)(Qw + d0 * 16);
        const LAS u64* rml = (const LAS u64*)(lds + OFF_MK) + r32 * RMS;
        const int vb0 = (int)(uintptr_t)V_lds + v_rd_base(lane);
        const int tboff = wid * 256 + 192 - (PAST + r32) + 4 * hi;
#define RESC(a) do { if (__any((a) < 1.f)) { if (hi == 0) al_l[r32] = (a); asm volatile("s_waitcnt lgkmcnt(0)" ::: "memory"); \
    _Pragma("unroll") for (int d = 0; d < 4; ++d) _Pragma("unroll") for (int r = 0; r < 16; ++r) o[d][r] *= al_l[crow(r, hi)]; } } while (0)
#define MB(P0, P1, t) mask_bias(P0, P1, rml[t], (t) >= NT - 3, tb + tboff + (t) * KVBLK, hi)
        f32x16 pA0, pA1, pB0, pB1; float mnA, mnB, alA, alB; bf16x8 pa0, pa1, pa2, pa3;
        WGBAR();
        qkt(pA0, pA1, K_lds, qr, r32, hi); MB(pA0, pA1, 0); partialSM(pA0, pA1, m_reg, mnA, alA);
        WGBAR();
        for (int j = 1; j + 1 < NT; j += 2) {
            SBAR(); qkt(pB0, pB1, K_lds + SHM_K, qr, r32, hi);
            finishSM(pA0, pA1, alA, l_reg, pa0, pa1, pa2, pa3); SBAR();
            pv_d0(o, vb0, pa0, pa1, pa2, pa3); MB(pB0, pB1, j); partialSM(pB0, pB1, m_reg, mnB, alB);
            WGBAR();
            RESC(alB);
            WGBAR();
            SBAR(); qkt(pA0, pA1, K_lds, qr, r32, hi);
            finishSM(pB0, pB1, alB, l_reg, pa0, pa1, pa2, pa3); SBAR();
            pv_d0(o, vb0 + (int)SHM_V, pa0, pa1, pa2, pa3); MB(pA0, pA1, j + 1); partialSM(pA0, pA1, m_reg, mnA, alA);
            WGBAR();
            RESC(alA);
            WGBAR();
        }
        finishSM(pA0, pA1, alA, l_reg, pa0, pa1, pa2, pa3); SBAR();
        pv_d0(o, vb0, pa0, pa1, pa2, pa3);
        if (hi == 0) li_l[r32] = l_reg;
        WGBAR();
        {
            LAS bf16_t* st = (LAS bf16_t*)lds;
#pragma unroll
            for (int r = 0; r < 16; ++r) { const int orow = crow(r, hi); const float rl = __builtin_amdgcn_rcpf(li_l[orow]);
#pragma unroll
                for (int d0 = 0; d0 < 4; ++d0) st[orow * 512 + wid * 128 + d0 * 32 + r32] = (bf16_t)(cvt_pk_bf16(o[d0][r] * rl, 0.f) & 0xffffu); }
        }
#undef RESC
#undef MB
    }
    if (wid >= 4) WGBAR();
    __syncthreads();
    og_store_rows(lds, SGg, OGg, kvh, 32, tid);
    __syncthreads();
}
}

__global__ void __launch_bounds__(NTHREADS, 2) mega(Params p) {
    extern __shared__ __attribute__((aligned(16))) unsigned char lds_raw[];
    LAS unsigned char* lds = (LAS unsigned char*)lds_raw;
    volatile LAS unsigned* MISC = (volatile LAS unsigned*)(lds + MISC_OFF);
    const int G = gridDim.x; const int bx = blockIdx.x;
    const int vcu = (G % 8 == 0) ? (bx % 8) * (G / 8) + bx / 8 : bx;
    const int NGW = G * NWAVES;
#define PHASE_IDS() int tid = threadIdx.x; asm volatile("" : "+v"(tid)); const int lane = tid & 63, wave = __builtin_amdgcn_readfirstlane(tid >> 6), gw = vcu * NWAVES + wave; (void)lane; (void)gw
    unsigned char* ws = p.ws; float* out = p.out;
    const int lo = p.ph_lo, hi_ph = p.ph_hi;
    for (int u = threadIdx.x; u < (LDS_BYTES - RING_BYTES) / 4; u += NTHREADS) ((LAS unsigned*)(lds + RING_BYTES))[u] = 0u;
    __syncthreads();
    XcdBarrier bar; bar.bar = (unsigned*)(ws + WS_CTL) + CW_BAR; bar.x = 0; bar.st = nullptr;
    if (hi_ph - lo > 1) bar = xcd_barrier_post((unsigned*)(ws + WS_CTL) + CW_BAR, MISC + 8);
#ifndef PH_MASK
#define PH_MASK 0x7fff
#endif
#define IN(k) (((PH_MASK >> (k)) & 1) && lo <= (k) && (k) < hi_ph)
#define SEAM(k) do { if (IN(k) && IN((k) + 1)) xcd_barrier(bar); } while (0)

    if (IN(0)) {
        PHASE_IDS();
        LAS float* scr = (LAS float*)(lds + wave * 16384);
        constexpr int I_IN = 64 * 67, I_GRP = 4 * 16 * 32, I_AMX = 64 * 40, I_AMX2 = 64 * 32, I_AMX3 = 64 * 16;
        constexpr int NITEMS = I_IN + I_GRP + I_AMX + I_AMX2 + 2 * I_AMX3;
        for (int it = gw; it < NITEMS; it += NGW) {
            int r = it;
            if (r < I_IN) { const int kb = r / 67, nb = r % 67, n0 = 6144 + nb * 32;
                transpose_item(p.attn_w_in, 12384, kb * 64, n0, (bf16_t*)(ws + WS_WT_IN), DM, nb * 32, scr, lane); continue; } r -= I_IN;
            if (r < I_GRP) { const int g = r / 512, q = r % 512;
                transpose_item(p.pool_group_w + (size_t)g * 1024 * 1024, 1024, (q / 32) * 64, (q % 32) * 32, (bf16_t*)(ws + WS_WT_GRP), 1024, g * 1024 + (q % 32) * 32, scr, lane); continue; } r -= I_GRP;
            if (r >= I_AMX + I_AMX2) {
                r -= I_AMX + I_AMX2; const bool second = r >= I_AMX3; if (second) r -= I_AMX3;
                const int kb = r >> 4, cb = r & 15, n0 = cb * 256 + lane * 4;
                const float* wp = (second ? p.pool_w_out : p.attn_w_out) + (size_t)kb * 64 * DM + n0; f32x4 m = (f32x4){0.f, 0.f, 0.f, 0.f};
#pragma unroll 8
                for (int k = 0; k < 64; ++k) { const f32x4 x = *(const f32x4*)(wp + (size_t)k * DM); m.x = fmaxf(m.x, fabsf(x.x)); m.y = fmaxf(m.y, fabsf(x.y)); m.z = fmaxf(m.z, fabsf(x.z)); m.w = fmaxf(m.w, fabsf(x.w)); }
                unsigned* cm = (unsigned*)(ws + (second ? WS_CAMAX4 : WS_CAMAX3)) + n0;
                atomicMax(cm, __float_as_uint(m.x)); atomicMax(cm + 1, __float_as_uint(m.y)); atomicMax(cm + 2, __float_as_uint(m.z)); atomicMax(cm + 3, __float_as_uint(m.w));
                continue;
            }
            if (r >= I_AMX) {
                r -= I_AMX; const int kb = r >> 5, cb = r & 31, n0 = cb * 256 + lane * 4;
                const float* wp = p.pool_w_in + (size_t)kb * 64 * 8192 + n0; const float* nw = p.norm_w + DM + kb * 64; f32x4 m = (f32x4){0.f, 0.f, 0.f, 0.f};
#pragma unroll 8
                for (int k = 0; k < 64; ++k) { const f32x4 x = *(const f32x4*)(wp + (size_t)k * 8192) * nw[k]; m.x = fmaxf(m.x, fabsf(x.x)); m.y = fmaxf(m.y, fabsf(x.y)); m.z = fmaxf(m.z, fabsf(x.z)); m.w = fmaxf(m.w, fabsf(x.w)); }
                unsigned* cm = (unsigned*)(ws + WS_CAMAX2) + cb * 256 + lane * 4;
                atomicMax(cm, __float_as_uint(m.x)); atomicMax(cm + 1, __float_as_uint(m.y)); atomicMax(cm + 2, __float_as_uint(m.z)); atomicMax(cm + 3, __float_as_uint(m.w));
                continue;
            }
            {
                const int kb = r / 40, cb = r % 40, n0 = (cb < 24 ? cb * 256 : 8288 + (cb - 24) * 256) + lane * 4;
                const float* wp = p.attn_w_in + (size_t)kb * 64 * 12384 + n0; f32x4 m = (f32x4){0.f, 0.f, 0.f, 0.f};
#pragma unroll 8
                for (int k = 0; k < 64; ++k) { const f32x4 x = *(const f32x4*)(wp + (size_t)k * 12384); m.x = fmaxf(m.x, fabsf(x.x)); m.y = fmaxf(m.y, fabsf(x.y)); m.z = fmaxf(m.z, fabsf(x.z)); m.w = fmaxf(m.w, fabsf(x.w)); }
                unsigned* cm = (unsigned*)(ws + WS_CAMAX) + cb * 256 + lane * 4;
                atomicMax(cm, __float_as_uint(m.x)); atomicMax(cm + 1, __float_as_uint(m.y)); atomicMax(cm + 2, __float_as_uint(m.z)); atomicMax(cm + 3, __float_as_uint(m.w));
            }
        }
        {
            u32x4* z = (u32x4*)((bf16_t*)(ws + WS_WT_IN) + (size_t)2144 * DM);
            for (size_t i = (size_t)gw * 64 + lane; i < (size_t)160 * DM * 2 / 16; i += (size_t)NGW * 64) z[i] = (u32x4){0u, 0u, 0u, 0u};
        }
        for (int m = gw; m < MT; m += NGW)
            rms_row_q(m < MP ? p.x_prompt + (size_t)m * DM : p.x_sample + (size_t)(m - MP) * DM, p.norm_w, (bf16_t*)(ws + WS_H) + (size_t)m * DM,
                      (signed char*)(ws + WS_H8) + (size_t)m * DM, (float*)(ws + WS_SA) + m, lane);
        {
            const size_t gt = (size_t)gw * 64 + lane, GT = (size_t)NGW * 64;
            constexpr size_t NK8 = (size_t)DB * SKV * DIDX / 8;
            for (size_t i = gt; i < NK8; i += GT) {
                const size_t row = i / 8, c8 = i % 8, bb = row / SKV, s = row % SKV;
                if (s >= (size_t)PAST && s < (size_t)PAST + DSQ) continue;
                u32x4 w = (u32x4){0u, 0u, 0u, 0u};
                if (s < (size_t)PAST) { const float* src = p.cache_kidx + (bb * PAST + s) * DIDX + c8 * 8; w = pack8(*(const f32x4*)src, *(const f32x4*)(src + 4)); }
                *(u32x4*)((bf16_t*)(ws + WS_KIS) + bb * SKV * DIDX + kif_off((int)s, (int)c8 * 8)) = w;
            }
        }
    }
    SEAM(0);
    if (IN(1)) {
        PHASE_IDS();
        LAS float* scr = (LAS float*)(lds + wave * 16384);
        for (int it = gw; it < 64 * 320; it += NGW) { const int kb = it / 320, nb = it % 320, n0 = nb < 192 ? nb * 32 : 8288 + (nb - 192) * 32;
            transpose_item_i8(p.attn_w_in, 12384, kb * 64, n0, (signed char*)(ws + WS_WT8), DM, nb * 32, scr, lane, (const unsigned*)(ws + WS_CAMAX), (float*)(ws + WS_SB)); }
        for (int it = gw; it < 64 * 256; it += NGW) { const int kb = it >> 8, nb = it & 255;
            transpose_item_i8(p.pool_w_in, 8192, kb * 64, nb * 32, (signed char*)(ws + WS_WP8), DM, nb * 32, scr, lane, (const unsigned*)(ws + WS_CAMAX2), (float*)(ws + WS_SB2), p.norm_w + DM); }
        for (int it = gw; it < 2 * 64 * 128; it += NGW) { const bool second = it >= 64 * 128; const int r = second ? it - 64 * 128 : it, kb = r >> 7, nb = r & 127;
            transpose_item_i8(second ? p.pool_w_out : p.attn_w_out, DM, kb * 64, nb * 32, (signed char*)(ws + (second ? WS_WPO8 : WS_WO8)), DM, nb * 32, scr, lane,
                              (const unsigned*)(ws + (second ? WS_CAMAX4 : WS_CAMAX3)), (float*)(ws + (second ? WS_SB4 : WS_SB3))); }
    }
    SEAM(1);
    if (IN(2)) {
        {
            pg8::Gemm g{(const bf16_t*)(ws + WS_H8), (const bf16_t*)(ws + WS_WT8), MT, NI8, DM / 2, DM / 2, DM / 2, 0};
            pg8::Order S; S.init(MT / 256, 40, 0, 0, G, bx);
            Epi1a E{ws, out};
            pg8::gemm_phase<Epi1a, false, true>(lds, g, S, E);
        }
        {
            pg8::Gemm g{(const bf16_t*)(ws + WS_H), (const bf16_t*)(ws + WS_WT_IN), MT, NB16, DM, DM, DM, 0};
            int G2 = G; asm volatile("" : "+s"(G2));
            pg8::Order S; S.init(MT / 256, 8, MT / 256, 1, G2, G2 - 1 - bx);
            Epi1b E{ws, out};
            pg8::gemm_phase<Epi1b, true>(lds, g, S, E);
        }
    }
    SEAM(2);
    if (IN(3)) {
        const bf16_t* QIF = (const bf16_t*)(ws + WS_QIB); const float* WI = (const float*)(ws + WS_WIB); float* SC = (float*)(ws + WS_SC);
        for (int it = vcu; it < 512; it += G) {
            if (it < 256) {
#pragma unroll 1
                for (int hh = 0; hh < 2; ++hh) { const int g = hh ? 511 - it : it, b = g >> 7, nt = ((g & 127) >> 1) + 1;
                    if (nt > 4) score_tiles(QIF + (size_t)g * 65536, WI + (size_t)g * 32 * HIDX, (const bf16_t*)(ws + WS_KIP) + (size_t)b * SEQ * DIDX, SC + (size_t)g * 32 * SCW, 0, 1, nt, lds); }
            } else {
                const int sb = (it - 256) >> 3, kr = (it - 256) & 7, g = 512 + sb;
                score_tiles(QIF + (size_t)g * 65536, WI + (size_t)g * 32 * HIDX, (const bf16_t*)(ws + WS_KIS) + (size_t)sb * SKV * DIDX, SC + (size_t)g * 32 * SCW, kr, 8, kr == 0 ? 9 : 8, lds);
            }
        }
    }
    SEAM(3);
    if (IN(4)) {
        PHASE_IDS();
        u64* RM = (u64*)(ws + WS_RM); const float* SC = (const float*)(ws + WS_SC);
        for (int pi = gw; pi < 2048; pi += NGW) {
            const int nq = (pi & 1) == 0 ? 9 : 8;
            float vv[NVJ];
#pragma unroll
            for (int j = 0; j < NVJ; ++j) vv[j] = 0.f;
            sel_load(SC + (size_t)pi * SCW, (pi >> 6) + 1, vv, lane);
#pragma unroll 1
            for (int k = 0; k < nq; ++k) {
                int m, nt, nv;
                if (k < 8) { const int b = k >> 1, t = (k & 1) ? 4095 - pi : pi; m = b * SEQ + t; nt = (t >> 6) + 1; nv = nt * 64; } else { m = MP + (pi >> 1); nt = 65; nv = PAST + DSQ; }
                int m2 = 0, nt2 = 0;
                if (k + 1 < 8) { const int b = (k + 1) >> 1, t = ((k + 1) & 1) ? 4095 - pi : pi; m2 = b * SEQ + t; nt2 = (t >> 6) + 1; } else if (k + 1 < nq) { m2 = MP + (pi >> 1); nt2 = 65; }
                select_row(vv, nt, nv, RM + (size_t)m * RMS, SC + (size_t)m2 * SCW, nt2, lane);
            }
        }
    }
    SEAM(4);
    if (IN(5)) {
        const u64* RM = (const u64*)(ws + WS_RM);
        const bf16_t* QB = (const bf16_t*)(ws + WS_QB); const bf16_t* SG = (const bf16_t*)(ws + WS_SG); bf16_t* OG = (bf16_t*)(ws + WS_OG);
        for (int sl = vcu; sl < 1280; sl += G) {
            const int v = sl & 255, k = sl >> 8, ks = v % 5;
            if (k != ks) {
                const int it = v + 256 * (k - (k > ks ? 1 : 0));
                const int b = it >> 8, kvh = (it >> 5) & 7, pr = it & 31;
                const bf16_t* Kh = (const bf16_t*)(ws + WS_KP) + (size_t)b * SEQ * KVW + kvh * 128; const bf16_t* Vh = (const bf16_t*)(ws + WS_VP) + (size_t)b * SEQ * KVW + kvh * 128;
#pragma unroll 1
                for (int half = 0; half < 2; ++half) {
                    const int c = half ? 63 - pr : pr; const size_t m0 = (size_t)b * SEQ + c * 64;
                    att::attn_block(QB + m0 * DM, Kh, Vh, RM + m0 * RMS, SG + m0 * DM, OG + m0 * DM, c + 1, c * 64, kvh, p.rel_bias, (LAS char*)lds);
                }
            } else {
                const int b = v >> 3, kvh = v & 7; const size_t m0 = (size_t)MP + b * 32;
                att::attn_sample_block(QB + m0 * DM, p.cache_k + ((size_t)b * PAST * NKVH + kvh) * 128, p.cache_v + ((size_t)b * PAST * NKVH + kvh) * 128,
                                       (const bf16_t*)(ws + WS_KSN) + (size_t)b * 32 * KVW + kvh * 128, (const bf16_t*)(ws + WS_VSN) + (size_t)b * 32 * KVW + kvh * 128,
                                       RM + m0 * RMS, SG + m0 * DM, OG + m0 * DM, kvh, p.rel_bias, (LAS char*)lds);
            }
        }
    }
    SEAM(5);
    if (IN(6)) {
        PHASE_IDS();
        for (int m = gw; m < MT; m += NGW) { float am, ss; quant_row_bf16((const bf16_t*)(ws + WS_OG) + (size_t)m * DM, (signed char*)(ws + WS_H8) + (size_t)m * DM, am, ss, lane);
            if (lane == 0) ((float*)(ws + WS_SA))[m] = am * (1.0f / 127.0f); }
    }
    SEAM(6);
    if (IN(7)) {
        pg8::Gemm g{(const bf16_t*)(ws + WS_H8), (const bf16_t*)(ws + WS_WO8), MT, DM, DM / 2, DM / 2, DM / 2, 0};
        pg8::Order S; S.init(MP / 256, 16, 256, 2, G, bx);
        EpiX1 E{p.x_prompt, nullptr, (bf16_t*)(ws + WS_H), (float*)(ws + WS_PS), (const float*)(ws + WS_SA), (const float*)(ws + WS_SB3)};
        pg8::gemm_phase<EpiX1, false, true>(lds, g, S, E);
    }
    SEAM(7);
    if (IN(8)) {
        PHASE_IDS();
        signed char* X8 = (signed char*)(ws + WS_H8); float* ROWF = (float*)(ws + WS_ROWF);
        for (int m = gw; m < MP; m += NGW) {
            float am, ss; quant_row_bf16((const bf16_t*)(ws + WS_H) + (size_t)m * DM, X8 + (size_t)m * DM, am, ss, lane);
            if (lane == 0) ROWF[m] = am * (1.0f / 127.0f) / sqrtf(ss * (1.0f / DM) + EPS);
        }
        for (int m = MP + gw; m < MT; m += NGW) {
            const f32x4* xr = (const f32x4*)(p.x_sample + (size_t)(m - MP) * DM) + lane; const f32x4* ps = (const f32x4*)((const float*)(ws + WS_PS) + (size_t)(m - MP) * DM) + lane;
            f32x4* x1 = (f32x4*)((float*)(ws + WS_X1) + (size_t)m * DM) + lane; float ss = 0.f, am = 0.f;
#define X1V(j) (xr[64 * (j)] + ((ps[64 * (j)] + ps[64 * (j) + (size_t)MS * DM / 4]) + (ps[64 * (j) + (size_t)2 * MS * DM / 4] + ps[64 * (j) + (size_t)3 * MS * DM / 4])))
#pragma unroll 2
            for (int j = 0; j < 16; ++j) { const f32x4 v = X1V(j); x1[64 * j] = v; ss += (v.x * v.x + v.y * v.y) + (v.z * v.z + v.w * v.w);
                am = fmaxf(am, fmaxf(fmaxf(fabsf(v.x), fabsf(v.y)), fmaxf(fabsf(v.z), fabsf(v.w)))); }
#pragma unroll
            for (int o = 1; o < 64; o <<= 1) am = fmaxf(am, __shfl_xor(am, o));
            ss = wave_sum(ss);
            const float inv = am > 0.f ? 127.0f / am : 0.f;
            unsigned* q = (unsigned*)(X8 + (size_t)m * DM) + lane;
            asm volatile("s_waitcnt vmcnt(0)" ::: "memory");
#pragma unroll 2
            for (int j = 0; j < 16; ++j) { const f32x4 v = x1[64 * j]; q[64 * j] = q8x4(v.x * inv, v.y * inv, v.z * inv, v.w * inv); }
#undef X1V
            if (lane == 0) ROWF[m] = am * (1.0f / 127.0f) / sqrtf(ss * (1.0f / DM) + EPS);
        }
        {
            bf16_t* U = (bf16_t*)(ws + WS_U);
            constexpr int NPAD = (NBATCH + DB) * 16 * 512;
            for (int i = gw * 64 + lane; i < NPAD; i += NGW * 64) {
                const int c = (i & 511) * 8, rr = i >> 9, sq = rr >> 4, k = rr & 15;
                u32x4 o = (u32x4){0u, 0u, 0u, 0u}; size_t row;
                if (sq < NBATCH) row = (size_t)sq * UP_SEQ + k;
                else { const int b = sq - NBATCH; row = (size_t)UP_ROWS + (size_t)b * US_SEQ + k;
                    if (k >= 1) { const float* hp = p.state_pool + ((size_t)b * 15 + (k - 1)) * DM + c; o = pack8(*(const f32x4*)hp, *(const f32x4*)(hp + 4)); } }
                *(u32x4*)(U + row * DM + c) = o;
            }
        }
    }
    SEAM(8);
    if (IN(9)) {
        pg8::Gemm g{(const bf16_t*)(ws + WS_H8), (const bf16_t*)(ws + WS_WP8), MT, 8192, DM / 2, DM / 2, DM / 2, 0};
        pg8::Order S; S.init(MT / 256, 32, 0, 0, G, bx);
        Epi3 E{ws, out};
        pg8::gemm_phase<Epi3, false, true>(lds, g, S, E);
    }
    SEAM(9);
    if (IN(10)) {
        PHASE_IDS();
        const bf16_t* __restrict__ U = (const bf16_t*)(ws + WS_U); bf16_t* __restrict__ MX = (bf16_t*)(ws + WS_MX);
        constexpr int RUN = 32, NRUN_P = MP / RUN, NITEM = (NRUN_P + DB) * 512;
        const int gt = gw * 64 + lane, GT = NGW * 64;
#define ACC8(S, X, SGN) do { S[0] += SGN bf_lo(X.x); S[1] += SGN bf_hi(X.x); S[2] += SGN bf_lo(X.y); S[3] += SGN bf_hi(X.y); S[4] += SGN bf_lo(X.z); S[5] += SGN bf_hi(X.z); S[6] += SGN bf_lo(X.w); S[7] += SGN bf_hi(X.w); } while (0)
        for (int i = gt; i < NITEM; i += GT) {
            const int run = i >> 9, c = (i & 511) * 8, w = 2 << (c >> 10);
            const bool samp = run >= NRUN_P;
            const int m0 = samp ? MP + (run - NRUN_P) * 32 : run * RUN;
            const int t0 = samp ? 0 : (m0 & 4095);
            const bf16_t* up = U + (size_t)u_row(m0) * DM + c;
            float s[8] = {0.f, 0.f, 0.f, 0.f, 0.f, 0.f, 0.f, 0.f};
            for (int k = 1; k <= w; ++k) { const u32x4 x = *(const u32x4*)(up - (size_t)k * DM); ACC8(s, x, +); }
            const float icw = 1.0f / (float)w;
#pragma unroll 1
            for (int tb = 0; tb < RUN; tb += 8) {
                u32x4 cur[8], old[8];
#pragma unroll
                for (int q = 0; q < 8; ++q) { cur[q] = *(const u32x4*)(up + (size_t)(tb + q) * DM); old[q] = *(const u32x4*)(up + ((ptrdiff_t)(tb + q) - w) * DM); }
#pragma unroll
                for (int q = 0; q < 8; ++q) {
                    const int t = t0 + tb + q;
                    ACC8(s, cur[q], +); ACC8(s, old[q], -);
                    const float ic = (samp || t + 1 >= w) ? icw : 1.0f / (float)(t + 1);
                    const float f[8] = {bf_lo(cur[q].x), bf_hi(cur[q].x), bf_lo(cur[q].y), bf_hi(cur[q].y), bf_lo(cur[q].z), bf_hi(cur[q].z), bf_lo(cur[q].w), bf_hi(cur[q].w)};
                    u32x4 o;
                    o.x = cvt_pk_bf16(s[0] * ic - f[0], s[1] * ic - f[1]); o.y = cvt_pk_bf16(s[2] * ic - f[2], s[3] * ic - f[3]);
                    o.z = cvt_pk_bf16(s[4] * ic - f[4], s[5] * ic - f[5]); o.w = cvt_pk_bf16(s[6] * ic - f[6], s[7] * ic - f[7]);
                    *(u32x4*)(MX + (size_t)(m0 + tb + q) * DM + c) = o;
                }
            }
        }
#undef ACC8
    }
    SEAM(10);
    if (IN(11)) {
        pg8::Gemm g{(const bf16_t*)(ws + WS_MX), (const bf16_t*)(ws + WS_WT_GRP), MT, DM, 1024, DM, 1024, 1};
        pg8::Order S; S.init(MT / 256, 16, 0, 0, G, bx);
        Epi4 E{ws, p.pool_scale};
        pg8::gemm_phase<Epi4>(lds, g, S, E);
    }
    SEAM(11);
    if (IN(12)) {
        PHASE_IDS();
        for (int m = gw; m < MT; m += NGW) { float am, ss; quant_row_bf16((const bf16_t*)(ws + WS_ZG) + (size_t)m * DM, (signed char*)(ws + WS_H8) + (size_t)m * DM, am, ss, lane);
            if (lane == 0) ((float*)(ws + WS_SA))[m] = am * (1.0f / 127.0f); }
    }
    SEAM(12);
    if (IN(13)) {
        pg8::Gemm g{(const bf16_t*)(ws + WS_H8), (const bf16_t*)(ws + WS_WPO8), MT, DM, DM / 2, DM / 2, DM / 2, 0};
        pg8::Order S; S.init(MP / 256, 16, 256, 2, G, bx);
        EpiX2 E{(bf16_t*)(ws + WS_H), (float*)(ws + WS_PS), (const float*)(ws + WS_SA), (const float*)(ws + WS_SB4)};
        pg8::gemm_phase<EpiX2, false, true>(lds, g, S, E);
    }
    SEAM(13);
    if (IN(14)) {
        PHASE_IDS();
        for (int m = gw; m < MP; m += NGW) {
            const u32x4* xb = (const u32x4*)((const bf16_t*)(ws + WS_H) + (size_t)m * DM) + lane; u32x4 x[8]; float ss = 0.f;
#pragma unroll
            for (int j = 0; j < 8; ++j) { x[j] = xb[64 * j]; const float f[8] = {bf_lo(x[j].x), bf_hi(x[j].x), bf_lo(x[j].y), bf_hi(x[j].y), bf_lo(x[j].z), bf_hi(x[j].z), bf_lo(x[j].w), bf_hi(x[j].w)};
#pragma unroll
                for (int e = 0; e < 8; ++e) ss = fmaf(f[e], f[e], ss); }
            const float rstd = 1.0f / sqrtf(wave_sum(ss) * (1.0f / DM) + EPS);
            const f32x4* wr = (const f32x4*)p.final_norm_w + 2 * lane; f32x4* yo = (f32x4*)(out + O_YP + (size_t)m * DM) + 2 * lane;
#pragma unroll
            for (int j = 0; j < 8; ++j) { const f32x4 w0 = wr[128 * j], w1 = wr[128 * j + 1];
                yo[128 * j] = (f32x4){bf_lo(x[j].x), bf_hi(x[j].x), bf_lo(x[j].y), bf_hi(x[j].y)} * rstd * w0; yo[128 * j + 1] = (f32x4){bf_lo(x[j].z), bf_hi(x[j].z), bf_lo(x[j].w), bf_hi(x[j].w)} * rstd * w1; }
        }
        for (int m = MP + gw; m < MT; m += NGW) {
            const f32x4* xr = (const f32x4*)((const float*)(ws + WS_X1) + (size_t)m * DM) + lane; const f32x4* ps = (const f32x4*)((const float*)(ws + WS_PS) + (size_t)(m - MP) * DM) + lane;
            const f32x4* wr = (const f32x4*)p.final_norm_w + lane; f32x4* yo = (f32x4*)(out + O_YS + (size_t)(m - MP) * DM) + lane;
            float ss = 0.f;
#define X2V(j) (xr[64 * (j)] + ((ps[64 * (j)] + ps[64 * (j) + (size_t)MS * DM / 4]) + (ps[64 * (j) + (size_t)2 * MS * DM / 4] + ps[64 * (j) + (size_t)3 * MS * DM / 4])))
#pragma unroll 2
            for (int j = 0; j < 16; ++j) { const f32x4 v = X2V(j); ss += (v.x * v.x + v.y * v.y) + (v.z * v.z + v.w * v.w); }
            const float rstd = 1.0f / sqrtf(wave_sum(ss) * (1.0f / DM) + EPS);
#pragma unroll 2
            for (int j = 0; j < 16; ++j) { const f32x4 v = X2V(j); yo[64 * j] = v * rstd * wr[64 * j]; }
#undef X2V
        }
    }
#undef IN
#undef SEAM
}

#ifndef MK_N_LAUNCHES
#define MK_N_LAUNCHES 1
#endif
extern "C" void kernel_launch(void* const* d_in, const int* in_sizes, int n_in, void* d_out, int out_size, void* d_ws, size_t ws_size, hipStream_t stream) {
    static int grid = 0;
    if (grid == 0) {
        if (n_in != 15 || (size_t)out_size != O_END || ws_size < WS_END) { fprintf(stderr, "kernel_launch: unexpected shapes: n_in %d out %d ws %zu (need >= %zu)\n", n_in, out_size, ws_size, (size_t)WS_END); grid = -1; return; }
        int dev = 0, cus = 0, per_cu = 0;
        if (hipGetDevice(&dev) != hipSuccess || hipDeviceGetAttribute(&cus, hipDeviceAttributeMultiprocessorCount, dev) != hipSuccess) { grid = -1; return; }
        if (hipFuncSetAttribute((const void*)mega, hipFuncAttributeMaxDynamicSharedMemorySize, LDS_BYTES) != hipSuccess) { fprintf(stderr, "kernel_launch: hipFuncSetAttribute failed\n"); grid = -1; return; }
        if (hipOccupancyMaxActiveBlocksPerMultiprocessor(&per_cu, (const void*)mega, NTHREADS, LDS_BYTES) != hipSuccess || per_cu < 1) { fprintf(stderr, "kernel_launch: occupancy query says %d\n", per_cu); }
        (void)hipGetLastError();
        grid = cus;
    }
    if (grid < 0) return;
    if (hipMemsetAsync((char*)d_ws + WS_CTL, 0, CTL_ZERO_BYTES, stream) != hipSuccess) return;
    Params p{};
    p.x_prompt = (const float*)d_in[0]; p.x_sample = (const float*)d_in[1]; p.cache_k = (const float*)d_in[2]; p.cache_v = (const float*)d_in[3];
    p.cache_kidx = (const float*)d_in[4]; p.state_pool = (const float*)d_in[5]; p.norm_w = (const float*)d_in[6]; p.final_norm_w = (const float*)d_in[7];
    p.attn_w_in = (const float*)d_in[8]; p.attn_w_out = (const float*)d_in[9]; p.rel_bias = (const float*)d_in[10]; p.pool_w_in = (const float*)d_in[11];
    p.pool_group_w = (const float*)d_in[12]; p.pool_scale = (const float*)d_in[13]; p.pool_w_out = (const float*)d_in[14];
    p.out = (float*)d_out; p.ws = (unsigned char*)d_ws;
    if (MK_N_LAUNCHES == 1) { p.ph_lo = 0; p.ph_hi = NPHASE; hipLaunchKernelGGL(mega, dim3(grid), dim3(NTHREADS), LDS_BYTES, stream, p); }
    else for (int k = 0; k < NPHASE; ++k) { p.ph_lo = k; p.ph_hi = k + 1; hipLaunchKernelGGL(mega, dim3(grid), dim3(NTHREADS), LDS_BYTES, stream, p); }
#ifdef PROBE_PHASE
    { p.ph_lo = PROBE_PHASE; p.ph_hi = PROBE_PHASE + 1; hipLaunchKernelGGL(mega, dim3(grid), dim3(NTHREADS), LDS_BYTES, stream, p); }
#endif
    const hipError_t le = hipPeekAtLastError();
    if (le != hipSuccess) fprintf(stderr, "kernel_launch: launch failed: %s\n", hipGetErrorName(le));
}
```

```cpp
#include <hip/hip_runtime.h>
#include <cstdio>
#include <cstdint>

#define LAS __attribute__((address_space(3)))
typedef unsigned short bf16_t;
typedef short bf16x8 __attribute__((ext_vector_type(8)));
typedef short s16x4 __attribute__((ext_vector_type(4)));
typedef float f32x4 __attribute__((ext_vector_type(4)));
typedef float f32x16 __attribute__((ext_vector_type(16)));
typedef unsigned u32x4 __attribute__((ext_vector_type(4)));
typedef unsigned u32x2 __attribute__((ext_vector_type(2)));
typedef unsigned long long u64;
typedef int i32x4 __attribute__((ext_vector_type(4)));

constexpr int DM = 4096, NBATCH = 4, SEQ = 4096, DB = 32, DSQ = 32, PAST = 4096;
constexpr int MP = NBATCH * SEQ, MS = DB * DSQ, MT = MP + MS;
constexpr int KVW = 1024, QIW = 2048, DIDX = 64, HIDX = 32, NKVH = 8;
constexpr int N1 = 12544;
constexpr int SKV = 4160;
constexpr int RMS = 65;
constexpr float EPS = 1e-6f;
constexpr int NWAVES = 8, NTHREADS = 512;
constexpr int NPHASE = 15;

constexpr size_t O_YP = 0, O_YS = 67108864, O_KP = 71303168, O_VP = 88080384, O_KIP = 104857600, O_POOLP = 105906176,
                 O_KS = 106151936, O_VS = 107200512, O_KIS = 108249088, O_POOLS = 108314624, O_END = 110280704;

constexpr size_t MiB = 1u << 20;
constexpr size_t WS_CTL = 0, CTL_ZERO_BYTES = 1 * MiB;
constexpr size_t WS_WT_IN = 1 * MiB, WS_WT_OUT = 99 * MiB, WS_WT_PIN = 131 * MiB, WS_WT_GRP = 195 * MiB, WS_WT_POUT = 203 * MiB;
constexpr size_t WS_H = 235 * MiB, WS_QB = 371 * MiB, WS_KP = 507 * MiB, WS_VP = 539 * MiB, WS_KS = 571 * MiB, WS_VS = 831 * MiB;
constexpr size_t WS_QIB = 1091 * MiB, WS_KIP = 1159 * MiB, WS_KIS = 1161 * MiB, WS_WIB = 1178 * MiB, WS_SG = 1181 * MiB, WS_RM = 1317 * MiB;
constexpr size_t WS_OG = 1326 * MiB, WS_X1 = 1462 * MiB, WS_SC = 1734 * MiB, WS_END = 2011 * MiB;
constexpr int SCW = 4160;
constexpr size_t WS_KSN = WS_KS, WS_VSN = WS_KS + 2 * MiB;
constexpr size_t WS_U = WS_QB, WS_SG2 = WS_SG, WS_MX = WS_OG, WS_ZG = WS_VS;
constexpr size_t WS_SS1 = WS_CTL + 256 * 1024;
constexpr size_t WS_PS = 600 * MiB;
constexpr size_t WS_H8 = 664 * MiB, WS_WT8 = 131 * MiB;
constexpr size_t WS_CAMAX = WS_CTL + 384 * 1024, WS_SB = WS_CTL + 448 * 1024, WS_SA = WS_CTL + 512 * 1024;
constexpr size_t WS_WP8 = 764 * MiB;
constexpr size_t WS_CAMAX2 = WS_CTL + 640 * 1024, WS_SB2 = WS_CTL + 704 * 1024, WS_ROWF = WS_CTL + 768 * 1024;
constexpr size_t WS_WO8 = 796 * MiB, WS_WPO8 = 812 * MiB;
constexpr size_t WS_CAMAX3 = WS_CTL + 848 * 1024, WS_CAMAX4 = WS_CTL + 864 * 1024, WS_SB3 = WS_CTL + 880 * 1024, WS_SB4 = WS_CTL + 896 * 1024;
constexpr int NB16 = 2304;
constexpr int NI8 = 10240;
constexpr int CW_BAR = 4096;

constexpr int LDS_BYTES = 147456, RING_BYTES = 131072, MISC_OFF = RING_BYTES + 320;

__device__ __forceinline__ unsigned cvt_pk_bf16(float lo, float hi) { unsigned r; asm("v_cvt_pk_bf16_f32 %0, %1, %2" : "=v"(r) : "v"(lo), "v"(hi)); return r; }
__device__ __forceinline__ float bf_lo(unsigned w) { return __uint_as_float(w << 16); }
__device__ __forceinline__ float bf_hi(unsigned w) { return __uint_as_float(w & 0xffff0000u); }
__device__ __forceinline__ float fma_abs(float a, float b, float c) { float d; asm("v_fma_f32 %0, %1, |%2|, %3" : "=v"(d) : "v"(a), "v"(b), "v"(c)); return d; }
__device__ __forceinline__ float silu_f(float x) { return x * __builtin_amdgcn_rcpf(1.0f + __builtin_amdgcn_exp2f(-1.4426950408889634f * x)); }
__device__ __forceinline__ float wave_sum(float v) {
#pragma unroll
    for (int o = 1; o < 64; o <<= 1) v += __shfl_xor(v, o);
    return v;
}
#define LDS_WAIT() asm volatile("s_waitcnt lgkmcnt(0)" ::: "memory")
#define VM_WAIT() asm volatile("s_waitcnt vmcnt(0)" ::: "memory")

#define XB_TMO      128
#define XB_XCNT(j)  (256  + 64 * (j))
#define XB_XSUB(j)  (1280 + 64 * (j))
#define XB_XGEN(j)  (2304 + 64 * (j))
#define XB_TOP      3328
#define XB_TOPGEN   3392
#define XCD_BAR_WORDS 3456
#define XB_SPIN_CAP (1u << 18)
__device__ __forceinline__ unsigned xb_ld(unsigned* p)              { return __hip_atomic_load(p, __ATOMIC_RELAXED, __HIP_MEMORY_SCOPE_AGENT); }
__device__ __forceinline__ unsigned xb_add(unsigned* p, unsigned v) { return __hip_atomic_fetch_add(p, v, __ATOMIC_RELAXED, __HIP_MEMORY_SCOPE_AGENT); }
__device__ __forceinline__ unsigned xb_xcc_id() { return (unsigned)__builtin_amdgcn_s_getreg((3 << 11) | 20) & 0xFu; }
#define XB_SPIN(cond, bar) do { unsigned _sp = 0; while (cond) { __builtin_amdgcn_s_sleep(1); \
    if ((++_sp & 255u) == 0u) { if (xb_ld(&(bar)[XB_TMO])) break; if (_sp > XB_SPIN_CAP) { atomicAdd(&(bar)[XB_TMO], 1u); break; } } } } while (0)
struct XcdBarrier { unsigned* bar; unsigned x; volatile LAS unsigned* st; };
__device__ __forceinline__ XcdBarrier xcd_barrier_post(unsigned* bar, volatile LAS unsigned* st) {
    XcdBarrier b; b.bar = bar; b.x = xb_xcc_id(); b.st = st;
    if (threadIdx.x == 0) (void)xb_add(&bar[XB_XCNT(b.x)], 1u);
    return b;
}
__device__ __forceinline__ void xcd_barrier_complete(unsigned* bar, unsigned x, unsigned& nloc, unsigned& nx) {
    const unsigned G = gridDim.x * gridDim.y * gridDim.z;
    unsigned sum, cnt, mine, sp = 0u;
    for (;;) {
        sum = 0u; cnt = 0u; mine = 0u;
#pragma unroll
        for (unsigned j = 0; j < 16; ++j) { const unsigned c = xb_ld(&bar[XB_XCNT(j)]); sum += c; cnt += (c > 0u) ? 1u : 0u; mine = (j == x) ? c : mine; }
        if (sum == G) break;
        __builtin_amdgcn_s_sleep(1);
        if ((++sp & 255u) == 0u) { if (xb_ld(&bar[XB_TMO])) break; if (sp > XB_SPIN_CAP) { atomicAdd(&bar[XB_TMO], 1u); break; } }
    }
    nloc = mine > 0u ? mine : 1u; nx = cnt > 0u ? cnt : 1u;
}
__device__ __forceinline__ void xcd_barrier(const XcdBarrier& b) {
    asm volatile("s_waitcnt vmcnt(0)" ::: "memory");
    __syncthreads();
    if (threadIdx.x == 0) {
        unsigned* bar = b.bar;
        __builtin_amdgcn_s_waitcnt(0);
        unsigned nloc = b.st[0], nx = b.st[1];
        if (nloc == 0u) { xcd_barrier_complete(bar, b.x, nloc, nx); b.st[0] = nloc; b.st[1] = nx; }
        const unsigned old = xb_add(&bar[XB_XSUB(b.x)], 1u);
        const unsigned gen = old / nloc;
        if (old + 1u == (gen + 1u) * nloc) {
            __builtin_amdgcn_fence(__ATOMIC_RELEASE, "agent");
            asm volatile("s_waitcnt vmcnt(0)" ::: "memory");
            const unsigned og = xb_add(&bar[XB_TOP], 1u);
            const unsigned tg = og / nx;
            if (og + 1u == (tg + 1u) * nx) xb_add(&bar[XB_TOPGEN], 1u);
            else XB_SPIN(xb_ld(&bar[XB_TOPGEN]) == tg, bar);
            __builtin_amdgcn_fence(__ATOMIC_ACQUIRE, "agent");
            xb_add(&bar[XB_XGEN(b.x)], 1u);
            asm volatile("s_waitcnt vmcnt(0)" ::: "memory");
        } else {
            XB_SPIN(xb_ld(&bar[XB_XGEN(b.x)]) == gen, bar);
            __builtin_amdgcn_fence(__ATOMIC_ACQUIRE, "agent");
            asm volatile("s_waitcnt vmcnt(0)" ::: "memory");
        }
    }
    __syncthreads();
}

namespace pg8 {
constexpr int BM = 256, BK = 64, HALF = 128, HTB = HALF * BK * 2, STAGE_BYTES = 8 * HTB, NXCD = 8, WGM = 8;
__host__ __device__ __forceinline__ int lds_byte(int r, int c) { const int st = (r >> 4) * 2 + (c >> 5), rr = r & 15, cc = c & 31, ob = rr * 64 + cc * 2; return st * 1024 + (ob ^ (((ob >> 9) & 1) << 5)); }
__host__ __device__ __forceinline__ void stage_rc(int b, int& R, int& C) { const int st = b / 1024, sb = b % 1024, swz = sb ^ (((sb >> 9) & 1) << 5); R = (st >> 1) * 16 + swz / 64; C = (st & 1) * 32 + (swz % 64) / 2; }
__host__ __device__ __forceinline__ int perm32(int rho) { const int n = rho >> 4, i = rho & 15; return 8 * (i >> 2) + 4 * n + (i & 3); }
struct Unit { int pm, pn, kq, half; };
struct Gemm { const bf16_t* A; const bf16_t* Bt; int M, N, K, lda, ldb, grouped; };
struct Order {
    int nM, nN, nfull, ntail, mode, G, c, qf, rf;
    __device__ void init(int nM_, int nN_, int ntail_, int mode_, int G_, int c_) { nM = nM_; nN = nN_; nfull = nM * nN; ntail = ntail_; mode = mode_; G = G_; c = c_;
        qf = __builtin_amdgcn_readfirstlane(nfull / G); rf = __builtin_amdgcn_readfirstlane(nfull % G); }
    __device__ bool next(int i, Unit& u) const {
        const long L = (long)i * G + c;
        if (L < nfull) {
            int wgid = (int)L; { const int q = nfull / NXCD, r = nfull % NXCD, xcd = wgid % NXCD, off = wgid / NXCD; wgid = (xcd < r ? xcd * (q + 1) : r * (q + 1) + (xcd - r) * q) + off; }
            const int nig = WGM * nN, gid = wgid / nig, fm = gid * WGM, gsz = (nM - fm) < WGM ? (nM - fm) : WGM;
            u.pm = fm + ((wgid % nig) % gsz); u.pn = (wgid % nig) / gsz; u.kq = -1; u.half = 0; return true;
        }
        int r = rf, q = qf, gr = G - rf, cc = c, ii = i; asm volatile("" : "+s"(r), "+s"(q), "+s"(gr), "+s"(cc), "+s"(ii));
        if (cc < r || ii < q) return false;
        const int e = (ii - q) * gr + (cc - r);
        if (e >= ntail) return false;
        if (mode == 1) { u.pm = e; u.pn = nN; u.kq = -1; u.half = 1; }
        else { const int t = e >> 2; u.pm = nM + (t >> 4); u.pn = t & 15; u.kq = e & 3; u.half = 0; }
        return true;
    }
};

template <class Epi, bool HALFCAP = false, bool I8 = false, bool ALIGN_EPI = true>
__device__ __forceinline__ void gemm_phase(LAS unsigned char* lds, const Gemm g, const Order& S, const Epi& E) {
    int tid = threadIdx.x; asm volatile("" : "+v"(tid));
    const int wid = __builtin_amdgcn_readfirstlane(tid >> 6), lane = tid & 63, wr = wid >> 2, wc = wid & 3, fr = lane & 15, fq = lane >> 4;
    const int K = g.K, ntf = K / BK;
    unsigned voffA[2], voffB[2];
#pragma unroll
    for (int i = 0; i < 2; ++i) { int R, C; stage_rc(tid * 16 + i * 8192, R, C); const int Rb = Epi::PERM ? ((R & ~31) + perm32(R & 31)) : R;
        voffA[i] = (unsigned)(R * g.lda + C) * 2u; voffB[i] = (unsigned)(Rb * g.ldb + C) * 2u; }
    const size_t kstep = (size_t)(BK * 2);
    const size_t hstepA = (size_t)HALF * g.lda * 2, hstepB = (size_t)HALF * g.ldb * 2;
    const size_t tstepA = 2 * hstepA, tstepB = 2 * hstepB;
    const unsigned ldsw = (unsigned)wid * 1024u;
    const int aoff = lds_byte(wr * 64 + fr, fq * 8), boff = lds_byte(wc * 32 + fr, fq * 8);
#define PG8_SA(b, h) (((b) * 2 + (h)) * HTB)
#define PG8_SB(b, h) ((4 + (b) * 2 + (h)) * HTB)
#define PG8_STAGE(bufoff, gbase, voff) do { _Pragma("unroll") for (int _i = 0; _i < 2; ++_i) \
        __builtin_amdgcn_global_load_lds((const unsigned*)((const char*)(gbase) + (voff)[_i]), (LAS unsigned*)(lds + (bufoff) + ldsw + _i * 8192), 16, 0, 0); } while (0)
#define PG8_LDA(dst, b, h) do { _Pragma("unroll") for (int m = 0; m < 4; ++m) _Pragma("unroll") for (int k = 0; k < 2; ++k) dst[m][k] = *(const LAS bf16x8*)(lds + PG8_SA(b, h) + aoff + m * 2048 + k * 1024); } while (0)
#define PG8_LDB(dst, b, h) do { _Pragma("unroll") for (int n = 0; n < 2; ++n) _Pragma("unroll") for (int k = 0; k < 2; ++k) dst[n][k] = *(const LAS bf16x8*)(lds + PG8_SB(b, h) + boff + n * 2048 + k * 1024); } while (0)
#define PG8_MMA(ai, bj, At, Bt) do { __builtin_amdgcn_s_setprio(1); _Pragma("unroll") for (int m = 0; m < 4; ++m) _Pragma("unroll") for (int n = 0; n < 2; ++n) _Pragma("unroll") for (int k = 0; k < 2; ++k) \
        { if constexpr (I8) acc[ai][bj][m][n] = __builtin_bit_cast(f32x4, __builtin_amdgcn_mfma_i32_16x16x64_i8(__builtin_bit_cast(i32x4, Bt[n][k]), __builtin_bit_cast(i32x4, At[m][k]), __builtin_bit_cast(i32x4, acc[ai][bj][m][n]), 0, 0, 0)); \
          else acc[ai][bj][m][n] = __builtin_amdgcn_mfma_f32_16x16x32_bf16(Bt[n][k], At[m][k], acc[ai][bj][m][n], 0, 0, 0); } __builtin_amdgcn_s_setprio(0); } while (0)
#define PG8_MMA1(ai, At, Bt) do { if (!HALFCAP || full) PG8_MMA(ai, 1, At, Bt); } while (0)
#define PG8_WAIT_V(n) asm volatile("s_waitcnt vmcnt(" #n ")" ::: "memory")
#define PG8_WAIT_L(n) asm volatile("s_waitcnt lgkmcnt(" #n ")" ::: "memory")
#define PG8_BAR __builtin_amdgcn_s_barrier()
#define PG8_SCHED __builtin_amdgcn_sched_barrier(0)
#define PG8_KOFF(u) ((u).kq < 0 ? (size_t)0 : (size_t)(u).kq * (size_t)(K / 4) * 2)
#define PG8_APTR(u) ((const char*)g.A + (size_t)(u).pm * tstepA + (g.grouped ? (size_t)((u).pn >> 2) * (size_t)K * 2 : (size_t)0) + PG8_KOFF(u))
#define PG8_BPTR(u) ((const char*)g.Bt + (size_t)(u).pn * tstepB + PG8_KOFF(u))
    Unit cur, nxt; int ui = 0;
    if (!S.next(0, cur)) return;
    f32x4 acc[2][2][4][2];
#pragma unroll
    for (int a = 0; a < 2; ++a)
#pragma unroll
        for (int b = 0; b < 2; ++b)
#pragma unroll
            for (int m = 0; m < 4; ++m)
#pragma unroll
                for (int n = 0; n < 2; ++n) acc[a][b][m][n] = (f32x4){0.f, 0.f, 0.f, 0.f};
    bf16x8 At[4][2], B0[2][2], B1[2][2];
    const char* cA = PG8_APTR(cur); const char* cB = PG8_BPTR(cur);
    PG8_STAGE(PG8_SB(0, 0), cB, voffB); PG8_STAGE(PG8_SB(0, 1), cB + hstepB, voffB); PG8_STAGE(PG8_SA(0, 0), cA, voffA); PG8_STAGE(PG8_SA(0, 1), cA + hstepA, voffA);
    if (wr == 1) PG8_BAR;
    PG8_WAIT_V(2); PG8_BAR;
    PG8_STAGE(PG8_SB(1, 0), cB + kstep, voffB); PG8_STAGE(PG8_SA(1, 0), cA + kstep, voffA); PG8_STAGE(PG8_SB(1, 1), cB + hstepB + kstep, voffB);
    PG8_WAIT_V(6); PG8_BAR;
    for (;;) {
        const bool has_next = S.next(ui + 1, nxt);
        const char* nA = has_next ? PG8_APTR(nxt) : cA; const char* nB = has_next ? PG8_BPTR(nxt) : cB;
        const int nt = cur.kq < 0 ? ntf : ntf / 4; const bool full = !cur.half; (void)full;
        for (int t = 0; t < nt; t += 2) {
            const bool last = (t == nt - 2);
            const char* a1 = cA + (size_t)(t + 1) * kstep;
            const char* a2 = last ? nA : cA + (size_t)(t + 2) * kstep; const char* b2 = last ? nB : cB + (size_t)(t + 2) * kstep;
            const char* a3 = a2 + kstep; const char* b3 = b2 + kstep;
            PG8_LDB(B0, 0, 0); PG8_LDB(B1, 0, 1); PG8_SCHED; PG8_LDA(At, 0, 0); PG8_STAGE(PG8_SA(1, 1), a1 + hstepA, voffA);
            PG8_WAIT_V(8); PG8_WAIT_L(0); PG8_BAR; PG8_MMA(0, 0, At, B0); PG8_MMA1(0, At, B1); PG8_BAR; PG8_SCHED;
            PG8_LDA(At, 0, 1); PG8_STAGE(PG8_SB(0, 0), b2, voffB); PG8_STAGE(PG8_SB(0, 1), b2 + hstepB, voffB); PG8_STAGE(PG8_SA(0, 0), a2, voffA);
            PG8_WAIT_V(8); PG8_WAIT_L(0); PG8_BAR; PG8_MMA(1, 0, At, B0); PG8_MMA1(1, At, B1); PG8_BAR; PG8_SCHED;
            PG8_LDB(B0, 1, 0); PG8_LDB(B1, 1, 1); PG8_SCHED; PG8_LDA(At, 1, 0); PG8_STAGE(PG8_SA(0, 1), a2 + hstepA, voffA);
            PG8_WAIT_V(8); PG8_WAIT_L(0); PG8_BAR; PG8_MMA(0, 0, At, B0); PG8_MMA1(0, At, B1); PG8_BAR; PG8_SCHED;
            PG8_LDA(At, 1, 1); PG8_STAGE(PG8_SB(1, 0), b3, voffB); PG8_STAGE(PG8_SB(1, 1), b3 + hstepB, voffB); PG8_STAGE(PG8_SA(1, 0), a3, voffA);
            PG8_WAIT_V(8); PG8_WAIT_L(0); PG8_BAR; PG8_MMA(1, 0, At, B0); PG8_MMA1(1, At, B1); PG8_BAR; PG8_SCHED;
        }
        if constexpr (ALIGN_EPI) { if (wr == 0) PG8_BAR; }
        E(acc, cur, wr, wc, fr, fq);
        if (!has_next) break;
#pragma unroll
        for (int a = 0; a < 2; ++a)
#pragma unroll
            for (int b = 0; b < 2; ++b)
#pragma unroll
                for (int m = 0; m < 4; ++m)
#pragma unroll
                    for (int n = 0; n < 2; ++n) acc[a][b][m][n] = (f32x4){0.f, 0.f, 0.f, 0.f};
        cur = nxt; cA = nA; cB = nB; ++ui;
        if constexpr (ALIGN_EPI) { if (wr == 1) PG8_BAR; }
    }
    PG8_WAIT_V(0);
    if constexpr (!ALIGN_EPI) { if (wr == 0) PG8_BAR; }
    PG8_BAR;
#undef PG8_SA
#undef PG8_SB
#undef PG8_STAGE
#undef PG8_LDA
#undef PG8_LDB
#undef PG8_MMA
#undef PG8_MMA1
#undef PG8_WAIT_V
#undef PG8_WAIT_L
#undef PG8_BAR
#undef PG8_SCHED
#undef PG8_KOFF
#undef PG8_APTR
#undef PG8_BPTR
}
}

struct Params {
    const float *x_prompt, *x_sample, *cache_k, *cache_v, *cache_kidx, *state_pool, *norm_w, *final_norm_w, *attn_w_in, *attn_w_out, *rel_bias,
                *pool_w_in, *pool_group_w, *pool_scale, *pool_w_out;
    float* out; unsigned char* ws; int ph_lo, ph_hi;
};

__device__ __forceinline__ u32x4 pack8(const f32x4 a, const f32x4 b) { u32x4 w; w.x = cvt_pk_bf16(a[0], a[1]); w.y = cvt_pk_bf16(a[2], a[3]); w.z = cvt_pk_bf16(b[0], b[1]); w.w = cvt_pk_bf16(b[2], b[3]); return w; }
__device__ __forceinline__ f32x4 silu4(f32x4 v) { return (f32x4){silu_f(v[0]), silu_f(v[1]), silu_f(v[2]), silu_f(v[3])}; }

constexpr int UP_SEQ = SEQ + 16, US_SEQ = DSQ + 16, UP_ROWS = NBATCH * UP_SEQ;
__device__ __forceinline__ int u_row(int r) { return r < MP ? (r >> 12) * UP_SEQ + 16 + (r & 4095) : UP_ROWS + ((r - MP) >> 5) * US_SEQ + 16 + ((r - MP) & 31); }
__device__ __forceinline__ size_t kif_off(int s, int d0) { return ((size_t)(((s >> 5) * 4 + (d0 >> 4)) * 64 + ((d0 >> 3) & 1) * 32 + (s & 31))) * 8; }

struct Epi1a {
    static constexpr bool PERM = true;
    unsigned char* ws; float* out;
    __device__ __forceinline__ void operator()(const f32x4 (&acc)[2][2][4][2], const pg8::Unit& u, int wr, int wc, int fr, int fq) const {
        const int pn = u.pn; const float* SA = (const float*)(ws + WS_SA); const float* SB = (const float*)(ws + WS_SB);
#pragma unroll
        for (int bj = 0; bj < 2; ++bj) {
            const int lc = bj * 128 + wc * 32 + 8 * fq, gc = pn * 256 + lc;
            const f32x4 sb0 = *(const f32x4*)(SB + gc), sb1 = *(const f32x4*)(SB + gc + 4);
#pragma unroll
            for (int ai = 0; ai < 2; ++ai)
#pragma unroll
                for (int m = 0; m < 4; ++m) {
                    const int r = u.pm * 256 + ai * 128 + wr * 64 + m * 16 + fr; const float sa = SA[r];
                    const i32x4 i0 = __builtin_bit_cast(i32x4, acc[ai][bj][m][0]), i1 = __builtin_bit_cast(i32x4, acc[ai][bj][m][1]);
                    const f32x4 v0 = (f32x4){(float)i0[0], (float)i0[1], (float)i0[2], (float)i0[3]} * sb0 * sa, v1 = (f32x4){(float)i1[0], (float)i1[1], (float)i1[2], (float)i1[3]} * sb1 * sa;
                    if (pn < 16) *(u32x4*)((bf16_t*)(ws + WS_QB) + (size_t)r * DM + gc) = pack8(v0, v1);
                    else if (pn < 24) {
                        const bool isv = pn >= 20; const int c = (pn & 3) * 256 + lc; const bool samp = r >= MP; const int rs = r - MP;
                        bf16_t* dst; float* fo;
                        if (!samp) { dst = (bf16_t*)(ws + (isv ? WS_VP : WS_KP)) + (size_t)r * KVW + c; fo = out + (isv ? O_VP : O_KP) + (size_t)r * KVW + c; }
                        else { dst = (bf16_t*)(ws + (isv ? WS_VSN : WS_KSN)) + (size_t)rs * KVW + c; fo = out + (isv ? O_VS : O_KS) + (size_t)rs * KVW + c; }
                        *(u32x4*)dst = pack8(v0, v1); *(f32x4*)fo = v0; *(f32x4*)(fo + 4) = v1;
                    }
                    else *(u32x4*)((bf16_t*)(ws + WS_SG) + (size_t)r * DM + (gc - 6144)) = pack8(silu4(v0), silu4(v1));
                }
        }
    }
};
struct Epi1b {
    static constexpr bool PERM = true;
    unsigned char* ws; float* out;
    __device__ __forceinline__ void operator()(const f32x4 (&acc)[2][2][4][2], const pg8::Unit& u, int wr, int wc, int fr, int fq) const {
        const int pn = u.pn;
#pragma unroll
        for (int ai = 0; ai < 2; ++ai)
#pragma unroll
            for (int m = 0; m < 4; ++m) {
                const int r = u.pm * 256 + ai * 128 + wr * 64 + m * 16 + fr;
                const bool samp = r >= MP; const int rs = r - MP, sb = rs >> 5, st = rs & 31;
#pragma unroll
                for (int bj = 0; bj < 2; ++bj) {
                    const int lc = bj * 128 + wc * 32 + 8 * fq;
                    const f32x4 v0 = acc[ai][bj][m][0], v1 = acc[ai][bj][m][1];
                    if (pn < 8) {
                        const int c = pn * 256 + lc, h = c >> 6, d = c & 63;
                        *(u32x4*)((bf16_t*)(ws + WS_QIB) + ((((size_t)(r >> 5) * 32 + h) * 4 + (d >> 4)) * 2 + ((d >> 3) & 1)) * 256 + (r & 31) * 8) = pack8(v0, v1);
                    } else {
                        if (lc < 64) {
                            bf16_t* dst; float* fo;
                            if (!samp) { dst = (bf16_t*)(ws + WS_KIP) + (size_t)(r >> 12) * SEQ * DIDX + kif_off(r & 4095, lc); fo = out + O_KIP + (size_t)r * DIDX + lc; }
                            else { dst = (bf16_t*)(ws + WS_KIS) + (size_t)sb * SKV * DIDX + kif_off(PAST + st, lc); fo = out + O_KIS + (size_t)rs * DIDX + lc; }
                            *(u32x4*)dst = pack8(v0, v1); *(f32x4*)fo = v0; *(f32x4*)(fo + 4) = v1;
                        } else if (lc < 96) {
                            float* fo = (float*)(ws + WS_WIB) + (size_t)r * HIDX + (lc - 64);
                            *(f32x4*)fo = v0; *(f32x4*)(fo + 4) = v1;
                        }
                    }
                }
            }
    }
};
__device__ __forceinline__ f32x4 cvt_i32x4(const f32x4 a) { const i32x4 i = __builtin_bit_cast(i32x4, a); return (f32x4){(float)i[0], (float)i[1], (float)i[2], (float)i[3]}; }
struct EpiX1 {
    static constexpr bool PERM = false;
    const float* xp; float* X1; bf16_t* XB; float* PS; const float* SA; const float* SB;
    __device__ __forceinline__ void operator()(const f32x4 (&acc)[2][2][4][2], const pg8::Unit& u, int wr, int wc, int fr, int fq) const {
        f32x4 sb[2][2];
#pragma unroll
        for (int bj = 0; bj < 2; ++bj)
#pragma unroll
            for (int n = 0; n < 2; ++n) sb[bj][n] = *(const f32x4*)(SB + u.pn * 256 + bj * 128 + wc * 32 + n * 16 + 4 * fq);
#pragma unroll
        for (int ai = 0; ai < 2; ++ai)
#pragma unroll
            for (int m = 0; m < 4; ++m) {
                const int r = u.pm * 256 + ai * 128 + wr * 64 + m * 16 + fr; const float sa = SA[r];
                if (u.kq >= 0) {
                    float* d = PS + ((size_t)u.kq * MS + (r - MP)) * DM;
#pragma unroll
                    for (int bj = 0; bj < 2; ++bj)
#pragma unroll
                        for (int n = 0; n < 2; ++n) *(f32x4*)(d + u.pn * 256 + bj * 128 + wc * 32 + n * 16 + 4 * fq) = cvt_i32x4(acc[ai][bj][m][n]) * sb[bj][n] * sa;
                } else {
                    const float* b = xp + (size_t)r * DM; bf16_t* db = XB + (size_t)r * DM;
#pragma unroll
                    for (int bj = 0; bj < 2; ++bj)
#pragma unroll
                        for (int n = 0; n < 2; ++n) { const int c = u.pn * 256 + bj * 128 + wc * 32 + n * 16 + 4 * fq;
                            const f32x4 v = *(const f32x4*)(b + c) + cvt_i32x4(acc[ai][bj][m][n]) * sb[bj][n] * sa;
                            u32x2 w; w.x = cvt_pk_bf16(v[0], v[1]); w.y = cvt_pk_bf16(v[2], v[3]); *(u32x2*)(db + c) = w; }
                }
            }
    }
};
struct EpiX2 {
    static constexpr bool PERM = false;
    bf16_t* XB; float* PS; const float* SA; const float* SB;
    __device__ __forceinline__ void operator()(const f32x4 (&acc)[2][2][4][2], const pg8::Unit& u, int wr, int wc, int fr, int fq) const {
        f32x4 sb[2][2];
#pragma unroll
        for (int bj = 0; bj < 2; ++bj)
#pragma unroll
            for (int n = 0; n < 2; ++n) sb[bj][n] = *(const f32x4*)(SB + u.pn * 256 + bj * 128 + wc * 32 + n * 16 + 4 * fq);
#pragma unroll
        for (int ai = 0; ai < 2; ++ai)
#pragma unroll
            for (int m = 0; m < 4; ++m) {
                const int r = u.pm * 256 + ai * 128 + wr * 64 + m * 16 + fr; const float sa = SA[r];
                float* d = PS + ((size_t)(u.kq >= 0 ? u.kq : 0) * MS + (r - MP)) * DM; bf16_t* db = XB + (size_t)r * DM;
#pragma unroll
                for (int bj = 0; bj < 2; ++bj)
#pragma unroll
                    for (int n = 0; n < 2; ++n) { const int c = u.pn * 256 + bj * 128 + wc * 32 + n * 16 + 4 * fq; const f32x4 v = cvt_i32x4(acc[ai][bj][m][n]) * sb[bj][n] * sa;
                        if (u.kq >= 0) *(f32x4*)(d + c) = v;
                        else { const u32x2 x = *(const u32x2*)(db + c); u32x2 w; w.x = cvt_pk_bf16(bf_lo(x.x) + v[0], bf_hi(x.x) + v[1]); w.y = cvt_pk_bf16(bf_lo(x.y) + v[2], bf_hi(x.y) + v[3]); *(u32x2*)(db + c) = w; } }
            }
    }
};
struct Epi3 {
    static constexpr bool PERM = true;
    unsigned char* ws; float* out;
    __device__ __forceinline__ void operator()(const f32x4 (&acc)[2][2][4][2], const pg8::Unit& u, int wr, int wc, int fr, int fq) const {
        const int pn = u.pn; const float* ROWF = (const float*)(ws + WS_ROWF); const float* SB2 = (const float*)(ws + WS_SB2);
#pragma unroll
        for (int ai = 0; ai < 2; ++ai)
#pragma unroll
            for (int m = 0; m < 4; ++m) {
                const int r = u.pm * 256 + ai * 128 + wr * 64 + m * 16 + fr;
                const float rowf = ROWF[r];
                float* po = nullptr;
                if (r < MP) { const int t = r & 4095; if (t >= SEQ - 15) po = out + O_POOLP + ((size_t)(r >> 12) * 15 + (t - (SEQ - 15))) * DM; }
                else { const int rs = r - MP, t = rs & 31; if (t >= DSQ - 15) po = out + O_POOLS + ((size_t)(rs >> 5) * 15 + (t - (DSQ - 15))) * DM; }
#pragma unroll
                for (int bj = 0; bj < 2; ++bj) {
                    const int lc = bj * 128 + wc * 32 + 8 * fq;
                    const f32x4 s0 = *(const f32x4*)(SB2 + pn * 256 + lc), s1 = *(const f32x4*)(SB2 + pn * 256 + lc + 4);
                    const i32x4 i0 = __builtin_bit_cast(i32x4, acc[ai][bj][m][0]), i1 = __builtin_bit_cast(i32x4, acc[ai][bj][m][1]);
                    const f32x4 v0 = (f32x4){(float)i0[0], (float)i0[1], (float)i0[2], (float)i0[3]} * s0 * rowf, v1 = (f32x4){(float)i1[0], (float)i1[1], (float)i1[2], (float)i1[3]} * s1 * rowf;
                    if (pn < 16) {
                        const int c = pn * 256 + lc;
                        *(u32x4*)((bf16_t*)(ws + WS_U) + (size_t)u_row(r) * DM + c) = pack8(v0, v1);
                        if (po) { *(f32x4*)(po + c) = v0; *(f32x4*)(po + c + 4) = v1; }
                    } else {
                        *(u32x4*)((bf16_t*)(ws + WS_SG2) + (size_t)r * DM + (pn - 16) * 256 + lc) = pack8(silu4(v0), silu4(v1));
                    }
                }
            }
    }
};
struct Epi4 {
    static constexpr bool PERM = true;
    unsigned char* ws; const float* scale;
    __device__ __forceinline__ void operator()(const f32x4 (&acc)[2][2][4][2], const pg8::Unit& u, int wr, int wc, int fr, int fq) const {
#pragma unroll
        for (int bj = 0; bj < 2; ++bj) {
            const int c = u.pn * 256 + bj * 128 + wc * 32 + 8 * fq;
            const f32x4 s0 = *(const f32x4*)(scale + c), s1 = *(const f32x4*)(scale + c + 4);
#pragma unroll
            for (int ai = 0; ai < 2; ++ai)
#pragma unroll
                for (int m = 0; m < 4; ++m) {
                    const int r = u.pm * 256 + ai * 128 + wr * 64 + m * 16 + fr;
                    const u32x4 gw = *(const u32x4*)((const bf16_t*)(ws + WS_SG2) + (size_t)r * DM + c);
                    const f32x4 g0 = (f32x4){bf_lo(gw.x), bf_hi(gw.x), bf_lo(gw.y), bf_hi(gw.y)}, g1 = (f32x4){bf_lo(gw.z), bf_hi(gw.z), bf_lo(gw.w), bf_hi(gw.w)};
                    *(u32x4*)((bf16_t*)(ws + WS_ZG) + (size_t)r * DM + c) = pack8(acc[ai][bj][m][0] * s0 * g0, acc[ai][bj][m][1] * s1 * g1);
                }
        }
    }
};

__device__ __forceinline__ void transpose_item(const float* W, int N, int k0, int n0, bf16_t* WT, int K, int drow0, int nvalid, LAS float* scr, int lane) {
    const int cq = lane & 15, rq = lane >> 4;
    const float* src = W + (size_t)(k0 + 4 * rq) * N + n0 + 4 * cq;
    f32x4 a[16];
#pragma unroll
    for (int g = 0; g < 4; ++g)
#pragma unroll
        for (int i = 0; i < 4; ++i) a[g * 4 + i] = *(const f32x4*)(src + (size_t)(16 * g + i) * N);
    LAS unsigned char* T = (LAS unsigned char*)scr;
#pragma unroll
    for (int g = 0; g < 4; ++g)
#pragma unroll
        for (int c = 0; c < 4; ++c) { u32x2 o; o.x = cvt_pk_bf16(a[g * 4 + 0][c], a[g * 4 + 1][c]); o.y = cvt_pk_bf16(a[g * 4 + 2][c], a[g * 4 + 3][c]);
            *(LAS u32x2*)(T + (4 * cq + c) * 136 + 32 * g + 8 * rq) = o; }
    LDS_WAIT(); asm volatile("" ::: "memory");
    const int kc = lane & 7;
#pragma unroll
    for (int sI = 0; sI < 8; ++sI) { const int n = 8 * sI + (lane >> 3);
        const u32x2 lo = *(const LAS u32x2*)(T + n * 136 + 16 * kc), hi = *(const LAS u32x2*)(T + n * 136 + 16 * kc + 8);
        if (n < nvalid) *(u32x4*)(WT + (size_t)(drow0 + n) * K + k0 + 8 * kc) = (u32x4){lo.x, lo.y, hi.x, hi.y}; }
    LDS_WAIT(); asm volatile("" ::: "memory");
}
__device__ __forceinline__ unsigned q8(float v) { return (unsigned)(int)__builtin_rintf(v) & 0xffu; }
__device__ __forceinline__ unsigned q8x4(float a, float b, float c, float d) { return q8(a) | (q8(b) << 8) | (q8(c) << 16) | (q8(d) << 24); }
__device__ __forceinline__ void transpose_item_i8(const float* W, int N, int k0, int n0, signed char* WT, int K, int drow0, LAS float* scr, int lane, const unsigned* camax, float* sbout, const float* kscale = nullptr) {
    const int cq = lane & 15, rq = lane >> 4;
    const float* src = W + (size_t)(k0 + 4 * rq) * N + n0 + 4 * cq;
    f32x4 ks[8];
    if (kscale) {
#pragma unroll
        for (int g = 0; g < 8; ++g) ks[g] = *(const f32x4*)(kscale + k0 + 16 * g + 4 * rq); }
    const u32x4 cm = *(const u32x4*)(camax + drow0 + 4 * cq);
    f32x4 a[32];
#pragma unroll
    for (int g = 0; g < 8; ++g)
#pragma unroll
        for (int i = 0; i < 4; ++i) a[g * 4 + i] = *(const f32x4*)(src + (size_t)(16 * g + i) * N);
    f32x4 inv;
#pragma unroll
    for (int c = 0; c < 4; ++c) { const float am = __uint_as_float(cm[c]); inv[c] = am > 0.f ? 127.0f / am : 0.f; }
    LAS unsigned char* T = (LAS unsigned char*)scr;
#pragma unroll
    for (int g = 0; g < 8; ++g) {
        f32x4 r0 = a[g * 4 + 0] * inv, r1 = a[g * 4 + 1] * inv, r2 = a[g * 4 + 2] * inv, r3 = a[g * 4 + 3] * inv;
        if (kscale) { r0 = r0 * ks[g][0]; r1 = r1 * ks[g][1]; r2 = r2 * ks[g][2]; r3 = r3 * ks[g][3]; }
#pragma unroll
        for (int c = 0; c < 4; ++c) *(LAS unsigned*)(T + (4 * cq + c) * 132 + 16 * g + 4 * rq) = q8x4(r0[c], r1[c], r2[c], r3[c]);
    }
    LDS_WAIT(); asm volatile("" ::: "memory");
    const int kc = lane & 7;
#pragma unroll
    for (int sI = 0; sI < 8; ++sI) { const int n = 8 * sI + (lane >> 3); const LAS unsigned* tp = (const LAS unsigned*)(T + n * 132 + 16 * kc);
        *(u32x4*)(WT + (size_t)(drow0 + n) * K + k0 + 16 * kc) = (u32x4){tp[0], tp[1], tp[2], tp[3]}; }
    if (k0 == 0) sbout[drow0 + lane] = __uint_as_float(camax[drow0 + lane]) * (1.0f / 127.0f);
    LDS_WAIT(); asm volatile("" ::: "memory");
}
template <bool KS>
__device__ __forceinline__ f32x4 col_amax64(const float* wp, size_t stride, const float* nw) {
    f32x4 m = (f32x4){0.f, 0.f, 0.f, 0.f}; f32x4 a[8], b[8];
#define CA_LD(dst) do { _Pragma("unroll") for (int i = 0; i < 8; ++i) dst[i] = *(const f32x4*)(wp + (size_t)i * stride); wp += 8 * stride; asm volatile("" ::: "memory"); } while (0)
#define CA_USE(src) do { _Pragma("unroll") for (int i = 0; i < 8; ++i) { f32x4 x = src[i]; if (KS) x = x * nw[i]; \
        m.x = fmaxf(m.x, fabsf(x.x)); m.y = fmaxf(m.y, fabsf(x.y)); m.z = fmaxf(m.z, fabsf(x.z)); m.w = fmaxf(m.w, fabsf(x.w)); } if (KS) nw += 8; } while (0)
    CA_LD(a);
#pragma unroll 1
    for (int kb = 0; kb < 4; ++kb) {
        CA_LD(b);
        CA_USE(a);
        if (kb < 3) CA_LD(a);
        CA_USE(b);
    }
#undef CA_LD
#undef CA_USE
    return m;
}
__device__ __forceinline__ void rms_row_q(f32x4 (&v)[16], const LAS f32x4* w, bf16_t* orow, signed char* qrow, float* sa, int lane) {
    const LAS f32x4* wr = w + lane;
    float s = 0.f;
#pragma unroll
    for (int j = 0; j < 16; ++j) s += (v[j].x * v[j].x + v[j].y * v[j].y) + (v[j].z * v[j].z + v[j].w * v[j].w);
    const float rstd = 1.0f / sqrtf(wave_sum(s) * (1.0f / DM) + EPS);
    float am = 0.f;
#pragma unroll
    for (int j = 0; j < 16; ++j) { v[j] = v[j] * rstd * wr[64 * j]; am = fmaxf(am, fmaxf(fmaxf(fabsf(v[j].x), fabsf(v[j].y)), fmaxf(fabsf(v[j].z), fabsf(v[j].w))));
        u32x2 o; o.x = cvt_pk_bf16(v[j].x, v[j].y); o.y = cvt_pk_bf16(v[j].z, v[j].w); ((u32x2*)orow + lane)[64 * j] = o;
        if ((j & 3) == 3) asm volatile("" ::: "memory"); }
#pragma unroll
    for (int o = 1; o < 64; o <<= 1) am = fmaxf(am, __shfl_xor(am, o));
    const float inv = am > 0.f ? 127.0f / am : 0.f;
#pragma unroll
    for (int j = 0; j < 16; ++j) ((unsigned*)qrow + lane)[64 * j] = q8x4(v[j].x * inv, v[j].y * inv, v[j].z * inv, v[j].w * inv);
    if (lane == 0) *sa = am * (1.0f / 127.0f);
}
template <class F>
__device__ __forceinline__ void quant_rows_bf16(const bf16_t* src, signed char* dst, int M, int gw, int NGW, int lane, F fin) {
    u32x4 x[8], xn[8];
    if (gw < M) {
#pragma unroll
        for (int j = 0; j < 8; ++j) x[j] = ((const u32x4*)(src + (size_t)gw * DM) + lane)[64 * j]; }
#pragma unroll 1
    for (int m = gw; m < M; m += NGW) {
        if (m + NGW < M) {
#pragma unroll
            for (int j = 0; j < 8; ++j) xn[j] = ((const u32x4*)(src + (size_t)(m + NGW) * DM) + lane)[64 * j]; }
        float am = 0.f, ss = 0.f;
#pragma unroll
        for (int j = 0; j < 8; ++j) {
            const float f[8] = {bf_lo(x[j].x), bf_hi(x[j].x), bf_lo(x[j].y), bf_hi(x[j].y), bf_lo(x[j].z), bf_hi(x[j].z), bf_lo(x[j].w), bf_hi(x[j].w)};
#pragma unroll
            for (int e = 0; e < 8; ++e) { am = fmaxf(am, fabsf(f[e])); ss = fmaf(f[e], f[e], ss); } }
#pragma unroll
        for (int o = 1; o < 64; o <<= 1) am = fmaxf(am, __shfl_xor(am, o));
        ss = wave_sum(ss);
        const float inv = am > 0.f ? 127.0f / am : 0.f;
        u32x2* q = (u32x2*)(dst + (size_t)m * DM) + lane;
#pragma unroll
        for (int j = 0; j < 8; ++j) { u32x2 o; o.x = q8x4(bf_lo(x[j].x) * inv, bf_hi(x[j].x) * inv, bf_lo(x[j].y) * inv, bf_hi(x[j].y) * inv);
            o.y = q8x4(bf_lo(x[j].z) * inv, bf_hi(x[j].z) * inv, bf_lo(x[j].w) * inv, bf_hi(x[j].w) * inv); q[64 * j] = o; }
        fin(m, am, ss);
#pragma unroll
        for (int j = 0; j < 8; ++j) x[j] = xn[j];
    }
}
template <bool F32OUT>
__device__ __forceinline__ void rms_row(const float* xrow, const float* w, void* orow, int lane) {
    const f32x4* xr = (const f32x4*)xrow + lane; const f32x4* wr = (const f32x4*)w + lane;
    f32x4 v[16]; float s = 0.f;
#pragma unroll
    for (int j = 0; j < 16; ++j) { v[j] = xr[64 * j]; s += (v[j].x * v[j].x + v[j].y * v[j].y) + (v[j].z * v[j].z + v[j].w * v[j].w); }
    const float rstd = 1.0f / sqrtf(wave_sum(s) * (1.0f / DM) + EPS);
#pragma unroll
    for (int j = 0; j < 16; ++j) { const f32x4 g = wr[64 * j]; const f32x4 y = v[j] * rstd * g;
        if (F32OUT) ((f32x4*)orow + lane)[64 * j] = y;
        else { u32x2 o; o.x = cvt_pk_bf16(y.x, y.y); o.y = cvt_pk_bf16(y.z, y.w); ((u32x2*)orow + lane)[64 * j] = o; } }
}

__device__ __forceinline__ unsigned ord_key(float f) { const unsigned b = __float_as_uint(f); return (b & 0x80000000u) ? ~b : (b | 0x80000000u); }
constexpr int NVJ = 65;
constexpr int SC_WT_OFF = RING_BYTES + 1024;
constexpr int SC_QB_OFF = SC_WT_OFF + 4096;
__device__ __forceinline__ void score_tiles(const bf16_t* __restrict__ qif, const float* __restrict__ wi, const bf16_t* __restrict__ kif, float* __restrict__ sc,
                                            int kt0, int step, int count, LAS unsigned char* lds) {
    int tid = threadIdx.x; asm volatile("" : "+v"(tid));
    const int wid = __builtin_amdgcn_readfirstlane(tid >> 6), lane = tid & 63, r32 = lane & 31, hi = lane >> 5;
    constexpr float WSC = 0.5f * 0.125f * 0.17677669529663687f;
    __syncthreads();
    {   const u32x4* src = (const u32x4*)qif; LAS u32x4* dst = (LAS u32x4*)lds;
        u32x4 t[16];
#pragma unroll
        for (int i = 0; i < 16; ++i) t[i] = src[tid + 512 * i];
#pragma unroll
        for (int i = 0; i < 16; ++i) dst[tid + 512 * i] = t[i];
        LAS float* wt = (LAS float*)(lds + SC_WT_OFF);
#pragma unroll
        for (int e = tid; e < 1024; e += NTHREADS) { const int h = e >> 5, hh = (e >> 4) & 1, r = e & 15, q = (r & 3) + 8 * (r >> 2) + 4 * hh;
            wt[e] = wi[q * HIDX + h] * WSC; }
    }
    __syncthreads();
    if (tid < 256) {
        const int q = tid >> 3, ch = tid & 7; float acc[8] = {0.f, 0.f, 0.f, 0.f, 0.f, 0.f, 0.f, 0.f};
        const LAS u32x4* Af = (const LAS u32x4*)lds + ch * 32 + q;
        const LAS float* wtq = (const LAS float*)(lds + SC_WT_OFF) + ((q >> 2) & 1) * 16 + (q & 3) + 4 * (q >> 3);
#pragma unroll 4
        for (int h = 0; h < 32; ++h) { const float w = wtq[h * 32]; const u32x4 x = Af[h * 256];
            acc[0] = fmaf(w, bf_lo(x.x), acc[0]); acc[1] = fmaf(w, bf_hi(x.x), acc[1]); acc[2] = fmaf(w, bf_lo(x.y), acc[2]); acc[3] = fmaf(w, bf_hi(x.y), acc[3]);
            acc[4] = fmaf(w, bf_lo(x.z), acc[4]); acc[5] = fmaf(w, bf_hi(x.z), acc[5]); acc[6] = fmaf(w, bf_lo(x.w), acc[6]); acc[7] = fmaf(w, bf_hi(x.w), acc[7]); }
        u32x4 vh, vl;
        vh.x = cvt_pk_bf16(acc[0], acc[1]); vh.y = cvt_pk_bf16(acc[2], acc[3]); vh.z = cvt_pk_bf16(acc[4], acc[5]); vh.w = cvt_pk_bf16(acc[6], acc[7]);
        vl.x = cvt_pk_bf16(acc[0] - bf_lo(vh.x), acc[1] - bf_hi(vh.x)); vl.y = cvt_pk_bf16(acc[2] - bf_lo(vh.y), acc[3] - bf_hi(vh.y));
        vl.z = cvt_pk_bf16(acc[4] - bf_lo(vh.z), acc[5] - bf_hi(vh.z)); vl.w = cvt_pk_bf16(acc[6] - bf_lo(vh.w), acc[7] - bf_hi(vh.w));
        LAS u32x4* qb = (LAS u32x4*)(lds + SC_QB_OFF);
        qb[ch * 32 + q] = vh; qb[256 + ch * 32 + q] = vl;
    }
    __syncthreads();
    const LAS bf16x8* A = (const LAS bf16x8*)lds + lane;
    const LAS bf16x8* QBF = (const LAS bf16x8*)(lds + SC_QB_OFF) + lane;
    const LAS f32x4* W4 = (const LAS f32x4*)(lds + SC_WT_OFF) + hi * 4;
#define FMA8(NOP, S, W, C, B, X) asm volatile(NOP "v_fma_f32 %0, %8, |%16|, %0\n\tv_fma_f32 %1, %9, |%17|, %1\n\tv_fma_f32 %2, %10, |%18|, %2\n\tv_fma_f32 %3, %11, |%19|, %3\n\t" \
        "v_fma_f32 %4, %12, |%20|, %4\n\tv_fma_f32 %5, %13, |%21|, %5\n\tv_fma_f32 %6, %14, |%22|, %6\n\tv_fma_f32 %7, %15, |%23|, %7" \
        : "+v"(S[B + 0]), "+v"(S[B + 1]), "+v"(S[B + 2]), "+v"(S[B + 3]), "+v"(S[B + 4]), "+v"(S[B + 5]), "+v"(S[B + 6]), "+v"(S[B + 7]) \
        : "v"(W[B + 0]), "v"(W[B + 1]), "v"(W[B + 2]), "v"(W[B + 3]), "v"(W[B + 4]), "v"(W[B + 5]), "v"(W[B + 6]), "v"(W[B + 7]), \
          "v"(C[B + 0]), "v"(C[B + 1]), "v"(C[B + 2]), "v"(C[B + 3]), "v"(C[B + 4]), "v"(C[B + 5]), "v"(C[B + 6]), "v"(C[B + 7]), "v"(X))
#define SC_LDA(dst, h) do { _Pragma("unroll") for (int ks = 0; ks < 4; ++ks) dst[ks] = A[((h) * 4 + ks) * 64]; } while (0)
#define SC_STEP(a, h) do { const f32x4 w0 = W4[(h) * 8 + 0], w1 = W4[(h) * 8 + 1], w2 = W4[(h) * 8 + 2], w3 = W4[(h) * 8 + 3]; \
        const float w[16] = {w0.x, w0.y, w0.z, w0.w, w1.x, w1.y, w1.z, w1.w, w2.x, w2.y, w2.z, w2.w, w3.x, w3.y, w3.z, w3.w}; \
        f32x16 c0 = {}, c1 = {}; \
        _Pragma("unroll") for (int ks = 0; ks < 4; ++ks) { c0 = __builtin_amdgcn_mfma_f32_32x32x16_bf16(a[ks], b0[ks], c0, 0, 0, 0); c1 = __builtin_amdgcn_mfma_f32_32x32x16_bf16(a[ks], b1[ks], c1, 0, 0, 0); } \
        FMA8("s_nop 11\n\t", s0, w, c0, 0, c1[15]); FMA8("", s0, w, c0, 8, c1[15]); FMA8("", s1, w, c1, 0, c1[15]); FMA8("", s1, w, c1, 8, c1[15]); } while (0)
    for (int idx = wid; idx < count; idx += NWAVES) {
        const int kt = kt0 + step * idx;
        const bf16x8* kb = (const bf16x8*)kif + (size_t)kt * 512 + lane;
        bf16x8 b0[4], b1[4];
#pragma unroll
        for (int ks = 0; ks < 4; ++ks) { b0[ks] = kb[ks * 64]; b1[ks] = kb[(4 + ks) * 64]; }
        f32x16 s0 = {}, s1 = {};
#pragma unroll
        for (int ks = 0; ks < 4; ++ks) { const bf16x8 qh = QBF[ks * 64], ql = QBF[256 + ks * 64];
            s0 = __builtin_amdgcn_mfma_f32_32x32x16_bf16(qh, b0[ks], s0, 0, 0, 0); s1 = __builtin_amdgcn_mfma_f32_32x32x16_bf16(qh, b1[ks], s1, 0, 0, 0);
            s0 = __builtin_amdgcn_mfma_f32_32x32x16_bf16(ql, b0[ks], s0, 0, 0, 0); s1 = __builtin_amdgcn_mfma_f32_32x32x16_bf16(ql, b1[ks], s1, 0, 0, 0); }
        bf16x8 aA[4], aB[4];
        SC_LDA(aA, 0);
#pragma unroll 1
        for (int h = 0; h < 32; h += 2) {
            SC_LDA(aB, h + 1);
            { bf16x8 (&a)[4] = aA; SC_STEP(a, h); }
            if (h + 2 < 32) SC_LDA(aA, h + 2);
            { bf16x8 (&a)[4] = aB; SC_STEP(a, h + 1); }
        }
        float* o = sc + (size_t)kt * 64 + r32;
#pragma unroll
        for (int r = 0; r < 16; ++r) { const int q = (r & 3) + 8 * (r >> 2) + 4 * hi; o[(size_t)q * SCW] = s0[r]; o[(size_t)q * SCW + 32] = s1[r]; }
    }
#undef SC_LDA
#undef SC_STEP
#undef FMA8
}
__device__ __forceinline__ void sel_load(const float* __restrict__ sc, int nt, float (&vv)[NVJ], int lane) {
    if (nt <= 4) return;
    const int ng = (nt + 3) >> 2;
#pragma unroll
    for (int g = 0; g < 16; ++g) if (g < ng) {
#pragma unroll
        for (int i = 0; i < 4; ++i) vv[4 * g + i] = sc[(4 * g + i) * 64 + lane]; }
    if (ng > 16) vv[64] = sc[64 * 64 + lane];
}
__device__ __forceinline__ void select_row(float (&vv)[NVJ], int nt, int nvalid, u64* __restrict__ rm, const float* __restrict__ sc_next, int nt_next, int lane) {
    if (nt <= 4) { if (lane < nt) rm[lane] = ~0ull; sel_load(sc_next, nt_next, vv, lane); return; }
    unsigned uk[NVJ];
    { const int ng = (nt + 3) >> 2;
#pragma unroll
      for (int j = 0; j < NVJ; ++j) uk[j] = ((j >> 2) < ng && j * 64 + lane < nvalid) ? ord_key(vv[j]) : 0u; }
    sel_load(sc_next, nt_next, vv, lane);
#define CNTV(cnt, thr, x) asm volatile("v_cmp_le_u32 vcc, %1, %2\n\tv_addc_co_u32 %0, vcc, 0, %0, vcc" : "+v"(cnt) : "v"(thr), "v"(x) : "vcc")
    const int ng = (nt + 3) >> 2;
    unsigned T = 0u; int cT = 0;
    for (int bit = 31; bit >= 0; --bit) {
        const unsigned cand = T | (1u << bit); int cl = 0;
#pragma unroll
        for (int g = 0; g < 16; ++g) if (g < ng) { CNTV(cl, cand, uk[4 * g]); CNTV(cl, cand, uk[4 * g + 1]); CNTV(cl, cand, uk[4 * g + 2]); CNTV(cl, cand, uk[4 * g + 3]); }
        if (ng > 16) CNTV(cl, cand, uk[64]);
        cl += __builtin_amdgcn_update_dpp(0, cl, 0xB1, 0xf, 0xf, false);
        cl += __builtin_amdgcn_update_dpp(0, cl, 0x4E, 0xf, 0xf, false);
        cl += __builtin_amdgcn_update_dpp(0, cl, 0x141, 0xf, 0xf, false);
        cl += __builtin_amdgcn_update_dpp(0, cl, 0x140, 0xf, 0xf, false);
        const int cnt = (__builtin_amdgcn_readlane(cl, 0) + __builtin_amdgcn_readlane(cl, 16)) + (__builtin_amdgcn_readlane(cl, 32) + __builtin_amdgcn_readlane(cl, 48));
        if (cnt >= 256) { T = cand; cT = cnt; if (cnt == 256) break; }
    }
#undef CNTV
    if (cT == 256) {
#pragma unroll
        for (int j = 0; j < NVJ; ++j) { u64 mk; asm volatile("v_cmp_le_u32 %0, %1, %2" : "=s"(mk) : "s"(T), "v"(uk[j])); if (lane == 0) rm[j] = mk; }
    } else {
        int cgt = 0;
#pragma unroll
        for (int j = 0; j < NVJ; ++j) { u64 t0_; asm volatile("v_cmp_lt_u32 %0, %1, %2" : "=&s"(t0_) : "s"(T), "v"(uk[j])); cgt += __builtin_popcountll(t0_); }
        int need = 256 - cgt;
#pragma unroll
        for (int j = 0; j < NVJ; ++j) {
            u64 gt, eq; asm volatile("v_cmp_lt_u32 %0, %1, %2" : "=s"(gt) : "s"(T), "v"(uk[j])); asm volatile("v_cmp_eq_u32 %0, %1, %2" : "=s"(eq) : "s"(T), "v"(uk[j]));
            const int below = __builtin_popcountll(eq & ((1ull << lane) - 1ull));
            const u64 take = __ballot(((eq >> lane) & 1ull) && below < need);
            need -= __builtin_popcountll(take);
            if (lane == 0) rm[j] = gt | take;
        }
    }
}

namespace att {
constexpr int D = 128, KVBLK = 64;
constexpr float SCALE = 0.088388347648318440f;
constexpr float THR = 8.f;
constexpr float NEG = -1e30f, MINIT = -1e20f;
constexpr size_t SHM_V = KVBLK * D * 2, SHM_K = KVBLK * D * 2;
constexpr size_t OFF_WS = 2 * SHM_V + 2 * SHM_K, OFF_TB = OFF_WS + 8 * 64 * 4, OFF_MK = OFF_TB + 4 * 256 * 4, LDS_ATTN = OFF_MK + 64 * 65 * 8;
static_assert(LDS_ATTN <= 131072, "attention LDS");
#define KSWZ(row, colB) ((row) * 256 + ((colB) ^ (((row) & 7) << 4)))
#define SBAR() __builtin_amdgcn_sched_barrier(0)
__device__ __forceinline__ int crow(int r, int hi) { return (r & 3) + 8 * (r >> 2) + 4 * hi; }
__device__ __forceinline__ void partialSM(f32x16& p0, f32x16& p1, float& m_reg, float& mn, float& alpha) {
    constexpr float C = SCALE * 1.4426950408889634f;
    float pmax = p0[0];
#pragma unroll
    for (int r = 1; r < 16; ++r) pmax = fmaxf(pmax, p0[r]);
#pragma unroll
    for (int r = 0; r < 16; ++r) pmax = fmaxf(pmax, p1[r]);
    { auto rr = __builtin_amdgcn_permlane32_swap(__float_as_uint(pmax), __float_as_uint(pmax), false, false);
      pmax = fmaxf(__uint_as_float(rr[0]), __uint_as_float(rr[1])); }
    if (__builtin_expect(__all(pmax - m_reg <= THR / SCALE), 1)) { mn = m_reg; alpha = 1.f; }
    else { mn = fmaxf(m_reg, pmax); alpha = __builtin_amdgcn_exp2f((m_reg - mn) * C); m_reg = mn; }
    const float mnC = -mn * C;
#pragma unroll
    for (int r = 0; r < 16; ++r) p0[r] = fmaf(p0[r], C, mnC);
#pragma unroll
    for (int r = 0; r < 16; ++r) p1[r] = fmaf(p1[r], C, mnC);
#pragma unroll
    for (int r = 0; r < 16; ++r) p0[r] = __builtin_amdgcn_exp2f(p0[r]);
}
__device__ __forceinline__ void finishSM(f32x16& p0, f32x16& p1, float alpha, float& l_reg, bf16x8& pa0, bf16x8& pa1, bf16x8& pa2, bf16x8& pa3) {
#pragma unroll
    for (int r = 0; r < 16; ++r) p1[r] = __builtin_amdgcn_exp2f(p1[r]);
    float ps = 0;
#pragma unroll
    for (int r = 0; r < 16; ++r) ps += p0[r];
#pragma unroll
    for (int r = 0; r < 16; ++r) ps += p1[r];
    { auto rr = __builtin_amdgcn_permlane32_swap(__float_as_uint(ps), __float_as_uint(ps), false, false);
      ps = __uint_as_float(rr[0]) + __uint_as_float(rr[1]); }
    l_reg = l_reg * alpha + ps;
#define PK4(P, BASE, OUT) do { unsigned a0 = cvt_pk_bf16(P[BASE + 0], P[BASE + 1]), a1 = cvt_pk_bf16(P[BASE + 2], P[BASE + 3]);   \
    unsigned b0 = cvt_pk_bf16(P[BASE + 4], P[BASE + 5]), b1 = cvt_pk_bf16(P[BASE + 6], P[BASE + 7]);                              \
    auto r0 = __builtin_amdgcn_permlane32_swap(a0, b0, false, false); auto r1 = __builtin_amdgcn_permlane32_swap(a1, b1, false, false); \
    u32x4 w = {r0[0], r1[0], r0[1], r1[1]}; OUT = *reinterpret_cast<bf16x8*>(&w); } while (0)
    PK4(p0, 0, pa0); PK4(p0, 8, pa1); PK4(p1, 0, pa2); PK4(p1, 8, pa3);
#undef PK4
}
__device__ __forceinline__ void qkt(f32x16& p0, f32x16& p1, const LAS char* Ks, const bf16x8* qr, int r32, int hi) {
    p0 = f32x16{}; p1 = f32x16{};
#pragma unroll
    for (int d0 = 0; d0 < 8; ++d0) { const int cb = (d0 * 16 + hi * 8) * 2;
        const bf16x8 b0 = *(const LAS bf16x8*)(Ks + KSWZ(r32, cb));
        const bf16x8 b1 = *(const LAS bf16x8*)(Ks + KSWZ(32 + r32, cb));
        p0 = __builtin_amdgcn_mfma_f32_32x32x16_bf16(b0, qr[d0], p0, 0, 0, 0);
        p1 = __builtin_amdgcn_mfma_f32_32x32x16_bf16(b1, qr[d0], p1, 0, 0, 0); }
}
__device__ __forceinline__ int v_st(int k, int c) { const int kk = (k & ~0xC) | ((k & 4) << 1) | ((k & 8) >> 1); return ((kk >> 3) * 4 + (c >> 5)) * 512 + ((kk & 7) * 32 + (c & 31)) * 2; }
__device__ __forceinline__ int v_rd_base(int lane) { return ((lane & 3) << 3) | (((lane >> 2) & 3) << 6) | (((lane >> 4) & 1) << 5) | (((lane >> 5) & 1) << 8); }
constexpr int v_rd_off(int d0, int ks, int half) { return d0 * 512 + ks * 4096 + half * 2048; }
template <int OFF> __device__ __forceinline__ s16x4 tr_read(int vb) {
    s16x4 r; asm volatile("ds_read_b64_tr_b16 %0, %1 offset:%2" : "=&v"(r) : "v"(vb), "i"(OFF) : "memory"); return r;
}
template <int D0> __device__ __forceinline__ void pv_one(f32x16& od, int vb, bf16x8 pa0, bf16x8 pa1, bf16x8 pa2, bf16x8 pa3) {
    const s16x4 l0 = tr_read<v_rd_off(D0, 0, 0)>(vb), h0 = tr_read<v_rd_off(D0, 0, 1)>(vb), l1 = tr_read<v_rd_off(D0, 1, 0)>(vb), h1 = tr_read<v_rd_off(D0, 1, 1)>(vb);
    const s16x4 l2 = tr_read<v_rd_off(D0, 2, 0)>(vb), h2 = tr_read<v_rd_off(D0, 2, 1)>(vb), l3 = tr_read<v_rd_off(D0, 3, 0)>(vb), h3 = tr_read<v_rd_off(D0, 3, 1)>(vb);
    asm volatile("s_waitcnt lgkmcnt(0)" ::: "memory"); SBAR();
#define PK(L, H) (bf16x8){L[0], L[1], L[2], L[3], H[0], H[1], H[2], H[3]}
    od = __builtin_amdgcn_mfma_f32_32x32x16_bf16(pa0, PK(l0, h0), od, 0, 0, 0);
    od = __builtin_amdgcn_mfma_f32_32x32x16_bf16(pa1, PK(l1, h1), od, 0, 0, 0);
    od = __builtin_amdgcn_mfma_f32_32x32x16_bf16(pa2, PK(l2, h2), od, 0, 0, 0);
    od = __builtin_amdgcn_mfma_f32_32x32x16_bf16(pa3, PK(l3, h3), od, 0, 0, 0);
#undef PK
}
__device__ __forceinline__ void pv_d0(f32x16* o, int vb, bf16x8 pa0, bf16x8 pa1, bf16x8 pa2, bf16x8 pa3) {
    pv_one<0>(o[0], vb, pa0, pa1, pa2, pa3); pv_one<1>(o[1], vb, pa0, pa1, pa2, pa3); pv_one<2>(o[2], vb, pa0, pa1, pa2, pa3); pv_one<3>(o[3], vb, pa0, pa1, pa2, pa3);
}
__device__ __forceinline__ void mask_bias(f32x16& p0, f32x16& p1, u64 mw, bool near, const LAS float* tbk, int hi) {
    if (near) {
#pragma unroll
        for (int r = 0; r < 16; ++r) { const int b = (r & 3) + 8 * (r >> 2); p0[r] += tbk[b]; p1[r] += tbk[32 + b]; }
    }
    const unsigned lo = (unsigned)mw >> (4 * hi), hh = (unsigned)(mw >> 32) >> (4 * hi);
#pragma unroll
    for (int r = 0; r < 16; ++r) { const int b = (r & 3) + 8 * (r >> 2);
        const unsigned m0 = (unsigned)__builtin_amdgcn_sbfe((int)lo, b, 1), m1 = (unsigned)__builtin_amdgcn_sbfe((int)hh, b, 1);
        p0[r] = __uint_as_float((m0 & __float_as_uint(p0[r])) | (~m0 & __float_as_uint(NEG)));
        p1[r] = __uint_as_float((m1 & __float_as_uint(p1[r])) | (~m1 & __float_as_uint(NEG))); }
}

__device__ __forceinline__ void og_store_rows(const LAS char* st, const bf16_t* __restrict__ SGg, bf16_t* __restrict__ OGg, int kvh, int nrows, int tid) {
    for (int c = tid; c < nrows * 64; c += NTHREADS) { const int row = c >> 6, ch = c & 63;
        const u32x4 ov = *(const LAS u32x4*)(st + row * 1024 + ch * 16);
        const size_t off = (size_t)row * DM + kvh * 512 + ch * 8;
        const u32x4 gv = *(const u32x4*)(SGg + off);
        u32x4 w; w.x = cvt_pk_bf16(bf_lo(ov.x) * bf_lo(gv.x), bf_hi(ov.x) * bf_hi(gv.x)); w.y = cvt_pk_bf16(bf_lo(ov.y) * bf_lo(gv.y), bf_hi(ov.y) * bf_hi(gv.y));
        w.z = cvt_pk_bf16(bf_lo(ov.z) * bf_lo(gv.z), bf_hi(ov.z) * bf_hi(gv.z)); w.w = cvt_pk_bf16(bf_lo(ov.w) * bf_lo(gv.w), bf_hi(ov.w) * bf_hi(gv.w));
        *(u32x4*)(OGg + off) = w; }
}
__device__ __forceinline__ void attn_block(const bf16_t* __restrict__ Qg, const bf16_t* __restrict__ Kh, const bf16_t* __restrict__ Vh, const u64* __restrict__ rmq,
                                           const bf16_t* __restrict__ SGg, bf16_t* __restrict__ OGg, int NT, int qpos0, int kvh, const float* __restrict__ rel_bias, LAS char* lds) {
    int tid = threadIdx.x; asm volatile("" : "+v"(tid));
    const int wid = __builtin_amdgcn_readfirstlane(tid >> 6), lane = tid & 63, r32 = lane & 31, hi = lane >> 5;
    const int hl = wid & 3, qs = wid >> 2, head = kvh * 4 + hl;
    LAS char* V_lds = lds; LAS char* K_lds = lds + 2 * SHM_V;
    LAS float* ws = (LAS float*)(lds + OFF_WS) + wid * 64; LAS float* li_l = ws; LAS float* al_l = ws + 32;
    LAS float* tb = (LAS float*)(lds + OFF_TB);
    for (int e = tid; e < 1024; e += NTHREADS) {
        const int h = e >> 8, rel = (e & 255) - 192, n = rel < 0 ? -rel : rel;
        int bk = n < 8 ? n : (n < 12 ? 8 : n < 16 ? 9 : n < 23 ? 10 : n < 32 ? 11 : n < 46 ? 12 : n < 64 ? 13 : n < 91 ? 14 : 15);
        if (rel > 0) bk += 16;
        tb[e] = (rel_bias[bk * 32 + kvh * 4 + h] - rel_bias[15 * 32 + kvh * 4 + h]) * (1.0f / SCALE);
    }
    {
        const u32x4* src = (const u32x4*)rmq; LAS u32x4* dst = (LAS u32x4*)(lds + OFF_MK);
        constexpr int NCH = 64 * RMS * 8 / 16;
        for (int e = tid; e < NCH; e += NTHREADS) dst[e] = src[e];
    }
    float m_reg = MINIT, l_reg = 0; f32x16 o[4] = {}; bf16x8 qr[8];
    const int qrow = qs * 32 + r32;
    const bf16_t* Qw = Qg + (size_t)qrow * DM + head * D + hi * 8;
#pragma unroll
    for (int d0 = 0; d0 < 8; ++d0) qr[d0] = *(const bf16x8*)(Qw + d0 * 16);
    const LAS u64* rml = (const LAS u64*)(lds + OFF_MK) + qrow * RMS;
    const int vb0 = (int)(uintptr_t)V_lds + v_rd_base(lane);
    const int tboff = hl * 256 + 192 - (qpos0 + qrow) + 4 * hi;
    constexpr int LDK = KVW;
    unsigned koff[2], voff[2];
#pragma unroll
    for (int i = 0; i < 2; ++i) { const int off = (wid * 2 + i) * 1024 + lane * 16;
        { const int row = off >> 8, cB = (off & 255) ^ ((row & 7) << 4); koff[i] = (unsigned)(row * LDK * 2 + cB); }
        { const int sub = off >> 9, kk = (sub >> 2) * 8 + ((off & 511) >> 6), k = (kk & ~0xC) | ((kk & 4) << 1) | ((kk & 8) >> 1), c = (sub & 3) * 32 + ((off & 63) >> 1); voff[i] = (unsigned)(k * LDK * 2 + c * 2); } }
#define DMA_K(t, slot) do { _Pragma("unroll") for (int i_ = 0; i_ < 2; ++i_) __builtin_amdgcn_global_load_lds((const unsigned*)((const char*)Kh + (size_t)(t) * (KVBLK * LDK * 2) + koff[i_]), \
        (LAS unsigned*)(K_lds + (slot) * SHM_K + (wid * 2 + i_) * 1024), 16, 0, 0); } while (0)
#define DMA_V(t, slot) do { _Pragma("unroll") for (int i_ = 0; i_ < 2; ++i_) __builtin_amdgcn_global_load_lds((const unsigned*)((const char*)Vh + (size_t)(t) * (KVBLK * LDK * 2) + voff[i_]), \
        (LAS unsigned*)(V_lds + (slot) * SHM_V + (wid * 2 + i_) * 1024), 16, 0, 0); } while (0)
#define STEPBAR() do { asm volatile("s_waitcnt vmcnt(0) lgkmcnt(0)" ::: "memory"); __builtin_amdgcn_s_barrier(); asm volatile("" ::: "memory"); } while (0)
#define RESC(a) do { if (__any((a) < 1.f)) { if (hi == 0) al_l[r32] = (a); asm volatile("s_waitcnt lgkmcnt(0)" ::: "memory"); \
    _Pragma("unroll") for (int d = 0; d < 4; ++d) _Pragma("unroll") for (int r = 0; r < 16; ++r) o[d][r] *= al_l[crow(r, hi)]; } } while (0)
#define MB(P0, P1, t) mask_bias(P0, P1, rml[t], (t) >= NT - 3, tb + tboff + (t) * KVBLK, hi)
    f32x16 pA0, pA1, pB0, pB1; float mnA, mnB, alA, alB; bf16x8 pa0, pa1, pa2, pa3;
    DMA_K(0, 0);
    STEPBAR();
    if (NT > 1) DMA_K(1, 1);
    DMA_V(0, 0);
    qkt(pA0, pA1, K_lds, qr, r32, hi); MB(pA0, pA1, 0); partialSM(pA0, pA1, m_reg, mnA, alA);
    int j = 1;
    for (; j + 1 < NT; j += 2) {
        STEPBAR();
        DMA_K(j + 1, 0); DMA_V(j, 1);
        SBAR(); qkt(pB0, pB1, K_lds + SHM_K, qr, r32, hi);
        finishSM(pA0, pA1, alA, l_reg, pa0, pa1, pa2, pa3); SBAR();
        pv_d0(o, vb0, pa0, pa1, pa2, pa3); MB(pB0, pB1, j); partialSM(pB0, pB1, m_reg, mnB, alB);
        RESC(alB);
        STEPBAR();
        if (j + 2 < NT) DMA_K(j + 2, 1);
        DMA_V(j + 1, 0);
        SBAR(); qkt(pA0, pA1, K_lds, qr, r32, hi);
        finishSM(pB0, pB1, alB, l_reg, pa0, pa1, pa2, pa3); SBAR();
        pv_d0(o, vb0 + (int)SHM_V, pa0, pa1, pa2, pa3); MB(pA0, pA1, j + 1); partialSM(pA0, pA1, m_reg, mnA, alA);
        RESC(alA);
    }
    if (j < NT) {
        STEPBAR();
        DMA_V(j, 1);
        SBAR(); qkt(pB0, pB1, K_lds + SHM_K, qr, r32, hi);
        finishSM(pA0, pA1, alA, l_reg, pa0, pa1, pa2, pa3); SBAR();
        pv_d0(o, vb0, pa0, pa1, pa2, pa3); MB(pB0, pB1, j); partialSM(pB0, pB1, m_reg, mnB, alB);
        RESC(alB);
        STEPBAR();
        finishSM(pB0, pB1, alB, l_reg, pa0, pa1, pa2, pa3); SBAR();
        pv_d0(o, vb0 + (int)SHM_V, pa0, pa1, pa2, pa3);
    } else {
        STEPBAR();
        finishSM(pA0, pA1, alA, l_reg, pa0, pa1, pa2, pa3); SBAR();
        pv_d0(o, vb0, pa0, pa1, pa2, pa3);
    }
    asm volatile("s_waitcnt vmcnt(0)" ::: "memory");
    if (hi == 0) li_l[r32] = l_reg;
    __syncthreads();
    {
        LAS bf16_t* st = (LAS bf16_t*)lds;
#pragma unroll
        for (int r = 0; r < 16; ++r) { const int orow = qs * 32 + crow(r, hi); const float rl = __builtin_amdgcn_rcpf(li_l[crow(r, hi)]);
#pragma unroll
            for (int d0 = 0; d0 < 4; ++d0) st[orow * 512 + hl * 128 + d0 * 32 + r32] = (bf16_t)(cvt_pk_bf16(o[d0][r] * rl, 0.f) & 0xffffu); }
    }
    __syncthreads();
    og_store_rows(lds, SGg, OGg, kvh, 64, tid);
    __syncthreads();
#undef DMA_K
#undef DMA_V
#undef STEPBAR
#undef RESC
#undef MB
}

#define WGBAR() do { asm volatile("s_waitcnt lgkmcnt(0)" ::: "memory"); __builtin_amdgcn_s_barrier(); asm volatile("" ::: "memory"); } while (0)
__device__ __forceinline__ void attn_sample_block(const bf16_t* __restrict__ Qg, const float* __restrict__ ck, const float* __restrict__ cv, const bf16_t* __restrict__ kn, const bf16_t* __restrict__ vn,
                                                  const u64* __restrict__ rmq, const bf16_t* __restrict__ SGg, bf16_t* __restrict__ OGg, int kvh, const float* __restrict__ rel_bias, LAS char* lds) {
    int tid = threadIdx.x; asm volatile("" : "+v"(tid));
    const int wid = __builtin_amdgcn_readfirstlane(tid >> 6), lane = tid & 63, r32 = lane & 31, hi = lane >> 5;
    constexpr int NT = 65;
    LAS char* V_lds = lds; LAS char* K_lds = lds + 2 * SHM_V;
    LAS float* tb = (LAS float*)(lds + OFF_TB);
    for (int e = tid; e < 1024; e += NTHREADS) {
        const int h = e >> 8, rel = (e & 255) - 192, n = rel < 0 ? -rel : rel;
        int bk = n < 8 ? n : (n < 12 ? 8 : n < 16 ? 9 : n < 23 ? 10 : n < 32 ? 11 : n < 46 ? 12 : n < 64 ? 13 : n < 91 ? 14 : 15);
        if (rel > 0) bk += 16;
        tb[e] = (rel_bias[bk * 32 + kvh * 4 + h] - rel_bias[15 * 32 + kvh * 4 + h]) * (1.0f / SCALE);
    }
    {   const u32x4* src = (const u32x4*)rmq; LAS u32x4* dst = (LAS u32x4*)(lds + OFF_MK);
        for (int e = tid; e < 32 * RMS * 8 / 16; e += NTHREADS) dst[e] = src[e]; }
    if (wid >= 4) {
        const int lt = tid - 256;
        f32x4 krA[4][2], vrA[4][2], krB[4][2], vrB[4][2];
        const int row0 = lt >> 4, c8 = (lt & 15) * 8;
#define LD_TILE(kr, vr, t) do { if ((t) < 64) { _Pragma("unroll") for (int i = 0; i < 4; ++i) { const size_t o_ = ((size_t)(t) * 64 + row0 + 16 * i) * KVW + c8; \
            kr[i][0] = *(const f32x4*)(ck + o_); kr[i][1] = *(const f32x4*)(ck + o_ + 4); vr[i][0] = *(const f32x4*)(cv + o_); vr[i][1] = *(const f32x4*)(cv + o_ + 4); } } } while (0)
#define WR_TILE(kr, vr, t, b) do { if ((t) < 64) { _Pragma("unroll") for (int i = 0; i < 4; ++i) { const int r_ = row0 + 16 * i; \
            *(LAS u32x4*)(K_lds + (b) * SHM_K + KSWZ(r_, c8 * 2)) = pack8(kr[i][0], kr[i][1]); *(LAS u32x4*)(V_lds + (b) * SHM_V + v_st(r_, c8)) = pack8(vr[i][0], vr[i][1]); } } \
        else if ((t) == 64) { _Pragma("unroll") for (int i = 0; i < 4; ++i) { const int r_ = row0 + 16 * i; u32x4 kx = (u32x4){0u, 0u, 0u, 0u}, vx = kx; \
            if (r_ < 32) { kx = *(const u32x4*)(kn + (size_t)r_ * KVW + c8); vx = *(const u32x4*)(vn + (size_t)r_ * KVW + c8); } \
            *(LAS u32x4*)(K_lds + (b) * SHM_K + KSWZ(r_, c8 * 2)) = kx; *(LAS u32x4*)(V_lds + (b) * SHM_V + v_st(r_, c8)) = vx; } } } while (0)
        LD_TILE(krA, vrA, 0); WR_TILE(krA, vrA, 0, 0); LD_TILE(krA, vrA, 1); LD_TILE(krB, vrB, 2);
        WGBAR();
        WR_TILE(krA, vrA, 1, 1); LD_TILE(krA, vrA, 3);
        WGBAR();
        for (int j = 1; j + 1 < NT; j += 2) {
            WGBAR();
            WR_TILE(krB, vrB, j + 1, 0);
            WGBAR();
            LD_TILE(krB, vrB, j + 3);
            WGBAR();
            WR_TILE(krA, vrA, j + 2, 1);
            WGBAR();
            LD_TILE(krA, vrA, j + 4);
        }
#undef LD_TILE
#undef WR_TILE
    } else {
        LAS float* ws = (LAS float*)(lds + OFF_WS) + wid * 64; LAS float* li_l = ws; LAS float* al_l = ws + 32;
        const int head = kvh * 4 + wid;
        float m_reg = MINIT, l_reg = 0; f32x16 o[4] = {}; bf16x8 qr[8];
        const bf16_t* Qw = Qg + (size_t)r32 * DM + head * D + hi * 8;
#pragma unroll
        for (int d0 = 0; d0 < 8; ++d0) qr[d0] = *(const bf16x8*)(Qw + d0 * 16);
        const LAS u64* rml = (const LAS u64*)(lds + OFF_MK) + r32 * RMS;
        const int vb0 = (int)(uintptr_t)V_lds + v_rd_base(lane);
        const int tboff = wid * 256 + 192 - (PAST + r32) + 4 * hi;
#define RESC(a) do { if (__any((a) < 1.f)) { if (hi == 0) al_l[r32] = (a); asm volatile("s_waitcnt lgkmcnt(0)" ::: "memory"); \
    _Pragma("unroll") for (int d = 0; d < 4; ++d) _Pragma("unroll") for (int r = 0; r < 16; ++r) o[d][r] *= al_l[crow(r, hi)]; } } while (0)
#define MB(P0, P1, t) mask_bias(P0, P1, rml[t], (t) >= NT - 3, tb + tboff + (t) * KVBLK, hi)
        f32x16 pA0, pA1, pB0, pB1; float mnA, mnB, alA, alB; bf16x8 pa0, pa1, pa2, pa3;
        WGBAR();
        qkt(pA0, pA1, K_lds, qr, r32, hi); MB(pA0, pA1, 0); partialSM(pA0, pA1, m_reg, mnA, alA);
        WGBAR();
        for (int j = 1; j + 1 < NT; j += 2) {
            SBAR(); qkt(pB0, pB1, K_lds + SHM_K, qr, r32, hi);
            finishSM(pA0, pA1, alA, l_reg, pa0, pa1, pa2, pa3); SBAR();
            pv_d0(o, vb0, pa0, pa1, pa2, pa3); MB(pB0, pB1, j); partialSM(pB0, pB1, m_reg, mnB, alB);
            WGBAR();
            RESC(alB);
            WGBAR();
            SBAR(); qkt(pA0, pA1, K_lds, qr, r32, hi);
            finishSM(pB0, pB1, alB, l_reg, pa0, pa1, pa2, pa3); SBAR();
            pv_d0(o, vb0 + (int)SHM_V, pa0, pa1, pa2, pa3); MB(pA0, pA1, j + 1); partialSM(pA0, pA1, m_reg, mnA, alA);
            WGBAR();
            RESC(alA);
            WGBAR();
        }
        finishSM(pA0, pA1, alA, l_reg, pa0, pa1, pa2, pa3); SBAR();
        pv_d0(o, vb0, pa0, pa1, pa2, pa3);
        if (hi == 0) li_l[r32] = l_reg;
        WGBAR();
        {
            LAS bf16_t* st = (LAS bf16_t*)lds;
#pragma unroll
            for (int r = 0; r < 16; ++r) { const int orow = crow(r, hi); const float rl = __builtin_amdgcn_rcpf(li_l[orow]);
#pragma unroll
                for (int d0 = 0; d0 < 4; ++d0) st[orow * 512 + wid * 128 + d0 * 32 + r32] = (bf16_t)(cvt_pk_bf16(o[d0][r] * rl, 0.f) & 0xffffu); }
        }
#undef RESC
#undef MB
    }
    if (wid >= 4) WGBAR();
    __syncthreads();
    og_store_rows(lds, SGg, OGg, kvh, 32, tid);
    __syncthreads();
}
}

__global__ void __launch_bounds__(NTHREADS, 2) mega(Params p) {
    extern __shared__ __attribute__((aligned(16))) unsigned char lds_raw[];
    LAS unsigned char* lds = (LAS unsigned char*)lds_raw;
    volatile LAS unsigned* MISC = (volatile LAS unsigned*)(lds + MISC_OFF);
    const int G = gridDim.x; const int bx = blockIdx.x;
    const int vcu = (G % 8 == 0) ? (bx % 8) * (G / 8) + bx / 8 : bx;
    const int NGW = G * NWAVES;
#define PHASE_IDS() int tid = threadIdx.x; asm volatile("" : "+v"(tid)); const int lane = tid & 63, wave = __builtin_amdgcn_readfirstlane(tid >> 6), gw = vcu * NWAVES + wave; (void)lane; (void)gw
    unsigned char* ws = p.ws; float* out = p.out;
    const int lo = p.ph_lo, hi_ph = p.ph_hi;
    for (int u = threadIdx.x; u < (LDS_BYTES - RING_BYTES) / 4; u += NTHREADS) ((LAS unsigned*)(lds + RING_BYTES))[u] = 0u;
    __syncthreads();
    XcdBarrier bar; bar.bar = (unsigned*)(ws + WS_CTL) + CW_BAR; bar.x = 0; bar.st = nullptr;
    if (hi_ph - lo > 1) bar = xcd_barrier_post((unsigned*)(ws + WS_CTL) + CW_BAR, MISC + 8);
#ifndef PH_MASK
#define PH_MASK 0x7fff
#endif
#define IN(k) (((PH_MASK >> (k)) & 1) && lo <= (k) && (k) < hi_ph)
#ifdef TPROBE
    unsigned long long tp0 = __builtin_amdgcn_s_memrealtime(), tp1 = 0;
#define TP_MARK(k) do { if ((k) == TPROBE - 1) tp0 = __builtin_amdgcn_s_memrealtime(); if ((k) == TPROBE) tp1 = __builtin_amdgcn_s_memrealtime(); } while (0)
#else
#define TP_MARK(k) do { } while (0)
#endif
#define SEAM(k) do { if (IN(k) && IN((k) + 1)) xcd_barrier(bar); TP_MARK(k); } while (0)

    if (IN(0)) {
        PHASE_IDS();
#ifdef BWTEST
        {
            float acc = 0.f; const size_t NCH = (size_t)DB * PAST * KVW / 4096;
#if BWTEST == 1
            for (size_t c = gw; c < 2 * NCH; c += NGW) { const f32x4* src = (const f32x4*)((c < NCH ? p.cache_k : p.cache_v) + (c % NCH) * 4096) + lane; f32x4 t[16];
#pragma unroll
                for (int j = 0; j < 16; ++j) t[j] = src[64 * j];
#pragma unroll
                for (int j = 0; j < 16; ++j) acc += (t[j].x + t[j].y) + (t[j].z + t[j].w); }
#else
            f32x4 t[16], tn[16];
            { const f32x4* src = (const f32x4*)(p.cache_k + (size_t)gw * 4096) + lane;
#pragma unroll
              for (int j = 0; j < 16; ++j) t[j] = src[64 * j]; }
#pragma unroll 1
            for (size_t c = gw; c < 2 * NCH; c += NGW) { const size_t cn = c + NGW;
                if (cn < 2 * NCH) { const f32x4* src = (const f32x4*)((cn < NCH ? p.cache_k : p.cache_v) + (cn % NCH) * 4096) + lane;
#pragma unroll
                    for (int j = 0; j < 16; ++j) tn[j] = src[64 * j]; }
#pragma unroll
                for (int j = 0; j < 16; ++j) acc += (t[j].x + t[j].y) + (t[j].z + t[j].w);
#pragma unroll
                for (int j = 0; j < 16; ++j) t[j] = tn[j]; }
#endif
            if (acc == 1.2345e-30f) out[0] = acc;
        }
#endif
        LAS float* scr = (LAS float*)(lds + wave * 16384);
        constexpr int I_IN = 64 * 34, I_GRP = 4 * 16 * 16, I_AMX = 64 * 40, I_AMX2 = 64 * 32, I_AMX3 = 64 * 16;
        constexpr int NITEMS = I_IN + I_GRP + I_AMX + I_AMX2 + 2 * I_AMX3;
        for (int it = gw; it < NITEMS; it += NGW) {
            int r = it;
            if (r < I_IN) { const int kb = r / 34, nb = r % 34, n0 = 6144 + nb * 64;
                transpose_item(p.attn_w_in, 12384, kb * 64, n0, (bf16_t*)(ws + WS_WT_IN), DM, nb * 64, nb == 33 ? 32 : 64, scr, lane); continue; } r -= I_IN;
            if (r < I_GRP) { const int g = r / 256, q = r % 256;
                transpose_item(p.pool_group_w + (size_t)g * 1024 * 1024, 1024, (q / 16) * 64, (q % 16) * 64, (bf16_t*)(ws + WS_WT_GRP), 1024, g * 1024 + (q % 16) * 64, 64, scr, lane); continue; } r -= I_GRP;
            if (r >= I_AMX + I_AMX2) {
                r -= I_AMX + I_AMX2; const bool second = r >= I_AMX3; if (second) r -= I_AMX3;
                const int kb = r >> 4, cb = r & 15, n0 = cb * 256 + lane * 4;
                const f32x4 m = col_amax64<false>((second ? p.pool_w_out : p.attn_w_out) + (size_t)kb * 64 * DM + n0, DM, nullptr);
                unsigned* cm = (unsigned*)(ws + (second ? WS_CAMAX4 : WS_CAMAX3)) + n0;
                atomicMax(cm, __float_as_uint(m.x)); atomicMax(cm + 1, __float_as_uint(m.y)); atomicMax(cm + 2, __float_as_uint(m.z)); atomicMax(cm + 3, __float_as_uint(m.w));
                continue;
            }
            if (r >= I_AMX) {
                r -= I_AMX; const int kb = r >> 5, cb = r & 31, n0 = cb * 256 + lane * 4;
                const f32x4 m = col_amax64<true>(p.pool_w_in + (size_t)kb * 64 * 8192 + n0, 8192, p.norm_w + DM + kb * 64);
                unsigned* cm = (unsigned*)(ws + WS_CAMAX2) + cb * 256 + lane * 4;
                atomicMax(cm, __float_as_uint(m.x)); atomicMax(cm + 1, __float_as_uint(m.y)); atomicMax(cm + 2, __float_as_uint(m.z)); atomicMax(cm + 3, __float_as_uint(m.w));
                continue;
            }
            {
                const int kb = r / 40, cb = r % 40, n0 = (cb < 24 ? cb * 256 : 8288 + (cb - 24) * 256) + lane * 4;
                const f32x4 m = col_amax64<false>(p.attn_w_in + (size_t)kb * 64 * 12384 + n0, 12384, nullptr);
                unsigned* cm = (unsigned*)(ws + WS_CAMAX) + cb * 256 + lane * 4;
                atomicMax(cm, __float_as_uint(m.x)); atomicMax(cm + 1, __float_as_uint(m.y)); atomicMax(cm + 2, __float_as_uint(m.z)); atomicMax(cm + 3, __float_as_uint(m.w));
            }
        }
        {
            u32x4* z = (u32x4*)((bf16_t*)(ws + WS_WT_IN) + (size_t)2144 * DM);
            for (size_t i = (size_t)gw * 64 + lane; i < (size_t)160 * DM * 2 / 16; i += (size_t)NGW * 64) z[i] = (u32x4){0u, 0u, 0u, 0u};
        }
        {
            __syncthreads();
            for (int i = tid; i < DM / 4; i += NTHREADS) ((LAS f32x4*)lds)[i] = ((const f32x4*)p.norm_w)[i];
            __syncthreads();
            f32x4 v[16], vn[16];
            if (gw < MT) { const f32x4* xr = (const f32x4*)(gw < MP ? p.x_prompt + (size_t)gw * DM : p.x_sample + (size_t)(gw - MP) * DM) + lane;
#pragma unroll
                for (int j = 0; j < 16; ++j) v[j] = xr[64 * j]; }
#pragma unroll 1
            for (int m = gw; m < MT; m += NGW) {
                const int mn = m + NGW;
                if (mn < MT) { const f32x4* xr = (const f32x4*)(mn < MP ? p.x_prompt + (size_t)mn * DM : p.x_sample + (size_t)(mn - MP) * DM) + lane;
#pragma unroll
                    for (int j = 0; j < 16; ++j) vn[j] = xr[64 * j]; }
                rms_row_q(v, (const LAS f32x4*)lds, (bf16_t*)(ws + WS_H) + (size_t)m * DM, (signed char*)(ws + WS_H8) + (size_t)m * DM, (float*)(ws + WS_SA) + m, lane);
#pragma unroll
                for (int j = 0; j < 16; ++j) v[j] = vn[j];
            }
        }
        {
            const size_t gt = (size_t)gw * 64 + lane, GT = (size_t)NGW * 64;
            constexpr size_t NK8 = (size_t)DB * SKV * DIDX / 8;
            for (size_t i = gt; i < NK8; i += GT) {
                const size_t row = i / 8, c8 = i % 8, bb = row / SKV, s = row % SKV;
                if (s >= (size_t)PAST && s < (size_t)PAST + DSQ) continue;
                u32x4 w = (u32x4){0u, 0u, 0u, 0u};
                if (s < (size_t)PAST) { const float* src = p.cache_kidx + (bb * PAST + s) * DIDX + c8 * 8; w = pack8(*(const f32x4*)src, *(const f32x4*)(src + 4)); }
                *(u32x4*)((bf16_t*)(ws + WS_KIS) + bb * SKV * DIDX + kif_off((int)s, (int)c8 * 8)) = w;
            }
        }
    }
    SEAM(0);
    if (IN(1)) {
        PHASE_IDS();
        LAS float* scr = (LAS float*)(lds + wave * 16384);
        for (int it = gw; it < 32 * 160; it += NGW) { const int kb = it / 160, nb = it % 160, n0 = nb < 96 ? nb * 64 : 8288 + (nb - 96) * 64;
            transpose_item_i8(p.attn_w_in, 12384, kb * 128, n0, (signed char*)(ws + WS_WT8), DM, nb * 64, scr, lane, (const unsigned*)(ws + WS_CAMAX), (float*)(ws + WS_SB)); }
        for (int it = gw; it < 32 * 128; it += NGW) { const int kb = it >> 7, nb = it & 127;
            transpose_item_i8(p.pool_w_in, 8192, kb * 128, nb * 64, (signed char*)(ws + WS_WP8), DM, nb * 64, scr, lane, (const unsigned*)(ws + WS_CAMAX2), (float*)(ws + WS_SB2), p.norm_w + DM); }
        for (int it = gw; it < 2 * 32 * 64; it += NGW) { const bool second = it >= 32 * 64; const int r = second ? it - 32 * 64 : it, kb = r >> 6, nb = r & 63;
            transpose_item_i8(second ? p.pool_w_out : p.attn_w_out, DM, kb * 128, nb * 64, (signed char*)(ws + (second ? WS_WPO8 : WS_WO8)), DM, nb * 64, scr, lane,
                              (const unsigned*)(ws + (second ? WS_CAMAX4 : WS_CAMAX3)), (float*)(ws + (second ? WS_SB4 : WS_SB3))); }
    }
    SEAM(1);
    if (IN(2)) {
        {
            pg8::Gemm g{(const bf16_t*)(ws + WS_H8), (const bf16_t*)(ws + WS_WT8), MT, NI8, DM / 2, DM / 2, DM / 2, 0};
            pg8::Order S; S.init(MT / 256, 40, 0, 0, G, bx);
            Epi1a E{ws, out};
            pg8::gemm_phase<Epi1a, false, true>(lds, g, S, E);
        }
        {
            pg8::Gemm g{(const bf16_t*)(ws + WS_H), (const bf16_t*)(ws + WS_WT_IN), MT, NB16, DM, DM, DM, 0};
            int G2 = G; asm volatile("" : "+s"(G2));
            pg8::Order S; S.init(MT / 256, 8, MT / 256, 1, G2, G2 - 1 - bx);
            Epi1b E{ws, out};
            pg8::gemm_phase<Epi1b, true>(lds, g, S, E);
        }
    }
    SEAM(2);
    if (IN(3)) {
        const bf16_t* QIF = (const bf16_t*)(ws + WS_QIB); const float* WI = (const float*)(ws + WS_WIB); float* SC = (float*)(ws + WS_SC);
        for (int it = vcu; it < 512; it += G) {
            if (it < 256) {
#pragma unroll 1
                for (int hh = 0; hh < 2; ++hh) { const int g = hh ? 511 - it : it, b = g >> 7, nt = ((g & 127) >> 1) + 1;
                    if (nt > 4) score_tiles(QIF + (size_t)g * 65536, WI + (size_t)g * 32 * HIDX, (const bf16_t*)(ws + WS_KIP) + (size_t)b * SEQ * DIDX, SC + (size_t)g * 32 * SCW, 0, 1, nt, lds); }
            } else {
                const int sb = (it - 256) >> 3, kr = (it - 256) & 7, g = 512 + sb;
                score_tiles(QIF + (size_t)g * 65536, WI + (size_t)g * 32 * HIDX, (const bf16_t*)(ws + WS_KIS) + (size_t)sb * SKV * DIDX, SC + (size_t)g * 32 * SCW, kr, 8, kr == 0 ? 9 : 8, lds);
            }
        }
    }
    SEAM(3);
    if (IN(4)) {
        PHASE_IDS();
        u64* RM = (u64*)(ws + WS_RM); const float* SC = (const float*)(ws + WS_SC);
        for (int pi = gw; pi < 2048; pi += NGW) {
            const int nq = (pi & 1) == 0 ? 9 : 8;
            float vv[NVJ];
#pragma unroll
            for (int j = 0; j < NVJ; ++j) vv[j] = 0.f;
            sel_load(SC + (size_t)pi * SCW, (pi >> 6) + 1, vv, lane);
#pragma unroll 1
            for (int k = 0; k < nq; ++k) {
                int m, nt, nv;
                if (k < 8) { const int b = k >> 1, t = (k & 1) ? 4095 - pi : pi; m = b * SEQ + t; nt = (t >> 6) + 1; nv = nt * 64; } else { m = MP + (pi >> 1); nt = 65; nv = PAST + DSQ; }
                int m2 = 0, nt2 = 0;
                if (k + 1 < 8) { const int b = (k + 1) >> 1, t = ((k + 1) & 1) ? 4095 - pi : pi; m2 = b * SEQ + t; nt2 = (t >> 6) + 1; } else if (k + 1 < nq) { m2 = MP + (pi >> 1); nt2 = 65; }
                select_row(vv, nt, nv, RM + (size_t)m * RMS, SC + (size_t)m2 * SCW, nt2, lane);
            }
        }
    }
    SEAM(4);
    if (IN(5)) {
        const u64* RM = (const u64*)(ws + WS_RM);
        const bf16_t* QB = (const bf16_t*)(ws + WS_QB); const bf16_t* SG = (const bf16_t*)(ws + WS_SG); bf16_t* OG = (bf16_t*)(ws + WS_OG);
        for (int sl = vcu; sl < 1280; sl += G) {
            const int v = sl & 255, k = sl >> 8, ks = v % 5;
            if (k != ks) {
                const int it = v + 256 * (k - (k > ks ? 1 : 0));
                const int b = it >> 8, kvh = (it >> 5) & 7, pr = it & 31;
                const bf16_t* Kh = (const bf16_t*)(ws + WS_KP) + (size_t)b * SEQ * KVW + kvh * 128; const bf16_t* Vh = (const bf16_t*)(ws + WS_VP) + (size_t)b * SEQ * KVW + kvh * 128;
#pragma unroll 1
                for (int half = 0; half < 2; ++half) {
                    const int c = half ? 63 - pr : pr; const size_t m0 = (size_t)b * SEQ + c * 64;
                    att::attn_block(QB + m0 * DM, Kh, Vh, RM + m0 * RMS, SG + m0 * DM, OG + m0 * DM, c + 1, c * 64, kvh, p.rel_bias, (LAS char*)lds);
                }
            } else {
                const int b = v >> 3, kvh = v & 7; const size_t m0 = (size_t)MP + b * 32;
                att::attn_sample_block(QB + m0 * DM, p.cache_k + ((size_t)b * PAST * NKVH + kvh) * 128, p.cache_v + ((size_t)b * PAST * NKVH + kvh) * 128,
                                       (const bf16_t*)(ws + WS_KSN) + (size_t)b * 32 * KVW + kvh * 128, (const bf16_t*)(ws + WS_VSN) + (size_t)b * 32 * KVW + kvh * 128,
                                       RM + m0 * RMS, SG + m0 * DM, OG + m0 * DM, kvh, p.rel_bias, (LAS char*)lds);
            }
        }
    }
    SEAM(5);
    if (IN(6)) {
        PHASE_IDS();
        float* SAo = (float*)(ws + WS_SA);
        quant_rows_bf16((const bf16_t*)(ws + WS_OG), (signed char*)(ws + WS_H8), MT, gw, NGW, lane, [&](int m, float am, float) { if (lane == 0) SAo[m] = am * (1.0f / 127.0f); });
    }
    SEAM(6);
    if (IN(7)) {
        pg8::Gemm g{(const bf16_t*)(ws + WS_H8), (const bf16_t*)(ws + WS_WO8), MT, DM, DM / 2, DM / 2, DM / 2, 0};
        pg8::Order S; S.init(MP / 256, 16, 256, 2, G, bx);
        EpiX1 E{p.x_prompt, nullptr, (bf16_t*)(ws + WS_H), (float*)(ws + WS_PS), (const float*)(ws + WS_SA), (const float*)(ws + WS_SB3)};
        pg8::gemm_phase<EpiX1, false, true>(lds, g, S, E);
    }
    SEAM(7);
    if (IN(8)) {
        signed char* X8 = (signed char*)(ws + WS_H8); float* ROWF = (float*)(ws + WS_ROWF);
        {
        PHASE_IDS();
        for (int m = MP + gw; m < MT; m += NGW) {
            const f32x4* xr = (const f32x4*)(p.x_sample + (size_t)(m - MP) * DM) + lane; const f32x4* ps = (const f32x4*)((const float*)(ws + WS_PS) + (size_t)(m - MP) * DM) + lane;
            f32x4* x1 = (f32x4*)((float*)(ws + WS_X1) + (size_t)m * DM) + lane; float ss = 0.f, am = 0.f; f32x4 v[16];
#pragma unroll
            for (int jb = 0; jb < 4; ++jb) {
                const f32x4* q0 = xr + 256 * jb; const f32x4* q1 = ps + 256 * jb; const f32x4* q2 = q1 + (size_t)MS * DM / 4; const f32x4* q3 = q2 + (size_t)MS * DM / 4; const f32x4* q4 = q3 + (size_t)MS * DM / 4;
                asm volatile("" : "+v"(q0), "+v"(q1), "+v"(q2), "+v"(q3), "+v"(q4) :: "memory");
#pragma unroll
                for (int jj = 0; jj < 4; ++jj) v[jb * 4 + jj] = q0[64 * jj] + ((q1[64 * jj] + q2[64 * jj]) + (q3[64 * jj] + q4[64 * jj]));
            }
#pragma unroll
            for (int j = 0; j < 16; ++j) { x1[64 * j] = v[j]; ss += (v[j].x * v[j].x + v[j].y * v[j].y) + (v[j].z * v[j].z + v[j].w * v[j].w);
                am = fmaxf(am, fmaxf(fmaxf(fabsf(v[j].x), fabsf(v[j].y)), fmaxf(fabsf(v[j].z), fabsf(v[j].w)))); }
#pragma unroll
            for (int o = 1; o < 64; o <<= 1) am = fmaxf(am, __shfl_xor(am, o));
            ss = wave_sum(ss);
            const float inv = am > 0.f ? 127.0f / am : 0.f;
            unsigned* q = (unsigned*)(X8 + (size_t)m * DM) + lane;
#pragma unroll
            for (int j = 0; j < 16; ++j) q[64 * j] = q8x4(v[j].x * inv, v[j].y * inv, v[j].z * inv, v[j].w * inv);
            if (lane == 0) ROWF[m] = am * (1.0f / 127.0f) / sqrtf(ss * (1.0f / DM) + EPS);
        }
        }
        {
            PHASE_IDS();
            quant_rows_bf16((const bf16_t*)(ws + WS_H), X8, MP, gw, NGW, lane, [&](int m, float am, float ss) { if (lane == 0) ROWF[m] = am * (1.0f / 127.0f) / sqrtf(ss * (1.0f / DM) + EPS); });
        }
        {
            PHASE_IDS();
            bf16_t* U = (bf16_t*)(ws + WS_U);
            constexpr int NPAD = (NBATCH + DB) * 16 * 512;
            for (int i = gw * 64 + lane; i < NPAD; i += NGW * 64) {
                const int c = (i & 511) * 8, rr = i >> 9, sq = rr >> 4, k = rr & 15;
                u32x4 o = (u32x4){0u, 0u, 0u, 0u}; size_t row;
                if (sq < NBATCH) row = (size_t)sq * UP_SEQ + k;
                else { const int b = sq - NBATCH; row = (size_t)UP_ROWS + (size_t)b * US_SEQ + k;
                    if (k >= 1) { const float* hp = p.state_pool + ((size_t)b * 15 + (k - 1)) * DM + c; o = pack8(*(const f32x4*)hp, *(const f32x4*)(hp + 4)); } }
                *(u32x4*)(U + row * DM + c) = o;
            }
        }
    }
    SEAM(8);
    if (IN(9)) {
        pg8::Gemm g{(const bf16_t*)(ws + WS_H8), (const bf16_t*)(ws + WS_WP8), MT, 8192, DM / 2, DM / 2, DM / 2, 0};
        pg8::Order S; S.init(MT / 256, 32, 0, 0, G, bx);
        Epi3 E{ws, out};
        pg8::gemm_phase<Epi3, false, true>(lds, g, S, E);
    }
    SEAM(9);
    if (IN(10)) {
        PHASE_IDS();
        const bf16_t* __restrict__ U = (const bf16_t*)(ws + WS_U); bf16_t* __restrict__ MX = (bf16_t*)(ws + WS_MX);
        constexpr int RUN = 32, NRUN_P = MP / RUN, NITEM = (NRUN_P + DB) * 512;
        const int gt = gw * 64 + lane, GT = NGW * 64;
#define ACC8(S, X, SGN) do { S[0] += SGN bf_lo(X.x); S[1] += SGN bf_hi(X.x); S[2] += SGN bf_lo(X.y); S[3] += SGN bf_hi(X.y); S[4] += SGN bf_lo(X.z); S[5] += SGN bf_hi(X.z); S[6] += SGN bf_lo(X.w); S[7] += SGN bf_hi(X.w); } while (0)
        for (int i = gt; i < NITEM; i += GT) {
            const int run = i >> 9, c = (i & 511) * 8, w = 2 << (c >> 10);
            const bool samp = run >= NRUN_P;
            const int m0 = samp ? MP + (run - NRUN_P) * 32 : run * RUN;
            const int t0 = samp ? 0 : (m0 & 4095);
            const bf16_t* up = U + (size_t)u_row(m0) * DM + c;
            float s[8] = {0.f, 0.f, 0.f, 0.f, 0.f, 0.f, 0.f, 0.f};
            for (int k = 1; k <= w; ++k) { const u32x4 x = *(const u32x4*)(up - (size_t)k * DM); ACC8(s, x, +); }
            const float icw = 1.0f / (float)w;
#pragma unroll 1
            for (int tb = 0; tb < RUN; tb += 8) {
                u32x4 cur[8], old[8];
#pragma unroll
                for (int q = 0; q < 8; ++q) { cur[q] = *(const u32x4*)(up + (size_t)(tb + q) * DM); old[q] = *(const u32x4*)(up + ((ptrdiff_t)(tb + q) - w) * DM); }
#pragma unroll
                for (int q = 0; q < 8; ++q) {
                    const int t = t0 + tb + q;
                    ACC8(s, cur[q], +); ACC8(s, old[q], -);
                    const float ic = (samp || t + 1 >= w) ? icw : 1.0f / (float)(t + 1);
                    const float f[8] = {bf_lo(cur[q].x), bf_hi(cur[q].x), bf_lo(cur[q].y), bf_hi(cur[q].y), bf_lo(cur[q].z), bf_hi(cur[q].z), bf_lo(cur[q].w), bf_hi(cur[q].w)};
                    u32x4 o;
                    o.x = cvt_pk_bf16(s[0] * ic - f[0], s[1] * ic - f[1]); o.y = cvt_pk_bf16(s[2] * ic - f[2], s[3] * ic - f[3]);
                    o.z = cvt_pk_bf16(s[4] * ic - f[4], s[5] * ic - f[5]); o.w = cvt_pk_bf16(s[6] * ic - f[6], s[7] * ic - f[7]);
                    *(u32x4*)(MX + (size_t)(m0 + tb + q) * DM + c) = o;
                }
            }
        }
#undef ACC8
    }
    SEAM(10);
    if (IN(11)) {
        pg8::Gemm g{(const bf16_t*)(ws + WS_MX), (const bf16_t*)(ws + WS_WT_GRP), MT, DM, 1024, DM, 1024, 1};
        pg8::Order S; S.init(MT / 256, 16, 0, 0, G, bx);
        Epi4 E{ws, p.pool_scale};
        pg8::gemm_phase<Epi4>(lds, g, S, E);
    }
    SEAM(11);
    if (IN(12)) {
        PHASE_IDS();
        float* SAo = (float*)(ws + WS_SA);
        quant_rows_bf16((const bf16_t*)(ws + WS_ZG), (signed char*)(ws + WS_H8), MT, gw, NGW, lane, [&](int m, float am, float) { if (lane == 0) SAo[m] = am * (1.0f / 127.0f); });
    }
    SEAM(12);
    if (IN(13)) {
        pg8::Gemm g{(const bf16_t*)(ws + WS_H8), (const bf16_t*)(ws + WS_WPO8), MT, DM, DM / 2, DM / 2, DM / 2, 0};
        pg8::Order S; S.init(MP / 256, 16, 256, 2, G, bx);
        EpiX2 E{(bf16_t*)(ws + WS_H), (float*)(ws + WS_PS), (const float*)(ws + WS_SA), (const float*)(ws + WS_SB4)};
        pg8::gemm_phase<EpiX2, false, true>(lds, g, S, E);
    }
    SEAM(13);
    if (IN(14)) {
        PHASE_IDS();
        for (int m = MP + gw; m < MT; m += NGW) {
            const f32x4* xr = (const f32x4*)((const float*)(ws + WS_X1) + (size_t)m * DM) + lane; const f32x4* ps = (const f32x4*)((const float*)(ws + WS_PS) + (size_t)(m - MP) * DM) + lane;
            const f32x4* wr = (const f32x4*)p.final_norm_w + lane; f32x4* yo = (f32x4*)(out + O_YS + (size_t)(m - MP) * DM) + lane;
            float ss = 0.f; f32x4 v[16];
#pragma unroll
            for (int jb = 0; jb < 4; ++jb) {
                const f32x4* q0 = xr + 256 * jb; const f32x4* q1 = ps + 256 * jb; const f32x4* q2 = q1 + (size_t)MS * DM / 4; const f32x4* q3 = q2 + (size_t)MS * DM / 4; const f32x4* q4 = q3 + (size_t)MS * DM / 4;
                asm volatile("" : "+v"(q0), "+v"(q1), "+v"(q2), "+v"(q3), "+v"(q4) :: "memory");
#pragma unroll
                for (int jj = 0; jj < 4; ++jj) v[jb * 4 + jj] = q0[64 * jj] + ((q1[64 * jj] + q2[64 * jj]) + (q3[64 * jj] + q4[64 * jj]));
            }
#pragma unroll
            for (int j = 0; j < 16; ++j) ss += (v[j].x * v[j].x + v[j].y * v[j].y) + (v[j].z * v[j].z + v[j].w * v[j].w);
            const float rstd = 1.0f / sqrtf(wave_sum(ss) * (1.0f / DM) + EPS);
#pragma unroll
            for (int j = 0; j < 16; ++j) yo[64 * j] = v[j] * rstd * wr[64 * j];
        }
        {
            const f32x4* wr = (const f32x4*)p.final_norm_w + lane; f32x4 w[16];
#pragma unroll
            for (int j = 0; j < 16; ++j) w[j] = wr[64 * j];
            const bf16_t* XB = (const bf16_t*)(ws + WS_H);
            u32x2 x[16], xn[16];
            if (gw < MP) {
#pragma unroll
                for (int j = 0; j < 16; ++j) x[j] = ((const u32x2*)(XB + (size_t)gw * DM) + lane)[64 * j]; }
#pragma unroll 1
            for (int m = gw; m < MP; m += NGW) {
                if (m + NGW < MP) {
#pragma unroll
                    for (int j = 0; j < 16; ++j) xn[j] = ((const u32x2*)(XB + (size_t)(m + NGW) * DM) + lane)[64 * j]; }
                float ss = 0.f;
#pragma unroll
                for (int j = 0; j < 16; ++j) { const float a = bf_lo(x[j].x), b = bf_hi(x[j].x), c = bf_lo(x[j].y), d = bf_hi(x[j].y); ss += (a * a + b * b) + (c * c + d * d); }
                const float rstd = 1.0f / sqrtf(wave_sum(ss) * (1.0f / DM) + EPS);
                f32x4* yo = (f32x4*)(out + O_YP + (size_t)m * DM) + lane;
#pragma unroll
                for (int j = 0; j < 16; ++j) yo[64 * j] = (f32x4){bf_lo(x[j].x), bf_hi(x[j].x), bf_lo(x[j].y), bf_hi(x[j].y)} * rstd * w[j];
#pragma unroll
                for (int j = 0; j < 16; ++j) x[j] = xn[j];
            }
        }
    }
#ifdef TPROBE
    if (TPROBE == NPHASE - 1) tp1 = __builtin_amdgcn_s_memrealtime();
    if (bx == 0) { const unsigned long long t = __builtin_amdgcn_s_memrealtime(), dt = (tp1 - tp0) * TPMUL; while (__builtin_amdgcn_s_memrealtime() - t < dt) __builtin_amdgcn_s_sleep(8); }
#endif
#undef IN
#undef SEAM
}

#ifndef MK_N_LAUNCHES
#define MK_N_LAUNCHES 1
#endif
extern "C" void kernel_launch(void* const* d_in, const int* in_sizes, int n_in, void* d_out, int out_size, void* d_ws, size_t ws_size, hipStream_t stream) {
    static int grid = 0;
    if (grid == 0) {
        if (n_in != 15 || (size_t)out_size != O_END || ws_size < WS_END) { fprintf(stderr, "kernel_launch: unexpected shapes: n_in %d out %d ws %zu (need >= %zu)\n", n_in, out_size, ws_size, (size_t)WS_END); grid = -1; return; }
        int dev = 0, cus = 0, per_cu = 0;
        if (hipGetDevice(&dev) != hipSuccess || hipDeviceGetAttribute(&cus, hipDeviceAttributeMultiprocessorCount, dev) != hipSuccess) { grid = -1; return; }
        if (hipFuncSetAttribute((const void*)mega, hipFuncAttributeMaxDynamicSharedMemorySize, LDS_BYTES) != hipSuccess) { fprintf(stderr, "kernel_launch: hipFuncSetAttribute failed\n"); grid = -1; return; }
        if (hipOccupancyMaxActiveBlocksPerMultiprocessor(&per_cu, (const void*)mega, NTHREADS, LDS_BYTES) != hipSuccess || per_cu < 1) { fprintf(stderr, "kernel_launch: occupancy query says %d\n", per_cu); }
        (void)hipGetLastError();
        grid = cus;
    }
    if (grid < 0) return;
    if (hipMemsetAsync((char*)d_ws + WS_CTL, 0, CTL_ZERO_BYTES, stream) != hipSuccess) return;
    Params p{};
    p.x_prompt = (const float*)d_in[0]; p.x_sample = (const float*)d_in[1]; p.cache_k = (const float*)d_in[2]; p.cache_v = (const float*)d_in[3];
    p.cache_kidx = (const float*)d_in[4]; p.state_pool = (const float*)d_in[5]; p.norm_w = (const float*)d_in[6]; p.final_norm_w = (const float*)d_in[7];
    p.attn_w_in = (const float*)d_in[8]; p.attn_w_out = (const float*)d_in[9]; p.rel_bias = (const float*)d_in[10]; p.pool_w_in = (const float*)d_in[11];
    p.pool_group_w = (const float*)d_in[12]; p.pool_scale = (const float*)d_in[13]; p.pool_w_out = (const float*)d_in[14];
    p.out = (float*)d_out; p.ws = (unsigned char*)d_ws;
    if (MK_N_LAUNCHES == 1) { p.ph_lo = 0; p.ph_hi = NPHASE; hipLaunchKernelGGL(mega, dim3(grid), dim3(NTHREADS), LDS_BYTES, stream, p); }
    else for (int k = 0; k < NPHASE; ++k) { p.ph_lo = k; p.ph_hi = k + 1; hipLaunchKernelGGL(mega, dim3(grid), dim3(NTHREADS), LDS_BYTES, stream, p); }
#ifdef PROBE_PHASE
    { p.ph_lo = PROBE_PHASE; p.ph_hi = PROBE_PHASE + 1; hipLaunchKernelGGL(mega, dim3(grid), dim3(NTHREADS), LDS_BYTES, stream, p); }
#endif
    const hipError_t le = hipPeekAtLastError();
    if (le != hipSuccess) fprintf(stderr, "kernel_launch: launch failed: %s\n", hipGetErrorName(le));
}
```

```cpp
#include <hip/hip_runtime.h>
#include <cstdio>
#include <cstdint>

#define LAS __attribute__((address_space(3)))
typedef unsigned short bf16_t;
typedef short bf16x8 __attribute__((ext_vector_type(8)));
typedef short s16x4 __attribute__((ext_vector_type(4)));
typedef float f32x4 __attribute__((ext_vector_type(4)));
typedef float f32x16 __attribute__((ext_vector_type(16)));
typedef unsigned u32x4 __attribute__((ext_vector_type(4)));
typedef unsigned u32x2 __attribute__((ext_vector_type(2)));
typedef unsigned long long u64;
typedef int i32x4 __attribute__((ext_vector_type(4)));

constexpr int DM = 4096, NBATCH = 4, SEQ = 4096, DB = 32, DSQ = 32, PAST = 4096;
constexpr int MP = NBATCH * SEQ, MS = DB * DSQ, MT = MP + MS;
constexpr int KVW = 1024, QIW = 2048, DIDX = 64, HIDX = 32, NKVH = 8;
constexpr int N1 = 12544;
constexpr int SKV = 4160;
constexpr int RMS = 65;
constexpr float EPS = 1e-6f;
constexpr int NWAVES = 8, NTHREADS = 512;
constexpr int NPHASE = 15;

constexpr size_t O_YP = 0, O_YS = 67108864, O_KP = 71303168, O_VP = 88080384, O_KIP = 104857600, O_POOLP = 105906176,
                 O_KS = 106151936, O_VS = 107200512, O_KIS = 108249088, O_POOLS = 108314624, O_END = 110280704;

constexpr size_t MiB = 1u << 20;
constexpr size_t WS_CTL = 0, CTL_ZERO_BYTES = 1 * MiB;
constexpr size_t WS_WT_IN = 1 * MiB, WS_WT_OUT = 99 * MiB, WS_WT_PIN = 131 * MiB, WS_WT_GRP = 195 * MiB, WS_WT_POUT = 203 * MiB;
constexpr size_t WS_H = 235 * MiB, WS_QB = 371 * MiB, WS_KP = 507 * MiB, WS_VP = 539 * MiB, WS_KS = 571 * MiB, WS_VS = 831 * MiB;
constexpr size_t WS_QIB = 1091 * MiB, WS_KIP = 1159 * MiB, WS_KIS = 1161 * MiB, WS_WIB = 1178 * MiB, WS_SG = 1181 * MiB, WS_RM = 1317 * MiB;
constexpr size_t WS_OG = 1326 * MiB, WS_X1 = 1462 * MiB, WS_SC = 1734 * MiB, WS_END = 2011 * MiB;
constexpr int SCW = 4160;
constexpr size_t WS_KSN = WS_KS, WS_VSN = WS_KS + 2 * MiB;
constexpr size_t WS_U = WS_QB, WS_SG2 = WS_SG, WS_MX = WS_OG, WS_ZG = WS_VS;
constexpr size_t WS_SS1 = WS_CTL + 256 * 1024;
constexpr size_t WS_PS = 600 * MiB;
constexpr size_t WS_H8 = 664 * MiB, WS_WT8 = 131 * MiB;
constexpr size_t WS_CAMAX = WS_CTL + 384 * 1024, WS_SB = WS_CTL + 448 * 1024, WS_SA = WS_CTL + 512 * 1024;
constexpr size_t WS_WP8 = 764 * MiB;
constexpr size_t WS_CAMAX2 = WS_CTL + 640 * 1024, WS_SB2 = WS_CTL + 704 * 1024, WS_ROWF = WS_CTL + 768 * 1024;
constexpr size_t WS_WO8 = 796 * MiB, WS_WPO8 = 812 * MiB;
constexpr size_t WS_CAMAX3 = WS_CTL + 848 * 1024, WS_CAMAX4 = WS_CTL + 864 * 1024, WS_SB3 = WS_CTL + 880 * 1024, WS_SB4 = WS_CTL + 896 * 1024;
constexpr int NB16 = 2304;
constexpr int NI8 = 10240;
constexpr int CW_BAR = 4096;

constexpr int LDS_BYTES = 147456, RING_BYTES = 131072, MISC_OFF = RING_BYTES + 320;

__device__ __forceinline__ unsigned cvt_pk_bf16(float lo, float hi) { unsigned r; asm("v_cvt_pk_bf16_f32 %0, %1, %2" : "=v"(r) : "v"(lo), "v"(hi)); return r; }
__device__ __forceinline__ float bf_lo(unsigned w) { return __uint_as_float(w << 16); }
__device__ __forceinline__ float bf_hi(unsigned w) { return __uint_as_float(w & 0xffff0000u); }
__device__ __forceinline__ float fma_abs(float a, float b, float c) { float d; asm("v_fma_f32 %0, %1, |%2|, %3" : "=v"(d) : "v"(a), "v"(b), "v"(c)); return d; }
__device__ __forceinline__ float silu_f(float x) { return x * __builtin_amdgcn_rcpf(1.0f + __builtin_amdgcn_exp2f(-1.4426950408889634f * x)); }
__device__ __forceinline__ float wave_sum(float v) {
#pragma unroll
    for (int o = 1; o < 64; o <<= 1) v += __shfl_xor(v, o);
    return v;
}
#define LDS_WAIT() asm volatile("s_waitcnt lgkmcnt(0)" ::: "memory")
#define VM_WAIT() asm volatile("s_waitcnt vmcnt(0)" ::: "memory")

#define XB_TMO      128
#define XB_XCNT(j)  (256  + 64 * (j))
#define XB_XSUB(j)  (1280 + 64 * (j))
#define XB_XGEN(j)  (2304 + 64 * (j))
#define XB_TOP      3328
#define XB_TOPGEN   3392
#define XCD_BAR_WORDS 3456
#define XB_SPIN_CAP (1u << 18)
__device__ __forceinline__ unsigned xb_ld(unsigned* p)              { return __hip_atomic_load(p, __ATOMIC_RELAXED, __HIP_MEMORY_SCOPE_AGENT); }
__device__ __forceinline__ unsigned xb_add(unsigned* p, unsigned v) { return __hip_atomic_fetch_add(p, v, __ATOMIC_RELAXED, __HIP_MEMORY_SCOPE_AGENT); }
__device__ __forceinline__ unsigned xb_xcc_id() { return (unsigned)__builtin_amdgcn_s_getreg((3 << 11) | 20) & 0xFu; }
#define XB_SPIN(cond, bar) do { unsigned _sp = 0; while (cond) { __builtin_amdgcn_s_sleep(1); \
    if ((++_sp & 255u) == 0u) { if (xb_ld(&(bar)[XB_TMO])) break; if (_sp > XB_SPIN_CAP) { atomicAdd(&(bar)[XB_TMO], 1u); break; } } } } while (0)
struct XcdBarrier { unsigned* bar; unsigned x; volatile LAS unsigned* st; };
__device__ __forceinline__ XcdBarrier xcd_barrier_post(unsigned* bar, volatile LAS unsigned* st) {
    XcdBarrier b; b.bar = bar; b.x = xb_xcc_id(); b.st = st;
    if (threadIdx.x == 0) (void)xb_add(&bar[XB_XCNT(b.x)], 1u);
    return b;
}
__device__ __forceinline__ void xcd_barrier_complete(unsigned* bar, unsigned x, unsigned& nloc, unsigned& nx) {
    const unsigned G = gridDim.x * gridDim.y * gridDim.z;
    unsigned sum, cnt, mine, sp = 0u;
    for (;;) {
        sum = 0u; cnt = 0u; mine = 0u;
#pragma unroll
        for (unsigned j = 0; j < 16; ++j) { const unsigned c = xb_ld(&bar[XB_XCNT(j)]); sum += c; cnt += (c > 0u) ? 1u : 0u; mine = (j == x) ? c : mine; }
        if (sum == G) break;
        __builtin_amdgcn_s_sleep(1);
        if ((++sp & 255u) == 0u) { if (xb_ld(&bar[XB_TMO])) break; if (sp > XB_SPIN_CAP) { atomicAdd(&bar[XB_TMO], 1u); break; } }
    }
    nloc = mine > 0u ? mine : 1u; nx = cnt > 0u ? cnt : 1u;
}
__device__ __forceinline__ void xcd_barrier(const XcdBarrier& b) {
    asm volatile("s_waitcnt vmcnt(0)" ::: "memory");
    __syncthreads();
    if (threadIdx.x == 0) {
        unsigned* bar = b.bar;
        __builtin_amdgcn_s_waitcnt(0);
        unsigned nloc = b.st[0], nx = b.st[1];
        if (nloc == 0u) { xcd_barrier_complete(bar, b.x, nloc, nx); b.st[0] = nloc; b.st[1] = nx; }
        const unsigned old = xb_add(&bar[XB_XSUB(b.x)], 1u);
        const unsigned gen = old / nloc;
        if (old + 1u == (gen + 1u) * nloc) {
            __builtin_amdgcn_fence(__ATOMIC_RELEASE, "agent");
            asm volatile("s_waitcnt vmcnt(0)" ::: "memory");
            const unsigned og = xb_add(&bar[XB_TOP], 1u);
            const unsigned tg = og / nx;
            if (og + 1u == (tg + 1u) * nx) xb_add(&bar[XB_TOPGEN], 1u);
            else XB_SPIN(xb_ld(&bar[XB_TOPGEN]) == tg, bar);
            __builtin_amdgcn_fence(__ATOMIC_ACQUIRE, "agent");
            xb_add(&bar[XB_XGEN(b.x)], 1u);
            asm volatile("s_waitcnt vmcnt(0)" ::: "memory");
        } else {
            XB_SPIN(xb_ld(&bar[XB_XGEN(b.x)]) == gen, bar);
            __builtin_amdgcn_fence(__ATOMIC_ACQUIRE, "agent");
            asm volatile("s_waitcnt vmcnt(0)" ::: "memory");
        }
    }
    __syncthreads();
}

namespace pg8 {
constexpr int BM = 256, BK = 64, HALF = 128, HTB = HALF * BK * 2, STAGE_BYTES = 8 * HTB, NXCD = 8, WGM = 8;
__host__ __device__ __forceinline__ int lds_byte(int r, int c) { const int st = (r >> 4) * 2 + (c >> 5), rr = r & 15, cc = c & 31, ob = rr * 64 + cc * 2; return st * 1024 + (ob ^ (((ob >> 9) & 1) << 5)); }
__host__ __device__ __forceinline__ void stage_rc(int b, int& R, int& C) { const int st = b / 1024, sb = b % 1024, swz = sb ^ (((sb >> 9) & 1) << 5); R = (st >> 1) * 16 + swz / 64; C = (st & 1) * 32 + (swz % 64) / 2; }
__host__ __device__ __forceinline__ int perm32(int rho) { const int n = rho >> 4, i = rho & 15; return 8 * (i >> 2) + 4 * n + (i & 3); }
struct Unit { int pm, pn, kq, half; };
struct Gemm { const bf16_t* A; const bf16_t* Bt; int M, N, K, lda, ldb, grouped; };
struct Order {
    int nM, nN, nfull, ntail, mode, G, c, qf, rf;
    __device__ void init(int nM_, int nN_, int ntail_, int mode_, int G_, int c_) { nM = nM_; nN = nN_; nfull = nM * nN; ntail = ntail_; mode = mode_; G = G_; c = c_;
        qf = __builtin_amdgcn_readfirstlane(nfull / G); rf = __builtin_amdgcn_readfirstlane(nfull % G); }
    __device__ bool next(int i, Unit& u) const {
        const long L = (long)i * G + c;
        if (L < nfull) {
            int wgid = (int)L; { const int q = nfull / NXCD, r = nfull % NXCD, xcd = wgid % NXCD, off = wgid / NXCD; wgid = (xcd < r ? xcd * (q + 1) : r * (q + 1) + (xcd - r) * q) + off; }
            const int nig = WGM * nN, gid = wgid / nig, fm = gid * WGM, gsz = (nM - fm) < WGM ? (nM - fm) : WGM;
            u.pm = fm + ((wgid % nig) % gsz); u.pn = (wgid % nig) / gsz; u.kq = -1; u.half = 0; return true;
        }
        int r = rf, q = qf, gr = G - rf, cc = c, ii = i; asm volatile("" : "+s"(r), "+s"(q), "+s"(gr), "+s"(cc), "+s"(ii));
        if (cc < r || ii < q) return false;
        const int e = (ii - q) * gr + (cc - r);
        if (e >= ntail) return false;
        if (mode == 1) { u.pm = e; u.pn = nN; u.kq = -1; u.half = 1; }
        else { const int t = e >> 2; u.pm = nM + (t >> 4); u.pn = t & 15; u.kq = e & 3; u.half = 0; }
        return true;
    }
};

template <class Epi, bool HALFCAP = false, bool I8 = false, bool ALIGN_EPI = true>
__device__ __forceinline__ void gemm_phase(LAS unsigned char* lds, const Gemm g, const Order& S, const Epi& E) {
    int tid = threadIdx.x; asm volatile("" : "+v"(tid));
    const int wid = __builtin_amdgcn_readfirstlane(tid >> 6), lane = tid & 63, wr = wid >> 2, wc = wid & 3, fr = lane & 15, fq = lane >> 4;
    const int K = g.K, ntf = K / BK;
    unsigned voffA[2], voffB[2];
#pragma unroll
    for (int i = 0; i < 2; ++i) { int R, C; stage_rc(tid * 16 + i * 8192, R, C); const int Rb = Epi::PERM ? ((R & ~31) + perm32(R & 31)) : R;
        voffA[i] = (unsigned)(R * g.lda + C) * 2u; voffB[i] = (unsigned)(Rb * g.ldb + C) * 2u; }
    const size_t kstep = (size_t)(BK * 2);
    const size_t hstepA = (size_t)HALF * g.lda * 2, hstepB = (size_t)HALF * g.ldb * 2;
    const size_t tstepA = 2 * hstepA, tstepB = 2 * hstepB;
    const unsigned ldsw = (unsigned)wid * 1024u;
    const int aoff = lds_byte(wr * 64 + fr, fq * 8), boff = lds_byte(wc * 32 + fr, fq * 8);
#define PG8_SA(b, h) (((b) * 2 + (h)) * HTB)
#define PG8_SB(b, h) ((4 + (b) * 2 + (h)) * HTB)
#define PG8_STAGE(bufoff, gbase, voff) do { _Pragma("unroll") for (int _i = 0; _i < 2; ++_i) \
        __builtin_amdgcn_global_load_lds((const unsigned*)((const char*)(gbase) + (voff)[_i]), (LAS unsigned*)(lds + (bufoff) + ldsw + _i * 8192), 16, 0, 0); } while (0)
#define PG8_LDA(dst, b, h) do { _Pragma("unroll") for (int m = 0; m < 4; ++m) _Pragma("unroll") for (int k = 0; k < 2; ++k) dst[m][k] = *(const LAS bf16x8*)(lds + PG8_SA(b, h) + aoff + m * 2048 + k * 1024); } while (0)
#define PG8_LDB(dst, b, h) do { _Pragma("unroll") for (int n = 0; n < 2; ++n) _Pragma("unroll") for (int k = 0; k < 2; ++k) dst[n][k] = *(const LAS bf16x8*)(lds + PG8_SB(b, h) + boff + n * 2048 + k * 1024); } while (0)
#define PG8_MMA(ai, bj, At, Bt) do { __builtin_amdgcn_s_setprio(1); _Pragma("unroll") for (int m = 0; m < 4; ++m) _Pragma("unroll") for (int n = 0; n < 2; ++n) _Pragma("unroll") for (int k = 0; k < 2; ++k) \
        { if constexpr (I8) acc[ai][bj][m][n] = __builtin_bit_cast(f32x4, __builtin_amdgcn_mfma_i32_16x16x64_i8(__builtin_bit_cast(i32x4, Bt[n][k]), __builtin_bit_cast(i32x4, At[m][k]), __builtin_bit_cast(i32x4, acc[ai][bj][m][n]), 0, 0, 0)); \
          else acc[ai][bj][m][n] = __builtin_amdgcn_mfma_f32_16x16x32_bf16(Bt[n][k], At[m][k], acc[ai][bj][m][n], 0, 0, 0); } __builtin_amdgcn_s_setprio(0); } while (0)
#define PG8_MMA1(ai, At, Bt) do { if (!HALFCAP || full) PG8_MMA(ai, 1, At, Bt); } while (0)
#define PG8_WAIT_V(n) asm volatile("s_waitcnt vmcnt(" #n ")" ::: "memory")
#define PG8_WAIT_L(n) asm volatile("s_waitcnt lgkmcnt(" #n ")" ::: "memory")
#define PG8_BAR __builtin_amdgcn_s_barrier()
#define PG8_SCHED __builtin_amdgcn_sched_barrier(0)
#define PG8_KOFF(u) ((u).kq < 0 ? (size_t)0 : (size_t)(u).kq * (size_t)(K / 4) * 2)
#define PG8_APTR(u) ((const char*)g.A + (size_t)(u).pm * tstepA + (g.grouped ? (size_t)((u).pn >> 2) * (size_t)K * 2 : (size_t)0) + PG8_KOFF(u))
#define PG8_BPTR(u) ((const char*)g.Bt + (size_t)(u).pn * tstepB + PG8_KOFF(u))
    Unit cur, nxt; int ui = 0;
    if (!S.next(0, cur)) return;
    f32x4 acc[2][2][4][2];
#pragma unroll
    for (int a = 0; a < 2; ++a)
#pragma unroll
        for (int b = 0; b < 2; ++b)
#pragma unroll
            for (int m = 0; m < 4; ++m)
#pragma unroll
                for (int n = 0; n < 2; ++n) acc[a][b][m][n] = (f32x4){0.f, 0.f, 0.f, 0.f};
    bf16x8 At[4][2], B0[2][2], B1[2][2];
    const char* cA = PG8_APTR(cur); const char* cB = PG8_BPTR(cur);
    PG8_STAGE(PG8_SB(0, 0), cB, voffB); PG8_STAGE(PG8_SB(0, 1), cB + hstepB, voffB); PG8_STAGE(PG8_SA(0, 0), cA, voffA); PG8_STAGE(PG8_SA(0, 1), cA + hstepA, voffA);
    if (wr == 1) PG8_BAR;
    PG8_WAIT_V(2); PG8_BAR;
    PG8_STAGE(PG8_SB(1, 0), cB + kstep, voffB); PG8_STAGE(PG8_SA(1, 0), cA + kstep, voffA); PG8_STAGE(PG8_SB(1, 1), cB + hstepB + kstep, voffB);
    PG8_WAIT_V(6); PG8_BAR;
    for (;;) {
        const bool has_next = S.next(ui + 1, nxt);
        const char* nA = has_next ? PG8_APTR(nxt) : cA; const char* nB = has_next ? PG8_BPTR(nxt) : cB;
        const int nt = cur.kq < 0 ? ntf : ntf / 4; const bool full = !cur.half; (void)full;
        for (int t = 0; t < nt; t += 2) {
            const bool last = (t == nt - 2);
            const char* a1 = cA + (size_t)(t + 1) * kstep;
            const char* a2 = last ? nA : cA + (size_t)(t + 2) * kstep; const char* b2 = last ? nB : cB + (size_t)(t + 2) * kstep;
            const char* a3 = a2 + kstep; const char* b3 = b2 + kstep;
            PG8_LDB(B0, 0, 0); PG8_LDB(B1, 0, 1); PG8_SCHED; PG8_LDA(At, 0, 0); PG8_STAGE(PG8_SA(1, 1), a1 + hstepA, voffA);
            PG8_WAIT_V(8); PG8_WAIT_L(0); PG8_BAR; PG8_MMA(0, 0, At, B0); PG8_MMA1(0, At, B1); PG8_BAR; PG8_SCHED;
            PG8_LDA(At, 0, 1); PG8_STAGE(PG8_SB(0, 0), b2, voffB); PG8_STAGE(PG8_SB(0, 1), b2 + hstepB, voffB); PG8_STAGE(PG8_SA(0, 0), a2, voffA);
            PG8_WAIT_V(8); PG8_WAIT_L(0); PG8_BAR; PG8_MMA(1, 0, At, B0); PG8_MMA1(1, At, B1); PG8_BAR; PG8_SCHED;
            PG8_LDB(B0, 1, 0); PG8_LDB(B1, 1, 1); PG8_SCHED; PG8_LDA(At, 1, 0); PG8_STAGE(PG8_SA(0, 1), a2 + hstepA, voffA);
            PG8_WAIT_V(8); PG8_WAIT_L(0); PG8_BAR; PG8_MMA(0, 0, At, B0); PG8_MMA1(0, At, B1); PG8_BAR; PG8_SCHED;
            PG8_LDA(At, 1, 1); PG8_STAGE(PG8_SB(1, 0), b3, voffB); PG8_STAGE(PG8_SB(1, 1), b3 + hstepB, voffB); PG8_STAGE(PG8_SA(1, 0), a3, voffA);
            PG8_WAIT_V(8); PG8_WAIT_L(0); PG8_BAR; PG8_MMA(1, 0, At, B0); PG8_MMA1(1, At, B1); PG8_BAR; PG8_SCHED;
        }
        if constexpr (ALIGN_EPI) { if (wr == 0) PG8_BAR; }
        E(acc, cur, wr, wc, fr, fq);
        if (!has_next) break;
#pragma unroll
        for (int a = 0; a < 2; ++a)
#pragma unroll
            for (int b = 0; b < 2; ++b)
#pragma unroll
                for (int m = 0; m < 4; ++m)
#pragma unroll
                    for (int n = 0; n < 2; ++n) acc[a][b][m][n] = (f32x4){0.f, 0.f, 0.f, 0.f};
        cur = nxt; cA = nA; cB = nB; ++ui;
        if constexpr (ALIGN_EPI) { if (wr == 1) PG8_BAR; }
    }
    PG8_WAIT_V(0);
    if constexpr (!ALIGN_EPI) { if (wr == 0) PG8_BAR; }
    PG8_BAR;
#undef PG8_SA
#undef PG8_SB
#undef PG8_STAGE
#undef PG8_LDA
#undef PG8_LDB
#undef PG8_MMA
#undef PG8_MMA1
#undef PG8_WAIT_V
#undef PG8_WAIT_L
#undef PG8_BAR
#undef PG8_SCHED
#undef PG8_KOFF
#undef PG8_APTR
#undef PG8_BPTR
}
}

struct Params {
    const float *x_prompt, *x_sample, *cache_k, *cache_v, *cache_kidx, *state_pool, *norm_w, *final_norm_w, *attn_w_in, *attn_w_out, *rel_bias,
                *pool_w_in, *pool_group_w, *pool_scale, *pool_w_out;
    float* out; unsigned char* ws; int ph_lo, ph_hi;
};

__device__ __forceinline__ u32x4 pack8(const f32x4 a, const f32x4 b) { u32x4 w; w.x = cvt_pk_bf16(a[0], a[1]); w.y = cvt_pk_bf16(a[2], a[3]); w.z = cvt_pk_bf16(b[0], b[1]); w.w = cvt_pk_bf16(b[2], b[3]); return w; }
__device__ __forceinline__ f32x4 silu4(f32x4 v) { return (f32x4){silu_f(v[0]), silu_f(v[1]), silu_f(v[2]), silu_f(v[3])}; }

constexpr int UP_SEQ = SEQ + 16, US_SEQ = DSQ + 16, UP_ROWS = NBATCH * UP_SEQ;
__device__ __forceinline__ int u_row(int r) { return r < MP ? (r >> 12) * UP_SEQ + 16 + (r & 4095) : UP_ROWS + ((r - MP) >> 5) * US_SEQ + 16 + ((r - MP) & 31); }
__device__ __forceinline__ size_t kif_off(int s, int d0) { return ((size_t)(((s >> 5) * 4 + (d0 >> 4)) * 64 + ((d0 >> 3) & 1) * 32 + (s & 31))) * 8; }

struct Epi1a {
    static constexpr bool PERM = true;
    unsigned char* ws; float* out;
    __device__ __forceinline__ void operator()(const f32x4 (&acc)[2][2][4][2], const pg8::Unit& u, int wr, int wc, int fr, int fq) const {
        const int pn = u.pn; const float* SA = (const float*)(ws + WS_SA); const float* SB = (const float*)(ws + WS_SB);
#pragma unroll
        for (int bj = 0; bj < 2; ++bj) {
            const int lc = bj * 128 + wc * 32 + 8 * fq, gc = pn * 256 + lc;
            const f32x4 sb0 = *(const f32x4*)(SB + gc), sb1 = *(const f32x4*)(SB + gc + 4);
#pragma unroll
            for (int ai = 0; ai < 2; ++ai)
#pragma unroll
                for (int m = 0; m < 4; ++m) {
                    const int r = u.pm * 256 + ai * 128 + wr * 64 + m * 16 + fr; const float sa = SA[r];
                    const i32x4 i0 = __builtin_bit_cast(i32x4, acc[ai][bj][m][0]), i1 = __builtin_bit_cast(i32x4, acc[ai][bj][m][1]);
                    const f32x4 v0 = (f32x4){(float)i0[0], (float)i0[1], (float)i0[2], (float)i0[3]} * sb0 * sa, v1 = (f32x4){(float)i1[0], (float)i1[1], (float)i1[2], (float)i1[3]} * sb1 * sa;
                    if (pn < 16) *(u32x4*)((bf16_t*)(ws + WS_QB) + (size_t)r * DM + gc) = pack8(v0, v1);
                    else if (pn < 24) {
                        const bool isv = pn >= 20; const int c = (pn & 3) * 256 + lc; const bool samp = r >= MP; const int rs = r - MP;
                        bf16_t* dst; float* fo;
                        if (!samp) { dst = (bf16_t*)(ws + (isv ? WS_VP : WS_KP)) + (size_t)r * KVW + c; fo = out + (isv ? O_VP : O_KP) + (size_t)r * KVW + c; }
                        else { dst = (bf16_t*)(ws + (isv ? WS_VSN : WS_KSN)) + (size_t)rs * KVW + c; fo = out + (isv ? O_VS : O_KS) + (size_t)rs * KVW + c; }
                        *(u32x4*)dst = pack8(v0, v1); *(f32x4*)fo = v0; *(f32x4*)(fo + 4) = v1;
                    }
                    else *(u32x4*)((bf16_t*)(ws + WS_SG) + (size_t)r * DM + (gc - 6144)) = pack8(silu4(v0), silu4(v1));
                }
        }
    }
};
struct Epi1b {
    static constexpr bool PERM = true;
    unsigned char* ws; float* out;
    __device__ __forceinline__ void operator()(const f32x4 (&acc)[2][2][4][2], const pg8::Unit& u, int wr, int wc, int fr, int fq) const {
        const int pn = u.pn;
#pragma unroll
        for (int ai = 0; ai < 2; ++ai)
#pragma unroll
            for (int m = 0; m < 4; ++m) {
                const int r = u.pm * 256 + ai * 128 + wr * 64 + m * 16 + fr;
                const bool samp = r >= MP; const int rs = r - MP, sb = rs >> 5, st = rs & 31;
#pragma unroll
                for (int bj = 0; bj < 2; ++bj) {
                    const int lc = bj * 128 + wc * 32 + 8 * fq;
                    const f32x4 v0 = acc[ai][bj][m][0], v1 = acc[ai][bj][m][1];
                    if (pn < 8) {
                        const int c = pn * 256 + lc, h = c >> 6, d = c & 63;
                        *(u32x4*)((bf16_t*)(ws + WS_QIB) + ((((size_t)(r >> 5) * 32 + h) * 4 + (d >> 4)) * 2 + ((d >> 3) & 1)) * 256 + (r & 31) * 8) = pack8(v0, v1);
                    } else {
                        if (lc < 64) {
                            bf16_t* dst; float* fo;
                            if (!samp) { dst = (bf16_t*)(ws + WS_KIP) + (size_t)(r >> 12) * SEQ * DIDX + kif_off(r & 4095, lc); fo = out + O_KIP + (size_t)r * DIDX + lc; }
                            else { dst = (bf16_t*)(ws + WS_KIS) + (size_t)sb * SKV * DIDX + kif_off(PAST + st, lc); fo = out + O_KIS + (size_t)rs * DIDX + lc; }
                            *(u32x4*)dst = pack8(v0, v1); *(f32x4*)fo = v0; *(f32x4*)(fo + 4) = v1;
                        } else if (lc < 96) {
                            float* fo = (float*)(ws + WS_WIB) + (size_t)r * HIDX + (lc - 64);
                            *(f32x4*)fo = v0; *(f32x4*)(fo + 4) = v1;
                        }
                    }
                }
            }
    }
};
__device__ __forceinline__ f32x4 cvt_i32x4(const f32x4 a) { const i32x4 i = __builtin_bit_cast(i32x4, a); return (f32x4){(float)i[0], (float)i[1], (float)i[2], (float)i[3]}; }
struct EpiX1 {
    static constexpr bool PERM = false;
    const float* xp; float* X1; bf16_t* XB; float* PS; const float* SA; const float* SB;
    __device__ __forceinline__ void operator()(const f32x4 (&acc)[2][2][4][2], const pg8::Unit& u, int wr, int wc, int fr, int fq) const {
        f32x4 sb[2][2];
#pragma unroll
        for (int bj = 0; bj < 2; ++bj)
#pragma unroll
            for (int n = 0; n < 2; ++n) sb[bj][n] = *(const f32x4*)(SB + u.pn * 256 + bj * 128 + wc * 32 + n * 16 + 4 * fq);
#pragma unroll
        for (int ai = 0; ai < 2; ++ai)
#pragma unroll
            for (int m = 0; m < 4; ++m) {
                const int r = u.pm * 256 + ai * 128 + wr * 64 + m * 16 + fr; const float sa = SA[r];
                if (u.kq >= 0) {
                    float* d = PS + ((size_t)u.kq * MS + (r - MP)) * DM;
#pragma unroll
                    for (int bj = 0; bj < 2; ++bj)
#pragma unroll
                        for (int n = 0; n < 2; ++n) *(f32x4*)(d + u.pn * 256 + bj * 128 + wc * 32 + n * 16 + 4 * fq) = cvt_i32x4(acc[ai][bj][m][n]) * sb[bj][n] * sa;
                } else {
                    const float* b = xp + (size_t)r * DM; bf16_t* db = XB + (size_t)r * DM;
#pragma unroll
                    for (int bj = 0; bj < 2; ++bj)
#pragma unroll
                        for (int n = 0; n < 2; ++n) { const int c = u.pn * 256 + bj * 128 + wc * 32 + n * 16 + 4 * fq;
                            const f32x4 v = *(const f32x4*)(b + c) + cvt_i32x4(acc[ai][bj][m][n]) * sb[bj][n] * sa;
                            u32x2 w; w.x = cvt_pk_bf16(v[0], v[1]); w.y = cvt_pk_bf16(v[2], v[3]); *(u32x2*)(db + c) = w; }
                }
            }
    }
};
struct EpiX2 {
    static constexpr bool PERM = false;
    bf16_t* XB; float* PS; const float* SA; const float* SB;
    __device__ __forceinline__ void operator()(const f32x4 (&acc)[2][2][4][2], const pg8::Unit& u, int wr, int wc, int fr, int fq) const {
        f32x4 sb[2][2];
#pragma unroll
        for (int bj = 0; bj < 2; ++bj)
#pragma unroll
            for (int n = 0; n < 2; ++n) sb[bj][n] = *(const f32x4*)(SB + u.pn * 256 + bj * 128 + wc * 32 + n * 16 + 4 * fq);
#pragma unroll
        for (int ai = 0; ai < 2; ++ai)
#pragma unroll
            for (int m = 0; m < 4; ++m) {
                const int r = u.pm * 256 + ai * 128 + wr * 64 + m * 16 + fr; const float sa = SA[r];
                float* d = PS + ((size_t)(u.kq >= 0 ? u.kq : 0) * MS + (r - MP)) * DM; bf16_t* db = XB + (size_t)r * DM;
#pragma unroll
                for (int bj = 0; bj < 2; ++bj)
#pragma unroll
                    for (int n = 0; n < 2; ++n) { const int c = u.pn * 256 + bj * 128 + wc * 32 + n * 16 + 4 * fq; const f32x4 v = cvt_i32x4(acc[ai][bj][m][n]) * sb[bj][n] * sa;
                        if (u.kq >= 0) *(f32x4*)(d + c) = v;
                        else { const u32x2 x = *(const u32x2*)(db + c); u32x2 w; w.x = cvt_pk_bf16(bf_lo(x.x) + v[0], bf_hi(x.x) + v[1]); w.y = cvt_pk_bf16(bf_lo(x.y) + v[2], bf_hi(x.y) + v[3]); *(u32x2*)(db + c) = w; } }
            }
    }
};
struct Epi3 {
    static constexpr bool PERM = true;
    unsigned char* ws; float* out;
    __device__ __forceinline__ void operator()(const f32x4 (&acc)[2][2][4][2], const pg8::Unit& u, int wr, int wc, int fr, int fq) const {
        const int pn = u.pn; const float* ROWF = (const float*)(ws + WS_ROWF); const float* SB2 = (const float*)(ws + WS_SB2);
#pragma unroll
        for (int ai = 0; ai < 2; ++ai)
#pragma unroll
            for (int m = 0; m < 4; ++m) {
                const int r = u.pm * 256 + ai * 128 + wr * 64 + m * 16 + fr;
                const float rowf = ROWF[r];
                float* po = nullptr;
                if (r < MP) { const int t = r & 4095; if (t >= SEQ - 15) po = out + O_POOLP + ((size_t)(r >> 12) * 15 + (t - (SEQ - 15))) * DM; }
                else { const int rs = r - MP, t = rs & 31; if (t >= DSQ - 15) po = out + O_POOLS + ((size_t)(rs >> 5) * 15 + (t - (DSQ - 15))) * DM; }
#pragma unroll
                for (int bj = 0; bj < 2; ++bj) {
                    const int lc = bj * 128 + wc * 32 + 8 * fq;
                    const f32x4 s0 = *(const f32x4*)(SB2 + pn * 256 + lc), s1 = *(const f32x4*)(SB2 + pn * 256 + lc + 4);
                    const i32x4 i0 = __builtin_bit_cast(i32x4, acc[ai][bj][m][0]), i1 = __builtin_bit_cast(i32x4, acc[ai][bj][m][1]);
                    const f32x4 v0 = (f32x4){(float)i0[0], (float)i0[1], (float)i0[2], (float)i0[3]} * s0 * rowf, v1 = (f32x4){(float)i1[0], (float)i1[1], (float)i1[2], (float)i1[3]} * s1 * rowf;
                    if (pn < 16) {
                        const int c = pn * 256 + lc;
                        *(u32x4*)((bf16_t*)(ws + WS_U) + (size_t)u_row(r) * DM + c) = pack8(v0, v1);
                        if (po) { *(f32x4*)(po + c) = v0; *(f32x4*)(po + c + 4) = v1; }
                    } else {
                        *(u32x4*)((bf16_t*)(ws + WS_SG2) + (size_t)r * DM + (pn - 16) * 256 + lc) = pack8(silu4(v0), silu4(v1));
                    }
                }
            }
    }
};
struct Epi4 {
    static constexpr bool PERM = true;
    unsigned char* ws; const float* scale;
    __device__ __forceinline__ void operator()(const f32x4 (&acc)[2][2][4][2], const pg8::Unit& u, int wr, int wc, int fr, int fq) const {
#pragma unroll
        for (int bj = 0; bj < 2; ++bj) {
            const int c = u.pn * 256 + bj * 128 + wc * 32 + 8 * fq;
            const f32x4 s0 = *(const f32x4*)(scale + c), s1 = *(const f32x4*)(scale + c + 4);
#pragma unroll
            for (int ai = 0; ai < 2; ++ai)
#pragma unroll
                for (int m = 0; m < 4; ++m) {
                    const int r = u.pm * 256 + ai * 128 + wr * 64 + m * 16 + fr;
                    const u32x4 gw = *(const u32x4*)((const bf16_t*)(ws + WS_SG2) + (size_t)r * DM + c);
                    const f32x4 g0 = (f32x4){bf_lo(gw.x), bf_hi(gw.x), bf_lo(gw.y), bf_hi(gw.y)}, g1 = (f32x4){bf_lo(gw.z), bf_hi(gw.z), bf_lo(gw.w), bf_hi(gw.w)};
                    *(u32x4*)((bf16_t*)(ws + WS_ZG) + (size_t)r * DM + c) = pack8(acc[ai][bj][m][0] * s0 * g0, acc[ai][bj][m][1] * s1 * g1);
                }
        }
    }
};

__device__ __forceinline__ void transpose_item(const float* W, int N, int k0, int n0, bf16_t* WT, int K, int drow0, int nvalid, LAS float* scr, int lane) {
    const int cq = lane & 15, rq = lane >> 4;
    const float* src = W + (size_t)(k0 + 4 * rq) * N + n0 + 4 * cq;
    f32x4 a[16];
#pragma unroll
    for (int g = 0; g < 4; ++g)
#pragma unroll
        for (int i = 0; i < 4; ++i) a[g * 4 + i] = *(const f32x4*)(src + (size_t)(16 * g + i) * N);
    LAS unsigned char* T = (LAS unsigned char*)scr;
#pragma unroll
    for (int g = 0; g < 4; ++g)
#pragma unroll
        for (int c = 0; c < 4; ++c) { u32x2 o; o.x = cvt_pk_bf16(a[g * 4 + 0][c], a[g * 4 + 1][c]); o.y = cvt_pk_bf16(a[g * 4 + 2][c], a[g * 4 + 3][c]);
            *(LAS u32x2*)(T + (4 * cq + c) * 136 + 32 * g + 8 * rq) = o; }
    LDS_WAIT(); asm volatile("" ::: "memory");
    const int kc = lane & 7;
#pragma unroll
    for (int sI = 0; sI < 8; ++sI) { const int n = 8 * sI + (lane >> 3);
        const u32x2 lo = *(const LAS u32x2*)(T + n * 136 + 16 * kc), hi = *(const LAS u32x2*)(T + n * 136 + 16 * kc + 8);
        if (n < nvalid) *(u32x4*)(WT + (size_t)(drow0 + n) * K + k0 + 8 * kc) = (u32x4){lo.x, lo.y, hi.x, hi.y}; }
    LDS_WAIT(); asm volatile("" ::: "memory");
}
__device__ __forceinline__ unsigned q8(float v) { return (unsigned)(int)__builtin_rintf(v) & 0xffu; }
__device__ __forceinline__ unsigned q8x4(float a, float b, float c, float d) { return q8(a) | (q8(b) << 8) | (q8(c) << 16) | (q8(d) << 24); }
__device__ __forceinline__ void transpose_item_i8(const float* W, int N, int k0, int n0, signed char* WT, int K, int drow0, LAS float* scr, int lane, const unsigned* camax, float* sbout, const float* kscale = nullptr) {
    const int cq = lane & 15, rq = lane >> 4;
    const float* src = W + (size_t)(k0 + 4 * rq) * N + n0 + 4 * cq;
    f32x4 ks[8];
    if (kscale) {
#pragma unroll
        for (int g = 0; g < 8; ++g) ks[g] = *(const f32x4*)(kscale + k0 + 16 * g + 4 * rq); }
    const u32x4 cm = *(const u32x4*)(camax + drow0 + 4 * cq);
    f32x4 a[32];
#pragma unroll
    for (int g = 0; g < 8; ++g)
#pragma unroll
        for (int i = 0; i < 4; ++i) a[g * 4 + i] = *(const f32x4*)(src + (size_t)(16 * g + i) * N);
    f32x4 inv;
#pragma unroll
    for (int c = 0; c < 4; ++c) { const float am = __uint_as_float(cm[c]); inv[c] = am > 0.f ? 127.0f / am : 0.f; }
    LAS unsigned char* T = (LAS unsigned char*)scr;
#pragma unroll
    for (int g = 0; g < 8; ++g) {
        f32x4 r0 = a[g * 4 + 0] * inv, r1 = a[g * 4 + 1] * inv, r2 = a[g * 4 + 2] * inv, r3 = a[g * 4 + 3] * inv;
        if (kscale) { r0 = r0 * ks[g][0]; r1 = r1 * ks[g][1]; r2 = r2 * ks[g][2]; r3 = r3 * ks[g][3]; }
#pragma unroll
        for (int c = 0; c < 4; ++c) *(LAS unsigned*)(T + (4 * cq + c) * 132 + 16 * g + 4 * rq) = q8x4(r0[c], r1[c], r2[c], r3[c]);
    }
    LDS_WAIT(); asm volatile("" ::: "memory");
    const int kc = lane & 7;
#pragma unroll
    for (int sI = 0; sI < 8; ++sI) { const int n = 8 * sI + (lane >> 3); const LAS unsigned* tp = (const LAS unsigned*)(T + n * 132 + 16 * kc);
        *(u32x4*)(WT + (size_t)(drow0 + n) * K + k0 + 16 * kc) = (u32x4){tp[0], tp[1], tp[2], tp[3]}; }
    if (k0 == 0) sbout[drow0 + lane] = __uint_as_float(camax[drow0 + lane]) * (1.0f / 127.0f);
    LDS_WAIT(); asm volatile("" ::: "memory");
}
template <bool KS>
__device__ __forceinline__ f32x4 col_amax64(const float* wp, size_t stride, const float* nw) {
    f32x4 m = (f32x4){0.f, 0.f, 0.f, 0.f}; f32x4 a[8], b[8];
#define CA_LD(dst) do { _Pragma("unroll") for (int i = 0; i < 8; ++i) dst[i] = *(const f32x4*)(wp + (size_t)i * stride); wp += 8 * stride; asm volatile("" ::: "memory"); } while (0)
#define CA_USE(src) do { _Pragma("unroll") for (int i = 0; i < 8; ++i) { f32x4 x = src[i]; if (KS) x = x * nw[i]; \
        m.x = fmaxf(m.x, fabsf(x.x)); m.y = fmaxf(m.y, fabsf(x.y)); m.z = fmaxf(m.z, fabsf(x.z)); m.w = fmaxf(m.w, fabsf(x.w)); } if (KS) nw += 8; } while (0)
    CA_LD(a);
#pragma unroll 1
    for (int kb = 0; kb < 4; ++kb) {
        CA_LD(b);
        CA_USE(a);
        if (kb < 3) CA_LD(a);
        CA_USE(b);
    }
#undef CA_LD
#undef CA_USE
    return m;
}
__device__ __forceinline__ void rms_row_q(f32x4 (&v)[16], const LAS f32x4* w, bf16_t* orow, signed char* qrow, float* sa, int lane) {
    const LAS f32x4* wr = w + lane;
    float s = 0.f;
#pragma unroll
    for (int j = 0; j < 16; ++j) s += (v[j].x * v[j].x + v[j].y * v[j].y) + (v[j].z * v[j].z + v[j].w * v[j].w);
    const float rstd = 1.0f / sqrtf(wave_sum(s) * (1.0f / DM) + EPS);
    float am = 0.f;
#pragma unroll
    for (int j = 0; j < 16; ++j) { v[j] = v[j] * rstd * wr[64 * j]; am = fmaxf(am, fmaxf(fmaxf(fabsf(v[j].x), fabsf(v[j].y)), fmaxf(fabsf(v[j].z), fabsf(v[j].w))));
        u32x2 o; o.x = cvt_pk_bf16(v[j].x, v[j].y); o.y = cvt_pk_bf16(v[j].z, v[j].w); ((u32x2*)orow + lane)[64 * j] = o;
        if ((j & 3) == 3) asm volatile("" ::: "memory"); }
#pragma unroll
    for (int o = 1; o < 64; o <<= 1) am = fmaxf(am, __shfl_xor(am, o));
    const float inv = am > 0.f ? 127.0f / am : 0.f;
#pragma unroll
    for (int j = 0; j < 16; ++j) ((unsigned*)qrow + lane)[64 * j] = q8x4(v[j].x * inv, v[j].y * inv, v[j].z * inv, v[j].w * inv);
    if (lane == 0) *sa = am * (1.0f / 127.0f);
}
template <class F>
__device__ __forceinline__ void quant_rows_bf16(const bf16_t* src, signed char* dst, int M, int gw, int NGW, int lane, F fin) {
    u32x4 x[8], xn[8];
    if (gw < M) {
#pragma unroll
        for (int j = 0; j < 8; ++j) x[j] = ((const u32x4*)(src + (size_t)gw * DM) + lane)[64 * j]; }
#pragma unroll 1
    for (int m = gw; m < M; m += NGW) {
        if (m + NGW < M) {
#pragma unroll
            for (int j = 0; j < 8; ++j) xn[j] = ((const u32x4*)(src + (size_t)(m + NGW) * DM) + lane)[64 * j]; }
        float am = 0.f, ss = 0.f;
#pragma unroll
        for (int j = 0; j < 8; ++j) {
            const float f[8] = {bf_lo(x[j].x), bf_hi(x[j].x), bf_lo(x[j].y), bf_hi(x[j].y), bf_lo(x[j].z), bf_hi(x[j].z), bf_lo(x[j].w), bf_hi(x[j].w)};
#pragma unroll
            for (int e = 0; e < 8; ++e) { am = fmaxf(am, fabsf(f[e])); ss = fmaf(f[e], f[e], ss); } }
#pragma unroll
        for (int o = 1; o < 64; o <<= 1) am = fmaxf(am, __shfl_xor(am, o));
        ss = wave_sum(ss);
        const float inv = am > 0.f ? 127.0f / am : 0.f;
        u32x2* q = (u32x2*)(dst + (size_t)m * DM) + lane;
#pragma unroll
        for (int j = 0; j < 8; ++j) { u32x2 o; o.x = q8x4(bf_lo(x[j].x) * inv, bf_hi(x[j].x) * inv, bf_lo(x[j].y) * inv, bf_hi(x[j].y) * inv);
            o.y = q8x4(bf_lo(x[j].z) * inv, bf_hi(x[j].z) * inv, bf_lo(x[j].w) * inv, bf_hi(x[j].w) * inv); q[64 * j] = o; }
        fin(m, am, ss);
#pragma unroll
        for (int j = 0; j < 8; ++j) x[j] = xn[j];
    }
}
template <bool F32OUT>
__device__ __forceinline__ void rms_row(const float* xrow, const float* w, void* orow, int lane) {
    const f32x4* xr = (const f32x4*)xrow + lane; const f32x4* wr = (const f32x4*)w + lane;
    f32x4 v[16]; float s = 0.f;
#pragma unroll
    for (int j = 0; j < 16; ++j) { v[j] = xr[64 * j]; s += (v[j].x * v[j].x + v[j].y * v[j].y) + (v[j].z * v[j].z + v[j].w * v[j].w); }
    const float rstd = 1.0f / sqrtf(wave_sum(s) * (1.0f / DM) + EPS);
#pragma unroll
    for (int j = 0; j < 16; ++j) { const f32x4 g = wr[64 * j]; const f32x4 y = v[j] * rstd * g;
        if (F32OUT) ((f32x4*)orow + lane)[64 * j] = y;
        else { u32x2 o; o.x = cvt_pk_bf16(y.x, y.y); o.y = cvt_pk_bf16(y.z, y.w); ((u32x2*)orow + lane)[64 * j] = o; } }
}

__device__ __forceinline__ unsigned ord_key(float f) { const unsigned b = __float_as_uint(f); return (b & 0x80000000u) ? ~b : (b | 0x80000000u); }
constexpr int NVJ = 65;
constexpr int SC_WT_OFF = RING_BYTES + 1024;
constexpr int SC_QB_OFF = SC_WT_OFF + 4096;
__device__ __forceinline__ void score_tiles(const bf16_t* __restrict__ qif, const float* __restrict__ wi, const bf16_t* __restrict__ kif, float* __restrict__ sc,
                                            int kt0, int step, int count, LAS unsigned char* lds) {
    int tid = threadIdx.x; asm volatile("" : "+v"(tid));
    const int wid = __builtin_amdgcn_readfirstlane(tid >> 6), lane = tid & 63, r32 = lane & 31, hi = lane >> 5;
    constexpr float WSC = 0.5f * 0.125f * 0.17677669529663687f;
    __syncthreads();
    {   const u32x4* src = (const u32x4*)qif; LAS u32x4* dst = (LAS u32x4*)lds;
        u32x4 t[16];
#pragma unroll
        for (int i = 0; i < 16; ++i) t[i] = src[tid + 512 * i];
#pragma unroll
        for (int i = 0; i < 16; ++i) dst[tid + 512 * i] = t[i];
        LAS float* wt = (LAS float*)(lds + SC_WT_OFF);
#pragma unroll
        for (int e = tid; e < 1024; e += NTHREADS) { const int h = e >> 5, hh = (e >> 4) & 1, r = e & 15, q = (r & 3) + 8 * (r >> 2) + 4 * hh;
            wt[e] = wi[q * HIDX + h] * WSC; }
    }
    __syncthreads();
    if (tid < 256) {
        const int q = tid >> 3, ch = tid & 7; float acc[8] = {0.f, 0.f, 0.f, 0.f, 0.f, 0.f, 0.f, 0.f};
        const LAS u32x4* Af = (const LAS u32x4*)lds + ch * 32 + q;
        const LAS float* wtq = (const LAS float*)(lds + SC_WT_OFF) + ((q >> 2) & 1) * 16 + (q & 3) + 4 * (q >> 3);
#pragma unroll 4
        for (int h = 0; h < 32; ++h) { const float w = wtq[h * 32]; const u32x4 x = Af[h * 256];
            acc[0] = fmaf(w, bf_lo(x.x), acc[0]); acc[1] = fmaf(w, bf_hi(x.x), acc[1]); acc[2] = fmaf(w, bf_lo(x.y), acc[2]); acc[3] = fmaf(w, bf_hi(x.y), acc[3]);
            acc[4] = fmaf(w, bf_lo(x.z), acc[4]); acc[5] = fmaf(w, bf_hi(x.z), acc[5]); acc[6] = fmaf(w, bf_lo(x.w), acc[6]); acc[7] = fmaf(w, bf_hi(x.w), acc[7]); }
        u32x4 vh, vl;
        vh.x = cvt_pk_bf16(acc[0], acc[1]); vh.y = cvt_pk_bf16(acc[2], acc[3]); vh.z = cvt_pk_bf16(acc[4], acc[5]); vh.w = cvt_pk_bf16(acc[6], acc[7]);
        vl.x = cvt_pk_bf16(acc[0] - bf_lo(vh.x), acc[1] - bf_hi(vh.x)); vl.y = cvt_pk_bf16(acc[2] - bf_lo(vh.y), acc[3] - bf_hi(vh.y));
        vl.z = cvt_pk_bf16(acc[4] - bf_lo(vh.z), acc[5] - bf_hi(vh.z)); vl.w = cvt_pk_bf16(acc[6] - bf_lo(vh.w), acc[7] - bf_hi(vh.w));
        LAS u32x4* qb = (LAS u32x4*)(lds + SC_QB_OFF);
        qb[ch * 32 + q] = vh; qb[256 + ch * 32 + q] = vl;
    }
    __syncthreads();
    const LAS bf16x8* A = (const LAS bf16x8*)lds + lane;
    const LAS bf16x8* QBF = (const LAS bf16x8*)(lds + SC_QB_OFF) + lane;
    const LAS f32x4* W4 = (const LAS f32x4*)(lds + SC_WT_OFF) + hi * 4;
#define FMA8(NOP, S, W, C, B, X) asm volatile(NOP "v_fma_f32 %0, %8, |%16|, %0\n\tv_fma_f32 %1, %9, |%17|, %1\n\tv_fma_f32 %2, %10, |%18|, %2\n\tv_fma_f32 %3, %11, |%19|, %3\n\t" \
        "v_fma_f32 %4, %12, |%20|, %4\n\tv_fma_f32 %5, %13, |%21|, %5\n\tv_fma_f32 %6, %14, |%22|, %6\n\tv_fma_f32 %7, %15, |%23|, %7" \
        : "+v"(S[B + 0]), "+v"(S[B + 1]), "+v"(S[B + 2]), "+v"(S[B + 3]), "+v"(S[B + 4]), "+v"(S[B + 5]), "+v"(S[B + 6]), "+v"(S[B + 7]) \
        : "v"(W[B + 0]), "v"(W[B + 1]), "v"(W[B + 2]), "v"(W[B + 3]), "v"(W[B + 4]), "v"(W[B + 5]), "v"(W[B + 6]), "v"(W[B + 7]), \
          "v"(C[B + 0]), "v"(C[B + 1]), "v"(C[B + 2]), "v"(C[B + 3]), "v"(C[B + 4]), "v"(C[B + 5]), "v"(C[B + 6]), "v"(C[B + 7]), "v"(X))
#define SC_LDA(dst, h) do { _Pragma("unroll") for (int ks = 0; ks < 4; ++ks) dst[ks] = A[((h) * 4 + ks) * 64]; } while (0)
#define SC_STEP(a, h) do { const f32x4 w0 = W4[(h) * 8 + 0], w1 = W4[(h) * 8 + 1], w2 = W4[(h) * 8 + 2], w3 = W4[(h) * 8 + 3]; \
        const float w[16] = {w0.x, w0.y, w0.z, w0.w, w1.x, w1.y, w1.z, w1.w, w2.x, w2.y, w2.z, w2.w, w3.x, w3.y, w3.z, w3.w}; \
        f32x16 c0 = {}, c1 = {}; \
        _Pragma("unroll") for (int ks = 0; ks < 4; ++ks) { c0 = __builtin_amdgcn_mfma_f32_32x32x16_bf16(a[ks], b0[ks], c0, 0, 0, 0); c1 = __builtin_amdgcn_mfma_f32_32x32x16_bf16(a[ks], b1[ks], c1, 0, 0, 0); } \
        FMA8("s_nop 11\n\t", s0, w, c0, 0, c1[15]); FMA8("", s0, w, c0, 8, c1[15]); FMA8("", s1, w, c1, 0, c1[15]); FMA8("", s1, w, c1, 8, c1[15]); } while (0)
    for (int idx = wid; idx < count; idx += NWAVES) {
        const int kt = kt0 + step * idx;
        const bf16x8* kb = (const bf16x8*)kif + (size_t)kt * 512 + lane;
        bf16x8 b0[4], b1[4];
#pragma unroll
        for (int ks = 0; ks < 4; ++ks) { b0[ks] = kb[ks * 64]; b1[ks] = kb[(4 + ks) * 64]; }
        f32x16 s0 = {}, s1 = {};
#pragma unroll
        for (int ks = 0; ks < 4; ++ks) { const bf16x8 qh = QBF[ks * 64], ql = QBF[256 + ks * 64];
            s0 = __builtin_amdgcn_mfma_f32_32x32x16_bf16(qh, b0[ks], s0, 0, 0, 0); s1 = __builtin_amdgcn_mfma_f32_32x32x16_bf16(qh, b1[ks], s1, 0, 0, 0);
            s0 = __builtin_amdgcn_mfma_f32_32x32x16_bf16(ql, b0[ks], s0, 0, 0, 0); s1 = __builtin_amdgcn_mfma_f32_32x32x16_bf16(ql, b1[ks], s1, 0, 0, 0); }
        bf16x8 aA[4], aB[4];
        SC_LDA(aA, 0);
#pragma unroll 1
        for (int h = 0; h < 32; h += 2) {
            SC_LDA(aB, h + 1);
            { bf16x8 (&a)[4] = aA; SC_STEP(a, h); }
            if (h + 2 < 32) SC_LDA(aA, h + 2);
            { bf16x8 (&a)[4] = aB; SC_STEP(a, h + 1); }
        }
        float* o = sc + (size_t)kt * 64 + r32;
#pragma unroll
        for (int r = 0; r < 16; ++r) { const int q = (r & 3) + 8 * (r >> 2) + 4 * hi; o[(size_t)q * SCW] = s0[r]; o[(size_t)q * SCW + 32] = s1[r]; }
    }
#undef SC_LDA
#undef SC_STEP
#undef FMA8
}
__device__ __forceinline__ void sel_load(const float* __restrict__ sc, int nt, float (&vv)[NVJ], int lane) {
    if (nt <= 4) return;
    const int ng = (nt + 3) >> 2;
#pragma unroll
    for (int g = 0; g < 16; ++g) if (g < ng) {
#pragma unroll
        for (int i = 0; i < 4; ++i) vv[4 * g + i] = sc[(4 * g + i) * 64 + lane]; }
    if (ng > 16) vv[64] = sc[64 * 64 + lane];
}
__device__ __forceinline__ void select_row(float (&vv)[NVJ], int nt, int nvalid, u64* __restrict__ rm, const float* __restrict__ sc_next, int nt_next, int lane) {
    if (nt <= 4) { if (lane < nt) rm[lane] = ~0ull; sel_load(sc_next, nt_next, vv, lane); return; }
    unsigned uk[NVJ];
    { const int ng = (nt + 3) >> 2;
#pragma unroll
      for (int j = 0; j < NVJ; ++j) uk[j] = ((j >> 2) < ng && j * 64 + lane < nvalid) ? ord_key(vv[j]) : 0u; }
    sel_load(sc_next, nt_next, vv, lane);
#define CNTV(cnt, thr, x) asm volatile("v_cmp_le_u32 vcc, %1, %2\n\tv_addc_co_u32 %0, vcc, 0, %0, vcc" : "+v"(cnt) : "v"(thr), "v"(x) : "vcc")
    const int ng = (nt + 3) >> 2;
    unsigned T = 0u; int cT = 0;
    for (int bit = 31; bit >= 0; --bit) {
        const unsigned cand = T | (1u << bit); int cl = 0;
#pragma unroll
        for (int g = 0; g < 16; ++g) if (g < ng) { CNTV(cl, cand, uk[4 * g]); CNTV(cl, cand, uk[4 * g + 1]); CNTV(cl, cand, uk[4 * g + 2]); CNTV(cl, cand, uk[4 * g + 3]); }
        if (ng > 16) CNTV(cl, cand, uk[64]);
        cl += __builtin_amdgcn_update_dpp(0, cl, 0xB1, 0xf, 0xf, false);
        cl += __builtin_amdgcn_update_dpp(0, cl, 0x4E, 0xf, 0xf, false);
        cl += __builtin_amdgcn_update_dpp(0, cl, 0x141, 0xf, 0xf, false);
        cl += __builtin_amdgcn_update_dpp(0, cl, 0x140, 0xf, 0xf, false);
        const int cnt = (__builtin_amdgcn_readlane(cl, 0) + __builtin_amdgcn_readlane(cl, 16)) + (__builtin_amdgcn_readlane(cl, 32) + __builtin_amdgcn_readlane(cl, 48));
        if (cnt >= 256) { T = cand; cT = cnt; if (cnt == 256) break; }
    }
#undef CNTV
    if (cT == 256) {
        unsigned wlo = 0u, whi = 0u;
#pragma unroll
        for (int j = 0; j < 64; ++j)
            asm volatile("v_cmp_le_u32 vcc, %2, %3\n\ts_nop 4\n\tv_writelane_b32 %0, vcc_lo, %4\n\tv_writelane_b32 %1, vcc_hi, %4" : "+v"(wlo), "+v"(whi) : "s"(T), "v"(uk[j]), "i"(j) : "vcc");
        u64 mk64; asm volatile("v_cmp_le_u32 %0, %1, %2" : "=s"(mk64) : "s"(T), "v"(uk[64]));
        rm[lane] = ((u64)whi << 32) | wlo;
        if (lane == 0) rm[64] = mk64;
    } else {
        int cgt = 0;
#pragma unroll
        for (int j = 0; j < NVJ; ++j) { u64 t0_; asm volatile("v_cmp_lt_u32 %0, %1, %2" : "=&s"(t0_) : "s"(T), "v"(uk[j])); cgt += __builtin_popcountll(t0_); }
        int need = 256 - cgt;
#pragma unroll
        for (int j = 0; j < NVJ; ++j) {
            u64 gt, eq; asm volatile("v_cmp_lt_u32 %0, %1, %2" : "=s"(gt) : "s"(T), "v"(uk[j])); asm volatile("v_cmp_eq_u32 %0, %1, %2" : "=s"(eq) : "s"(T), "v"(uk[j]));
            const int below = __builtin_popcountll(eq & ((1ull << lane) - 1ull));
            const u64 take = __ballot(((eq >> lane) & 1ull) && below < need);
            need -= __builtin_popcountll(take);
            if (lane == 0) rm[j] = gt | take;
        }
    }
}

namespace att {
constexpr int D = 128, KVBLK = 64;
constexpr float SCALE = 0.088388347648318440f;
constexpr float THR = 8.f;
constexpr float NEG = -1e30f, MINIT = -1e20f;
constexpr size_t SHM_V = KVBLK * D * 2, SHM_K = KVBLK * D * 2;
constexpr size_t OFF_WS = 2 * SHM_V + 2 * SHM_K, OFF_TB = OFF_WS + 8 * 64 * 4, OFF_MK = OFF_TB + 4 * 256 * 4, LDS_ATTN = OFF_MK + 64 * 65 * 8;
static_assert(LDS_ATTN <= 131072, "attention LDS");
#define KSWZ(row, colB) ((row) * 256 + ((colB) ^ (((row) & 7) << 4)))
#define SBAR() __builtin_amdgcn_sched_barrier(0)
__device__ __forceinline__ int crow(int r, int hi) { return (r & 3) + 8 * (r >> 2) + 4 * hi; }
__device__ __forceinline__ void partialSM(f32x16& p0, f32x16& p1, float& m_reg, float& mn, float& alpha) {
    constexpr float C = SCALE * 1.4426950408889634f;
    float pmax = p0[0];
#pragma unroll
    for (int r = 1; r < 16; ++r) pmax = fmaxf(pmax, p0[r]);
#pragma unroll
    for (int r = 0; r < 16; ++r) pmax = fmaxf(pmax, p1[r]);
    { auto rr = __builtin_amdgcn_permlane32_swap(__float_as_uint(pmax), __float_as_uint(pmax), false, false);
      pmax = fmaxf(__uint_as_float(rr[0]), __uint_as_float(rr[1])); }
    if (__builtin_expect(__all(pmax - m_reg <= THR / SCALE), 1)) { mn = m_reg; alpha = 1.f; }
    else { mn = fmaxf(m_reg, pmax); alpha = __builtin_amdgcn_exp2f((m_reg - mn) * C); m_reg = mn; }
    const float mnC = -mn * C;
#pragma unroll
    for (int r = 0; r < 16; ++r) p0[r] = fmaf(p0[r], C, mnC);
#pragma unroll
    for (int r = 0; r < 16; ++r) p1[r] = fmaf(p1[r], C, mnC);
#pragma unroll
    for (int r = 0; r < 16; ++r) p0[r] = __builtin_amdgcn_exp2f(p0[r]);
}
__device__ __forceinline__ void finishSM(f32x16& p0, f32x16& p1, float alpha, float& l_reg, bf16x8& pa0, bf16x8& pa1, bf16x8& pa2, bf16x8& pa3) {
#pragma unroll
    for (int r = 0; r < 16; ++r) p1[r] = __builtin_amdgcn_exp2f(p1[r]);
    float ps = 0;
#pragma unroll
    for (int r = 0; r < 16; ++r) ps += p0[r];
#pragma unroll
    for (int r = 0; r < 16; ++r) ps += p1[r];
    { auto rr = __builtin_amdgcn_permlane32_swap(__float_as_uint(ps), __float_as_uint(ps), false, false);
      ps = __uint_as_float(rr[0]) + __uint_as_float(rr[1]); }
    l_reg = l_reg * alpha + ps;
#define PK4(P, BASE, OUT) do { unsigned a0 = cvt_pk_bf16(P[BASE + 0], P[BASE + 1]), a1 = cvt_pk_bf16(P[BASE + 2], P[BASE + 3]);   \
    unsigned b0 = cvt_pk_bf16(P[BASE + 4], P[BASE + 5]), b1 = cvt_pk_bf16(P[BASE + 6], P[BASE + 7]);                              \
    auto r0 = __builtin_amdgcn_permlane32_swap(a0, b0, false, false); auto r1 = __builtin_amdgcn_permlane32_swap(a1, b1, false, false); \
    u32x4 w = {r0[0], r1[0], r0[1], r1[1]}; OUT = *reinterpret_cast<bf16x8*>(&w); } while (0)
    PK4(p0, 0, pa0); PK4(p0, 8, pa1); PK4(p1, 0, pa2); PK4(p1, 8, pa3);
#undef PK4
}
__device__ __forceinline__ void qkt(f32x16& p0, f32x16& p1, const LAS char* Ks, const bf16x8* qr, int r32, int hi) {
    p0 = f32x16{}; p1 = f32x16{};
#pragma unroll
    for (int d0 = 0; d0 < 8; ++d0) { const int cb = (d0 * 16 + hi * 8) * 2;
        const bf16x8 b0 = *(const LAS bf16x8*)(Ks + KSWZ(r32, cb));
        const bf16x8 b1 = *(const LAS bf16x8*)(Ks + KSWZ(32 + r32, cb));
        p0 = __builtin_amdgcn_mfma_f32_32x32x16_bf16(b0, qr[d0], p0, 0, 0, 0);
        p1 = __builtin_amdgcn_mfma_f32_32x32x16_bf16(b1, qr[d0], p1, 0, 0, 0); }
}
__device__ __forceinline__ int v_st(int k, int c) { const int kk = (k & ~0xC) | ((k & 4) << 1) | ((k & 8) >> 1); return ((kk >> 3) * 4 + (c >> 5)) * 512 + ((kk & 7) * 32 + (c & 31)) * 2; }
__device__ __forceinline__ int v_rd_base(int lane) { return ((lane & 3) << 3) | (((lane >> 2) & 3) << 6) | (((lane >> 4) & 1) << 5) | (((lane >> 5) & 1) << 8); }
constexpr int v_rd_off(int d0, int ks, int half) { return d0 * 512 + ks * 4096 + half * 2048; }
template <int OFF> __device__ __forceinline__ s16x4 tr_read(int vb) {
    s16x4 r; asm volatile("ds_read_b64_tr_b16 %0, %1 offset:%2" : "=&v"(r) : "v"(vb), "i"(OFF) : "memory"); return r;
}
template <int D0> __device__ __forceinline__ void pv_one(f32x16& od, int vb, bf16x8 pa0, bf16x8 pa1, bf16x8 pa2, bf16x8 pa3) {
    const s16x4 l0 = tr_read<v_rd_off(D0, 0, 0)>(vb), h0 = tr_read<v_rd_off(D0, 0, 1)>(vb), l1 = tr_read<v_rd_off(D0, 1, 0)>(vb), h1 = tr_read<v_rd_off(D0, 1, 1)>(vb);
    const s16x4 l2 = tr_read<v_rd_off(D0, 2, 0)>(vb), h2 = tr_read<v_rd_off(D0, 2, 1)>(vb), l3 = tr_read<v_rd_off(D0, 3, 0)>(vb), h3 = tr_read<v_rd_off(D0, 3, 1)>(vb);
    asm volatile("s_waitcnt lgkmcnt(0)" ::: "memory"); SBAR();
#define PK(L, H) (bf16x8){L[0], L[1], L[2], L[3], H[0], H[1], H[2], H[3]}
    od = __builtin_amdgcn_mfma_f32_32x32x16_bf16(pa0, PK(l0, h0), od, 0, 0, 0);
    od = __builtin_amdgcn_mfma_f32_32x32x16_bf16(pa1, PK(l1, h1), od, 0, 0, 0);
    od = __builtin_amdgcn_mfma_f32_32x32x16_bf16(pa2, PK(l2, h2), od, 0, 0, 0);
    od = __builtin_amdgcn_mfma_f32_32x32x16_bf16(pa3, PK(l3, h3), od, 0, 0, 0);
#undef PK
}
__device__ __forceinline__ void pv_d0(f32x16* o, int vb, bf16x8 pa0, bf16x8 pa1, bf16x8 pa2, bf16x8 pa3) {
    pv_one<0>(o[0], vb, pa0, pa1, pa2, pa3); pv_one<1>(o[1], vb, pa0, pa1, pa2, pa3); pv_one<2>(o[2], vb, pa0, pa1, pa2, pa3); pv_one<3>(o[3], vb, pa0, pa1, pa2, pa3);
}
__device__ __forceinline__ void mask_bias(f32x16& p0, f32x16& p1, u64 mw, bool near, const LAS float* tbk, int hi) {
    if (near) {
#pragma unroll
        for (int r = 0; r < 16; ++r) { const int b = (r & 3) + 8 * (r >> 2); p0[r] += tbk[b]; p1[r] += tbk[32 + b]; }
    }
    const unsigned lo = (unsigned)mw >> (4 * hi), hh = (unsigned)(mw >> 32) >> (4 * hi);
#pragma unroll
    for (int r = 0; r < 16; ++r) { const int b = (r & 3) + 8 * (r >> 2);
        const unsigned m0 = (unsigned)__builtin_amdgcn_sbfe((int)lo, b, 1), m1 = (unsigned)__builtin_amdgcn_sbfe((int)hh, b, 1);
        p0[r] = __uint_as_float((m0 & __float_as_uint(p0[r])) | (~m0 & __float_as_uint(NEG)));
        p1[r] = __uint_as_float((m1 & __float_as_uint(p1[r])) | (~m1 & __float_as_uint(NEG))); }
}

__device__ __forceinline__ void og_store_rows(const LAS char* st, const bf16_t* __restrict__ SGg, bf16_t* __restrict__ OGg, int kvh, int nrows, int tid) {
    for (int c = tid; c < nrows * 64; c += NTHREADS) { const int row = c >> 6, ch = c & 63;
        const u32x4 ov = *(const LAS u32x4*)(st + row * 1024 + ch * 16);
        const size_t off = (size_t)row * DM + kvh * 512 + ch * 8;
        const u32x4 gv = *(const u32x4*)(SGg + off);
        u32x4 w; w.x = cvt_pk_bf16(bf_lo(ov.x) * bf_lo(gv.x), bf_hi(ov.x) * bf_hi(gv.x)); w.y = cvt_pk_bf16(bf_lo(ov.y) * bf_lo(gv.y), bf_hi(ov.y) * bf_hi(gv.y));
        w.z = cvt_pk_bf16(bf_lo(ov.z) * bf_lo(gv.z), bf_hi(ov.z) * bf_hi(gv.z)); w.w = cvt_pk_bf16(bf_lo(ov.w) * bf_lo(gv.w), bf_hi(ov.w) * bf_hi(gv.w));
        *(u32x4*)(OGg + off) = w; }
}
__device__ __forceinline__ void attn_block(const bf16_t* __restrict__ Qg, const bf16_t* __restrict__ Kh, const bf16_t* __restrict__ Vh, const u64* __restrict__ rmq,
                                           const bf16_t* __restrict__ SGg, bf16_t* __restrict__ OGg, int NT, int qpos0, int kvh, const float* __restrict__ rel_bias, LAS char* lds) {
    int tid = threadIdx.x; asm volatile("" : "+v"(tid));
    const int wid = __builtin_amdgcn_readfirstlane(tid >> 6), lane = tid & 63, r32 = lane & 31, hi = lane >> 5;
    const int hl = wid & 3, qs = wid >> 2, head = kvh * 4 + hl;
    LAS char* V_lds = lds; LAS char* K_lds = lds + 2 * SHM_V;
    LAS float* ws = (LAS float*)(lds + OFF_WS) + wid * 64; LAS float* li_l = ws; LAS float* al_l = ws + 32;
    LAS float* tb = (LAS float*)(lds + OFF_TB);
    for (int e = tid; e < 1024; e += NTHREADS) {
        const int h = e >> 8, rel = (e & 255) - 192, n = rel < 0 ? -rel : rel;
        int bk = n < 8 ? n : (n < 12 ? 8 : n < 16 ? 9 : n < 23 ? 10 : n < 32 ? 11 : n < 46 ? 12 : n < 64 ? 13 : n < 91 ? 14 : 15);
        if (rel > 0) bk += 16;
        tb[e] = (rel_bias[bk * 32 + kvh * 4 + h] - rel_bias[15 * 32 + kvh * 4 + h]) * (1.0f / SCALE);
    }
    {
        const u32x4* src = (const u32x4*)rmq; LAS u32x4* dst = (LAS u32x4*)(lds + OFF_MK);
        constexpr int NCH = 64 * RMS * 8 / 16;
        for (int e = tid; e < NCH; e += NTHREADS) dst[e] = src[e];
    }
    float m_reg = MINIT, l_reg = 0; f32x16 o[4] = {}; bf16x8 qr[8];
    const int qrow = qs * 32 + r32;
    const bf16_t* Qw = Qg + (size_t)qrow * DM + head * D + hi * 8;
#pragma unroll
    for (int d0 = 0; d0 < 8; ++d0) qr[d0] = *(const bf16x8*)(Qw + d0 * 16);
    const LAS u64* rml = (const LAS u64*)(lds + OFF_MK) + qrow * RMS;
    const int vb0 = (int)(uintptr_t)V_lds + v_rd_base(lane);
    const int tboff = hl * 256 + 192 - (qpos0 + qrow) + 4 * hi;
    constexpr int LDK = KVW;
    unsigned koff[2], voff[2];
#pragma unroll
    for (int i = 0; i < 2; ++i) { const int off = (wid * 2 + i) * 1024 + lane * 16;
        { const int row = off >> 8, cB = (off & 255) ^ ((row & 7) << 4); koff[i] = (unsigned)(row * LDK * 2 + cB); }
        { const int sub = off >> 9, kk = (sub >> 2) * 8 + ((off & 511) >> 6), k = (kk & ~0xC) | ((kk & 4) << 1) | ((kk & 8) >> 1), c = (sub & 3) * 32 + ((off & 63) >> 1); voff[i] = (unsigned)(k * LDK * 2 + c * 2); } }
#define DMA_K(t, slot) do { _Pragma("unroll") for (int i_ = 0; i_ < 2; ++i_) __builtin_amdgcn_global_load_lds((const unsigned*)((const char*)Kh + (size_t)(t) * (KVBLK * LDK * 2) + koff[i_]), \
        (LAS unsigned*)(K_lds + (slot) * SHM_K + (wid * 2 + i_) * 1024), 16, 0, 0); } while (0)
#define DMA_V(t, slot) do { _Pragma("unroll") for (int i_ = 0; i_ < 2; ++i_) __builtin_amdgcn_global_load_lds((const unsigned*)((const char*)Vh + (size_t)(t) * (KVBLK * LDK * 2) + voff[i_]), \
        (LAS unsigned*)(V_lds + (slot) * SHM_V + (wid * 2 + i_) * 1024), 16, 0, 0); } while (0)
#define STEPBAR() do { asm volatile("s_waitcnt vmcnt(0) lgkmcnt(0)" ::: "memory"); __builtin_amdgcn_s_barrier(); asm volatile("" ::: "memory"); } while (0)
#define RESC(a) do { if (__any((a) < 1.f)) { if (hi == 0) al_l[r32] = (a); asm volatile("s_waitcnt lgkmcnt(0)" ::: "memory"); \
    _Pragma("unroll") for (int d = 0; d < 4; ++d) _Pragma("unroll") for (int r = 0; r < 16; ++r) o[d][r] *= al_l[crow(r, hi)]; } } while (0)
#define MB(P0, P1, t) mask_bias(P0, P1, rml[t], (t) >= NT - 3, tb + tboff + (t) * KVBLK, hi)
    f32x16 pA0, pA1, pB0, pB1; float mnA, mnB, alA, alB; bf16x8 pa0, pa1, pa2, pa3;
    DMA_K(0, 0);
    STEPBAR();
    if (NT > 1) DMA_K(1, 1);
    DMA_V(0, 0);
    qkt(pA0, pA1, K_lds, qr, r32, hi); MB(pA0, pA1, 0); partialSM(pA0, pA1, m_reg, mnA, alA);
    int j = 1;
    for (; j + 1 < NT; j += 2) {
        STEPBAR();
        DMA_K(j + 1, 0); DMA_V(j, 1);
        SBAR(); qkt(pB0, pB1, K_lds + SHM_K, qr, r32, hi);
        finishSM(pA0, pA1, alA, l_reg, pa0, pa1, pa2, pa3); SBAR();
        pv_d0(o, vb0, pa0, pa1, pa2, pa3); MB(pB0, pB1, j); partialSM(pB0, pB1, m_reg, mnB, alB);
        RESC(alB);
        STEPBAR();
        if (j + 2 < NT) DMA_K(j + 2, 1);
        DMA_V(j + 1, 0);
        SBAR(); qkt(pA0, pA1, K_lds, qr, r32, hi);
        finishSM(pB0, pB1, alB, l_reg, pa0, pa1, pa2, pa3); SBAR();
        pv_d0(o, vb0 + (int)SHM_V, pa0, pa1, pa2, pa3); MB(pA0, pA1, j + 1); partialSM(pA0, pA1, m_reg, mnA, alA);
        RESC(alA);
    }
    if (j < NT) {
        STEPBAR();
        DMA_V(j, 1);
        SBAR(); qkt(pB0, pB1, K_lds + SHM_K, qr, r32, hi);
        finishSM(pA0, pA1, alA, l_reg, pa0, pa1, pa2, pa3); SBAR();
        pv_d0(o, vb0, pa0, pa1, pa2, pa3); MB(pB0, pB1, j); partialSM(pB0, pB1, m_reg, mnB, alB);
        RESC(alB);
        STEPBAR();
        finishSM(pB0, pB1, alB, l_reg, pa0, pa1, pa2, pa3); SBAR();
        pv_d0(o, vb0 + (int)SHM_V, pa0, pa1, pa2, pa3);
    } else {
        STEPBAR();
        finishSM(pA0, pA1, alA, l_reg, pa0, pa1, pa2, pa3); SBAR();
        pv_d0(o, vb0, pa0, pa1, pa2, pa3);
    }
    asm volatile("s_waitcnt vmcnt(0)" ::: "memory");
    if (hi == 0) li_l[r32] = l_reg;
    __syncthreads();
    {
        LAS bf16_t* st = (LAS bf16_t*)lds;
#pragma unroll
        for (int r = 0; r < 16; ++r) { const int orow = qs * 32 + crow(r, hi); const float rl = __builtin_amdgcn_rcpf(li_l[crow(r, hi)]);
#pragma unroll
            for (int d0 = 0; d0 < 4; ++d0) st[orow * 512 + hl * 128 + d0 * 32 + r32] = (bf16_t)(cvt_pk_bf16(o[d0][r] * rl, 0.f) & 0xffffu); }
    }
    __syncthreads();
    og_store_rows(lds, SGg, OGg, kvh, 64, tid);
    __syncthreads();
#undef DMA_K
#undef DMA_V
#undef STEPBAR
#undef RESC
#undef MB
}

#define WGBAR() do { asm volatile("s_waitcnt lgkmcnt(0)" ::: "memory"); __builtin_amdgcn_s_barrier(); asm volatile("" ::: "memory"); } while (0)
__device__ __forceinline__ void attn_sample_block(const bf16_t* __restrict__ Qg, const float* __restrict__ ck, const float* __restrict__ cv, const bf16_t* __restrict__ kn, const bf16_t* __restrict__ vn,
                                                  const u64* __restrict__ rmq, const bf16_t* __restrict__ SGg, bf16_t* __restrict__ OGg, int kvh, const float* __restrict__ rel_bias, LAS char* lds) {
    int tid = threadIdx.x; asm volatile("" : "+v"(tid));
    const int wid = __builtin_amdgcn_readfirstlane(tid >> 6), lane = tid & 63, r32 = lane & 31, hi = lane >> 5;
    constexpr int NT = 65;
    LAS char* V_lds = lds; LAS char* K_lds = lds + 2 * SHM_V;
    LAS float* tb = (LAS float*)(lds + OFF_TB);
    for (int e = tid; e < 1024; e += NTHREADS) {
        const int h = e >> 8, rel = (e & 255) - 192, n = rel < 0 ? -rel : rel;
        int bk = n < 8 ? n : (n < 12 ? 8 : n < 16 ? 9 : n < 23 ? 10 : n < 32 ? 11 : n < 46 ? 12 : n < 64 ? 13 : n < 91 ? 14 : 15);
        if (rel > 0) bk += 16;
        tb[e] = (rel_bias[bk * 32 + kvh * 4 + h] - rel_bias[15 * 32 + kvh * 4 + h]) * (1.0f / SCALE);
    }
    {   const u32x4* src = (const u32x4*)rmq; LAS u32x4* dst = (LAS u32x4*)(lds + OFF_MK);
        for (int e = tid; e < 32 * RMS * 8 / 16; e += NTHREADS) dst[e] = src[e]; }
    if (wid >= 4) {
        const int lt = tid - 256;
        f32x4 krA[4][2], vrA[4][2], krB[4][2], vrB[4][2];
        const int row0 = lt >> 4, c8 = (lt & 15) * 8;
#define LD_TILE(kr, vr, t) do { if ((t) < 64) { _Pragma("unroll") for (int i = 0; i < 4; ++i) { const size_t o_ = ((size_t)(t) * 64 + row0 + 16 * i) * KVW + c8; \
            kr[i][0] = *(const f32x4*)(ck + o_); kr[i][1] = *(const f32x4*)(ck + o_ + 4); vr[i][0] = *(const f32x4*)(cv + o_); vr[i][1] = *(const f32x4*)(cv + o_ + 4); } } } while (0)
#define WR_TILE(kr, vr, t, b) do { if ((t) < 64) { _Pragma("unroll") for (int i = 0; i < 4; ++i) { const int r_ = row0 + 16 * i; \
            *(LAS u32x4*)(K_lds + (b) * SHM_K + KSWZ(r_, c8 * 2)) = pack8(kr[i][0], kr[i][1]); *(LAS u32x4*)(V_lds + (b) * SHM_V + v_st(r_, c8)) = pack8(vr[i][0], vr[i][1]); } } \
        else if ((t) == 64) { _Pragma("unroll") for (int i = 0; i < 4; ++i) { const int r_ = row0 + 16 * i; u32x4 kx = (u32x4){0u, 0u, 0u, 0u}, vx = kx; \
            if (r_ < 32) { kx = *(const u32x4*)(kn + (size_t)r_ * KVW + c8); vx = *(const u32x4*)(vn + (size_t)r_ * KVW + c8); } \
            *(LAS u32x4*)(K_lds + (b) * SHM_K + KSWZ(r_, c8 * 2)) = kx; *(LAS u32x4*)(V_lds + (b) * SHM_V + v_st(r_, c8)) = vx; } } } while (0)
        LD_TILE(krA, vrA, 0); WR_TILE(krA, vrA, 0, 0); LD_TILE(krA, vrA, 1); LD_TILE(krB, vrB, 2);
        WGBAR();
        WR_TILE(krA, vrA, 1, 1); LD_TILE(krA, vrA, 3);
        WGBAR();
        for (int j = 1; j + 1 < NT; j += 2) {
            WGBAR();
            WR_TILE(krB, vrB, j + 1, 0);
            WGBAR();
            LD_TILE(krB, vrB, j + 3);
            WGBAR();
            WR_TILE(krA, vrA, j + 2, 1);
            WGBAR();
            LD_TILE(krA, vrA, j + 4);
        }
#undef LD_TILE
#undef WR_TILE
    } else {
        LAS float* ws = (LAS float*)(lds + OFF_WS) + wid * 64; LAS float* li_l = ws; LAS float* al_l = ws + 32;
        const int head = kvh * 4 + wid;
        float m_reg = MINIT, l_reg = 0; f32x16 o[4] = {}; bf16x8 qr[8];
        const bf16_t* Qw = Qg + (size_t)r32 * DM + head * D + hi * 8;
#pragma unroll
        for (int d0 = 0; d0 < 8; ++d0) qr[d0] = *(const bf16x8*)(Qw + d0 * 16);
        const LAS u64* rml = (const LAS u64*)(lds + OFF_MK) + r32 * RMS;
        const int vb0 = (int)(uintptr_t)V_lds + v_rd_base(lane);
        const int tboff = wid * 256 + 192 - (PAST + r32) + 4 * hi;
#define RESC(a) do { if (__any((a) < 1.f)) { if (hi == 0) al_l[r32] = (a); asm volatile("s_waitcnt lgkmcnt(0)" ::: "memory"); \
    _Pragma("unroll") for (int d = 0; d < 4; ++d) _Pragma("unroll") for (int r = 0; r < 16; ++r) o[d][r] *= al_l[crow(r, hi)]; } } while (0)
#define MB(P0, P1, t) mask_bias(P0, P1, rml[t], (t) >= NT - 3, tb + tboff + (t) * KVBLK, hi)
        f32x16 pA0, pA1, pB0, pB1; float mnA, mnB, alA, alB; bf16x8 pa0, pa1, pa2, pa3;
        WGBAR();
        qkt(pA0, pA1, K_lds, qr, r32, hi); MB(pA0, pA1, 0); partialSM(pA0, pA1, m_reg, mnA, alA);
        WGBAR();
        for (int j = 1; j + 1 < NT; j += 2) {
            SBAR(); qkt(pB0, pB1, K_lds + SHM_K, qr, r32, hi);
            finishSM(pA0, pA1, alA, l_reg, pa0, pa1, pa2, pa3); SBAR();
            pv_d0(o, vb0, pa0, pa1, pa2, pa3); MB(pB0, pB1, j); partialSM(pB0, pB1, m_reg, mnB, alB);
            WGBAR();
            RESC(alB);
            WGBAR();
            SBAR(); qkt(pA0, pA1, K_lds, qr, r32, hi);
            finishSM(pB0, pB1, alB, l_reg, pa0, pa1, pa2, pa3); SBAR();
            pv_d0(o, vb0 + (int)SHM_V, pa0, pa1, pa2, pa3); MB(pA0, pA1, j + 1); partialSM(pA0, pA1, m_reg, mnA, alA);
            WGBAR();
            RESC(alA);
            WGBAR();
        }
        finishSM(pA0, pA1, alA, l_reg, pa0, pa1, pa2, pa3); SBAR();
        pv_d0(o, vb0, pa0, pa1, pa2, pa3);
        if (hi == 0) li_l[r32] = l_reg;
        WGBAR();
        {
            LAS bf16_t* st = (LAS bf16_t*)lds;
#pragma unroll
            for (int r = 0; r < 16; ++r) { const int orow = crow(r, hi); const float rl = __builtin_amdgcn_rcpf(li_l[orow]);
#pragma unroll
                for (int d0 = 0; d0 < 4; ++d0) st[orow * 512 + wid * 128 + d0 * 32 + r32] = (bf16_t)(cvt_pk_bf16(o[d0][r] * rl, 0.f) & 0xffffu); }
        }
#undef RESC
#undef MB
    }
    if (wid >= 4) WGBAR();
    __syncthreads();
    og_store_rows(lds, SGg, OGg, kvh, 32, tid);
    __syncthreads();
}
}

__global__ void __launch_bounds__(NTHREADS, 2) mega(Params p) {
    extern __shared__ __attribute__((aligned(16))) unsigned char lds_raw[];
    LAS unsigned char* lds = (LAS unsigned char*)lds_raw;
    volatile LAS unsigned* MISC = (volatile LAS unsigned*)(lds + MISC_OFF);
    const int G = gridDim.x; const int bx = blockIdx.x;
    const int vcu = (G % 8 == 0) ? (bx % 8) * (G / 8) + bx / 8 : bx;
    const int NGW = G * NWAVES;
#define PHASE_IDS() int tid = threadIdx.x; asm volatile("" : "+v"(tid)); const int lane = tid & 63, wave = __builtin_amdgcn_readfirstlane(tid >> 6), gw = vcu * NWAVES + wave; (void)lane; (void)gw
    unsigned char* ws = p.ws; float* out = p.out;
    const int lo = p.ph_lo, hi_ph = p.ph_hi;
    for (int u = threadIdx.x; u < (LDS_BYTES - RING_BYTES) / 4; u += NTHREADS) ((LAS unsigned*)(lds + RING_BYTES))[u] = 0u;
    __syncthreads();
    XcdBarrier bar; bar.bar = (unsigned*)(ws + WS_CTL) + CW_BAR; bar.x = 0; bar.st = nullptr;
    if (hi_ph - lo > 1) bar = xcd_barrier_post((unsigned*)(ws + WS_CTL) + CW_BAR, MISC + 8);
#ifndef PH_MASK
#define PH_MASK 0x7fff
#endif
#define IN(k) (((PH_MASK >> (k)) & 1) && lo <= (k) && (k) < hi_ph)
#ifdef TPROBE
    unsigned long long tp0 = __builtin_amdgcn_s_memrealtime(), tp1 = 0;
#define TP_MARK(k) do { if ((k) == TPROBE - 1) tp0 = __builtin_amdgcn_s_memrealtime(); if ((k) == TPROBE) tp1 = __builtin_amdgcn_s_memrealtime(); } while (0)
#else
#define TP_MARK(k) do { } while (0)
#endif
#define SEAM(k) do { if (IN(k) && IN((k) + 1)) xcd_barrier(bar); TP_MARK(k); } while (0)

    if (IN(0)) {
        PHASE_IDS();
        {
            for (int i = tid; i < DM / 4; i += NTHREADS) ((LAS f32x4*)lds)[i] = ((const f32x4*)p.norm_w)[i];
            __syncthreads();
            f32x4 v[16], vn[16];
            if (gw < MT) { const f32x4* xr = (const f32x4*)(gw < MP ? p.x_prompt + (size_t)gw * DM : p.x_sample + (size_t)(gw - MP) * DM) + lane;
#pragma unroll
                for (int j = 0; j < 16; ++j) v[j] = xr[64 * j]; }
#pragma unroll 1
            for (int m = gw; m < MT; m += NGW) {
                const int mn = m + NGW;
                if (mn < MT) { const f32x4* xr = (const f32x4*)(mn < MP ? p.x_prompt + (size_t)mn * DM : p.x_sample + (size_t)(mn - MP) * DM) + lane;
#pragma unroll
                    for (int j = 0; j < 16; ++j) vn[j] = xr[64 * j]; }
                rms_row_q(v, (const LAS f32x4*)lds, (bf16_t*)(ws + WS_H) + (size_t)m * DM, (signed char*)(ws + WS_H8) + (size_t)m * DM, (float*)(ws + WS_SA) + m, lane);
#pragma unroll
                for (int j = 0; j < 16; ++j) v[j] = vn[j];
            }
        }
        {
            const size_t gt = (size_t)gw * 64 + lane, GT = (size_t)NGW * 64;
            constexpr size_t NK8 = (size_t)DB * SKV * DIDX / 8;
            for (size_t i = gt; i < NK8; i += GT) {
                const size_t row = i / 8, c8 = i % 8, bb = row / SKV, s = row % SKV;
                if (s >= (size_t)PAST && s < (size_t)PAST + DSQ) continue;
                u32x4 w = (u32x4){0u, 0u, 0u, 0u};
                if (s < (size_t)PAST) { const float* src = p.cache_kidx + (bb * PAST + s) * DIDX + c8 * 8; w = pack8(*(const f32x4*)src, *(const f32x4*)(src + 4)); }
                *(u32x4*)((bf16_t*)(ws + WS_KIS) + bb * SKV * DIDX + kif_off((int)s, (int)c8 * 8)) = w;
            }
        }
        {
            u32x4* z = (u32x4*)((bf16_t*)(ws + WS_WT_IN) + (size_t)2144 * DM);
            for (size_t i = (size_t)gw * 64 + lane; i < (size_t)160 * DM * 2 / 16; i += (size_t)NGW * 64) z[i] = (u32x4){0u, 0u, 0u, 0u};
        }
        __syncthreads();
        LAS float* scr = (LAS float*)(lds + wave * 16384);
        constexpr int I_IN = 64 * 34, I_GRP = 4 * 16 * 16, I_AMX = 64 * 40, I_AMX2 = 64 * 32, I_AMX3 = 64 * 16;
        constexpr int NITEMS = I_IN + I_GRP + I_AMX + I_AMX2 + 2 * I_AMX3;
        for (int it = gw; it < NITEMS; it += NGW) {
            int r = it;
            if (r < I_IN) { const int kb = r / 34, nb = r % 34, n0 = 6144 + nb * 64;
                transpose_item(p.attn_w_in, 12384, kb * 64, n0, (bf16_t*)(ws + WS_WT_IN), DM, nb * 64, nb == 33 ? 32 : 64, scr, lane); continue; } r -= I_IN;
            if (r < I_GRP) { const int g = r / 256, q = r % 256;
                transpose_item(p.pool_group_w + (size_t)g * 1024 * 1024, 1024, (q / 16) * 64, (q % 16) * 64, (bf16_t*)(ws + WS_WT_GRP), 1024, g * 1024 + (q % 16) * 64, 64, scr, lane); continue; } r -= I_GRP;
            if (r >= I_AMX + I_AMX2) {
                r -= I_AMX + I_AMX2; const bool second = r >= I_AMX3; if (second) r -= I_AMX3;
                const int kb = r >> 4, cb = r & 15, n0 = cb * 256 + lane * 4;
                const f32x4 m = col_amax64<false>((second ? p.pool_w_out : p.attn_w_out) + (size_t)kb * 64 * DM + n0, DM, nullptr);
                unsigned* cm = (unsigned*)(ws + (second ? WS_CAMAX4 : WS_CAMAX3)) + n0;
                atomicMax(cm, __float_as_uint(m.x)); atomicMax(cm + 1, __float_as_uint(m.y)); atomicMax(cm + 2, __float_as_uint(m.z)); atomicMax(cm + 3, __float_as_uint(m.w));
                continue;
            }
            if (r >= I_AMX) {
                r -= I_AMX; const int kb = r >> 5, cb = r & 31, n0 = cb * 256 + lane * 4;
                const f32x4 m = col_amax64<true>(p.pool_w_in + (size_t)kb * 64 * 8192 + n0, 8192, p.norm_w + DM + kb * 64);
                unsigned* cm = (unsigned*)(ws + WS_CAMAX2) + cb * 256 + lane * 4;
                atomicMax(cm, __float_as_uint(m.x)); atomicMax(cm + 1, __float_as_uint(m.y)); atomicMax(cm + 2, __float_as_uint(m.z)); atomicMax(cm + 3, __float_as_uint(m.w));
                continue;
            }
            {
                const int kb = r / 40, cb = r % 40, n0 = (cb < 24 ? cb * 256 : 8288 + (cb - 24) * 256) + lane * 4;
                const f32x4 m = col_amax64<false>(p.attn_w_in + (size_t)kb * 64 * 12384 + n0, 12384, nullptr);
                unsigned* cm = (unsigned*)(ws + WS_CAMAX) + cb * 256 + lane * 4;
                atomicMax(cm, __float_as_uint(m.x)); atomicMax(cm + 1, __float_as_uint(m.y)); atomicMax(cm + 2, __float_as_uint(m.z)); atomicMax(cm + 3, __float_as_uint(m.w));
            }
        }
    }
    SEAM(0);
    if (IN(1)) {
        PHASE_IDS();
        LAS float* scr = (LAS float*)(lds + wave * 16384);
        for (int it = gw; it < 2 * 32 * 64; it += NGW) { const bool second = it < 32 * 64; const int r = second ? it : it - 32 * 64, kb = r >> 6, nb = r & 63;
            transpose_item_i8(second ? p.pool_w_out : p.attn_w_out, DM, kb * 128, nb * 64, (signed char*)(ws + (second ? WS_WPO8 : WS_WO8)), DM, nb * 64, scr, lane,
                              (const unsigned*)(ws + (second ? WS_CAMAX4 : WS_CAMAX3)), (float*)(ws + (second ? WS_SB4 : WS_SB3))); }
        for (int it = gw; it < 32 * 128; it += NGW) { const int kb = it >> 7, nb = it & 127;
            transpose_item_i8(p.pool_w_in, 8192, kb * 128, nb * 64, (signed char*)(ws + WS_WP8), DM, nb * 64, scr, lane, (const unsigned*)(ws + WS_CAMAX2), (float*)(ws + WS_SB2), p.norm_w + DM); }
        for (int it = gw; it < 32 * 160; it += NGW) { const int kb = it / 160, nb = it % 160, n0 = nb < 96 ? nb * 64 : 8288 + (nb - 96) * 64;
            transpose_item_i8(p.attn_w_in, 12384, kb * 128, n0, (signed char*)(ws + WS_WT8), DM, nb * 64, scr, lane, (const unsigned*)(ws + WS_CAMAX), (float*)(ws + WS_SB)); }
    }
    SEAM(1);
    if (IN(2)) {
        {
            pg8::Gemm g{(const bf16_t*)(ws + WS_H8), (const bf16_t*)(ws + WS_WT8), MT, NI8, DM / 2, DM / 2, DM / 2, 0};
            pg8::Order S; S.init(MT / 256, 40, 0, 0, G, bx);
            Epi1a E{ws, out};
            pg8::gemm_phase<Epi1a, false, true>(lds, g, S, E);
        }
        {
            pg8::Gemm g{(const bf16_t*)(ws + WS_H), (const bf16_t*)(ws + WS_WT_IN), MT, NB16, DM, DM, DM, 0};
            int G2 = G; asm volatile("" : "+s"(G2));
            pg8::Order S; S.init(MT / 256, 8, MT / 256, 1, G2, G2 - 1 - bx);
            Epi1b E{ws, out};
            pg8::gemm_phase<Epi1b, true>(lds, g, S, E);
        }
    }
    SEAM(2);
    if (IN(3)) {
        const bf16_t* QIF = (const bf16_t*)(ws + WS_QIB); const float* WI = (const float*)(ws + WS_WIB); float* SC = (float*)(ws + WS_SC);
        for (int it = vcu; it < 512; it += G) {
            if (it < 256) {
#pragma unroll 1
                for (int hh = 0; hh < 2; ++hh) { const int g = hh ? 511 - it : it, b = g >> 7, nt = ((g & 127) >> 1) + 1;
                    if (nt > 4) score_tiles(QIF + (size_t)g * 65536, WI + (size_t)g * 32 * HIDX, (const bf16_t*)(ws + WS_KIP) + (size_t)b * SEQ * DIDX, SC + (size_t)g * 32 * SCW, 0, 1, nt, lds); }
            } else {
                const int sb = (it - 256) >> 3, kr = (it - 256) & 7, g = 512 + sb;
                score_tiles(QIF + (size_t)g * 65536, WI + (size_t)g * 32 * HIDX, (const bf16_t*)(ws + WS_KIS) + (size_t)sb * SKV * DIDX, SC + (size_t)g * 32 * SCW, kr, 8, kr == 0 ? 9 : 8, lds);
            }
        }
    }
    SEAM(3);
    if (IN(4)) {
        PHASE_IDS();
        u64* RM = (u64*)(ws + WS_RM); const float* SC = (const float*)(ws + WS_SC);
        for (int pi = gw; pi < 2048; pi += NGW) {
            const int nq = (pi & 1) == 0 ? 9 : 8;
            float vv[NVJ];
#pragma unroll
            for (int j = 0; j < NVJ; ++j) vv[j] = 0.f;
            sel_load(SC + (size_t)pi * SCW, (pi >> 6) + 1, vv, lane);
#pragma unroll 1
            for (int k = 0; k < nq; ++k) {
                int m, nt, nv;
                if (k < 8) { const int b = k >> 1, t = (k & 1) ? 4095 - pi : pi; m = b * SEQ + t; nt = (t >> 6) + 1; nv = nt * 64; } else { m = MP + (pi >> 1); nt = 65; nv = PAST + DSQ; }
                int m2 = 0, nt2 = 0;
                if (k + 1 < 8) { const int b = (k + 1) >> 1, t = ((k + 1) & 1) ? 4095 - pi : pi; m2 = b * SEQ + t; nt2 = (t >> 6) + 1; } else if (k + 1 < nq) { m2 = MP + (pi >> 1); nt2 = 65; }
                select_row(vv, nt, nv, RM + (size_t)m * RMS, SC + (size_t)m2 * SCW, nt2, lane);
            }
        }
    }
    SEAM(4);
    if (IN(5)) {
        const u64* RM = (const u64*)(ws + WS_RM);
        const bf16_t* QB = (const bf16_t*)(ws + WS_QB); const bf16_t* SG = (const bf16_t*)(ws + WS_SG); bf16_t* OG = (bf16_t*)(ws + WS_OG);
        for (int sl = vcu; sl < 1280; sl += G) {
            const int v = sl & 255, k = sl >> 8, ks = v % 5;
            if (k != ks) {
                const int it = v + 256 * (k - (k > ks ? 1 : 0));
                const int b = it >> 8, kvh = (it >> 5) & 7, pr = it & 31;
                const bf16_t* Kh = (const bf16_t*)(ws + WS_KP) + (size_t)b * SEQ * KVW + kvh * 128; const bf16_t* Vh = (const bf16_t*)(ws + WS_VP) + (size_t)b * SEQ * KVW + kvh * 128;
#pragma unroll 1
                for (int half = 0; half < 2; ++half) {
                    const int c = half ? 63 - pr : pr; const size_t m0 = (size_t)b * SEQ + c * 64;
                    att::attn_block(QB + m0 * DM, Kh, Vh, RM + m0 * RMS, SG + m0 * DM, OG + m0 * DM, c + 1, c * 64, kvh, p.rel_bias, (LAS char*)lds);
                }
            } else {
                const int b = v >> 3, kvh = v & 7; const size_t m0 = (size_t)MP + b * 32;
                att::attn_sample_block(QB + m0 * DM, p.cache_k + ((size_t)b * PAST * NKVH + kvh) * 128, p.cache_v + ((size_t)b * PAST * NKVH + kvh) * 128,
                                       (const bf16_t*)(ws + WS_KSN) + (size_t)b * 32 * KVW + kvh * 128, (const bf16_t*)(ws + WS_VSN) + (size_t)b * 32 * KVW + kvh * 128,
                                       RM + m0 * RMS, SG + m0 * DM, OG + m0 * DM, kvh, p.rel_bias, (LAS char*)lds);
            }
        }
    }
    SEAM(5);
    if (IN(6)) {
        PHASE_IDS();
        float* SAo = (float*)(ws + WS_SA);
        quant_rows_bf16((const bf16_t*)(ws + WS_OG), (signed char*)(ws + WS_H8), MT, gw, NGW, lane, [&](int m, float am, float) { if (lane == 0) SAo[m] = am * (1.0f / 127.0f); });
    }
    SEAM(6);
    if (IN(7)) {
        pg8::Gemm g{(const bf16_t*)(ws + WS_H8), (const bf16_t*)(ws + WS_WO8), MT, DM, DM / 2, DM / 2, DM / 2, 0};
        pg8::Order S; S.init(MP / 256, 16, 256, 2, G, bx);
        EpiX1 E{p.x_prompt, nullptr, (bf16_t*)(ws + WS_H), (float*)(ws + WS_PS), (const float*)(ws + WS_SA), (const float*)(ws + WS_SB3)};
        pg8::gemm_phase<EpiX1, false, true>(lds, g, S, E);
    }
    SEAM(7);
    if (IN(8)) {
        signed char* X8 = (signed char*)(ws + WS_H8); float* ROWF = (float*)(ws + WS_ROWF);
        {
        PHASE_IDS();
        for (int m = MP + gw; m < MT; m += NGW) {
            const f32x4* xr = (const f32x4*)(p.x_sample + (size_t)(m - MP) * DM) + lane; const f32x4* ps = (const f32x4*)((const float*)(ws + WS_PS) + (size_t)(m - MP) * DM) + lane;
            f32x4* x1 = (f32x4*)((float*)(ws + WS_X1) + (size_t)m * DM) + lane; float ss = 0.f, am = 0.f; f32x4 v[16];
#pragma unroll
            for (int jb = 0; jb < 4; ++jb) {
                const f32x4* q0 = xr + 256 * jb; const f32x4* q1 = ps + 256 * jb; const f32x4* q2 = q1 + (size_t)MS * DM / 4; const f32x4* q3 = q2 + (size_t)MS * DM / 4; const f32x4* q4 = q3 + (size_t)MS * DM / 4;
                asm volatile("" : "+v"(q0), "+v"(q1), "+v"(q2), "+v"(q3), "+v"(q4) :: "memory");
#pragma unroll
                for (int jj = 0; jj < 4; ++jj) v[jb * 4 + jj] = q0[64 * jj] + ((q1[64 * jj] + q2[64 * jj]) + (q3[64 * jj] + q4[64 * jj]));
            }
#pragma unroll
            for (int j = 0; j < 16; ++j) { x1[64 * j] = v[j]; ss += (v[j].x * v[j].x + v[j].y * v[j].y) + (v[j].z * v[j].z + v[j].w * v[j].w);
                am = fmaxf(am, fmaxf(fmaxf(fabsf(v[j].x), fabsf(v[j].y)), fmaxf(fabsf(v[j].z), fabsf(v[j].w)))); }
#pragma unroll
            for (int o = 1; o < 64; o <<= 1) am = fmaxf(am, __shfl_xor(am, o));
            ss = wave_sum(ss);
            const float inv = am > 0.f ? 127.0f / am : 0.f;
            unsigned* q = (unsigned*)(X8 + (size_t)m * DM) + lane;
#pragma unroll
            for (int j = 0; j < 16; ++j) q[64 * j] = q8x4(v[j].x * inv, v[j].y * inv, v[j].z * inv, v[j].w * inv);
            if (lane == 0) ROWF[m] = am * (1.0f / 127.0f) / sqrtf(ss * (1.0f / DM) + EPS);
        }
        }
        {
            PHASE_IDS();
            quant_rows_bf16((const bf16_t*)(ws + WS_H), X8, MP, gw, NGW, lane, [&](int m, float am, float ss) { if (lane == 0) ROWF[m] = am * (1.0f / 127.0f) / sqrtf(ss * (1.0f / DM) + EPS); });
        }
        {
            PHASE_IDS();
            bf16_t* U = (bf16_t*)(ws + WS_U);
            constexpr int NPAD = (NBATCH + DB) * 16 * 512;
            for (int i = gw * 64 + lane; i < NPAD; i += NGW * 64) {
                const int c = (i & 511) * 8, rr = i >> 9, sq = rr >> 4, k = rr & 15;
                u32x4 o = (u32x4){0u, 0u, 0u, 0u}; size_t row;
                if (sq < NBATCH) row = (size_t)sq * UP_SEQ + k;
                else { const int b = sq - NBATCH; row = (size_t)UP_ROWS + (size_t)b * US_SEQ + k;
                    if (k >= 1) { const float* hp = p.state_pool + ((size_t)b * 15 + (k - 1)) * DM + c; o = pack8(*(const f32x4*)hp, *(const f32x4*)(hp + 4)); } }
                *(u32x4*)(U + row * DM + c) = o;
            }
        }
    }
    SEAM(8);
    if (IN(9)) {
        pg8::Gemm g{(const bf16_t*)(ws + WS_H8), (const bf16_t*)(ws + WS_WP8), MT, 8192, DM / 2, DM / 2, DM / 2, 0};
        pg8::Order S; S.init(MT / 256, 32, 0, 0, G, bx);
        Epi3 E{ws, out};
        pg8::gemm_phase<Epi3, false, true>(lds, g, S, E);
    }
    SEAM(9);
    if (IN(10)) {
        PHASE_IDS();
        const bf16_t* __restrict__ U = (const bf16_t*)(ws + WS_U); bf16_t* __restrict__ MX = (bf16_t*)(ws + WS_MX);
        const int gt = gw * 64 + lane, GT = NGW * 64;
#define ACC8(S, X, SGN) do { S[0] += SGN bf_lo(X.x); S[1] += SGN bf_hi(X.x); S[2] += SGN bf_lo(X.y); S[3] += SGN bf_hi(X.y); S[4] += SGN bf_lo(X.z); S[5] += SGN bf_hi(X.z); S[6] += SGN bf_lo(X.w); S[7] += SGN bf_hi(X.w); } while (0)
        for (int i = gt; i < 256 * 512; i += GT) {
            const int rg = i >> 9, c = (i & 511) * 8, w = 2 << (c >> 10);
            const float icw = 1.0f / (float)w;
            const int pm0 = rg < 224 ? rg * 68 : 224 * 68 + (rg - 224) * 36, pn = rg < 224 ? 68 : 36;
            const int cut = ((pm0 + pn - 1) >> 12) != (pm0 >> 12) ? (((pm0 >> 12) + 1) << 12) - pm0 : pn;
#pragma unroll 1
            for (int sg = 0; sg < 3; ++sg) {
                int m0, n;
                if (sg == 0) { m0 = pm0; n = cut; } else if (sg == 1) { m0 = pm0 + cut; n = pn - cut; } else { m0 = MP + (rg - 224) * 32; n = rg < 224 ? 0 : 32; }
                if (n <= 0) continue;
                const bool samp = m0 >= MP;
                const int t0 = samp ? 0 : (m0 & 4095);
                const bf16_t* up = U + (size_t)u_row(m0) * DM + c;
                float s[8] = {0.f, 0.f, 0.f, 0.f, 0.f, 0.f, 0.f, 0.f};
                for (int k = 1; k <= w; ++k) { const u32x4 x = *(const u32x4*)(up - (size_t)k * DM); ACC8(s, x, +); }
#pragma unroll 1
                for (int tb = 0; tb < n; tb += 4) {
                    u32x4 cur[4], old[4];
#pragma unroll
                    for (int q = 0; q < 4; ++q) { cur[q] = *(const u32x4*)(up + (size_t)(tb + q) * DM); old[q] = *(const u32x4*)(up + ((ptrdiff_t)(tb + q) - w) * DM); }
#pragma unroll
                    for (int q = 0; q < 4; ++q) {
                        const int t = t0 + tb + q;
                        ACC8(s, cur[q], +); ACC8(s, old[q], -);
                        const float ic = (samp || t + 1 >= w) ? icw : 1.0f / (float)(t + 1);
                        const float f[8] = {bf_lo(cur[q].x), bf_hi(cur[q].x), bf_lo(cur[q].y), bf_hi(cur[q].y), bf_lo(cur[q].z), bf_hi(cur[q].z), bf_lo(cur[q].w), bf_hi(cur[q].w)};
                        u32x4 o;
                        o.x = cvt_pk_bf16(s[0] * ic - f[0], s[1] * ic - f[1]); o.y = cvt_pk_bf16(s[2] * ic - f[2], s[3] * ic - f[3]);
                        o.z = cvt_pk_bf16(s[4] * ic - f[4], s[5] * ic - f[5]); o.w = cvt_pk_bf16(s[6] * ic - f[6], s[7] * ic - f[7]);
                        *(u32x4*)(MX + (size_t)(m0 + tb + q) * DM + c) = o;
                    }
                }
            }
        }
#undef ACC8
    }
    SEAM(10);
    if (IN(11)) {
        pg8::Gemm g{(const bf16_t*)(ws + WS_MX), (const bf16_t*)(ws + WS_WT_GRP), MT, DM, 1024, DM, 1024, 1};
        pg8::Order S; S.init(MT / 256, 16, 0, 0, G, bx);
        Epi4 E{ws, p.pool_scale};
        pg8::gemm_phase<Epi4>(lds, g, S, E);
    }
    SEAM(11);
    if (IN(12)) {
        PHASE_IDS();
        float* SAo = (float*)(ws + WS_SA);
        quant_rows_bf16((const bf16_t*)(ws + WS_ZG), (signed char*)(ws + WS_H8), MT, gw, NGW, lane, [&](int m, float am, float) { if (lane == 0) SAo[m] = am * (1.0f / 127.0f); });
    }
    SEAM(12);
    if (IN(13)) {
        pg8::Gemm g{(const bf16_t*)(ws + WS_H8), (const bf16_t*)(ws + WS_WPO8), MT, DM, DM / 2, DM / 2, DM / 2, 0};
        pg8::Order S; S.init(MP / 256, 16, 256, 2, G, bx);
        EpiX2 E{(bf16_t*)(ws + WS_H), (float*)(ws + WS_PS), (const float*)(ws + WS_SA), (const float*)(ws + WS_SB4)};
        pg8::gemm_phase<EpiX2, false, true>(lds, g, S, E);
    }
    SEAM(13);
    if (IN(14)) {
        PHASE_IDS();
        for (int m = MP + gw; m < MT; m += NGW) {
            const f32x4* xr = (const f32x4*)((const float*)(ws + WS_X1) + (size_t)m * DM) + lane; const f32x4* ps = (const f32x4*)((const float*)(ws + WS_PS) + (size_t)(m - MP) * DM) + lane;
            const f32x4* wr = (const f32x4*)p.final_norm_w + lane; f32x4* yo = (f32x4*)(out + O_YS + (size_t)(m - MP) * DM) + lane;
            float ss = 0.f; f32x4 v[16];
#pragma unroll
            for (int jb = 0; jb < 4; ++jb) {
                const f32x4* q0 = xr + 256 * jb; const f32x4* q1 = ps + 256 * jb; const f32x4* q2 = q1 + (size_t)MS * DM / 4; const f32x4* q3 = q2 + (size_t)MS * DM / 4; const f32x4* q4 = q3 + (size_t)MS * DM / 4;
                asm volatile("" : "+v"(q0), "+v"(q1), "+v"(q2), "+v"(q3), "+v"(q4) :: "memory");
#pragma unroll
                for (int jj = 0; jj < 4; ++jj) v[jb * 4 + jj] = q0[64 * jj] + ((q1[64 * jj] + q2[64 * jj]) + (q3[64 * jj] + q4[64 * jj]));
            }
#pragma unroll
            for (int j = 0; j < 16; ++j) ss += (v[j].x * v[j].x + v[j].y * v[j].y) + (v[j].z * v[j].z + v[j].w * v[j].w);
            const float rstd = 1.0f / sqrtf(wave_sum(ss) * (1.0f / DM) + EPS);
#pragma unroll
            for (int j = 0; j < 16; ++j) yo[64 * j] = v[j] * rstd * wr[64 * j];
        }
        {
            const f32x4* wr = (const f32x4*)p.final_norm_w + lane; f32x4 w[16];
#pragma unroll
            for (int j = 0; j < 16; ++j) w[j] = wr[64 * j];
            const bf16_t* XB = (const bf16_t*)(ws + WS_H);
            u32x2 x[16], xn[16];
            if (gw < MP) {
#pragma unroll
                for (int j = 0; j < 16; ++j) x[j] = ((const u32x2*)(XB + (size_t)gw * DM) + lane)[64 * j]; }
#pragma unroll 1
            for (int m = gw; m < MP; m += NGW) {
                if (m + NGW < MP) {
#pragma unroll
                    for (int j = 0; j < 16; ++j) xn[j] = ((const u32x2*)(XB + (size_t)(m + NGW) * DM) + lane)[64 * j]; }
                float ss = 0.f;
#pragma unroll
                for (int j = 0; j < 16; ++j) { const float a = bf_lo(x[j].x), b = bf_hi(x[j].x), c = bf_lo(x[j].y), d = bf_hi(x[j].y); ss += (a * a + b * b) + (c * c + d * d); }
                const float rstd = 1.0f / sqrtf(wave_sum(ss) * (1.0f / DM) + EPS);
                f32x4* yo = (f32x4*)(out + O_YP + (size_t)m * DM) + lane;
#pragma unroll
                for (int j = 0; j < 16; ++j) yo[64 * j] = (f32x4){bf_lo(x[j].x), bf_hi(x[j].x), bf_lo(x[j].y), bf_hi(x[j].y)} * rstd * w[j];
#pragma unroll
                for (int j = 0; j < 16; ++j) x[j] = xn[j];
            }
        }
    }
#ifdef TPROBE
    if (TPROBE == NPHASE - 1) tp1 = __builtin_amdgcn_s_memrealtime();
    if (bx == 0) { const unsigned long long t = __builtin_amdgcn_s_memrealtime(), dt = (tp1 - tp0) * TPMUL; while (__builtin_amdgcn_s_memrealtime() - t < dt) __builtin_amdgcn_s_sleep(8); }
#endif
#undef IN
#undef SEAM
}

#ifndef MK_N_LAUNCHES
#define MK_N_LAUNCHES 1
#endif
extern "C" void kernel_launch(void* const* d_in, const int* in_sizes, int n_in, void* d_out, int out_size, void* d_ws, size_t ws_size, hipStream_t stream) {
    static int grid = 0;
    if (grid == 0) {
        if (n_in != 15 || (size_t)out_size != O_END || ws_size < WS_END) { fprintf(stderr, "kernel_launch: unexpected shapes: n_in %d out %d ws %zu (need >= %zu)\n", n_in, out_size, ws_size, (size_t)WS_END); grid = -1; return; }
        int dev = 0, cus = 0, per_cu = 0;
        if (hipGetDevice(&dev) != hipSuccess || hipDeviceGetAttribute(&cus, hipDeviceAttributeMultiprocessorCount, dev) != hipSuccess) { grid = -1; return; }
        if (hipFuncSetAttribute((const void*)mega, hipFuncAttributeMaxDynamicSharedMemorySize, LDS_BYTES) != hipSuccess) { fprintf(stderr, "kernel_launch: hipFuncSetAttribute failed\n"); grid = -1; return; }
        if (hipOccupancyMaxActiveBlocksPerMultiprocessor(&per_cu, (const void*)mega, NTHREADS, LDS_BYTES) != hipSuccess || per_cu < 1) { fprintf(stderr, "kernel_launch: occupancy query says %d\n", per_cu); }
        (void)hipGetLastError();
        grid = cus;
    }
    if (grid < 0) return;
    if (hipMemsetAsync((char*)d_ws + WS_CTL, 0, CTL_ZERO_BYTES, stream) != hipSuccess) return;
    Params p{};
    p.x_prompt = (const float*)d_in[0]; p.x_sample = (const float*)d_in[1]; p.cache_k = (const float*)d_in[2]; p.cache_v = (const float*)d_in[3];
    p.cache_kidx = (const float*)d_in[4]; p.state_pool = (const float*)d_in[5]; p.norm_w = (const float*)d_in[6]; p.final_norm_w = (const float*)d_in[7];
    p.attn_w_in = (const float*)d_in[8]; p.attn_w_out = (const float*)d_in[9]; p.rel_bias = (const float*)d_in[10]; p.pool_w_in = (const float*)d_in[11];
    p.pool_group_w = (const float*)d_in[12]; p.pool_scale = (const float*)d_in[13]; p.pool_w_out = (const float*)d_in[14];
    p.out = (float*)d_out; p.ws = (unsigned char*)d_ws;
    if (MK_N_LAUNCHES == 1) { p.ph_lo = 0; p.ph_hi = NPHASE; hipLaunchKernelGGL(mega, dim3(grid), dim3(NTHREADS), LDS_BYTES, stream, p); }
    else for (int k = 0; k < NPHASE; ++k) { p.ph_lo = k; p.ph_hi = k + 1; hipLaunchKernelGGL(mega, dim3(grid), dim3(NTHREADS), LDS_BYTES, stream, p); }
#ifdef PROBE_PHASE
    { p.ph_lo = PROBE_PHASE; p.ph_hi = PROBE_PHASE + 1; hipLaunchKernelGGL(mega, dim3(grid), dim3(NTHREADS), LDS_BYTES, stream, p); }
#endif
    const hipError_t le = hipPeekAtLastError();
    if (le != hipSuccess) fprintf(stderr, "kernel_launch: launch failed: %s\n", hipGetErrorName(le));
}
```

```cpp
#include <hip/hip_runtime.h>
#include <cstdio>
#include <cstdint>

#define LAS __attribute__((address_space(3)))
typedef unsigned short bf16_t;
typedef short bf16x8 __attribute__((ext_vector_type(8)));
typedef short s16x4 __attribute__((ext_vector_type(4)));
typedef float f32x4 __attribute__((ext_vector_type(4)));
typedef float f32x16 __attribute__((ext_vector_type(16)));
typedef unsigned u32x4 __attribute__((ext_vector_type(4)));
typedef unsigned u32x2 __attribute__((ext_vector_type(2)));
typedef unsigned long long u64;
typedef int i32x4 __attribute__((ext_vector_type(4)));

constexpr int DM = 4096, NBATCH = 4, SEQ = 4096, DB = 32, DSQ = 32, PAST = 4096;
constexpr int MP = NBATCH * SEQ, MS = DB * DSQ, MT = MP + MS;
constexpr int KVW = 1024, QIW = 2048, DIDX = 64, HIDX = 32, NKVH = 8;
constexpr int N1 = 12544;
constexpr int SKV = 4160;
constexpr int RMS = 65;
constexpr float EPS = 1e-6f;
constexpr int NWAVES = 8, NTHREADS = 512;
constexpr int NPHASE = 15;

constexpr size_t O_YP = 0, O_YS = 67108864, O_KP = 71303168, O_VP = 88080384, O_KIP = 104857600, O_POOLP = 105906176,
                 O_KS = 106151936, O_VS = 107200512, O_KIS = 108249088, O_POOLS = 108314624, O_END = 110280704;

constexpr size_t MiB = 1u << 20;
constexpr size_t WS_CTL = 0, CTL_ZERO_BYTES = 1 * MiB;
constexpr size_t WS_WT_IN = 1 * MiB, WS_WT_OUT = 99 * MiB, WS_WT_PIN = 131 * MiB, WS_WT_GRP = 195 * MiB, WS_WT_POUT = 203 * MiB;
constexpr size_t WS_H = 235 * MiB, WS_QB = 371 * MiB, WS_KP = 507 * MiB, WS_VP = 539 * MiB, WS_KS = 571 * MiB, WS_VS = 831 * MiB;
constexpr size_t WS_QIB = 1091 * MiB, WS_KIP = 1159 * MiB, WS_KIS = 1161 * MiB, WS_WIB = 1178 * MiB, WS_SG = 1181 * MiB, WS_RM = 1317 * MiB;
constexpr size_t WS_OG = 1326 * MiB, WS_X1 = 1462 * MiB, WS_SC = 1734 * MiB, WS_END = 2011 * MiB;
constexpr int SCW = 4160;
constexpr size_t WS_KSN = WS_KS, WS_VSN = WS_KS + 2 * MiB;
constexpr size_t WS_U = WS_QB, WS_SG2 = WS_SG, WS_MX = WS_OG, WS_ZG = WS_VS;
constexpr size_t WS_SS1 = WS_CTL + 256 * 1024;
constexpr size_t WS_PS = 600 * MiB;
constexpr size_t WS_H8 = 664 * MiB, WS_WT8 = 131 * MiB;
constexpr size_t WS_CAMAX = WS_CTL + 384 * 1024, WS_SB = WS_CTL + 448 * 1024, WS_SA = WS_CTL + 512 * 1024;
constexpr size_t WS_WP8 = 764 * MiB;
constexpr size_t WS_CAMAX2 = WS_CTL + 640 * 1024, WS_SB2 = WS_CTL + 704 * 1024, WS_ROWF = WS_CTL + 768 * 1024;
constexpr size_t WS_WO8 = 796 * MiB, WS_WPO8 = 812 * MiB;
constexpr size_t WS_CAMAX3 = WS_CTL + 848 * 1024, WS_CAMAX4 = WS_CTL + 864 * 1024, WS_SB3 = WS_CTL + 880 * 1024, WS_SB4 = WS_CTL + 896 * 1024;
constexpr int NB16 = 2304;
constexpr int NI8 = 10240;
constexpr int CW_BAR = 4096;

constexpr int LDS_BYTES = 147456, RING_BYTES = 131072, MISC_OFF = RING_BYTES + 320;

__device__ __forceinline__ unsigned cvt_pk_bf16(float lo, float hi) { unsigned r; asm("v_cvt_pk_bf16_f32 %0, %1, %2" : "=v"(r) : "v"(lo), "v"(hi)); return r; }
__device__ __forceinline__ float bf_lo(unsigned w) { return __uint_as_float(w << 16); }
__device__ __forceinline__ float bf_hi(unsigned w) { return __uint_as_float(w & 0xffff0000u); }
__device__ __forceinline__ float fma_abs(float a, float b, float c) { float d; asm("v_fma_f32 %0, %1, |%2|, %3" : "=v"(d) : "v"(a), "v"(b), "v"(c)); return d; }
__device__ __forceinline__ float silu_f(float x) { return x * __builtin_amdgcn_rcpf(1.0f + __builtin_amdgcn_exp2f(-1.4426950408889634f * x)); }
__device__ __forceinline__ float wave_sum(float v) {
#pragma unroll
    for (int o = 1; o < 64; o <<= 1) v += __shfl_xor(v, o);
    return v;
}
#define LDS_WAIT() asm volatile("s_waitcnt lgkmcnt(0)" ::: "memory")
#define VM_WAIT() asm volatile("s_waitcnt vmcnt(0)" ::: "memory")

#define XB_TMO      128
#define XB_XCNT(j)  (256  + 64 * (j))
#define XB_XSUB(j)  (1280 + 64 * (j))
#define XB_XGEN(j)  (2304 + 64 * (j))
#define XB_TOP      3328
#define XB_TOPGEN   3392
#define XCD_BAR_WORDS 3456
#define XB_SPIN_CAP (1u << 18)
__device__ __forceinline__ unsigned xb_ld(unsigned* p)              { return __hip_atomic_load(p, __ATOMIC_RELAXED, __HIP_MEMORY_SCOPE_AGENT); }
__device__ __forceinline__ unsigned xb_add(unsigned* p, unsigned v) { return __hip_atomic_fetch_add(p, v, __ATOMIC_RELAXED, __HIP_MEMORY_SCOPE_AGENT); }
__device__ __forceinline__ unsigned xb_xcc_id() { return (unsigned)__builtin_amdgcn_s_getreg((3 << 11) | 20) & 0xFu; }
#define XB_SPIN(cond, bar) do { unsigned _sp = 0; while (cond) { __builtin_amdgcn_s_sleep(1); \
    if ((++_sp & 255u) == 0u) { if (xb_ld(&(bar)[XB_TMO])) break; if (_sp > XB_SPIN_CAP) { atomicAdd(&(bar)[XB_TMO], 1u); break; } } } } while (0)
struct XcdBarrier { unsigned* bar; unsigned x; volatile LAS unsigned* st; };
__device__ __forceinline__ XcdBarrier xcd_barrier_post(unsigned* bar, volatile LAS unsigned* st) {
    XcdBarrier b; b.bar = bar; b.x = xb_xcc_id(); b.st = st;
    if (threadIdx.x == 0) (void)xb_add(&bar[XB_XCNT(b.x)], 1u);
    return b;
}
__device__ __forceinline__ void xcd_barrier_complete(unsigned* bar, unsigned x, unsigned& nloc, unsigned& nx) {
    const unsigned G = gridDim.x * gridDim.y * gridDim.z;
    unsigned sum, cnt, mine, sp = 0u;
    for (;;) {
        sum = 0u; cnt = 0u; mine = 0u;
#pragma unroll
        for (unsigned j = 0; j < 16; ++j) { const unsigned c = xb_ld(&bar[XB_XCNT(j)]); sum += c; cnt += (c > 0u) ? 1u : 0u; mine = (j == x) ? c : mine; }
        if (sum == G) break;
        __builtin_amdgcn_s_sleep(1);
        if ((++sp & 255u) == 0u) { if (xb_ld(&bar[XB_TMO])) break; if (sp > XB_SPIN_CAP) { atomicAdd(&bar[XB_TMO], 1u); break; } }
    }
    nloc = mine > 0u ? mine : 1u; nx = cnt > 0u ? cnt : 1u;
}
__device__ __forceinline__ void xcd_barrier(const XcdBarrier& b) {
    asm volatile("s_waitcnt vmcnt(0)" ::: "memory");
    __syncthreads();
    if (threadIdx.x == 0) {
        unsigned* bar = b.bar;
        __builtin_amdgcn_s_waitcnt(0);
        unsigned nloc = b.st[0], nx = b.st[1];
        if (nloc == 0u) { xcd_barrier_complete(bar, b.x, nloc, nx); b.st[0] = nloc; b.st[1] = nx; }
        const unsigned old = xb_add(&bar[XB_XSUB(b.x)], 1u);
        const unsigned gen = old / nloc;
        if (old + 1u == (gen + 1u) * nloc) {
            __builtin_amdgcn_fence(__ATOMIC_RELEASE, "agent");
            asm volatile("s_waitcnt vmcnt(0)" ::: "memory");
            const unsigned og = xb_add(&bar[XB_TOP], 1u);
            const unsigned tg = og / nx;
            if (og + 1u == (tg + 1u) * nx) xb_add(&bar[XB_TOPGEN], 1u);
            else XB_SPIN(xb_ld(&bar[XB_TOPGEN]) == tg, bar);
            __builtin_amdgcn_fence(__ATOMIC_ACQUIRE, "agent");
            xb_add(&bar[XB_XGEN(b.x)], 1u);
            asm volatile("s_waitcnt vmcnt(0)" ::: "memory");
        } else {
            XB_SPIN(xb_ld(&bar[XB_XGEN(b.x)]) == gen, bar);
            __builtin_amdgcn_fence(__ATOMIC_ACQUIRE, "agent");
            asm volatile("s_waitcnt vmcnt(0)" ::: "memory");
        }
    }
    __syncthreads();
}

namespace pg8 {
constexpr int BM = 256, BK = 64, HALF = 128, HTB = HALF * BK * 2, STAGE_BYTES = 8 * HTB, NXCD = 8, WGM = 8;
__host__ __device__ __forceinline__ int lds_byte(int r, int c) { const int st = (r >> 4) * 2 + (c >> 5), rr = r & 15, cc = c & 31, ob = rr * 64 + cc * 2; return st * 1024 + (ob ^ (((ob >> 9) & 1) << 5)); }
__host__ __device__ __forceinline__ void stage_rc(int b, int& R, int& C) { const int st = b / 1024, sb = b % 1024, swz = sb ^ (((sb >> 9) & 1) << 5); R = (st >> 1) * 16 + swz / 64; C = (st & 1) * 32 + (swz % 64) / 2; }
__host__ __device__ __forceinline__ int perm32(int rho) { const int n = rho >> 4, i = rho & 15; return 8 * (i >> 2) + 4 * n + (i & 3); }
struct Unit { int pm, pn, kq, half; };
struct Gemm { const bf16_t* A; const bf16_t* Bt; int M, N, K, lda, ldb, grouped; };
struct Order {
    int nM, nN, nfull, ntail, mode, G, c, qf, rf;
    __device__ void init(int nM_, int nN_, int ntail_, int mode_, int G_, int c_) { nM = nM_; nN = nN_; nfull = nM * nN; ntail = ntail_; mode = mode_; G = G_; c = c_;
        qf = __builtin_amdgcn_readfirstlane(nfull / G); rf = __builtin_amdgcn_readfirstlane(nfull % G); }
    __device__ bool next(int i, Unit& u) const {
        if (mode == 2 && ntail == G && rf == 0 && ((c >> 3) & 1) == 0) {
            if (i == 0) { const int t = c >> 2; u.pm = nM + (t >> 4); u.pn = t & 15; u.kq = c & 3; u.half = 0; return true; }
            if (i > qf) return false;
            i -= 1;
        }
        const long L = (long)i * G + c;
        if (L < nfull) {
            int wgid = (int)L; { const int q = nfull / NXCD, r = nfull % NXCD, xcd = wgid % NXCD, off = wgid / NXCD; wgid = (xcd < r ? xcd * (q + 1) : r * (q + 1) + (xcd - r) * q) + off; }
            const int nig = WGM * nN, gid = wgid / nig, fm = gid * WGM, gsz = (nM - fm) < WGM ? (nM - fm) : WGM;
            u.pm = fm + ((wgid % nig) % gsz); u.pn = (wgid % nig) / gsz; u.kq = -1; u.half = 0; return true;
        }
        int r = rf, q = qf, gr = G - rf, cc = c, ii = i; asm volatile("" : "+s"(r), "+s"(q), "+s"(gr), "+s"(cc), "+s"(ii));
        if (cc < r || ii < q) return false;
        const int e = (ii - q) * gr + (cc - r);
        if (e >= ntail) return false;
        if (mode == 1) { u.pm = e; u.pn = nN; u.kq = -1; u.half = 1; }
        else { const int t = e >> 2; u.pm = nM + (t >> 4); u.pn = t & 15; u.kq = e & 3; u.half = 0; }
        return true;
    }
};

template <class Epi, bool HALFCAP = false, bool I8 = false, bool ALIGN_EPI = true>
__device__ __forceinline__ void gemm_phase(LAS unsigned char* lds, const Gemm g, const Order& S, const Epi& E) {
    int tid = threadIdx.x; asm volatile("" : "+v"(tid));
    const int wid = __builtin_amdgcn_readfirstlane(tid >> 6), lane = tid & 63, wr = wid >> 2, wc = wid & 3, fr = lane & 15, fq = lane >> 4;
    const int K = g.K, ntf = K / BK;
    unsigned voffA[2], voffB[2];
#pragma unroll
    for (int i = 0; i < 2; ++i) { int R, C; stage_rc(tid * 16 + i * 8192, R, C); const int Rb = Epi::PERM ? ((R & ~31) + perm32(R & 31)) : R;
        voffA[i] = (unsigned)(R * g.lda + C) * 2u; voffB[i] = (unsigned)(Rb * g.ldb + C) * 2u; }
    const size_t kstep = (size_t)(BK * 2);
    const size_t hstepA = (size_t)HALF * g.lda * 2, hstepB = (size_t)HALF * g.ldb * 2;
    const size_t tstepA = 2 * hstepA, tstepB = 2 * hstepB;
    const unsigned ldsw = (unsigned)wid * 1024u;
    const int aoff = lds_byte(wr * 64 + fr, fq * 8), boff = lds_byte(wc * 32 + fr, fq * 8);
#define PG8_SA(b, h) (((b) * 2 + (h)) * HTB)
#define PG8_SB(b, h) ((4 + (b) * 2 + (h)) * HTB)
#define PG8_STAGE(bufoff, gbase, voff) do { _Pragma("unroll") for (int _i = 0; _i < 2; ++_i) \
        __builtin_amdgcn_global_load_lds((const unsigned*)((const char*)(gbase) + (voff)[_i]), (LAS unsigned*)(lds + (bufoff) + ldsw + _i * 8192), 16, 0, 0); } while (0)
#define PG8_LDA(dst, b, h) do { _Pragma("unroll") for (int m = 0; m < 4; ++m) _Pragma("unroll") for (int k = 0; k < 2; ++k) dst[m][k] = *(const LAS bf16x8*)(lds + PG8_SA(b, h) + aoff + m * 2048 + k * 1024); } while (0)
#define PG8_LDB(dst, b, h) do { _Pragma("unroll") for (int n = 0; n < 2; ++n) _Pragma("unroll") for (int k = 0; k < 2; ++k) dst[n][k] = *(const LAS bf16x8*)(lds + PG8_SB(b, h) + boff + n * 2048 + k * 1024); } while (0)
#define PG8_MMA(ai, bj, At, Bt) do { __builtin_amdgcn_s_setprio(1); _Pragma("unroll") for (int m = 0; m < 4; ++m) _Pragma("unroll") for (int n = 0; n < 2; ++n) _Pragma("unroll") for (int k = 0; k < 2; ++k) \
        { if constexpr (I8) acc[ai][bj][m][n] = __builtin_bit_cast(f32x4, __builtin_amdgcn_mfma_i32_16x16x64_i8(__builtin_bit_cast(i32x4, Bt[n][k]), __builtin_bit_cast(i32x4, At[m][k]), __builtin_bit_cast(i32x4, acc[ai][bj][m][n]), 0, 0, 0)); \
          else acc[ai][bj][m][n] = __builtin_amdgcn_mfma_f32_16x16x32_bf16(Bt[n][k], At[m][k], acc[ai][bj][m][n], 0, 0, 0); } __builtin_amdgcn_s_setprio(0); } while (0)
#define PG8_MMA1(ai, At, Bt) do { if (!HALFCAP || full) PG8_MMA(ai, 1, At, Bt); } while (0)
#define PG8_WAIT_V(n) asm volatile("s_waitcnt vmcnt(" #n ")" ::: "memory")
#define PG8_WAIT_L(n) asm volatile("s_waitcnt lgkmcnt(" #n ")" ::: "memory")
#define PG8_BAR __builtin_amdgcn_s_barrier()
#define PG8_SCHED __builtin_amdgcn_sched_barrier(0)
#define PG8_KOFF(u) ((u).kq < 0 ? (size_t)0 : (size_t)(u).kq * (size_t)(K / 4) * 2)
#define PG8_APTR(u) ((const char*)g.A + (size_t)(u).pm * tstepA + (g.grouped ? (size_t)((u).pn >> 2) * (size_t)K * 2 : (size_t)0) + PG8_KOFF(u))
#define PG8_BPTR(u) ((const char*)g.Bt + (size_t)(u).pn * tstepB + PG8_KOFF(u))
    Unit cur, nxt; int ui = 0;
    if (!S.next(0, cur)) return;
    f32x4 acc[2][2][4][2];
#pragma unroll
    for (int a = 0; a < 2; ++a)
#pragma unroll
        for (int b = 0; b < 2; ++b)
#pragma unroll
            for (int m = 0; m < 4; ++m)
#pragma unroll
                for (int n = 0; n < 2; ++n) acc[a][b][m][n] = (f32x4){0.f, 0.f, 0.f, 0.f};
    bf16x8 At[4][2], B0[2][2], B1[2][2];
    const char* cA = PG8_APTR(cur); const char* cB = PG8_BPTR(cur);
    PG8_STAGE(PG8_SB(0, 0), cB, voffB); PG8_STAGE(PG8_SB(0, 1), cB + hstepB, voffB); PG8_STAGE(PG8_SA(0, 0), cA, voffA); PG8_STAGE(PG8_SA(0, 1), cA + hstepA, voffA);
    if (wr == 1) PG8_BAR;
    PG8_WAIT_V(2); PG8_BAR;
    PG8_STAGE(PG8_SB(1, 0), cB + kstep, voffB); PG8_STAGE(PG8_SA(1, 0), cA + kstep, voffA); PG8_STAGE(PG8_SB(1, 1), cB + hstepB + kstep, voffB);
    PG8_WAIT_V(6); PG8_BAR;
    for (;;) {
        const bool has_next = S.next(ui + 1, nxt);
        const char* nA = has_next ? PG8_APTR(nxt) : cA; const char* nB = has_next ? PG8_BPTR(nxt) : cB;
        const int nt = cur.kq < 0 ? ntf : ntf / 4; const bool full = !cur.half; (void)full;
        for (int t = 0; t < nt; t += 2) {
            const bool last = (t == nt - 2);
            const char* a1 = cA + (size_t)(t + 1) * kstep;
            const char* a2 = last ? nA : cA + (size_t)(t + 2) * kstep; const char* b2 = last ? nB : cB + (size_t)(t + 2) * kstep;
            const char* a3 = a2 + kstep; const char* b3 = b2 + kstep;
            PG8_LDB(B0, 0, 0); PG8_LDB(B1, 0, 1); PG8_SCHED; PG8_LDA(At, 0, 0); PG8_STAGE(PG8_SA(1, 1), a1 + hstepA, voffA);
            PG8_WAIT_V(8); PG8_WAIT_L(0); PG8_BAR; PG8_MMA(0, 0, At, B0); PG8_MMA1(0, At, B1); PG8_BAR; PG8_SCHED;
            PG8_LDA(At, 0, 1); PG8_STAGE(PG8_SB(0, 0), b2, voffB); PG8_STAGE(PG8_SB(0, 1), b2 + hstepB, voffB); PG8_STAGE(PG8_SA(0, 0), a2, voffA);
            PG8_WAIT_V(8); PG8_WAIT_L(0); PG8_BAR; PG8_MMA(1, 0, At, B0); PG8_MMA1(1, At, B1); PG8_BAR; PG8_SCHED;
            PG8_LDB(B0, 1, 0); PG8_LDB(B1, 1, 1); PG8_SCHED; PG8_LDA(At, 1, 0); PG8_STAGE(PG8_SA(0, 1), a2 + hstepA, voffA);
            PG8_WAIT_V(8); PG8_WAIT_L(0); PG8_BAR; PG8_MMA(0, 0, At, B0); PG8_MMA1(0, At, B1); PG8_BAR; PG8_SCHED;
            PG8_LDA(At, 1, 1); PG8_STAGE(PG8_SB(1, 0), b3, voffB); PG8_STAGE(PG8_SB(1, 1), b3 + hstepB, voffB); PG8_STAGE(PG8_SA(1, 0), a3, voffA);
            PG8_WAIT_V(8); PG8_WAIT_L(0); PG8_BAR; PG8_MMA(1, 0, At, B0); PG8_MMA1(1, At, B1); PG8_BAR; PG8_SCHED;
        }
        if constexpr (ALIGN_EPI) { if (wr == 0) PG8_BAR; }
        E(acc, cur, wr, wc, fr, fq);
        if (!has_next) break;
#pragma unroll
        for (int a = 0; a < 2; ++a)
#pragma unroll
            for (int b = 0; b < 2; ++b)
#pragma unroll
                for (int m = 0; m < 4; ++m)
#pragma unroll
                    for (int n = 0; n < 2; ++n) acc[a][b][m][n] = (f32x4){0.f, 0.f, 0.f, 0.f};
        cur = nxt; cA = nA; cB = nB; ++ui;
        if constexpr (ALIGN_EPI) { if (wr == 1) PG8_BAR; }
    }
    PG8_WAIT_V(0);
    if constexpr (!ALIGN_EPI) { if (wr == 0) PG8_BAR; }
    PG8_BAR;
#undef PG8_SA
#undef PG8_SB
#undef PG8_STAGE
#undef PG8_LDA
#undef PG8_LDB
#undef PG8_MMA
#undef PG8_MMA1
#undef PG8_WAIT_V
#undef PG8_WAIT_L
#undef PG8_BAR
#undef PG8_SCHED
#undef PG8_KOFF
#undef PG8_APTR
#undef PG8_BPTR
}
}

struct Params {
    const float *x_prompt, *x_sample, *cache_k, *cache_v, *cache_kidx, *state_pool, *norm_w, *final_norm_w, *attn_w_in, *attn_w_out, *rel_bias,
                *pool_w_in, *pool_group_w, *pool_scale, *pool_w_out;
    float* out; unsigned char* ws; int ph_lo, ph_hi;
};

__device__ __forceinline__ u32x4 pack8(const f32x4 a, const f32x4 b) { u32x4 w; w.x = cvt_pk_bf16(a[0], a[1]); w.y = cvt_pk_bf16(a[2], a[3]); w.z = cvt_pk_bf16(b[0], b[1]); w.w = cvt_pk_bf16(b[2], b[3]); return w; }
__device__ __forceinline__ f32x4 silu4(f32x4 v) { return (f32x4){silu_f(v[0]), silu_f(v[1]), silu_f(v[2]), silu_f(v[3])}; }

constexpr int UP_SEQ = SEQ + 16, US_SEQ = DSQ + 16, UP_ROWS = NBATCH * UP_SEQ;
__device__ __forceinline__ int u_row(int r) { return r < MP ? (r >> 12) * UP_SEQ + 16 + (r & 4095) : UP_ROWS + ((r - MP) >> 5) * US_SEQ + 16 + ((r - MP) & 31); }
__device__ __forceinline__ size_t kif_off(int s, int d0) { return ((size_t)(((s >> 5) * 4 + (d0 >> 4)) * 64 + ((d0 >> 3) & 1) * 32 + (s & 31))) * 8; }

struct Epi1a {
    static constexpr bool PERM = true;
    unsigned char* ws; float* out;
    __device__ __forceinline__ void operator()(const f32x4 (&acc)[2][2][4][2], const pg8::Unit& u, int wr, int wc, int fr, int fq) const {
        const int pn = u.pn; const float* SA = (const float*)(ws + WS_SA); const float* SB = (const float*)(ws + WS_SB);
#pragma unroll
        for (int bj = 0; bj < 2; ++bj) {
            const int lc = bj * 128 + wc * 32 + 8 * fq, gc = pn * 256 + lc;
            const f32x4 sb0 = *(const f32x4*)(SB + gc), sb1 = *(const f32x4*)(SB + gc + 4);
#pragma unroll
            for (int ai = 0; ai < 2; ++ai)
#pragma unroll
                for (int m = 0; m < 4; ++m) {
                    const int r = u.pm * 256 + ai * 128 + wr * 64 + m * 16 + fr; const float sa = SA[r];
                    const i32x4 i0 = __builtin_bit_cast(i32x4, acc[ai][bj][m][0]), i1 = __builtin_bit_cast(i32x4, acc[ai][bj][m][1]);
                    const f32x4 v0 = (f32x4){(float)i0[0], (float)i0[1], (float)i0[2], (float)i0[3]} * sb0 * sa, v1 = (f32x4){(float)i1[0], (float)i1[1], (float)i1[2], (float)i1[3]} * sb1 * sa;
                    if (pn < 16) *(u32x4*)((bf16_t*)(ws + WS_QB) + (size_t)r * DM + gc) = pack8(v0, v1);
                    else if (pn < 24) {
                        const bool isv = pn >= 20; const int c = (pn & 3) * 256 + lc; const bool samp = r >= MP; const int rs = r - MP;
                        bf16_t* dst; float* fo;
                        if (!samp) { dst = (bf16_t*)(ws + (isv ? WS_VP : WS_KP)) + (size_t)r * KVW + c; fo = out + (isv ? O_VP : O_KP) + (size_t)r * KVW + c; }
                        else { dst = (bf16_t*)(ws + (isv ? WS_VSN : WS_KSN)) + (size_t)rs * KVW + c; fo = out + (isv ? O_VS : O_KS) + (size_t)rs * KVW + c; }
                        *(u32x4*)dst = pack8(v0, v1); *(f32x4*)fo = v0; *(f32x4*)(fo + 4) = v1;
                    }
                    else *(u32x4*)((bf16_t*)(ws + WS_SG) + (size_t)r * DM + (gc - 6144)) = pack8(silu4(v0), silu4(v1));
                }
        }
    }
};
struct Epi1b {
    static constexpr bool PERM = true;
    unsigned char* ws; float* out;
    __device__ __forceinline__ void operator()(const f32x4 (&acc)[2][2][4][2], const pg8::Unit& u, int wr, int wc, int fr, int fq) const {
        const int pn = u.pn;
#pragma unroll
        for (int ai = 0; ai < 2; ++ai)
#pragma unroll
            for (int m = 0; m < 4; ++m) {
                const int r = u.pm * 256 + ai * 128 + wr * 64 + m * 16 + fr;
                const bool samp = r >= MP; const int rs = r - MP, sb = rs >> 5, st = rs & 31;
#pragma unroll
                for (int bj = 0; bj < 2; ++bj) {
                    const int lc = bj * 128 + wc * 32 + 8 * fq;
                    const f32x4 v0 = acc[ai][bj][m][0], v1 = acc[ai][bj][m][1];
                    if (pn < 8) {
                        const int c = pn * 256 + lc, h = c >> 6, d = c & 63;
                        *(u32x4*)((bf16_t*)(ws + WS_QIB) + ((((size_t)(r >> 5) * 32 + h) * 4 + (d >> 4)) * 2 + ((d >> 3) & 1)) * 256 + (r & 31) * 8) = pack8(v0, v1);
                    } else {
                        if (lc < 64) {
                            bf16_t* dst; float* fo;
                            if (!samp) { dst = (bf16_t*)(ws + WS_KIP) + (size_t)(r >> 12) * SEQ * DIDX + kif_off(r & 4095, lc); fo = out + O_KIP + (size_t)r * DIDX + lc; }
                            else { dst = (bf16_t*)(ws + WS_KIS) + (size_t)sb * SKV * DIDX + kif_off(PAST + st, lc); fo = out + O_KIS + (size_t)rs * DIDX + lc; }
                            *(u32x4*)dst = pack8(v0, v1); *(f32x4*)fo = v0; *(f32x4*)(fo + 4) = v1;
                        } else if (lc < 96) {
                            float* fo = (float*)(ws + WS_WIB) + (size_t)r * HIDX + (lc - 64);
                            *(f32x4*)fo = v0; *(f32x4*)(fo + 4) = v1;
                        }
                    }
                }
            }
    }
};
__device__ __forceinline__ f32x4 cvt_i32x4(const f32x4 a) { const i32x4 i = __builtin_bit_cast(i32x4, a); return (f32x4){(float)i[0], (float)i[1], (float)i[2], (float)i[3]}; }
struct EpiX1 {
    static constexpr bool PERM = false;
    const float* xp; float* X1; bf16_t* XB; float* PS; const float* SA; const float* SB;
    __device__ __forceinline__ void operator()(const f32x4 (&acc)[2][2][4][2], const pg8::Unit& u, int wr, int wc, int fr, int fq) const {
        f32x4 sb[2][2];
#pragma unroll
        for (int bj = 0; bj < 2; ++bj)
#pragma unroll
            for (int n = 0; n < 2; ++n) sb[bj][n] = *(const f32x4*)(SB + u.pn * 256 + bj * 128 + wc * 32 + n * 16 + 4 * fq);
#pragma unroll
        for (int ai = 0; ai < 2; ++ai)
#pragma unroll
            for (int m = 0; m < 4; ++m) {
                const int r = u.pm * 256 + ai * 128 + wr * 64 + m * 16 + fr; const float sa = SA[r];
                if (u.kq >= 0) {
                    float* d = PS + ((size_t)u.kq * MS + (r - MP)) * DM;
#pragma unroll
                    for (int bj = 0; bj < 2; ++bj)
#pragma unroll
                        for (int n = 0; n < 2; ++n) *(f32x4*)(d + u.pn * 256 + bj * 128 + wc * 32 + n * 16 + 4 * fq) = cvt_i32x4(acc[ai][bj][m][n]) * sb[bj][n] * sa;
                } else {
                    const float* b = xp + (size_t)r * DM; bf16_t* db = XB + (size_t)r * DM;
#pragma unroll
                    for (int bj = 0; bj < 2; ++bj)
#pragma unroll
                        for (int n = 0; n < 2; ++n) { const int c = u.pn * 256 + bj * 128 + wc * 32 + n * 16 + 4 * fq;
                            const f32x4 v = *(const f32x4*)(b + c) + cvt_i32x4(acc[ai][bj][m][n]) * sb[bj][n] * sa;
                            u32x2 w; w.x = cvt_pk_bf16(v[0], v[1]); w.y = cvt_pk_bf16(v[2], v[3]); *(u32x2*)(db + c) = w; }
                }
            }
    }
};
struct EpiX2 {
    static constexpr bool PERM = false;
    bf16_t* XB; float* PS; const float* SA; const float* SB;
    __device__ __forceinline__ void operator()(const f32x4 (&acc)[2][2][4][2], const pg8::Unit& u, int wr, int wc, int fr, int fq) const {
        f32x4 sb[2][2];
#pragma unroll
        for (int bj = 0; bj < 2; ++bj)
#pragma unroll
            for (int n = 0; n < 2; ++n) sb[bj][n] = *(const f32x4*)(SB + u.pn * 256 + bj * 128 + wc * 32 + n * 16 + 4 * fq);
#pragma unroll
        for (int ai = 0; ai < 2; ++ai)
#pragma unroll
            for (int m = 0; m < 4; ++m) {
                const int r = u.pm * 256 + ai * 128 + wr * 64 + m * 16 + fr; const float sa = SA[r];
                float* d = PS + ((size_t)(u.kq >= 0 ? u.kq : 0) * MS + (r - MP)) * DM; bf16_t* db = XB + (size_t)r * DM;
#pragma unroll
                for (int bj = 0; bj < 2; ++bj)
#pragma unroll
                    for (int n = 0; n < 2; ++n) { const int c = u.pn * 256 + bj * 128 + wc * 32 + n * 16 + 4 * fq; const f32x4 v = cvt_i32x4(acc[ai][bj][m][n]) * sb[bj][n] * sa;
                        if (u.kq >= 0) *(f32x4*)(d + c) = v;
                        else { const u32x2 x = *(const u32x2*)(db + c); u32x2 w; w.x = cvt_pk_bf16(bf_lo(x.x) + v[0], bf_hi(x.x) + v[1]); w.y = cvt_pk_bf16(bf_lo(x.y) + v[2], bf_hi(x.y) + v[3]); *(u32x2*)(db + c) = w; } }
            }
    }
};
struct Epi3 {
    static constexpr bool PERM = true;
    unsigned char* ws; float* out;
    __device__ __forceinline__ void operator()(const f32x4 (&acc)[2][2][4][2], const pg8::Unit& u, int wr, int wc, int fr, int fq) const {
        const int pn = u.pn; const float* ROWF = (const float*)(ws + WS_ROWF); const float* SB2 = (const float*)(ws + WS_SB2);
#pragma unroll
        for (int ai = 0; ai < 2; ++ai)
#pragma unroll
            for (int m = 0; m < 4; ++m) {
                const int r = u.pm * 256 + ai * 128 + wr * 64 + m * 16 + fr;
                const float rowf = ROWF[r];
                float* po = nullptr;
                if (r < MP) { const int t = r & 4095; if (t >= SEQ - 15) po = out + O_POOLP + ((size_t)(r >> 12) * 15 + (t - (SEQ - 15))) * DM; }
                else { const int rs = r - MP, t = rs & 31; if (t >= DSQ - 15) po = out + O_POOLS + ((size_t)(rs >> 5) * 15 + (t - (DSQ - 15))) * DM; }
#pragma unroll
                for (int bj = 0; bj < 2; ++bj) {
                    const int lc = bj * 128 + wc * 32 + 8 * fq;
                    const f32x4 s0 = *(const f32x4*)(SB2 + pn * 256 + lc), s1 = *(const f32x4*)(SB2 + pn * 256 + lc + 4);
                    const i32x4 i0 = __builtin_bit_cast(i32x4, acc[ai][bj][m][0]), i1 = __builtin_bit_cast(i32x4, acc[ai][bj][m][1]);
                    const f32x4 v0 = (f32x4){(float)i0[0], (float)i0[1], (float)i0[2], (float)i0[3]} * s0 * rowf, v1 = (f32x4){(float)i1[0], (float)i1[1], (float)i1[2], (float)i1[3]} * s1 * rowf;
                    if (pn < 16) {
                        const int c = pn * 256 + lc;
                        *(u32x4*)((bf16_t*)(ws + WS_U) + (size_t)u_row(r) * DM + c) = pack8(v0, v1);
                        if (po) { *(f32x4*)(po + c) = v0; *(f32x4*)(po + c + 4) = v1; }
                    } else {
                        *(u32x4*)((bf16_t*)(ws + WS_SG2) + (size_t)r * DM + (pn - 16) * 256 + lc) = pack8(silu4(v0), silu4(v1));
                    }
                }
            }
    }
};
struct Epi4 {
    static constexpr bool PERM = true;
    unsigned char* ws; const float* scale;
    __device__ __forceinline__ void operator()(const f32x4 (&acc)[2][2][4][2], const pg8::Unit& u, int wr, int wc, int fr, int fq) const {
#pragma unroll
        for (int bj = 0; bj < 2; ++bj) {
            const int c = u.pn * 256 + bj * 128 + wc * 32 + 8 * fq;
            const f32x4 s0 = *(const f32x4*)(scale + c), s1 = *(const f32x4*)(scale + c + 4);
#pragma unroll
            for (int ai = 0; ai < 2; ++ai)
#pragma unroll
                for (int m = 0; m < 4; ++m) {
                    const int r = u.pm * 256 + ai * 128 + wr * 64 + m * 16 + fr;
                    const u32x4 gw = *(const u32x4*)((const bf16_t*)(ws + WS_SG2) + (size_t)r * DM + c);
                    const f32x4 g0 = (f32x4){bf_lo(gw.x), bf_hi(gw.x), bf_lo(gw.y), bf_hi(gw.y)}, g1 = (f32x4){bf_lo(gw.z), bf_hi(gw.z), bf_lo(gw.w), bf_hi(gw.w)};
                    *(u32x4*)((bf16_t*)(ws + WS_ZG) + (size_t)r * DM + c) = pack8(acc[ai][bj][m][0] * s0 * g0, acc[ai][bj][m][1] * s1 * g1);
                }
        }
    }
};

__device__ __forceinline__ void transpose_item(const float* W, int N, int k0, int n0, bf16_t* WT, int K, int drow0, int nvalid, LAS float* scr, int lane) {
    const int cq = lane & 15, rq = lane >> 4;
    const float* src = W + (size_t)(k0 + 4 * rq) * N + n0 + 4 * cq;
    f32x4 a[16];
#pragma unroll
    for (int g = 0; g < 4; ++g)
#pragma unroll
        for (int i = 0; i < 4; ++i) a[g * 4 + i] = *(const f32x4*)(src + (size_t)(16 * g + i) * N);
    LAS unsigned char* T = (LAS unsigned char*)scr;
#pragma unroll
    for (int g = 0; g < 4; ++g)
#pragma unroll
        for (int c = 0; c < 4; ++c) { u32x2 o; o.x = cvt_pk_bf16(a[g * 4 + 0][c], a[g * 4 + 1][c]); o.y = cvt_pk_bf16(a[g * 4 + 2][c], a[g * 4 + 3][c]);
            *(LAS u32x2*)(T + (4 * cq + c) * 136 + 32 * g + 8 * rq) = o; }
    LDS_WAIT(); asm volatile("" ::: "memory");
    const int kc = lane & 7;
#pragma unroll
    for (int sI = 0; sI < 8; ++sI) { const int n = 8 * sI + (lane >> 3);
        const u32x2 lo = *(const LAS u32x2*)(T + n * 136 + 16 * kc), hi = *(const LAS u32x2*)(T + n * 136 + 16 * kc + 8);
        if (n < nvalid) *(u32x4*)(WT + (size_t)(drow0 + n) * K + k0 + 8 * kc) = (u32x4){lo.x, lo.y, hi.x, hi.y}; }
    LDS_WAIT(); asm volatile("" ::: "memory");
}
__device__ __forceinline__ unsigned q8(float v) { return (unsigned)(int)__builtin_rintf(v) & 0xffu; }
__device__ __forceinline__ unsigned q8x4(float a, float b, float c, float d) { return q8(a) | (q8(b) << 8) | (q8(c) << 16) | (q8(d) << 24); }
__device__ __forceinline__ void transpose_item_i8(const float* W, int N, int k0, int n0, signed char* WT, int K, int drow0, LAS float* scr, int lane, const unsigned* camax, float* sbout, const float* kscale = nullptr) {
    const int cq = lane & 15, rq = lane >> 4;
    const float* src = W + (size_t)(k0 + 4 * rq) * N + n0 + 4 * cq;
    f32x4 ks[8];
    if (kscale) {
#pragma unroll
        for (int g = 0; g < 8; ++g) ks[g] = *(const f32x4*)(kscale + k0 + 16 * g + 4 * rq); }
    const u32x4 cm = *(const u32x4*)(camax + drow0 + 4 * cq);
    f32x4 a[32];
#pragma unroll
    for (int g = 0; g < 8; ++g)
#pragma unroll
        for (int i = 0; i < 4; ++i) a[g * 4 + i] = *(const f32x4*)(src + (size_t)(16 * g + i) * N);
    f32x4 inv;
#pragma unroll
    for (int c = 0; c < 4; ++c) { const float am = __uint_as_float(cm[c]); inv[c] = am > 0.f ? 127.0f / am : 0.f; }
    LAS unsigned char* T = (LAS unsigned char*)scr;
#pragma unroll
    for (int g = 0; g < 8; ++g) {
        f32x4 r0 = a[g * 4 + 0] * inv, r1 = a[g * 4 + 1] * inv, r2 = a[g * 4 + 2] * inv, r3 = a[g * 4 + 3] * inv;
        if (kscale) { r0 = r0 * ks[g][0]; r1 = r1 * ks[g][1]; r2 = r2 * ks[g][2]; r3 = r3 * ks[g][3]; }
#pragma unroll
        for (int c = 0; c < 4; ++c) *(LAS unsigned*)(T + (4 * cq + c) * 132 + 16 * g + 4 * rq) = q8x4(r0[c], r1[c], r2[c], r3[c]);
    }
    LDS_WAIT(); asm volatile("" ::: "memory");
    const int kc = lane & 7;
#pragma unroll
    for (int sI = 0; sI < 8; ++sI) { const int n = 8 * sI + (lane >> 3); const LAS unsigned* tp = (const LAS unsigned*)(T + n * 132 + 16 * kc);
        *(u32x4*)(WT + (size_t)(drow0 + n) * K + k0 + 16 * kc) = (u32x4){tp[0], tp[1], tp[2], tp[3]}; }
    if (k0 == 0) sbout[drow0 + lane] = __uint_as_float(camax[drow0 + lane]) * (1.0f / 127.0f);
    LDS_WAIT(); asm volatile("" ::: "memory");
}
template <bool KS>
__device__ __forceinline__ f32x4 col_amax64(const float* wp, size_t stride, const float* nw) {
    f32x4 m = (f32x4){0.f, 0.f, 0.f, 0.f}; f32x4 a[8], b[8];
#define CA_LD(dst) do { _Pragma("unroll") for (int i = 0; i < 8; ++i) dst[i] = *(const f32x4*)(wp + (size_t)i * stride); wp += 8 * stride; asm volatile("" ::: "memory"); } while (0)
#define CA_USE(src) do { _Pragma("unroll") for (int i = 0; i < 8; ++i) { f32x4 x = src[i]; if (KS) x = x * nw[i]; \
        m.x = fmaxf(m.x, fabsf(x.x)); m.y = fmaxf(m.y, fabsf(x.y)); m.z = fmaxf(m.z, fabsf(x.z)); m.w = fmaxf(m.w, fabsf(x.w)); } if (KS) nw += 8; } while (0)
    CA_LD(a);
#pragma unroll 1
    for (int kb = 0; kb < 4; ++kb) {
        CA_LD(b);
        CA_USE(a);
        if (kb < 3) CA_LD(a);
        CA_USE(b);
    }
#undef CA_LD
#undef CA_USE
    return m;
}
__device__ __forceinline__ void rms_row_q(f32x4 (&v)[16], const LAS f32x4* w, bf16_t* orow, signed char* qrow, float* sa, int lane) {
    const LAS f32x4* wr = w + lane;
    float s = 0.f;
#pragma unroll
    for (int j = 0; j < 16; ++j) s += (v[j].x * v[j].x + v[j].y * v[j].y) + (v[j].z * v[j].z + v[j].w * v[j].w);
    const float rstd = 1.0f / sqrtf(wave_sum(s) * (1.0f / DM) + EPS);
    float am = 0.f;
#pragma unroll
    for (int j = 0; j < 16; ++j) { v[j] = v[j] * rstd * wr[64 * j]; am = fmaxf(am, fmaxf(fmaxf(fabsf(v[j].x), fabsf(v[j].y)), fmaxf(fabsf(v[j].z), fabsf(v[j].w))));
        u32x2 o; o.x = cvt_pk_bf16(v[j].x, v[j].y); o.y = cvt_pk_bf16(v[j].z, v[j].w); ((u32x2*)orow + lane)[64 * j] = o;
        if ((j & 3) == 3) asm volatile("" ::: "memory"); }
#pragma unroll
    for (int o = 1; o < 64; o <<= 1) am = fmaxf(am, __shfl_xor(am, o));
    const float inv = am > 0.f ? 127.0f / am : 0.f;
#pragma unroll
    for (int j = 0; j < 16; ++j) ((unsigned*)qrow + lane)[64 * j] = q8x4(v[j].x * inv, v[j].y * inv, v[j].z * inv, v[j].w * inv);
    if (lane == 0) *sa = am * (1.0f / 127.0f);
}
template <class F>
__device__ __forceinline__ void quant_rows_bf16(const bf16_t* src, signed char* dst, int M, int gw, int NGW, int lane, F fin) {
    u32x4 x[8], xn[8];
    if (gw < M) {
#pragma unroll
        for (int j = 0; j < 8; ++j) x[j] = ((const u32x4*)(src + (size_t)gw * DM) + lane)[64 * j]; }
#pragma unroll 1
    for (int m = gw; m < M; m += NGW) {
        if (m + NGW < M) {
#pragma unroll
            for (int j = 0; j < 8; ++j) xn[j] = ((const u32x4*)(src + (size_t)(m + NGW) * DM) + lane)[64 * j]; }
        float am = 0.f, ss = 0.f;
#pragma unroll
        for (int j = 0; j < 8; ++j) {
            const float f[8] = {bf_lo(x[j].x), bf_hi(x[j].x), bf_lo(x[j].y), bf_hi(x[j].y), bf_lo(x[j].z), bf_hi(x[j].z), bf_lo(x[j].w), bf_hi(x[j].w)};
#pragma unroll
            for (int e = 0; e < 8; ++e) { am = fmaxf(am, fabsf(f[e])); ss = fmaf(f[e], f[e], ss); } }
#pragma unroll
        for (int o = 1; o < 64; o <<= 1) am = fmaxf(am, __shfl_xor(am, o));
        ss = wave_sum(ss);
        const float inv = am > 0.f ? 127.0f / am : 0.f;
        u32x2* q = (u32x2*)(dst + (size_t)m * DM) + lane;
#pragma unroll
        for (int j = 0; j < 8; ++j) { u32x2 o; o.x = q8x4(bf_lo(x[j].x) * inv, bf_hi(x[j].x) * inv, bf_lo(x[j].y) * inv, bf_hi(x[j].y) * inv);
            o.y = q8x4(bf_lo(x[j].z) * inv, bf_hi(x[j].z) * inv, bf_lo(x[j].w) * inv, bf_hi(x[j].w) * inv); q[64 * j] = o; }
        fin(m, am, ss);
#pragma unroll
        for (int j = 0; j < 8; ++j) x[j] = xn[j];
    }
}
template <bool F32OUT>
__device__ __forceinline__ void rms_row(const float* xrow, const float* w, void* orow, int lane) {
    const f32x4* xr = (const f32x4*)xrow + lane; const f32x4* wr = (const f32x4*)w + lane;
    f32x4 v[16]; float s = 0.f;
#pragma unroll
    for (int j = 0; j < 16; ++j) { v[j] = xr[64 * j]; s += (v[j].x * v[j].x + v[j].y * v[j].y) + (v[j].z * v[j].z + v[j].w * v[j].w); }
    const float rstd = 1.0f / sqrtf(wave_sum(s) * (1.0f / DM) + EPS);
#pragma unroll
    for (int j = 0; j < 16; ++j) { const f32x4 g = wr[64 * j]; const f32x4 y = v[j] * rstd * g;
        if (F32OUT) ((f32x4*)orow + lane)[64 * j] = y;
        else { u32x2 o; o.x = cvt_pk_bf16(y.x, y.y); o.y = cvt_pk_bf16(y.z, y.w); ((u32x2*)orow + lane)[64 * j] = o; } }
}

__device__ __forceinline__ unsigned ord_key(float f) { const unsigned b = __float_as_uint(f); return (b & 0x80000000u) ? ~b : (b | 0x80000000u); }
constexpr int NVJ = 65;
constexpr int SC_WT_OFF = RING_BYTES + 1024;
constexpr int SC_QB_OFF = SC_WT_OFF + 4096;
__device__ __forceinline__ void score_tiles(const bf16_t* __restrict__ qif, const float* __restrict__ wi, const bf16_t* __restrict__ kif, float* __restrict__ sc,
                                            int kt0, int step, int count, LAS unsigned char* lds) {
    int tid = threadIdx.x; asm volatile("" : "+v"(tid));
    const int wid = __builtin_amdgcn_readfirstlane(tid >> 6), lane = tid & 63, r32 = lane & 31, hi = lane >> 5;
    constexpr float WSC = 0.5f * 0.125f * 0.17677669529663687f;
    __syncthreads();
    {   const u32x4* src = (const u32x4*)qif; LAS u32x4* dst = (LAS u32x4*)lds;
        u32x4 t[16];
#pragma unroll
        for (int i = 0; i < 16; ++i) t[i] = src[tid + 512 * i];
#pragma unroll
        for (int i = 0; i < 16; ++i) dst[tid + 512 * i] = t[i];
        LAS float* wt = (LAS float*)(lds + SC_WT_OFF);
#pragma unroll
        for (int e = tid; e < 1024; e += NTHREADS) { const int h = e >> 5, hh = (e >> 4) & 1, r = e & 15, q = (r & 3) + 8 * (r >> 2) + 4 * hh;
            wt[e] = wi[q * HIDX + h] * WSC; }
    }
    __syncthreads();
    if (tid < 256) {
        const int q = tid >> 3, ch = tid & 7; float acc[8] = {0.f, 0.f, 0.f, 0.f, 0.f, 0.f, 0.f, 0.f};
        const LAS u32x4* Af = (const LAS u32x4*)lds + ch * 32 + q;
        const LAS float* wtq = (const LAS float*)(lds + SC_WT_OFF) + ((q >> 2) & 1) * 16 + (q & 3) + 4 * (q >> 3);
#pragma unroll 4
        for (int h = 0; h < 32; ++h) { const float w = wtq[h * 32]; const u32x4 x = Af[h * 256];
            acc[0] = fmaf(w, bf_lo(x.x), acc[0]); acc[1] = fmaf(w, bf_hi(x.x), acc[1]); acc[2] = fmaf(w, bf_lo(x.y), acc[2]); acc[3] = fmaf(w, bf_hi(x.y), acc[3]);
            acc[4] = fmaf(w, bf_lo(x.z), acc[4]); acc[5] = fmaf(w, bf_hi(x.z), acc[5]); acc[6] = fmaf(w, bf_lo(x.w), acc[6]); acc[7] = fmaf(w, bf_hi(x.w), acc[7]); }
        u32x4 vh, vl;
        vh.x = cvt_pk_bf16(acc[0], acc[1]); vh.y = cvt_pk_bf16(acc[2], acc[3]); vh.z = cvt_pk_bf16(acc[4], acc[5]); vh.w = cvt_pk_bf16(acc[6], acc[7]);
        vl.x = cvt_pk_bf16(acc[0] - bf_lo(vh.x), acc[1] - bf_hi(vh.x)); vl.y = cvt_pk_bf16(acc[2] - bf_lo(vh.y), acc[3] - bf_hi(vh.y));
        vl.z = cvt_pk_bf16(acc[4] - bf_lo(vh.z), acc[5] - bf_hi(vh.z)); vl.w = cvt_pk_bf16(acc[6] - bf_lo(vh.w), acc[7] - bf_hi(vh.w));
        LAS u32x4* qb = (LAS u32x4*)(lds + SC_QB_OFF);
        qb[ch * 32 + q] = vh; qb[256 + ch * 32 + q] = vl;
    }
    __syncthreads();
    const LAS bf16x8* A = (const LAS bf16x8*)lds + lane;
    const LAS bf16x8* QBF = (const LAS bf16x8*)(lds + SC_QB_OFF) + lane;
    const LAS f32x4* W4 = (const LAS f32x4*)(lds + SC_WT_OFF) + hi * 4;
#define FMA8(NOP, S, W, C, B, X) asm volatile(NOP "v_fma_f32 %0, %8, |%16|, %0\n\tv_fma_f32 %1, %9, |%17|, %1\n\tv_fma_f32 %2, %10, |%18|, %2\n\tv_fma_f32 %3, %11, |%19|, %3\n\t" \
        "v_fma_f32 %4, %12, |%20|, %4\n\tv_fma_f32 %5, %13, |%21|, %5\n\tv_fma_f32 %6, %14, |%22|, %6\n\tv_fma_f32 %7, %15, |%23|, %7" \
        : "+v"(S[B + 0]), "+v"(S[B + 1]), "+v"(S[B + 2]), "+v"(S[B + 3]), "+v"(S[B + 4]), "+v"(S[B + 5]), "+v"(S[B + 6]), "+v"(S[B + 7]) \
        : "v"(W[B + 0]), "v"(W[B + 1]), "v"(W[B + 2]), "v"(W[B + 3]), "v"(W[B + 4]), "v"(W[B + 5]), "v"(W[B + 6]), "v"(W[B + 7]), \
          "v"(C[B + 0]), "v"(C[B + 1]), "v"(C[B + 2]), "v"(C[B + 3]), "v"(C[B + 4]), "v"(C[B + 5]), "v"(C[B + 6]), "v"(C[B + 7]), "v"(X))
#define SC_LDA(dst, h) do { _Pragma("unroll") for (int ks = 0; ks < 4; ++ks) dst[ks] = A[((h) * 4 + ks) * 64]; } while (0)
#define SC_STEP(a, h) do { const f32x4 w0 = W4[(h) * 8 + 0], w1 = W4[(h) * 8 + 1], w2 = W4[(h) * 8 + 2], w3 = W4[(h) * 8 + 3]; \
        const float w[16] = {w0.x, w0.y, w0.z, w0.w, w1.x, w1.y, w1.z, w1.w, w2.x, w2.y, w2.z, w2.w, w3.x, w3.y, w3.z, w3.w}; \
        f32x16 c0 = {}, c1 = {}; \
        _Pragma("unroll") for (int ks = 0; ks < 4; ++ks) { c0 = __builtin_amdgcn_mfma_f32_32x32x16_bf16(a[ks], b0[ks], c0, 0, 0, 0); c1 = __builtin_amdgcn_mfma_f32_32x32x16_bf16(a[ks], b1[ks], c1, 0, 0, 0); } \
        FMA8("s_nop 11\n\t", s0, w, c0, 0, c1[15]); FMA8("", s0, w, c0, 8, c1[15]); FMA8("", s1, w, c1, 0, c1[15]); FMA8("", s1, w, c1, 8, c1[15]); } while (0)
    for (int idx = wid; idx < count; idx += NWAVES) {
        const int kt = kt0 + step * idx;
        const bf16x8* kb = (const bf16x8*)kif + (size_t)kt * 512 + lane;
        bf16x8 b0[4], b1[4];
#pragma unroll
        for (int ks = 0; ks < 4; ++ks) { b0[ks] = kb[ks * 64]; b1[ks] = kb[(4 + ks) * 64]; }
        f32x16 s0 = {}, s1 = {};
#pragma unroll
        for (int ks = 0; ks < 4; ++ks) { const bf16x8 qh = QBF[ks * 64], ql = QBF[256 + ks * 64];
            s0 = __builtin_amdgcn_mfma_f32_32x32x16_bf16(qh, b0[ks], s0, 0, 0, 0); s1 = __builtin_amdgcn_mfma_f32_32x32x16_bf16(qh, b1[ks], s1, 0, 0, 0);
            s0 = __builtin_amdgcn_mfma_f32_32x32x16_bf16(ql, b0[ks], s0, 0, 0, 0); s1 = __builtin_amdgcn_mfma_f32_32x32x16_bf16(ql, b1[ks], s1, 0, 0, 0); }
        bf16x8 aA[4], aB[4];
        SC_LDA(aA, 0);
#pragma unroll 1
        for (int h = 0; h < 32; h += 2) {
            SC_LDA(aB, h + 1);
            { bf16x8 (&a)[4] = aA; SC_STEP(a, h); }
            if (h + 2 < 32) SC_LDA(aA, h + 2);
            { bf16x8 (&a)[4] = aB; SC_STEP(a, h + 1); }
        }
        float* o = sc + (size_t)kt * 64 + r32;
#pragma unroll
        for (int r = 0; r < 16; ++r) { const int q = (r & 3) + 8 * (r >> 2) + 4 * hi; o[(size_t)q * SCW] = s0[r]; o[(size_t)q * SCW + 32] = s1[r]; }
    }
#undef SC_LDA
#undef SC_STEP
#undef FMA8
}
__device__ __forceinline__ void sel_load(const float* __restrict__ sc, int nt, float (&vv)[NVJ], int lane) {
    if (nt <= 4) return;
    const int ng = (nt + 3) >> 2;
#pragma unroll
    for (int g = 0; g < 16; ++g) if (g < ng) {
#pragma unroll
        for (int i = 0; i < 4; ++i) vv[4 * g + i] = sc[(4 * g + i) * 64 + lane]; }
    if (ng > 16) vv[64] = sc[64 * 64 + lane];
}
__device__ __forceinline__ void select_row(float (&vv)[NVJ], int nt, int nvalid, u64* __restrict__ rm, const float* __restrict__ sc_next, int nt_next, int lane) {
    if (nt <= 4) { if (lane < nt) rm[lane] = ~0ull; sel_load(sc_next, nt_next, vv, lane); return; }
    unsigned uk[NVJ];
    { const int ng = (nt + 3) >> 2;
#pragma unroll
      for (int j = 0; j < NVJ; ++j) uk[j] = ((j >> 2) < ng && j * 64 + lane < nvalid) ? ord_key(vv[j]) : 0u; }
    sel_load(sc_next, nt_next, vv, lane);
#define CNTV(cnt, thr, x) asm volatile("v_cmp_le_u32 vcc, %1, %2\n\tv_addc_co_u32 %0, vcc, 0, %0, vcc" : "+v"(cnt) : "v"(thr), "v"(x) : "vcc")
    const int ng = (nt + 3) >> 2;
    unsigned T = 0u; int cT = 0;
    for (int bit = 31; bit >= 0; --bit) {
        const unsigned cand = T | (1u << bit); int cl = 0;
#pragma unroll
        for (int g = 0; g < 16; ++g) if (g < ng) { CNTV(cl, cand, uk[4 * g]); CNTV(cl, cand, uk[4 * g + 1]); CNTV(cl, cand, uk[4 * g + 2]); CNTV(cl, cand, uk[4 * g + 3]); }
        if (ng > 16) CNTV(cl, cand, uk[64]);
        cl += __builtin_amdgcn_update_dpp(0, cl, 0xB1, 0xf, 0xf, false);
        cl += __builtin_amdgcn_update_dpp(0, cl, 0x4E, 0xf, 0xf, false);
        cl += __builtin_amdgcn_update_dpp(0, cl, 0x141, 0xf, 0xf, false);
        cl += __builtin_amdgcn_update_dpp(0, cl, 0x140, 0xf, 0xf, false);
        const int cnt = (__builtin_amdgcn_readlane(cl, 0) + __builtin_amdgcn_readlane(cl, 16)) + (__builtin_amdgcn_readlane(cl, 32) + __builtin_amdgcn_readlane(cl, 48));
        if (cnt >= 256) { T = cand; cT = cnt; if (cnt == 256) break; }
    }
#undef CNTV
    if (cT == 256) {
        unsigned wlo = 0u, whi = 0u;
#pragma unroll
        for (int j = 0; j < 64; ++j)
            asm volatile("v_cmp_le_u32 vcc, %2, %3\n\ts_nop 4\n\tv_writelane_b32 %0, vcc_lo, %4\n\tv_writelane_b32 %1, vcc_hi, %4" : "+v"(wlo), "+v"(whi) : "s"(T), "v"(uk[j]), "i"(j) : "vcc");
        u64 mk64; asm volatile("v_cmp_le_u32 %0, %1, %2" : "=s"(mk64) : "s"(T), "v"(uk[64]));
        rm[lane] = ((u64)whi << 32) | wlo;
        if (lane == 0) rm[64] = mk64;
    } else {
        int cgt = 0;
#pragma unroll
        for (int j = 0; j < NVJ; ++j) { u64 t0_; asm volatile("v_cmp_lt_u32 %0, %1, %2" : "=&s"(t0_) : "s"(T), "v"(uk[j])); cgt += __builtin_popcountll(t0_); }
        int need = 256 - cgt;
#pragma unroll
        for (int j = 0; j < NVJ; ++j) {
            u64 gt, eq; asm volatile("v_cmp_lt_u32 %0, %1, %2" : "=s"(gt) : "s"(T), "v"(uk[j])); asm volatile("v_cmp_eq_u32 %0, %1, %2" : "=s"(eq) : "s"(T), "v"(uk[j]));
            const int below = __builtin_popcountll(eq & ((1ull << lane) - 1ull));
            const u64 take = __ballot(((eq >> lane) & 1ull) && below < need);
            need -= __builtin_popcountll(take);
            if (lane == 0) rm[j] = gt | take;
        }
    }
}

namespace att {
constexpr int D = 128, KVBLK = 64;
constexpr float SCALE = 0.088388347648318440f;
constexpr float THR = 8.f;
constexpr float NEG = -1e30f, MINIT = -1e20f;
constexpr size_t SHM_V = KVBLK * D * 2, SHM_K = KVBLK * D * 2;
constexpr size_t OFF_WS = 2 * SHM_V + 2 * SHM_K, OFF_TB = OFF_WS + 8 * 64 * 4, OFF_MK = OFF_TB + 4 * 256 * 4, LDS_ATTN = OFF_MK + 64 * 65 * 8;
static_assert(LDS_ATTN <= 131072, "attention LDS");
#define KSWZ(row, colB) ((row) * 256 + ((colB) ^ (((row) & 7) << 4)))
#define SBAR() __builtin_amdgcn_sched_barrier(0)
__device__ __forceinline__ int crow(int r, int hi) { return (r & 3) + 8 * (r >> 2) + 4 * hi; }
__device__ __forceinline__ void partialSM(f32x16& p0, f32x16& p1, float& m_reg, float& mn, float& alpha) {
    constexpr float C = SCALE * 1.4426950408889634f;
    float pmax = p0[0];
#pragma unroll
    for (int r = 1; r < 16; ++r) pmax = fmaxf(pmax, p0[r]);
#pragma unroll
    for (int r = 0; r < 16; ++r) pmax = fmaxf(pmax, p1[r]);
    { auto rr = __builtin_amdgcn_permlane32_swap(__float_as_uint(pmax), __float_as_uint(pmax), false, false);
      pmax = fmaxf(__uint_as_float(rr[0]), __uint_as_float(rr[1])); }
    if (__builtin_expect(__all(pmax - m_reg <= THR / SCALE), 1)) { mn = m_reg; alpha = 1.f; }
    else { mn = fmaxf(m_reg, pmax); alpha = __builtin_amdgcn_exp2f((m_reg - mn) * C); m_reg = mn; }
    const float mnC = -mn * C;
#pragma unroll
    for (int r = 0; r < 16; ++r) p0[r] = fmaf(p0[r], C, mnC);
#pragma unroll
    for (int r = 0; r < 16; ++r) p1[r] = fmaf(p1[r], C, mnC);
#pragma unroll
    for (int r = 0; r < 16; ++r) p0[r] = __builtin_amdgcn_exp2f(p0[r]);
}
__device__ __forceinline__ void finishSM(f32x16& p0, f32x16& p1, float alpha, float& l_reg, bf16x8& pa0, bf16x8& pa1, bf16x8& pa2, bf16x8& pa3) {
#pragma unroll
    for (int r = 0; r < 16; ++r) p1[r] = __builtin_amdgcn_exp2f(p1[r]);
    float ps = 0;
#pragma unroll
    for (int r = 0; r < 16; ++r) ps += p0[r];
#pragma unroll
    for (int r = 0; r < 16; ++r) ps += p1[r];
    { auto rr = __builtin_amdgcn_permlane32_swap(__float_as_uint(ps), __float_as_uint(ps), false, false);
      ps = __uint_as_float(rr[0]) + __uint_as_float(rr[1]); }
    l_reg = l_reg * alpha + ps;
#define PK4(P, BASE, OUT) do { unsigned a0 = cvt_pk_bf16(P[BASE + 0], P[BASE + 1]), a1 = cvt_pk_bf16(P[BASE + 2], P[BASE + 3]);   \
    unsigned b0 = cvt_pk_bf16(P[BASE + 4], P[BASE + 5]), b1 = cvt_pk_bf16(P[BASE + 6], P[BASE + 7]);                              \
    auto r0 = __builtin_amdgcn_permlane32_swap(a0, b0, false, false); auto r1 = __builtin_amdgcn_permlane32_swap(a1, b1, false, false); \
    u32x4 w = {r0[0], r1[0], r0[1], r1[1]}; OUT = *reinterpret_cast<bf16x8*>(&w); } while (0)
    PK4(p0, 0, pa0); PK4(p0, 8, pa1); PK4(p1, 0, pa2); PK4(p1, 8, pa3);
#undef PK4
}
__device__ __forceinline__ void qkt(f32x16& p0, f32x16& p1, const LAS char* Ks, const bf16x8* qr, int r32, int hi) {
    p0 = f32x16{}; p1 = f32x16{};
#pragma unroll
    for (int d0 = 0; d0 < 8; ++d0) { const int cb = (d0 * 16 + hi * 8) * 2;
        const bf16x8 b0 = *(const LAS bf16x8*)(Ks + KSWZ(r32, cb));
        const bf16x8 b1 = *(const LAS bf16x8*)(Ks + KSWZ(32 + r32, cb));
        p0 = __builtin_amdgcn_mfma_f32_32x32x16_bf16(b0, qr[d0], p0, 0, 0, 0);
        p1 = __builtin_amdgcn_mfma_f32_32x32x16_bf16(b1, qr[d0], p1, 0, 0, 0); }
}
__device__ __forceinline__ int v_st(int k, int c) { const int kk = (k & ~0xC) | ((k & 4) << 1) | ((k & 8) >> 1); return ((kk >> 3) * 4 + (c >> 5)) * 512 + ((kk & 7) * 32 + (c & 31)) * 2; }
__device__ __forceinline__ int v_rd_base(int lane) { return ((lane & 3) << 3) | (((lane >> 2) & 3) << 6) | (((lane >> 4) & 1) << 5) | (((lane >> 5) & 1) << 8); }
constexpr int v_rd_off(int d0, int ks, int half) { return d0 * 512 + ks * 4096 + half * 2048; }
template <int OFF> __device__ __forceinline__ s16x4 tr_read(int vb) {
    s16x4 r; asm volatile("ds_read_b64_tr_b16 %0, %1 offset:%2" : "=&v"(r) : "v"(vb), "i"(OFF) : "memory"); return r;
}
template <int D0> __device__ __forceinline__ void pv_one(f32x16& od, int vb, bf16x8 pa0, bf16x8 pa1, bf16x8 pa2, bf16x8 pa3) {
    const s16x4 l0 = tr_read<v_rd_off(D0, 0, 0)>(vb), h0 = tr_read<v_rd_off(D0, 0, 1)>(vb), l1 = tr_read<v_rd_off(D0, 1, 0)>(vb), h1 = tr_read<v_rd_off(D0, 1, 1)>(vb);
    const s16x4 l2 = tr_read<v_rd_off(D0, 2, 0)>(vb), h2 = tr_read<v_rd_off(D0, 2, 1)>(vb), l3 = tr_read<v_rd_off(D0, 3, 0)>(vb), h3 = tr_read<v_rd_off(D0, 3, 1)>(vb);
    asm volatile("s_waitcnt lgkmcnt(0)" ::: "memory"); SBAR();
#define PK(L, H) (bf16x8){L[0], L[1], L[2], L[3], H[0], H[1], H[2], H[3]}
    od = __builtin_amdgcn_mfma_f32_32x32x16_bf16(pa0, PK(l0, h0), od, 0, 0, 0);
    od = __builtin_amdgcn_mfma_f32_32x32x16_bf16(pa1, PK(l1, h1), od, 0, 0, 0);
    od = __builtin_amdgcn_mfma_f32_32x32x16_bf16(pa2, PK(l2, h2), od, 0, 0, 0);
    od = __builtin_amdgcn_mfma_f32_32x32x16_bf16(pa3, PK(l3, h3), od, 0, 0, 0);
#undef PK
}
__device__ __forceinline__ void pv_d0(f32x16* o, int vb, bf16x8 pa0, bf16x8 pa1, bf16x8 pa2, bf16x8 pa3) {
    pv_one<0>(o[0], vb, pa0, pa1, pa2, pa3); pv_one<1>(o[1], vb, pa0, pa1, pa2, pa3); pv_one<2>(o[2], vb, pa0, pa1, pa2, pa3); pv_one<3>(o[3], vb, pa0, pa1, pa2, pa3);
}
__device__ __forceinline__ void mask_bias(f32x16& p0, f32x16& p1, u64 mw, bool near, const LAS float* tbk, int hi) {
    if (near) {
#pragma unroll
        for (int r = 0; r < 16; ++r) { const int b = (r & 3) + 8 * (r >> 2); p0[r] += tbk[b]; p1[r] += tbk[32 + b]; }
    }
    const unsigned lo = (unsigned)mw >> (4 * hi), hh = (unsigned)(mw >> 32) >> (4 * hi);
#pragma unroll
    for (int r = 0; r < 16; ++r) { const int b = (r & 3) + 8 * (r >> 2);
        const unsigned m0 = (unsigned)__builtin_amdgcn_sbfe((int)lo, b, 1), m1 = (unsigned)__builtin_amdgcn_sbfe((int)hh, b, 1);
        p0[r] = __uint_as_float((m0 & __float_as_uint(p0[r])) | (~m0 & __float_as_uint(NEG)));
        p1[r] = __uint_as_float((m1 & __float_as_uint(p1[r])) | (~m1 & __float_as_uint(NEG))); }
}

__device__ __forceinline__ void og_store_rows(const LAS char* st, const bf16_t* __restrict__ SGg, bf16_t* __restrict__ OGg, int kvh, int nrows, int tid) {
    for (int c = tid; c < nrows * 64; c += NTHREADS) { const int row = c >> 6, ch = c & 63;
        const u32x4 ov = *(const LAS u32x4*)(st + row * 1024 + ch * 16);
        const size_t off = (size_t)row * DM + kvh * 512 + ch * 8;
        const u32x4 gv = *(const u32x4*)(SGg + off);
        u32x4 w; w.x = cvt_pk_bf16(bf_lo(ov.x) * bf_lo(gv.x), bf_hi(ov.x) * bf_hi(gv.x)); w.y = cvt_pk_bf16(bf_lo(ov.y) * bf_lo(gv.y), bf_hi(ov.y) * bf_hi(gv.y));
        w.z = cvt_pk_bf16(bf_lo(ov.z) * bf_lo(gv.z), bf_hi(ov.z) * bf_hi(gv.z)); w.w = cvt_pk_bf16(bf_lo(ov.w) * bf_lo(gv.w), bf_hi(ov.w) * bf_hi(gv.w));
        *(u32x4*)(OGg + off) = w; }
}
__device__ __forceinline__ void attn_block(const bf16_t* __restrict__ Qg, const bf16_t* __restrict__ Kh, const bf16_t* __restrict__ Vh, const u64* __restrict__ rmq,
                                           const bf16_t* __restrict__ SGg, bf16_t* __restrict__ OGg, int NT, int qpos0, int kvh, const float* __restrict__ rel_bias, LAS char* lds) {
    int tid = threadIdx.x; asm volatile("" : "+v"(tid));
    const int wid = __builtin_amdgcn_readfirstlane(tid >> 6), lane = tid & 63, r32 = lane & 31, hi = lane >> 5;
    const int hl = wid & 3, qs = wid >> 2, head = kvh * 4 + hl;
    LAS char* V_lds = lds; LAS char* K_lds = lds + 2 * SHM_V;
    LAS float* ws = (LAS float*)(lds + OFF_WS) + wid * 64; LAS float* li_l = ws; LAS float* al_l = ws + 32;
    LAS float* tb = (LAS float*)(lds + OFF_TB);
    for (int e = tid; e < 1024; e += NTHREADS) {
        const int h = e >> 8, rel = (e & 255) - 192, n = rel < 0 ? -rel : rel;
        int bk = n < 8 ? n : (n < 12 ? 8 : n < 16 ? 9 : n < 23 ? 10 : n < 32 ? 11 : n < 46 ? 12 : n < 64 ? 13 : n < 91 ? 14 : 15);
        if (rel > 0) bk += 16;
        tb[e] = (rel_bias[bk * 32 + kvh * 4 + h] - rel_bias[15 * 32 + kvh * 4 + h]) * (1.0f / SCALE);
    }
    {
        const u32x4* src = (const u32x4*)rmq; LAS u32x4* dst = (LAS u32x4*)(lds + OFF_MK);
        constexpr int NCH = 64 * RMS * 8 / 16;
        for (int e = tid; e < NCH; e += NTHREADS) dst[e] = src[e];
    }
    float m_reg = MINIT, l_reg = 0; f32x16 o[4] = {}; bf16x8 qr[8];
    const int qrow = qs * 32 + r32;
    const bf16_t* Qw = Qg + (size_t)qrow * DM + head * D + hi * 8;
#pragma unroll
    for (int d0 = 0; d0 < 8; ++d0) qr[d0] = *(const bf16x8*)(Qw + d0 * 16);
    const LAS u64* rml = (const LAS u64*)(lds + OFF_MK) + qrow * RMS;
    const int vb0 = (int)(uintptr_t)V_lds + v_rd_base(lane);
    const int tboff = hl * 256 + 192 - (qpos0 + qrow) + 4 * hi;
    constexpr int LDK = KVW;
    unsigned koff[2], voff[2];
#pragma unroll
    for (int i = 0; i < 2; ++i) { const int off = (wid * 2 + i) * 1024 + lane * 16;
        { const int row = off >> 8, cB = (off & 255) ^ ((row & 7) << 4); koff[i] = (unsigned)(row * LDK * 2 + cB); }
        { const int sub = off >> 9, kk = (sub >> 2) * 8 + ((off & 511) >> 6), k = (kk & ~0xC) | ((kk & 4) << 1) | ((kk & 8) >> 1), c = (sub & 3) * 32 + ((off & 63) >> 1); voff[i] = (unsigned)(k * LDK * 2 + c * 2); } }
#define DMA_K(t, slot) do { _Pragma("unroll") for (int i_ = 0; i_ < 2; ++i_) __builtin_amdgcn_global_load_lds((const unsigned*)((const char*)Kh + (size_t)(t) * (KVBLK * LDK * 2) + koff[i_]), \
        (LAS unsigned*)(K_lds + (slot) * SHM_K + (wid * 2 + i_) * 1024), 16, 0, 0); } while (0)
#define DMA_V(t, slot) do { _Pragma("unroll") for (int i_ = 0; i_ < 2; ++i_) __builtin_amdgcn_global_load_lds((const unsigned*)((const char*)Vh + (size_t)(t) * (KVBLK * LDK * 2) + voff[i_]), \
        (LAS unsigned*)(V_lds + (slot) * SHM_V + (wid * 2 + i_) * 1024), 16, 0, 0); } while (0)
#define STEPBAR() do { asm volatile("s_waitcnt vmcnt(0) lgkmcnt(0)" ::: "memory"); __builtin_amdgcn_s_barrier(); asm volatile("" ::: "memory"); } while (0)
#define RESC(a) do { if (__any((a) < 1.f)) { if (hi == 0) al_l[r32] = (a); asm volatile("s_waitcnt lgkmcnt(0)" ::: "memory"); \
    _Pragma("unroll") for (int d = 0; d < 4; ++d) _Pragma("unroll") for (int r = 0; r < 16; ++r) o[d][r] *= al_l[crow(r, hi)]; } } while (0)
#define MB(P0, P1, t) mask_bias(P0, P1, rml[t], (t) >= NT - 3, tb + tboff + (t) * KVBLK, hi)
    f32x16 pA0, pA1, pB0, pB1; float mnA, mnB, alA, alB; bf16x8 pa0, pa1, pa2, pa3;
    DMA_K(0, 0);
    STEPBAR();
    if (NT > 1) DMA_K(1, 1);
    DMA_V(0, 0);
    qkt(pA0, pA1, K_lds, qr, r32, hi); MB(pA0, pA1, 0); partialSM(pA0, pA1, m_reg, mnA, alA);
    int j = 1;
    for (; j + 1 < NT; j += 2) {
        STEPBAR();
        DMA_K(j + 1, 0); DMA_V(j, 1);
        SBAR(); qkt(pB0, pB1, K_lds + SHM_K, qr, r32, hi);
        finishSM(pA0, pA1, alA, l_reg, pa0, pa1, pa2, pa3); SBAR();
        pv_d0(o, vb0, pa0, pa1, pa2, pa3); MB(pB0, pB1, j); partialSM(pB0, pB1, m_reg, mnB, alB);
        RESC(alB);
        STEPBAR();
        if (j + 2 < NT) DMA_K(j + 2, 1);
        DMA_V(j + 1, 0);
        SBAR(); qkt(pA0, pA1, K_lds, qr, r32, hi);
        finishSM(pB0, pB1, alB, l_reg, pa0, pa1, pa2, pa3); SBAR();
        pv_d0(o, vb0 + (int)SHM_V, pa0, pa1, pa2, pa3); MB(pA0, pA1, j + 1); partialSM(pA0, pA1, m_reg, mnA, alA);
        RESC(alA);
    }
    if (j < NT) {
        STEPBAR();
        DMA_V(j, 1);
        SBAR(); qkt(pB0, pB1, K_lds + SHM_K, qr, r32, hi);
        finishSM(pA0, pA1, alA, l_reg, pa0, pa1, pa2, pa3); SBAR();
        pv_d0(o, vb0, pa0, pa1, pa2, pa3); MB(pB0, pB1, j); partialSM(pB0, pB1, m_reg, mnB, alB);
        RESC(alB);
        STEPBAR();
        finishSM(pB0, pB1, alB, l_reg, pa0, pa1, pa2, pa3); SBAR();
        pv_d0(o, vb0 + (int)SHM_V, pa0, pa1, pa2, pa3);
    } else {
        STEPBAR();
        finishSM(pA0, pA1, alA, l_reg, pa0, pa1, pa2, pa3); SBAR();
        pv_d0(o, vb0, pa0, pa1, pa2, pa3);
    }
    asm volatile("s_waitcnt vmcnt(0)" ::: "memory");
    if (hi == 0) li_l[r32] = l_reg;
    __syncthreads();
    {
        LAS bf16_t* st = (LAS bf16_t*)lds;
#pragma unroll
        for (int r = 0; r < 16; ++r) { const int orow = qs * 32 + crow(r, hi); const float rl = __builtin_amdgcn_rcpf(li_l[crow(r, hi)]);
#pragma unroll
            for (int d0 = 0; d0 < 4; ++d0) st[orow * 512 + hl * 128 + d0 * 32 + r32] = (bf16_t)(cvt_pk_bf16(o[d0][r] * rl, 0.f) & 0xffffu); }
    }
    __syncthreads();
    og_store_rows(lds, SGg, OGg, kvh, 64, tid);
    __syncthreads();
#undef DMA_K
#undef DMA_V
#undef STEPBAR
#undef RESC
#undef MB
}

#define WGBAR() do { asm volatile("s_waitcnt lgkmcnt(0)" ::: "memory"); __builtin_amdgcn_s_barrier(); asm volatile("" ::: "memory"); } while (0)
__device__ __forceinline__ void attn_sample_block(const bf16_t* __restrict__ Qg, const float* __restrict__ ck, const float* __restrict__ cv, const bf16_t* __restrict__ kn, const bf16_t* __restrict__ vn,
                                                  const u64* __restrict__ rmq, const bf16_t* __restrict__ SGg, bf16_t* __restrict__ OGg, int kvh, const float* __restrict__ rel_bias, LAS char* lds) {
    int tid = threadIdx.x; asm volatile("" : "+v"(tid));
    const int wid = __builtin_amdgcn_readfirstlane(tid >> 6), lane = tid & 63, r32 = lane & 31, hi = lane >> 5;
    constexpr int NT = 65;
    LAS char* V_lds = lds; LAS char* K_lds = lds + 2 * SHM_V;
    LAS float* tb = (LAS float*)(lds + OFF_TB);
    for (int e = tid; e < 1024; e += NTHREADS) {
        const int h = e >> 8, rel = (e & 255) - 192, n = rel < 0 ? -rel : rel;
        int bk = n < 8 ? n : (n < 12 ? 8 : n < 16 ? 9 : n < 23 ? 10 : n < 32 ? 11 : n < 46 ? 12 : n < 64 ? 13 : n < 91 ? 14 : 15);
        if (rel > 0) bk += 16;
        tb[e] = (rel_bias[bk * 32 + kvh * 4 + h] - rel_bias[15 * 32 + kvh * 4 + h]) * (1.0f / SCALE);
    }
    {   const u32x4* src = (const u32x4*)rmq; LAS u32x4* dst = (LAS u32x4*)(lds + OFF_MK);
        for (int e = tid; e < 32 * RMS * 8 / 16; e += NTHREADS) dst[e] = src[e]; }
    if (wid >= 4) {
        const int lt = tid - 256;
        f32x4 krA[4][2], vrA[4][2], krB[4][2], vrB[4][2];
        const int row0 = lt >> 4, c8 = (lt & 15) * 8;
#define LD_TILE(kr, vr, t) do { if ((t) < 64) { _Pragma("unroll") for (int i = 0; i < 4; ++i) { const size_t o_ = ((size_t)(t) * 64 + row0 + 16 * i) * KVW + c8; \
            kr[i][0] = *(const f32x4*)(ck + o_); kr[i][1] = *(const f32x4*)(ck + o_ + 4); vr[i][0] = *(const f32x4*)(cv + o_); vr[i][1] = *(const f32x4*)(cv + o_ + 4); } } } while (0)
#define WR_TILE(kr, vr, t, b) do { if ((t) < 64) { _Pragma("unroll") for (int i = 0; i < 4; ++i) { const int r_ = row0 + 16 * i; \
            *(LAS u32x4*)(K_lds + (b) * SHM_K + KSWZ(r_, c8 * 2)) = pack8(kr[i][0], kr[i][1]); *(LAS u32x4*)(V_lds + (b) * SHM_V + v_st(r_, c8)) = pack8(vr[i][0], vr[i][1]); } } \
        else if ((t) == 64) { _Pragma("unroll") for (int i = 0; i < 4; ++i) { const int r_ = row0 + 16 * i; u32x4 kx = (u32x4){0u, 0u, 0u, 0u}, vx = kx; \
            if (r_ < 32) { kx = *(const u32x4*)(kn + (size_t)r_ * KVW + c8); vx = *(const u32x4*)(vn + (size_t)r_ * KVW + c8); } \
            *(LAS u32x4*)(K_lds + (b) * SHM_K + KSWZ(r_, c8 * 2)) = kx; *(LAS u32x4*)(V_lds + (b) * SHM_V + v_st(r_, c8)) = vx; } } } while (0)
        LD_TILE(krA, vrA, 0); WR_TILE(krA, vrA, 0, 0); LD_TILE(krA, vrA, 1); LD_TILE(krB, vrB, 2);
        WGBAR();
        WR_TILE(krA, vrA, 1, 1); LD_TILE(krA, vrA, 3);
        WGBAR();
        for (int j = 1; j + 1 < NT; j += 2) {
            WGBAR();
            WR_TILE(krB, vrB, j + 1, 0);
            WGBAR();
            LD_TILE(krB, vrB, j + 3);
            WGBAR();
            WR_TILE(krA, vrA, j + 2, 1);
            WGBAR();
            LD_TILE(krA, vrA, j + 4);
        }
#undef LD_TILE
#undef WR_TILE
    } else {
        LAS float* ws = (LAS float*)(lds + OFF_WS) + wid * 64; LAS float* li_l = ws; LAS float* al_l = ws + 32;
        const int head = kvh * 4 + wid;
        float m_reg = MINIT, l_reg = 0; f32x16 o[4] = {}; bf16x8 qr[8];
        const bf16_t* Qw = Qg + (size_t)r32 * DM + head * D + hi * 8;
#pragma unroll
        for (int d0 = 0; d0 < 8; ++d0) qr[d0] = *(const bf16x8*)(Qw + d0 * 16);
        const LAS u64* rml = (const LAS u64*)(lds + OFF_MK) + r32 * RMS;
        const int vb0 = (int)(uintptr_t)V_lds + v_rd_base(lane);
        const int tboff = wid * 256 + 192 - (PAST + r32) + 4 * hi;
#define RESC(a) do { if (__any((a) < 1.f)) { if (hi == 0) al_l[r32] = (a); asm volatile("s_waitcnt lgkmcnt(0)" ::: "memory"); \
    _Pragma("unroll") for (int d = 0; d < 4; ++d) _Pragma("unroll") for (int r = 0; r < 16; ++r) o[d][r] *= al_l[crow(r, hi)]; } } while (0)
#define MB(P0, P1, t) mask_bias(P0, P1, rml[t], (t) >= NT - 3, tb + tboff + (t) * KVBLK, hi)
        f32x16 pA0, pA1, pB0, pB1; float mnA, mnB, alA, alB; bf16x8 pa0, pa1, pa2, pa3;
        WGBAR();
        qkt(pA0, pA1, K_lds, qr, r32, hi); MB(pA0, pA1, 0); partialSM(pA0, pA1, m_reg, mnA, alA);
        WGBAR();
        for (int j = 1; j + 1 < NT; j += 2) {
            SBAR(); qkt(pB0, pB1, K_lds + SHM_K, qr, r32, hi);
            finishSM(pA0, pA1, alA, l_reg, pa0, pa1, pa2, pa3); SBAR();
            pv_d0(o, vb0, pa0, pa1, pa2, pa3); MB(pB0, pB1, j); partialSM(pB0, pB1, m_reg, mnB, alB);
            WGBAR();
            RESC(alB);
            WGBAR();
            SBAR(); qkt(pA0, pA1, K_lds, qr, r32, hi);
            finishSM(pB0, pB1, alB, l_reg, pa0, pa1, pa2, pa3); SBAR();
            pv_d0(o, vb0 + (int)SHM_V, pa0, pa1, pa2, pa3); MB(pA0, pA1, j + 1); partialSM(pA0, pA1, m_reg, mnA, alA);
            WGBAR();
            RESC(alA);
            WGBAR();
        }
        finishSM(pA0, pA1, alA, l_reg, pa0, pa1, pa2, pa3); SBAR();
        pv_d0(o, vb0, pa0, pa1, pa2, pa3);
        if (hi == 0) li_l[r32] = l_reg;
        WGBAR();
        {
            LAS bf16_t* st = (LAS bf16_t*)lds;
#pragma unroll
            for (int r = 0; r < 16; ++r) { const int orow = crow(r, hi); const float rl = __builtin_amdgcn_rcpf(li_l[orow]);
#pragma unroll
                for (int d0 = 0; d0 < 4; ++d0) st[orow * 512 + wid * 128 + d0 * 32 + r32] = (bf16_t)(cvt_pk_bf16(o[d0][r] * rl, 0.f) & 0xffffu); }
        }
#undef RESC
#undef MB
    }
    if (wid >= 4) WGBAR();
    __syncthreads();
    og_store_rows(lds, SGg, OGg, kvh, 32, tid);
    __syncthreads();
}
}

__global__ void __launch_bounds__(NTHREADS, 2) mega(Params p) {
    extern __shared__ __attribute__((aligned(16))) unsigned char lds_raw[];
    LAS unsigned char* lds = (LAS unsigned char*)lds_raw;
    volatile LAS unsigned* MISC = (volatile LAS unsigned*)(lds + MISC_OFF);
    const int G = gridDim.x; const int bx = blockIdx.x;
    const int vcu = (G % 8 == 0) ? (bx % 8) * (G / 8) + bx / 8 : bx;
    const int NGW = G * NWAVES;
#define PHASE_IDS() int tid = threadIdx.x; asm volatile("" : "+v"(tid)); const int lane = tid & 63, wave = __builtin_amdgcn_readfirstlane(tid >> 6), gw = vcu * NWAVES + wave; (void)lane; (void)gw
    unsigned char* ws = p.ws; float* out = p.out;
    const int lo = p.ph_lo, hi_ph = p.ph_hi;
    for (int u = threadIdx.x; u < (LDS_BYTES - RING_BYTES) / 4; u += NTHREADS) ((LAS unsigned*)(lds + RING_BYTES))[u] = 0u;
    __syncthreads();
    XcdBarrier bar; bar.bar = (unsigned*)(ws + WS_CTL) + CW_BAR; bar.x = 0; bar.st = nullptr;
    if (hi_ph - lo > 1) bar = xcd_barrier_post((unsigned*)(ws + WS_CTL) + CW_BAR, MISC + 8);
#ifndef PH_MASK
#define PH_MASK 0x7fff
#endif
#define IN(k) (((PH_MASK >> (k)) & 1) && lo <= (k) && (k) < hi_ph)
#ifdef TPROBE
    unsigned long long tp0 = __builtin_amdgcn_s_memrealtime(), tp1 = 0;
#define TP_MARK(k) do { if ((k) == TPROBE - 1) tp0 = __builtin_amdgcn_s_memrealtime(); if ((k) == TPROBE) tp1 = __builtin_amdgcn_s_memrealtime(); } while (0)
#else
#define TP_MARK(k) do { } while (0)
#endif
#define SEAM(k) do { if (IN(k) && IN((k) + 1)) xcd_barrier(bar); TP_MARK(k); } while (0)

    if (IN(0)) {
        PHASE_IDS();
        {
            for (int i = tid; i < DM / 4; i += NTHREADS) ((LAS f32x4*)lds)[i] = ((const f32x4*)p.norm_w)[i];
            __syncthreads();
            f32x4 v[16], vn[16];
            if (gw < MT) { const f32x4* xr = (const f32x4*)(gw < MP ? p.x_prompt + (size_t)gw * DM : p.x_sample + (size_t)(gw - MP) * DM) + lane;
#pragma unroll
                for (int j = 0; j < 16; ++j) v[j] = xr[64 * j]; }
#pragma unroll 1
            for (int m = gw; m < MT; m += NGW) {
                const int mn = m + NGW;
                if (mn < MT) { const f32x4* xr = (const f32x4*)(mn < MP ? p.x_prompt + (size_t)mn * DM : p.x_sample + (size_t)(mn - MP) * DM) + lane;
#pragma unroll
                    for (int j = 0; j < 16; ++j) vn[j] = xr[64 * j]; }
                rms_row_q(v, (const LAS f32x4*)lds, (bf16_t*)(ws + WS_H) + (size_t)m * DM, (signed char*)(ws + WS_H8) + (size_t)m * DM, (float*)(ws + WS_SA) + m, lane);
#pragma unroll
                for (int j = 0; j < 16; ++j) v[j] = vn[j];
            }
        }
        {
            const size_t gt = (size_t)gw * 64 + lane, GT = (size_t)NGW * 64;
            constexpr size_t NK8 = (size_t)DB * SKV * DIDX / 8;
            for (size_t i = gt; i < NK8; i += GT) {
                const size_t row = i / 8, c8 = i % 8, bb = row / SKV, s = row % SKV;
                if (s >= (size_t)PAST && s < (size_t)PAST + DSQ) continue;
                u32x4 w = (u32x4){0u, 0u, 0u, 0u};
                if (s < (size_t)PAST) { const float* src = p.cache_kidx + (bb * PAST + s) * DIDX + c8 * 8; w = pack8(*(const f32x4*)src, *(const f32x4*)(src + 4)); }
                *(u32x4*)((bf16_t*)(ws + WS_KIS) + bb * SKV * DIDX + kif_off((int)s, (int)c8 * 8)) = w;
            }
        }
        {
            u32x4* z = (u32x4*)((bf16_t*)(ws + WS_WT_IN) + (size_t)2144 * DM);
            for (size_t i = (size_t)gw * 64 + lane; i < (size_t)160 * DM * 2 / 16; i += (size_t)NGW * 64) z[i] = (u32x4){0u, 0u, 0u, 0u};
        }
        __syncthreads();
        LAS float* scr = (LAS float*)(lds + wave * 16384);
        constexpr int I_IN = 64 * 34, I_GRP = 4 * 16 * 16, I_AMX = 64 * 40, I_AMX2 = 64 * 32, I_AMX3 = 64 * 16;
        constexpr int NITEMS = I_IN + I_GRP + I_AMX + I_AMX2 + 2 * I_AMX3;
        for (int it = gw; it < NITEMS; it += NGW) {
            int r = it;
            if (r < I_IN) { const int kb = r / 34, nb = r % 34, n0 = 6144 + nb * 64;
                transpose_item(p.attn_w_in, 12384, kb * 64, n0, (bf16_t*)(ws + WS_WT_IN), DM, nb * 64, nb == 33 ? 32 : 64, scr, lane); continue; } r -= I_IN;
            if (r < I_GRP) { const int g = r / 256, q = r % 256;
                transpose_item(p.pool_group_w + (size_t)g * 1024 * 1024, 1024, (q / 16) * 64, (q % 16) * 64, (bf16_t*)(ws + WS_WT_GRP), 1024, g * 1024 + (q % 16) * 64, 64, scr, lane); continue; } r -= I_GRP;
            if (r >= I_AMX + I_AMX2) {
                r -= I_AMX + I_AMX2; const bool second = r >= I_AMX3; if (second) r -= I_AMX3;
                const int kb = r >> 4, cb = r & 15, n0 = cb * 256 + lane * 4;
                const f32x4 m = col_amax64<false>((second ? p.pool_w_out : p.attn_w_out) + (size_t)kb * 64 * DM + n0, DM, nullptr);
                unsigned* cm = (unsigned*)(ws + (second ? WS_CAMAX4 : WS_CAMAX3)) + n0;
                atomicMax(cm, __float_as_uint(m.x)); atomicMax(cm + 1, __float_as_uint(m.y)); atomicMax(cm + 2, __float_as_uint(m.z)); atomicMax(cm + 3, __float_as_uint(m.w));
                continue;
            }
            if (r >= I_AMX) {
                r -= I_AMX; const int kb = r >> 5, cb = r & 31, n0 = cb * 256 + lane * 4;
                const f32x4 m = col_amax64<true>(p.pool_w_in + (size_t)kb * 64 * 8192 + n0, 8192, p.norm_w + DM + kb * 64);
                unsigned* cm = (unsigned*)(ws + WS_CAMAX2) + cb * 256 + lane * 4;
                atomicMax(cm, __float_as_uint(m.x)); atomicMax(cm + 1, __float_as_uint(m.y)); atomicMax(cm + 2, __float_as_uint(m.z)); atomicMax(cm + 3, __float_as_uint(m.w));
                continue;
            }
            {
                const int kb = r / 40, cb = r % 40, n0 = (cb < 24 ? cb * 256 : 8288 + (cb - 24) * 256) + lane * 4;
                const f32x4 m = col_amax64<false>(p.attn_w_in + (size_t)kb * 64 * 12384 + n0, 12384, nullptr);
                unsigned* cm = (unsigned*)(ws + WS_CAMAX) + cb * 256 + lane * 4;
                atomicMax(cm, __float_as_uint(m.x)); atomicMax(cm + 1, __float_as_uint(m.y)); atomicMax(cm + 2, __float_as_uint(m.z)); atomicMax(cm + 3, __float_as_uint(m.w));
            }
        }
    }
    SEAM(0);
    if (IN(1)) {
        PHASE_IDS();
        LAS float* scr = (LAS float*)(lds + wave * 16384);
        for (int it = gw; it < 2 * 32 * 64; it += NGW) { const bool second = it < 32 * 64; const int r = second ? it : it - 32 * 64, kb = r >> 6, nb = r & 63;
            transpose_item_i8(second ? p.pool_w_out : p.attn_w_out, DM, kb * 128, nb * 64, (signed char*)(ws + (second ? WS_WPO8 : WS_WO8)), DM, nb * 64, scr, lane,
                              (const unsigned*)(ws + (second ? WS_CAMAX4 : WS_CAMAX3)), (float*)(ws + (second ? WS_SB4 : WS_SB3))); }
        for (int it = gw; it < 32 * 128; it += NGW) { const int kb = it >> 7, nb = it & 127;
            transpose_item_i8(p.pool_w_in, 8192, kb * 128, nb * 64, (signed char*)(ws + WS_WP8), DM, nb * 64, scr, lane, (const unsigned*)(ws + WS_CAMAX2), (float*)(ws + WS_SB2), p.norm_w + DM); }
        for (int it = gw; it < 32 * 160; it += NGW) { const int kb = it / 160, nb = it % 160, n0 = nb < 96 ? nb * 64 : 8288 + (nb - 96) * 64;
            transpose_item_i8(p.attn_w_in, 12384, kb * 128, n0, (signed char*)(ws + WS_WT8), DM, nb * 64, scr, lane, (const unsigned*)(ws + WS_CAMAX), (float*)(ws + WS_SB)); }
    }
    SEAM(1);
    if (IN(2)) {
        {
            pg8::Gemm g{(const bf16_t*)(ws + WS_H8), (const bf16_t*)(ws + WS_WT8), MT, NI8, DM / 2, DM / 2, DM / 2, 0};
            pg8::Order S; S.init(MT / 256, 40, 0, 0, G, bx);
            Epi1a E{ws, out};
            pg8::gemm_phase<Epi1a, false, true>(lds, g, S, E);
        }
        {
            pg8::Gemm g{(const bf16_t*)(ws + WS_H), (const bf16_t*)(ws + WS_WT_IN), MT, NB16, DM, DM, DM, 0};
            int G2 = G; asm volatile("" : "+s"(G2));
            pg8::Order S; S.init(MT / 256, 8, MT / 256, 1, G2, G2 - 1 - bx);
            Epi1b E{ws, out};
            pg8::gemm_phase<Epi1b, true>(lds, g, S, E);
        }
    }
    SEAM(2);
    if (IN(3)) {
        const bf16_t* QIF = (const bf16_t*)(ws + WS_QIB); const float* WI = (const float*)(ws + WS_WIB); float* SC = (float*)(ws + WS_SC);
        for (int it = vcu; it < 512; it += G) {
            if (it < 256) {
#pragma unroll 1
                for (int hh = 0; hh < 2; ++hh) { const int g = hh ? 511 - it : it, b = g >> 7, nt = ((g & 127) >> 1) + 1;
                    if (nt > 4) score_tiles(QIF + (size_t)g * 65536, WI + (size_t)g * 32 * HIDX, (const bf16_t*)(ws + WS_KIP) + (size_t)b * SEQ * DIDX, SC + (size_t)g * 32 * SCW, 0, 1, nt, lds); }
            } else {
                const int sb = (it - 256) >> 3, kr = (it - 256) & 7, g = 512 + sb;
                score_tiles(QIF + (size_t)g * 65536, WI + (size_t)g * 32 * HIDX, (const bf16_t*)(ws + WS_KIS) + (size_t)sb * SKV * DIDX, SC + (size_t)g * 32 * SCW, kr, 8, kr == 0 ? 9 : 8, lds);
            }
        }
    }
    SEAM(3);
    if (IN(4)) {
        PHASE_IDS();
        u64* RM = (u64*)(ws + WS_RM); const float* SC = (const float*)(ws + WS_SC);
        for (int pi = gw; pi < 2048; pi += NGW) {
            const int nq = (pi & 1) == 0 ? 9 : 8;
            float vv[NVJ];
#pragma unroll
            for (int j = 0; j < NVJ; ++j) vv[j] = 0.f;
            sel_load(SC + (size_t)pi * SCW, (pi >> 6) + 1, vv, lane);
#pragma unroll 1
            for (int k = 0; k < nq; ++k) {
                int m, nt, nv;
                if (k < 8) { const int b = k >> 1, t = (k & 1) ? 4095 - pi : pi; m = b * SEQ + t; nt = (t >> 6) + 1; nv = nt * 64; } else { m = MP + (pi >> 1); nt = 65; nv = PAST + DSQ; }
                int m2 = 0, nt2 = 0;
                if (k + 1 < 8) { const int b = (k + 1) >> 1, t = ((k + 1) & 1) ? 4095 - pi : pi; m2 = b * SEQ + t; nt2 = (t >> 6) + 1; } else if (k + 1 < nq) { m2 = MP + (pi >> 1); nt2 = 65; }
                select_row(vv, nt, nv, RM + (size_t)m * RMS, SC + (size_t)m2 * SCW, nt2, lane);
            }
        }
    }
    SEAM(4);
    if (IN(5)) {
        const u64* RM = (const u64*)(ws + WS_RM);
        const bf16_t* QB = (const bf16_t*)(ws + WS_QB); const bf16_t* SG = (const bf16_t*)(ws + WS_SG); bf16_t* OG = (bf16_t*)(ws + WS_OG);
        for (int sl = vcu; sl < 1280; sl += G) {
            const int v = sl & 255, k = sl >> 8, ks = v % 5;
            if (k != ks) {
                const int it = v + 256 * (k - (k > ks ? 1 : 0));
                const int b = it >> 8, kvh = (it >> 5) & 7, pr = it & 31;
                const bf16_t* Kh = (const bf16_t*)(ws + WS_KP) + (size_t)b * SEQ * KVW + kvh * 128; const bf16_t* Vh = (const bf16_t*)(ws + WS_VP) + (size_t)b * SEQ * KVW + kvh * 128;
#pragma unroll 1
                for (int half = 0; half < 2; ++half) {
                    const int c = half ? 63 - pr : pr; const size_t m0 = (size_t)b * SEQ + c * 64;
                    att::attn_block(QB + m0 * DM, Kh, Vh, RM + m0 * RMS, SG + m0 * DM, OG + m0 * DM, c + 1, c * 64, kvh, p.rel_bias, (LAS char*)lds);
                }
            } else {
                const int b = v >> 3, kvh = v & 7; const size_t m0 = (size_t)MP + b * 32;
                att::attn_sample_block(QB + m0 * DM, p.cache_k + ((size_t)b * PAST * NKVH + kvh) * 128, p.cache_v + ((size_t)b * PAST * NKVH + kvh) * 128,
                                       (const bf16_t*)(ws + WS_KSN) + (size_t)b * 32 * KVW + kvh * 128, (const bf16_t*)(ws + WS_VSN) + (size_t)b * 32 * KVW + kvh * 128,
                                       RM + m0 * RMS, SG + m0 * DM, OG + m0 * DM, kvh, p.rel_bias, (LAS char*)lds);
            }
        }
    }
    SEAM(5);
    if (IN(6)) {
        PHASE_IDS();
        float* SAo = (float*)(ws + WS_SA);
        quant_rows_bf16((const bf16_t*)(ws + WS_OG), (signed char*)(ws + WS_H8), MT, gw, NGW, lane, [&](int m, float am, float) { if (lane == 0) SAo[m] = am * (1.0f / 127.0f); });
    }
    SEAM(6);
    if (IN(7)) {
        pg8::Gemm g{(const bf16_t*)(ws + WS_H8), (const bf16_t*)(ws + WS_WO8), MT, DM, DM / 2, DM / 2, DM / 2, 0};
        pg8::Order S; S.init(MP / 256, 16, 256, 2, G, bx);
        EpiX1 E{p.x_prompt, nullptr, (bf16_t*)(ws + WS_H), (float*)(ws + WS_PS), (const float*)(ws + WS_SA), (const float*)(ws + WS_SB3)};
        pg8::gemm_phase<EpiX1, false, true>(lds, g, S, E);
    }
    SEAM(7);
    if (IN(8)) {
        signed char* X8 = (signed char*)(ws + WS_H8); float* ROWF = (float*)(ws + WS_ROWF);
        {
        PHASE_IDS();
        for (int m = MP + gw; m < MT; m += NGW) {
            const f32x4* xr = (const f32x4*)(p.x_sample + (size_t)(m - MP) * DM) + lane; const f32x4* ps = (const f32x4*)((const float*)(ws + WS_PS) + (size_t)(m - MP) * DM) + lane;
            f32x4* x1 = (f32x4*)((float*)(ws + WS_X1) + (size_t)m * DM) + lane; float ss = 0.f, am = 0.f; f32x4 v[16];
#pragma unroll
            for (int jb = 0; jb < 4; ++jb) {
                const f32x4* q0 = xr + 256 * jb; const f32x4* q1 = ps + 256 * jb; const f32x4* q2 = q1 + (size_t)MS * DM / 4; const f32x4* q3 = q2 + (size_t)MS * DM / 4; const f32x4* q4 = q3 + (size_t)MS * DM / 4;
                asm volatile("" : "+v"(q0), "+v"(q1), "+v"(q2), "+v"(q3), "+v"(q4) :: "memory");
#pragma unroll
                for (int jj = 0; jj < 4; ++jj) v[jb * 4 + jj] = q0[64 * jj] + ((q1[64 * jj] + q2[64 * jj]) + (q3[64 * jj] + q4[64 * jj]));
            }
#pragma unroll
            for (int j = 0; j < 16; ++j) { x1[64 * j] = v[j]; ss += (v[j].x * v[j].x + v[j].y * v[j].y) + (v[j].z * v[j].z + v[j].w * v[j].w);
                am = fmaxf(am, fmaxf(fmaxf(fabsf(v[j].x), fabsf(v[j].y)), fmaxf(fabsf(v[j].z), fabsf(v[j].w)))); }
#pragma unroll
            for (int o = 1; o < 64; o <<= 1) am = fmaxf(am, __shfl_xor(am, o));
            ss = wave_sum(ss);
            const float inv = am > 0.f ? 127.0f / am : 0.f;
            unsigned* q = (unsigned*)(X8 + (size_t)m * DM) + lane;
#pragma unroll
            for (int j = 0; j < 16; ++j) q[64 * j] = q8x4(v[j].x * inv, v[j].y * inv, v[j].z * inv, v[j].w * inv);
            if (lane == 0) ROWF[m] = am * (1.0f / 127.0f) / sqrtf(ss * (1.0f / DM) + EPS);
        }
        }
        {
            PHASE_IDS();
            quant_rows_bf16((const bf16_t*)(ws + WS_H), X8, MP, gw, NGW, lane, [&](int m, float am, float ss) { if (lane == 0) ROWF[m] = am * (1.0f / 127.0f) / sqrtf(ss * (1.0f / DM) + EPS); });
        }
        {
            PHASE_IDS();
            bf16_t* U = (bf16_t*)(ws + WS_U);
            constexpr int NPAD = (NBATCH + DB) * 16 * 512;
            for (int i = gw * 64 + lane; i < NPAD; i += NGW * 64) {
                const int c = (i & 511) * 8, rr = i >> 9, sq = rr >> 4, k = rr & 15;
                u32x4 o = (u32x4){0u, 0u, 0u, 0u}; size_t row;
                if (sq < NBATCH) row = (size_t)sq * UP_SEQ + k;
                else { const int b = sq - NBATCH; row = (size_t)UP_ROWS + (size_t)b * US_SEQ + k;
                    if (k >= 1) { const float* hp = p.state_pool + ((size_t)b * 15 + (k - 1)) * DM + c; o = pack8(*(const f32x4*)hp, *(const f32x4*)(hp + 4)); } }
                *(u32x4*)(U + row * DM + c) = o;
            }
        }
    }
    SEAM(8);
    if (IN(9)) {
        pg8::Gemm g{(const bf16_t*)(ws + WS_H8), (const bf16_t*)(ws + WS_WP8), MT, 8192, DM / 2, DM / 2, DM / 2, 0};
        pg8::Order S; S.init(MT / 256, 32, 0, 0, G, bx);
        Epi3 E{ws, out};
        pg8::gemm_phase<Epi3, false, true>(lds, g, S, E);
    }
    SEAM(9);
    if (IN(10)) {
        PHASE_IDS();
        const bf16_t* __restrict__ U = (const bf16_t*)(ws + WS_U); bf16_t* __restrict__ MX = (bf16_t*)(ws + WS_MX);
        const int gt = gw * 64 + lane, GT = NGW * 64;
#define ACC8(S, X, SGN) do { S[0] += SGN bf_lo(X.x); S[1] += SGN bf_hi(X.x); S[2] += SGN bf_lo(X.y); S[3] += SGN bf_hi(X.y); S[4] += SGN bf_lo(X.z); S[5] += SGN bf_hi(X.z); S[6] += SGN bf_lo(X.w); S[7] += SGN bf_hi(X.w); } while (0)
        for (int i = gt; i < 256 * 512; i += GT) {
            const int rg = i >> 9, c = (i & 511) * 8, w = 2 << (c >> 10);
            const float icw = 1.0f / (float)w;
            const int pm0 = rg < 224 ? rg * 68 : 224 * 68 + (rg - 224) * 36, pn = rg < 224 ? 68 : 36;
            const int cut = ((pm0 + pn - 1) >> 12) != (pm0 >> 12) ? (((pm0 >> 12) + 1) << 12) - pm0 : pn;
#pragma unroll 1
            for (int sg = 0; sg < 3; ++sg) {
                int m0, n;
                if (sg == 0) { m0 = pm0; n = cut; } else if (sg == 1) { m0 = pm0 + cut; n = pn - cut; } else { m0 = MP + (rg - 224) * 32; n = rg < 224 ? 0 : 32; }
                if (n <= 0) continue;
                const bool samp = m0 >= MP;
                const int t0 = samp ? 0 : (m0 & 4095);
                const bf16_t* up = U + (size_t)u_row(m0) * DM + c;
                float s[8] = {0.f, 0.f, 0.f, 0.f, 0.f, 0.f, 0.f, 0.f};
                for (int k = 1; k <= w; ++k) { const u32x4 x = *(const u32x4*)(up - (size_t)k * DM); ACC8(s, x, +); }
#pragma unroll 1
                for (int tb = 0; tb < n; tb += 4) {
                    u32x4 cur[4], old[4];
#pragma unroll
                    for (int q = 0; q < 4; ++q) { cur[q] = *(const u32x4*)(up + (size_t)(tb + q) * DM); old[q] = *(const u32x4*)(up + ((ptrdiff_t)(tb + q) - w) * DM); }
#pragma unroll
                    for (int q = 0; q < 4; ++q) {
                        const int t = t0 + tb + q;
                        ACC8(s, cur[q], +); ACC8(s, old[q], -);
                        const float ic = (samp || t + 1 >= w) ? icw : 1.0f / (float)(t + 1);
                        const float f[8] = {bf_lo(cur[q].x), bf_hi(cur[q].x), bf_lo(cur[q].y), bf_hi(cur[q].y), bf_lo(cur[q].z), bf_hi(cur[q].z), bf_lo(cur[q].w), bf_hi(cur[q].w)};
                        u32x4 o;
                        o.x = cvt_pk_bf16(s[0] * ic - f[0], s[1] * ic - f[1]); o.y = cvt_pk_bf16(s[2] * ic - f[2], s[3] * ic - f[3]);
                        o.z = cvt_pk_bf16(s[4] * ic - f[4], s[5] * ic - f[5]); o.w = cvt_pk_bf16(s[6] * ic - f[6], s[7] * ic - f[7]);
                        *(u32x4*)(MX + (size_t)(m0 + tb + q) * DM + c) = o;
                    }
                }
            }
        }
#undef ACC8
    }
    SEAM(10);
    if (IN(11)) {
        pg8::Gemm g{(const bf16_t*)(ws + WS_MX), (const bf16_t*)(ws + WS_WT_GRP), MT, DM, 1024, DM, 1024, 1};
        pg8::Order S; S.init(MT / 256, 16, 0, 0, G, bx);
        Epi4 E{ws, p.pool_scale};
        pg8::gemm_phase<Epi4>(lds, g, S, E);
    }
    SEAM(11);
    if (IN(12)) {
        PHASE_IDS();
        float* SAo = (float*)(ws + WS_SA);
        quant_rows_bf16((const bf16_t*)(ws + WS_ZG), (signed char*)(ws + WS_H8), MT, gw, NGW, lane, [&](int m, float am, float) { if (lane == 0) SAo[m] = am * (1.0f / 127.0f); });
    }
    SEAM(12);
    if (IN(13)) {
        pg8::Gemm g{(const bf16_t*)(ws + WS_H8), (const bf16_t*)(ws + WS_WPO8), MT, DM, DM / 2, DM / 2, DM / 2, 0};
        pg8::Order S; S.init(MP / 256, 16, 256, 2, G, bx);
        EpiX2 E{(bf16_t*)(ws + WS_H), (float*)(ws + WS_PS), (const float*)(ws + WS_SA), (const float*)(ws + WS_SB4)};
        pg8::gemm_phase<EpiX2, false, true>(lds, g, S, E);
    }
    SEAM(13);
    if (IN(14)) {
        PHASE_IDS();
        for (int m = MP + gw; m < MT; m += NGW) {
            const f32x4* xr = (const f32x4*)((const float*)(ws + WS_X1) + (size_t)m * DM) + lane; const f32x4* ps = (const f32x4*)((const float*)(ws + WS_PS) + (size_t)(m - MP) * DM) + lane;
            const f32x4* wr = (const f32x4*)p.final_norm_w + lane; f32x4* yo = (f32x4*)(out + O_YS + (size_t)(m - MP) * DM) + lane;
            float ss = 0.f; f32x4 v[16];
#pragma unroll
            for (int jb = 0; jb < 4; ++jb) {
                const f32x4* q0 = xr + 256 * jb; const f32x4* q1 = ps + 256 * jb; const f32x4* q2 = q1 + (size_t)MS * DM / 4; const f32x4* q3 = q2 + (size_t)MS * DM / 4; const f32x4* q4 = q3 + (size_t)MS * DM / 4;
                asm volatile("" : "+v"(q0), "+v"(q1), "+v"(q2), "+v"(q3), "+v"(q4) :: "memory");
#pragma unroll
                for (int jj = 0; jj < 4; ++jj) v[jb * 4 + jj] = q0[64 * jj] + ((q1[64 * jj] + q2[64 * jj]) + (q3[64 * jj] + q4[64 * jj]));
            }
#pragma unroll
            for (int j = 0; j < 16; ++j) ss += (v[j].x * v[j].x + v[j].y * v[j].y) + (v[j].z * v[j].z + v[j].w * v[j].w);
            const float rstd = 1.0f / sqrtf(wave_sum(ss) * (1.0f / DM) + EPS);
#pragma unroll
            for (int j = 0; j < 16; ++j) yo[64 * j] = v[j] * rstd * wr[64 * j];
        }
        {
            const f32x4* wr = (const f32x4*)p.final_norm_w + lane; f32x4 w[16];
#pragma unroll
            for (int j = 0; j < 16; ++j) w[j] = wr[64 * j];
            const bf16_t* XB = (const bf16_t*)(ws + WS_H);
            u32x2 x[16], xn[16];
            if (gw < MP) {
#pragma unroll
                for (int j = 0; j < 16; ++j) x[j] = ((const u32x2*)(XB + (size_t)gw * DM) + lane)[64 * j]; }
#pragma unroll 1
            for (int m = gw; m < MP; m += NGW) {
                if (m + NGW < MP) {
#pragma unroll
                    for (int j = 0; j < 16; ++j) xn[j] = ((const u32x2*)(XB + (size_t)(m + NGW) * DM) + lane)[64 * j]; }
                float ss = 0.f;
#pragma unroll
                for (int j = 0; j < 16; ++j) { const float a = bf_lo(x[j].x), b = bf_hi(x[j].x), c = bf_lo(x[j].y), d = bf_hi(x[j].y); ss += (a * a + b * b) + (c * c + d * d); }
                const float rstd = 1.0f / sqrtf(wave_sum(ss) * (1.0f / DM) + EPS);
                f32x4* yo = (f32x4*)(out + O_YP + (size_t)m * DM) + lane;
#pragma unroll
                for (int j = 0; j < 16; ++j) yo[64 * j] = (f32x4){bf_lo(x[j].x), bf_hi(x[j].x), bf_lo(x[j].y), bf_hi(x[j].y)} * rstd * w[j];
#pragma unroll
                for (int j = 0; j < 16; ++j) x[j] = xn[j];
            }
        }
    }
#ifdef TPROBE
    if (TPROBE == NPHASE - 1) tp1 = __builtin_amdgcn_s_memrealtime();
    if (bx == 0) { const unsigned long long t = __builtin_amdgcn_s_memrealtime(), dt = (tp1 - tp0) * TPMUL; while (__builtin_amdgcn_s_memrealtime() - t < dt) __builtin_amdgcn_s_sleep(8); }
#endif
#undef IN
#undef SEAM
}

#ifndef MK_N_LAUNCHES
#define MK_N_LAUNCHES 1
#endif
extern "C" void kernel_launch(void* const* d_in, const int* in_sizes, int n_in, void* d_out, int out_size, void* d_ws, size_t ws_size, hipStream_t stream) {
    static int grid = 0;
    if (grid == 0) {
        if (n_in != 15 || (size_t)out_size != O_END || ws_size < WS_END) { fprintf(stderr, "kernel_launch: unexpected shapes: n_in %d out %d ws %zu (need >= %zu)\n", n_in, out_size, ws_size, (size_t)WS_END); grid = -1; return; }
        int dev = 0, cus = 0, per_cu = 0;
        if (hipGetDevice(&dev) != hipSuccess || hipDeviceGetAttribute(&cus, hipDeviceAttributeMultiprocessorCount, dev) != hipSuccess) { grid = -1; return; }
        if (hipFuncSetAttribute((const void*)mega, hipFuncAttributeMaxDynamicSharedMemorySize, LDS_BYTES) != hipSuccess) { fprintf(stderr, "kernel_launch: hipFuncSetAttribute failed\n"); grid = -1; return; }
        if (hipOccupancyMaxActiveBlocksPerMultiprocessor(&per_cu, (const void*)mega, NTHREADS, LDS_BYTES) != hipSuccess || per_cu < 1) { fprintf(stderr, "kernel_launch: occupancy query says %d\n", per_cu); }
        (void)hipGetLastError();
        grid = cus;
    }
    if (grid < 0) return;
    if (hipMemsetAsync((char*)d_ws + WS_CTL, 0, CTL_ZERO_BYTES, stream) != hipSuccess) return;
    Params p{};
    p.x_prompt = (const float*)d_in[0]; p.x_sample = (const float*)d_in[1]; p.cache_k = (const float*)d_in[2]; p.cache_v = (const float*)d_in[3];
    p.cache_kidx = (const float*)d_in[4]; p.state_pool = (const float*)d_in[5]; p.norm_w = (const float*)d_in[6]; p.final_norm_w = (const float*)d_in[7];
    p.attn_w_in = (const float*)d_in[8]; p.attn_w_out = (const float*)d_in[9]; p.rel_bias = (const float*)d_in[10]; p.pool_w_in = (const float*)d_in[11];
    p.pool_group_w = (const float*)d_in[12]; p.pool_scale = (const float*)d_in[13]; p.pool_w_out = (const float*)d_in[14];
    p.out = (float*)d_out; p.ws = (unsigned char*)d_ws;
    if (MK_N_LAUNCHES == 1) { p.ph_lo = 0; p.ph_hi = NPHASE; hipLaunchKernelGGL(mega, dim3(grid), dim3(NTHREADS), LDS_BYTES, stream, p); }
    else for (int k = 0; k < NPHASE; ++k) { p.ph_lo = k; p.ph_hi = k + 1; hipLaunchKernelGGL(mega, dim3(grid), dim3(NTHREADS), LDS_BYTES, stream, p); }
#ifdef PROBE_PHASE
    { p.ph_lo = PROBE_PHASE; p.ph_hi = PROBE_PHASE + 1; hipLaunchKernelGGL(mega, dim3(grid), dim3(NTHREADS), LDS_BYTES, stream, p); }
#endif
    const hipError_t le = hipPeekAtLastError();
    if (le != hipSuccess) fprintf(stderr, "kernel_launch: launch failed: %s\n", hipGetErrorName(le));
}
```

```cpp
#include <hip/hip_runtime.h>
#include <cstdio>
#include <cstdint>

#define LAS __attribute__((address_space(3)))
typedef unsigned short bf16_t;
typedef short bf16x8 __attribute__((ext_vector_type(8)));
typedef short s16x4 __attribute__((ext_vector_type(4)));
typedef float f32x4 __attribute__((ext_vector_type(4)));
typedef float f32x16 __attribute__((ext_vector_type(16)));
typedef unsigned u32x4 __attribute__((ext_vector_type(4)));
typedef unsigned u32x2 __attribute__((ext_vector_type(2)));
typedef unsigned long long u64;
typedef int i32x4 __attribute__((ext_vector_type(4)));

constexpr int DM = 4096, NBATCH = 4, SEQ = 4096, DB = 32, DSQ = 32, PAST = 4096;
constexpr int MP = NBATCH * SEQ, MS = DB * DSQ, MT = MP + MS;
constexpr int KVW = 1024, QIW = 2048, DIDX = 64, HIDX = 32, NKVH = 8;
constexpr int N1 = 12544;
constexpr int SKV = 4160;
constexpr int RMS = 65;
constexpr float EPS = 1e-6f;
constexpr int NWAVES = 8, NTHREADS = 512;
constexpr int NPHASE = 15;

constexpr size_t O_YP = 0, O_YS = 67108864, O_KP = 71303168, O_VP = 88080384, O_KIP = 104857600, O_POOLP = 105906176,
                 O_KS = 106151936, O_VS = 107200512, O_KIS = 108249088, O_POOLS = 108314624, O_END = 110280704;

constexpr size_t MiB = 1u << 20;
constexpr size_t WS_CTL = 0, CTL_ZERO_BYTES = 1 * MiB;
constexpr size_t WS_WT_IN = 1 * MiB, WS_WT_OUT = 99 * MiB, WS_WT_PIN = 131 * MiB, WS_WT_GRP = 195 * MiB, WS_WT_POUT = 203 * MiB;
constexpr size_t WS_H = 235 * MiB, WS_QB = 371 * MiB, WS_KP = 507 * MiB, WS_VP = 539 * MiB, WS_KS = 571 * MiB, WS_VS = 831 * MiB;
constexpr size_t WS_QIB = 1091 * MiB, WS_KIP = 1159 * MiB, WS_KIS = 1161 * MiB, WS_WIB = 1178 * MiB, WS_SG = 1181 * MiB, WS_RM = 1317 * MiB;
constexpr size_t WS_OG = 1326 * MiB, WS_X1 = 1462 * MiB, WS_SC = 1734 * MiB, WS_END = 2011 * MiB;
constexpr int SCW = 4160;
constexpr size_t WS_KSN = WS_KS, WS_VSN = WS_KS + 2 * MiB;
constexpr size_t WS_U = WS_QB, WS_SG2 = WS_SG, WS_MX = WS_OG, WS_ZG = WS_VS;
constexpr size_t WS_SS1 = WS_CTL + 256 * 1024;
constexpr size_t WS_PS = 600 * MiB;
constexpr size_t WS_H8 = 664 * MiB, WS_WT8 = 131 * MiB;
constexpr size_t WS_CAMAX = WS_CTL + 384 * 1024, WS_SB = WS_CTL + 448 * 1024, WS_SA = WS_CTL + 512 * 1024;
constexpr size_t WS_WP8 = 764 * MiB;
constexpr size_t WS_CAMAX2 = WS_CTL + 640 * 1024, WS_SB2 = WS_CTL + 704 * 1024, WS_ROWF = WS_CTL + 768 * 1024;
constexpr size_t WS_WO8 = 796 * MiB, WS_WPO8 = 812 * MiB;
constexpr size_t WS_CAMAX3 = WS_CTL + 848 * 1024, WS_CAMAX4 = WS_CTL + 864 * 1024, WS_SB3 = WS_CTL + 880 * 1024, WS_SB4 = WS_CTL + 896 * 1024;
constexpr int NB16 = 2304;
constexpr int NI8 = 10240;
constexpr int CW_BAR = 4096;

constexpr int LDS_BYTES = 147456, RING_BYTES = 131072, MISC_OFF = RING_BYTES + 320;

__device__ __forceinline__ unsigned cvt_pk_bf16(float lo, float hi) { unsigned r; asm("v_cvt_pk_bf16_f32 %0, %1, %2" : "=v"(r) : "v"(lo), "v"(hi)); return r; }
__device__ __forceinline__ float bf_lo(unsigned w) { return __uint_as_float(w << 16); }
__device__ __forceinline__ float bf_hi(unsigned w) { return __uint_as_float(w & 0xffff0000u); }
__device__ __forceinline__ float fma_abs(float a, float b, float c) { float d; asm("v_fma_f32 %0, %1, |%2|, %3" : "=v"(d) : "v"(a), "v"(b), "v"(c)); return d; }
__device__ __forceinline__ float silu_f(float x) { return x * __builtin_amdgcn_rcpf(1.0f + __builtin_amdgcn_exp2f(-1.4426950408889634f * x)); }
__device__ __forceinline__ float wave_sum(float v) {
#pragma unroll
    for (int o = 1; o < 64; o <<= 1) v += __shfl_xor(v, o);
    return v;
}
#define LDS_WAIT() asm volatile("s_waitcnt lgkmcnt(0)" ::: "memory")
#define VM_WAIT() asm volatile("s_waitcnt vmcnt(0)" ::: "memory")

#define XB_TMO      128
#define XB_XCNT(j)  (256  + 64 * (j))
#define XB_XSUB(j)  (1280 + 64 * (j))
#define XB_XGEN(j)  (2304 + 64 * (j))
#define XB_TOP      3328
#define XB_TOPGEN   3392
#define XCD_BAR_WORDS 3456
#define XB_SPIN_CAP (1u << 18)
__device__ __forceinline__ unsigned xb_ld(unsigned* p)              { return __hip_atomic_load(p, __ATOMIC_RELAXED, __HIP_MEMORY_SCOPE_AGENT); }
__device__ __forceinline__ unsigned xb_add(unsigned* p, unsigned v) { return __hip_atomic_fetch_add(p, v, __ATOMIC_RELAXED, __HIP_MEMORY_SCOPE_AGENT); }
__device__ __forceinline__ unsigned xb_xcc_id() { return (unsigned)__builtin_amdgcn_s_getreg((3 << 11) | 20) & 0xFu; }
#define XB_SPIN(cond, bar) do { unsigned _sp = 0; while (cond) { __builtin_amdgcn_s_sleep(1); \
    if ((++_sp & 255u) == 0u) { if (xb_ld(&(bar)[XB_TMO])) break; if (_sp > XB_SPIN_CAP) { atomicAdd(&(bar)[XB_TMO], 1u); break; } } } } while (0)
struct XcdBarrier { unsigned* bar; unsigned x; volatile LAS unsigned* st; };
__device__ __forceinline__ XcdBarrier xcd_barrier_post(unsigned* bar, volatile LAS unsigned* st) {
    XcdBarrier b; b.bar = bar; b.x = xb_xcc_id(); b.st = st;
    if (threadIdx.x == 0) (void)xb_add(&bar[XB_XCNT(b.x)], 1u);
    return b;
}
__device__ __forceinline__ void xcd_barrier_complete(unsigned* bar, unsigned x, unsigned& nloc, unsigned& nx) {
    const unsigned G = gridDim.x * gridDim.y * gridDim.z;
    unsigned sum, cnt, mine, sp = 0u;
    for (;;) {
        sum = 0u; cnt = 0u; mine = 0u;
#pragma unroll
        for (unsigned j = 0; j < 16; ++j) { const unsigned c = xb_ld(&bar[XB_XCNT(j)]); sum += c; cnt += (c > 0u) ? 1u : 0u; mine = (j == x) ? c : mine; }
        if (sum == G) break;
        __builtin_amdgcn_s_sleep(1);
        if ((++sp & 255u) == 0u) { if (xb_ld(&bar[XB_TMO])) break; if (sp > XB_SPIN_CAP) { atomicAdd(&bar[XB_TMO], 1u); break; } }
    }
    nloc = mine > 0u ? mine : 1u; nx = cnt > 0u ? cnt : 1u;
}
__device__ __forceinline__ void xcd_barrier(const XcdBarrier& b) {
    asm volatile("s_waitcnt vmcnt(0)" ::: "memory");
    __syncthreads();
    if (threadIdx.x == 0) {
        unsigned* bar = b.bar;
        __builtin_amdgcn_s_waitcnt(0);
        unsigned nloc = b.st[0], nx = b.st[1];
        if (nloc == 0u) { xcd_barrier_complete(bar, b.x, nloc, nx); b.st[0] = nloc; b.st[1] = nx; }
        const unsigned old = xb_add(&bar[XB_XSUB(b.x)], 1u);
        const unsigned gen = old / nloc;
        if (old + 1u == (gen + 1u) * nloc) {
            __builtin_amdgcn_fence(__ATOMIC_RELEASE, "agent");
            asm volatile("s_waitcnt vmcnt(0)" ::: "memory");
            const unsigned og = xb_add(&bar[XB_TOP], 1u);
            const unsigned tg = og / nx;
            if (og + 1u == (tg + 1u) * nx) xb_add(&bar[XB_TOPGEN], 1u);
            else XB_SPIN(xb_ld(&bar[XB_TOPGEN]) == tg, bar);
            __builtin_amdgcn_fence(__ATOMIC_ACQUIRE, "agent");
            xb_add(&bar[XB_XGEN(b.x)], 1u);
            asm volatile("s_waitcnt vmcnt(0)" ::: "memory");
        } else {
            XB_SPIN(xb_ld(&bar[XB_XGEN(b.x)]) == gen, bar);
            __builtin_amdgcn_fence(__ATOMIC_ACQUIRE, "agent");
            asm volatile("s_waitcnt vmcnt(0)" ::: "memory");
        }
    }
    __syncthreads();
}

namespace pg8 {
constexpr int BM = 256, BK = 64, HALF = 128, HTB = HALF * BK * 2, STAGE_BYTES = 8 * HTB, NXCD = 8, WGM = 8;
__host__ __device__ __forceinline__ int lds_byte(int r, int c) { const int st = (r >> 4) * 2 + (c >> 5), rr = r & 15, cc = c & 31, ob = rr * 64 + cc * 2; return st * 1024 + (ob ^ (((ob >> 9) & 1) << 5)); }
__host__ __device__ __forceinline__ void stage_rc(int b, int& R, int& C) { const int st = b / 1024, sb = b % 1024, swz = sb ^ (((sb >> 9) & 1) << 5); R = (st >> 1) * 16 + swz / 64; C = (st & 1) * 32 + (swz % 64) / 2; }
__host__ __device__ __forceinline__ int perm32(int rho) { const int n = rho >> 4, i = rho & 15; return 8 * (i >> 2) + 4 * n + (i & 3); }
struct Unit { int pm, pn, kq, half; };
struct Gemm { const bf16_t* A; const bf16_t* Bt; int M, N, K, lda, ldb, grouped; };
struct Order {
    int nM, nN, nfull, ntail, mode, G, c, qf, rf;
    __device__ void init(int nM_, int nN_, int ntail_, int mode_, int G_, int c_) { nM = nM_; nN = nN_; nfull = nM * nN; ntail = ntail_; mode = mode_; G = G_; c = c_;
        qf = __builtin_amdgcn_readfirstlane(nfull / G); rf = __builtin_amdgcn_readfirstlane(nfull % G); }
    __device__ bool next(int i, Unit& u) const {
        if (mode == 2 && ntail == G && rf == 0 && ((c >> 3) & 1) == 0) {
            if (i == 0) { const int t = c >> 2; u.pm = nM + (t >> 4); u.pn = t & 15; u.kq = c & 3; u.half = 0; return true; }
            if (i > qf) return false;
            i -= 1;
        }
        const long L = (long)i * G + c;
        if (L < nfull) {
            int wgid = (int)L; { const int q = nfull / NXCD, r = nfull % NXCD, xcd = wgid % NXCD, off = wgid / NXCD; wgid = (xcd < r ? xcd * (q + 1) : r * (q + 1) + (xcd - r) * q) + off; }
            const int nig = WGM * nN, gid = wgid / nig, fm = gid * WGM, gsz = (nM - fm) < WGM ? (nM - fm) : WGM;
            u.pm = fm + ((wgid % nig) % gsz); u.pn = (wgid % nig) / gsz; u.kq = -1; u.half = 0; return true;
        }
        int r = rf, q = qf, gr = G - rf, cc = c, ii = i; asm volatile("" : "+s"(r), "+s"(q), "+s"(gr), "+s"(cc), "+s"(ii));
        if (cc < r || ii < q) return false;
        const int e = (ii - q) * gr + (cc - r);
        if (e >= ntail) return false;
        if (mode == 1) { u.pm = e; u.pn = nN; u.kq = -1; u.half = 1; }
        else { const int t = e >> 2; u.pm = nM + (t >> 4); u.pn = t & 15; u.kq = e & 3; u.half = 0; }
        return true;
    }
};

template <class Epi, bool HALFCAP = false, bool I8 = false, bool ALIGN_EPI = true>
__device__ __forceinline__ void gemm_phase(LAS unsigned char* lds, const Gemm g, const Order& S, const Epi& E) {
    int tid = threadIdx.x; asm volatile("" : "+v"(tid));
    const int wid = __builtin_amdgcn_readfirstlane(tid >> 6), lane = tid & 63, wr = wid >> 2, wc = wid & 3, fr = lane & 15, fq = lane >> 4;
    const int K = g.K, ntf = K / BK;
    unsigned voffA[2], voffB[2];
#pragma unroll
    for (int i = 0; i < 2; ++i) { int R, C; stage_rc(tid * 16 + i * 8192, R, C); const int Rb = Epi::PERM ? ((R & ~31) + perm32(R & 31)) : R;
        voffA[i] = (unsigned)(R * g.lda + C) * 2u; voffB[i] = (unsigned)(Rb * g.ldb + C) * 2u; }
    const size_t kstep = (size_t)(BK * 2);
    const size_t hstepA = (size_t)HALF * g.lda * 2, hstepB = (size_t)HALF * g.ldb * 2;
    const size_t tstepA = 2 * hstepA, tstepB = 2 * hstepB;
    const unsigned ldsw = (unsigned)wid * 1024u;
    const int aoff = lds_byte(wr * 64 + fr, fq * 8), boff = lds_byte(wc * 32 + fr, fq * 8);
#define PG8_SA(b, h) (((b) * 2 + (h)) * HTB)
#define PG8_SB(b, h) ((4 + (b) * 2 + (h)) * HTB)
#define PG8_STAGE(bufoff, gbase, voff) do { _Pragma("unroll") for (int _i = 0; _i < 2; ++_i) \
        __builtin_amdgcn_global_load_lds((const unsigned*)((const char*)(gbase) + (voff)[_i]), (LAS unsigned*)(lds + (bufoff) + ldsw + _i * 8192), 16, 0, 0); } while (0)
#define PG8_LDA(dst, b, h) do { _Pragma("unroll") for (int m = 0; m < 4; ++m) _Pragma("unroll") for (int k = 0; k < 2; ++k) dst[m][k] = *(const LAS bf16x8*)(lds + PG8_SA(b, h) + aoff + m * 2048 + k * 1024); } while (0)
#define PG8_LDB(dst, b, h) do { _Pragma("unroll") for (int n = 0; n < 2; ++n) _Pragma("unroll") for (int k = 0; k < 2; ++k) dst[n][k] = *(const LAS bf16x8*)(lds + PG8_SB(b, h) + boff + n * 2048 + k * 1024); } while (0)
#define PG8_MMA(ai, bj, At, Bt) do { __builtin_amdgcn_s_setprio(1); _Pragma("unroll") for (int m = 0; m < 4; ++m) _Pragma("unroll") for (int n = 0; n < 2; ++n) _Pragma("unroll") for (int k = 0; k < 2; ++k) \
        { if constexpr (I8) acc[ai][bj][m][n] = __builtin_bit_cast(f32x4, __builtin_amdgcn_mfma_i32_16x16x64_i8(__builtin_bit_cast(i32x4, Bt[n][k]), __builtin_bit_cast(i32x4, At[m][k]), __builtin_bit_cast(i32x4, acc[ai][bj][m][n]), 0, 0, 0)); \
          else acc[ai][bj][m][n] = __builtin_amdgcn_mfma_f32_16x16x32_bf16(Bt[n][k], At[m][k], acc[ai][bj][m][n], 0, 0, 0); } __builtin_amdgcn_s_setprio(0); } while (0)
#define PG8_MMA1(ai, At, Bt) do { if (!HALFCAP || full) PG8_MMA(ai, 1, At, Bt); } while (0)
#define PG8_WAIT_V(n) asm volatile("s_waitcnt vmcnt(" #n ")" ::: "memory")
#define PG8_WAIT_L(n) asm volatile("s_waitcnt lgkmcnt(" #n ")" ::: "memory")
#define PG8_BAR __builtin_amdgcn_s_barrier()
#define PG8_SCHED __builtin_amdgcn_sched_barrier(0)
#define PG8_KOFF(u) ((u).kq < 0 ? (size_t)0 : (size_t)(u).kq * (size_t)(K / 4) * 2)
#define PG8_APTR(u) ((const char*)g.A + (size_t)(u).pm * tstepA + (g.grouped ? (size_t)((u).pn >> 2) * (size_t)K * 2 : (size_t)0) + PG8_KOFF(u))
#define PG8_BPTR(u) ((const char*)g.Bt + (size_t)(u).pn * tstepB + PG8_KOFF(u))
    Unit cur, nxt; int ui = 0;
    if (!S.next(0, cur)) return;
    f32x4 acc[2][2][4][2];
#pragma unroll
    for (int a = 0; a < 2; ++a)
#pragma unroll
        for (int b = 0; b < 2; ++b)
#pragma unroll
            for (int m = 0; m < 4; ++m)
#pragma unroll
                for (int n = 0; n < 2; ++n) acc[a][b][m][n] = (f32x4){0.f, 0.f, 0.f, 0.f};
    bf16x8 At[4][2], B0[2][2], B1[2][2];
    const char* cA = PG8_APTR(cur); const char* cB = PG8_BPTR(cur);
    PG8_STAGE(PG8_SB(0, 0), cB, voffB); PG8_STAGE(PG8_SB(0, 1), cB + hstepB, voffB); PG8_STAGE(PG8_SA(0, 0), cA, voffA); PG8_STAGE(PG8_SA(0, 1), cA + hstepA, voffA);
    if (wr == 1) PG8_BAR;
    PG8_WAIT_V(2); PG8_BAR;
    PG8_STAGE(PG8_SB(1, 0), cB + kstep, voffB); PG8_STAGE(PG8_SA(1, 0), cA + kstep, voffA); PG8_STAGE(PG8_SB(1, 1), cB + hstepB + kstep, voffB);
    PG8_WAIT_V(6); PG8_BAR;
    for (;;) {
        const bool has_next = S.next(ui + 1, nxt);
        const char* nA = has_next ? PG8_APTR(nxt) : cA; const char* nB = has_next ? PG8_BPTR(nxt) : cB;
        const int nt = cur.kq < 0 ? ntf : ntf / 4; const bool full = !cur.half; (void)full;
        for (int t = 0; t < nt; t += 2) {
            const bool last = (t == nt - 2);
            const char* a1 = cA + (size_t)(t + 1) * kstep;
            const char* a2 = last ? nA : cA + (size_t)(t + 2) * kstep; const char* b2 = last ? nB : cB + (size_t)(t + 2) * kstep;
            const char* a3 = a2 + kstep; const char* b3 = b2 + kstep;
            PG8_LDB(B0, 0, 0); PG8_LDB(B1, 0, 1); PG8_SCHED; PG8_LDA(At, 0, 0); PG8_STAGE(PG8_SA(1, 1), a1 + hstepA, voffA);
            PG8_WAIT_V(8); PG8_WAIT_L(0); PG8_BAR; PG8_MMA(0, 0, At, B0); PG8_MMA1(0, At, B1); PG8_BAR; PG8_SCHED;
            PG8_LDA(At, 0, 1); PG8_STAGE(PG8_SB(0, 0), b2, voffB); PG8_STAGE(PG8_SB(0, 1), b2 + hstepB, voffB); PG8_STAGE(PG8_SA(0, 0), a2, voffA);
            PG8_WAIT_V(8); PG8_WAIT_L(0); PG8_BAR; PG8_MMA(1, 0, At, B0); PG8_MMA1(1, At, B1); PG8_BAR; PG8_SCHED;
            PG8_LDB(B0, 1, 0); PG8_LDB(B1, 1, 1); PG8_SCHED; PG8_LDA(At, 1, 0); PG8_STAGE(PG8_SA(0, 1), a2 + hstepA, voffA);
            PG8_WAIT_V(8); PG8_WAIT_L(0); PG8_BAR; PG8_MMA(0, 0, At, B0); PG8_MMA1(0, At, B1); PG8_BAR; PG8_SCHED;
            PG8_LDA(At, 1, 1); PG8_STAGE(PG8_SB(1, 0), b3, voffB); PG8_STAGE(PG8_SB(1, 1), b3 + hstepB, voffB); PG8_STAGE(PG8_SA(1, 0), a3, voffA);
            PG8_WAIT_V(8); PG8_WAIT_L(0); PG8_BAR; PG8_MMA(1, 0, At, B0); PG8_MMA1(1, At, B1); PG8_BAR; PG8_SCHED;
        }
        if constexpr (ALIGN_EPI) { if (wr == 0) PG8_BAR; }
        E(acc, cur, wr, wc, fr, fq);
        if (!has_next) break;
#pragma unroll
        for (int a = 0; a < 2; ++a)
#pragma unroll
            for (int b = 0; b < 2; ++b)
#pragma unroll
                for (int m = 0; m < 4; ++m)
#pragma unroll
                    for (int n = 0; n < 2; ++n) acc[a][b][m][n] = (f32x4){0.f, 0.f, 0.f, 0.f};
        cur = nxt; cA = nA; cB = nB; ++ui;
        if constexpr (ALIGN_EPI) { if (wr == 1) PG8_BAR; }
    }
    PG8_WAIT_V(0);
    if constexpr (!ALIGN_EPI) { if (wr == 0) PG8_BAR; }
    PG8_BAR;
#undef PG8_SA
#undef PG8_SB
#undef PG8_STAGE
#undef PG8_LDA
#undef PG8_LDB
#undef PG8_MMA
#undef PG8_MMA1
#undef PG8_WAIT_V
#undef PG8_WAIT_L
#undef PG8_BAR
#undef PG8_SCHED
#undef PG8_KOFF
#undef PG8_APTR
#undef PG8_BPTR
}
}

struct Params {
    const float *x_prompt, *x_sample, *cache_k, *cache_v, *cache_kidx, *state_pool, *norm_w, *final_norm_w, *attn_w_in, *attn_w_out, *rel_bias,
                *pool_w_in, *pool_group_w, *pool_scale, *pool_w_out;
    float* out; unsigned char* ws; int ph_lo, ph_hi;
};

__device__ __forceinline__ u32x4 pack8(const f32x4 a, const f32x4 b) { u32x4 w; w.x = cvt_pk_bf16(a[0], a[1]); w.y = cvt_pk_bf16(a[2], a[3]); w.z = cvt_pk_bf16(b[0], b[1]); w.w = cvt_pk_bf16(b[2], b[3]); return w; }
__device__ __forceinline__ f32x4 silu4(f32x4 v) { return (f32x4){silu_f(v[0]), silu_f(v[1]), silu_f(v[2]), silu_f(v[3])}; }

constexpr int UP_SEQ = SEQ + 16, US_SEQ = DSQ + 16, UP_ROWS = NBATCH * UP_SEQ;
__device__ __forceinline__ int u_row(int r) { return r < MP ? (r >> 12) * UP_SEQ + 16 + (r & 4095) : UP_ROWS + ((r - MP) >> 5) * US_SEQ + 16 + ((r - MP) & 31); }
__device__ __forceinline__ size_t kif_off(int s, int d0) { return ((size_t)(((s >> 5) * 4 + (d0 >> 4)) * 64 + ((d0 >> 3) & 1) * 32 + (s & 31))) * 8; }

struct Epi1a {
    static constexpr bool PERM = true;
    unsigned char* ws; float* out;
    __device__ __forceinline__ void operator()(const f32x4 (&acc)[2][2][4][2], const pg8::Unit& u, int wr, int wc, int fr, int fq) const {
        const int pn = u.pn; const float* SA = (const float*)(ws + WS_SA); const float* SB = (const float*)(ws + WS_SB);
#pragma unroll
        for (int bj = 0; bj < 2; ++bj) {
            const int lc = bj * 128 + wc * 32 + 8 * fq, gc = pn * 256 + lc;
            const f32x4 sb0 = *(const f32x4*)(SB + gc), sb1 = *(const f32x4*)(SB + gc + 4);
#pragma unroll
            for (int ai = 0; ai < 2; ++ai)
#pragma unroll
                for (int m = 0; m < 4; ++m) {
                    const int r = u.pm * 256 + ai * 128 + wr * 64 + m * 16 + fr; const float sa = SA[r];
                    const i32x4 i0 = __builtin_bit_cast(i32x4, acc[ai][bj][m][0]), i1 = __builtin_bit_cast(i32x4, acc[ai][bj][m][1]);
                    const f32x4 v0 = (f32x4){(float)i0[0], (float)i0[1], (float)i0[2], (float)i0[3]} * sb0 * sa, v1 = (f32x4){(float)i1[0], (float)i1[1], (float)i1[2], (float)i1[3]} * sb1 * sa;
                    if (pn < 16) *(u32x4*)((bf16_t*)(ws + WS_QB) + (size_t)r * DM + gc) = pack8(v0, v1);
                    else if (pn < 24) {
                        const bool isv = pn >= 20; const int c = (pn & 3) * 256 + lc; const bool samp = r >= MP; const int rs = r - MP;
                        bf16_t* dst; float* fo;
                        if (!samp) { dst = (bf16_t*)(ws + (isv ? WS_VP : WS_KP)) + (size_t)r * KVW + c; fo = out + (isv ? O_VP : O_KP) + (size_t)r * KVW + c; }
                        else { dst = (bf16_t*)(ws + (isv ? WS_VSN : WS_KSN)) + (size_t)rs * KVW + c; fo = out + (isv ? O_VS : O_KS) + (size_t)rs * KVW + c; }
                        *(u32x4*)dst = pack8(v0, v1); *(f32x4*)fo = v0; *(f32x4*)(fo + 4) = v1;
                    }
                    else *(u32x4*)((bf16_t*)(ws + WS_SG) + (size_t)r * DM + (gc - 6144)) = pack8(silu4(v0), silu4(v1));
                }
        }
    }
};
struct Epi1b {
    static constexpr bool PERM = true;
    unsigned char* ws; float* out;
    __device__ __forceinline__ void operator()(const f32x4 (&acc)[2][2][4][2], const pg8::Unit& u, int wr, int wc, int fr, int fq) const {
        const int pn = u.pn;
#pragma unroll
        for (int ai = 0; ai < 2; ++ai)
#pragma unroll
            for (int m = 0; m < 4; ++m) {
                const int r = u.pm * 256 + ai * 128 + wr * 64 + m * 16 + fr;
                const bool samp = r >= MP; const int rs = r - MP, sb = rs >> 5, st = rs & 31;
#pragma unroll
                for (int bj = 0; bj < 2; ++bj) {
                    const int lc = bj * 128 + wc * 32 + 8 * fq;
                    const f32x4 v0 = acc[ai][bj][m][0], v1 = acc[ai][bj][m][1];
                    if (pn < 8) {
                        const int c = pn * 256 + lc, h = c >> 6, d = c & 63;
                        *(u32x4*)((bf16_t*)(ws + WS_QIB) + ((((size_t)(r >> 5) * 32 + h) * 4 + (d >> 4)) * 2 + ((d >> 3) & 1)) * 256 + (r & 31) * 8) = pack8(v0, v1);
                    } else {
                        if (lc < 64) {
                            bf16_t* dst; float* fo;
                            if (!samp) { dst = (bf16_t*)(ws + WS_KIP) + (size_t)(r >> 12) * SEQ * DIDX + kif_off(r & 4095, lc); fo = out + O_KIP + (size_t)r * DIDX + lc; }
                            else { dst = (bf16_t*)(ws + WS_KIS) + (size_t)sb * SKV * DIDX + kif_off(PAST + st, lc); fo = out + O_KIS + (size_t)rs * DIDX + lc; }
                            *(u32x4*)dst = pack8(v0, v1); *(f32x4*)fo = v0; *(f32x4*)(fo + 4) = v1;
                        } else if (lc < 96) {
                            float* fo = (float*)(ws + WS_WIB) + (size_t)r * HIDX + (lc - 64);
                            *(f32x4*)fo = v0; *(f32x4*)(fo + 4) = v1;
                        }
                    }
                }
            }
    }
};
__device__ __forceinline__ f32x4 cvt_i32x4(const f32x4 a) { const i32x4 i = __builtin_bit_cast(i32x4, a); return (f32x4){(float)i[0], (float)i[1], (float)i[2], (float)i[3]}; }
struct EpiX1 {
    static constexpr bool PERM = true;
    const float* xp; float* X1; bf16_t* XB; float* PS; const float* SA; const float* SB;
    __device__ __forceinline__ void operator()(const f32x4 (&acc)[2][2][4][2], const pg8::Unit& u, int wr, int wc, int fr, int fq) const {
        f32x4 sb[2][2];
#pragma unroll
        for (int bj = 0; bj < 2; ++bj)
#pragma unroll
            for (int n = 0; n < 2; ++n) sb[bj][n] = *(const f32x4*)(SB + u.pn * 256 + bj * 128 + wc * 32 + 8 * fq + 4 * n);
#pragma unroll
        for (int ai = 0; ai < 2; ++ai)
#pragma unroll
            for (int m = 0; m < 4; ++m) {
                const int r = u.pm * 256 + ai * 128 + wr * 64 + m * 16 + fr; const float sa = SA[r];
                if (u.kq >= 0) {
                    float* d = PS + ((size_t)u.kq * MS + (r - MP)) * DM;
#pragma unroll
                    for (int bj = 0; bj < 2; ++bj)
#pragma unroll
                        for (int n = 0; n < 2; ++n) *(f32x4*)(d + u.pn * 256 + bj * 128 + wc * 32 + 8 * fq + 4 * n) = cvt_i32x4(acc[ai][bj][m][n]) * sb[bj][n] * sa;
                } else {
                    const float* b = xp + (size_t)r * DM; bf16_t* db = XB + (size_t)r * DM;
#pragma unroll
                    for (int bj = 0; bj < 2; ++bj) { const int c = u.pn * 256 + bj * 128 + wc * 32 + 8 * fq;
                        const f32x4 v0 = *(const f32x4*)(b + c) + cvt_i32x4(acc[ai][bj][m][0]) * sb[bj][0] * sa, v1 = *(const f32x4*)(b + c + 4) + cvt_i32x4(acc[ai][bj][m][1]) * sb[bj][1] * sa;
                        *(u32x4*)(db + c) = pack8(v0, v1); }
                }
            }
    }
};
struct EpiX2 {
    static constexpr bool PERM = true;
    bf16_t* XB; float* PS; const float* SA; const float* SB;
    __device__ __forceinline__ void operator()(const f32x4 (&acc)[2][2][4][2], const pg8::Unit& u, int wr, int wc, int fr, int fq) const {
        f32x4 sb[2][2];
#pragma unroll
        for (int bj = 0; bj < 2; ++bj)
#pragma unroll
            for (int n = 0; n < 2; ++n) sb[bj][n] = *(const f32x4*)(SB + u.pn * 256 + bj * 128 + wc * 32 + 8 * fq + 4 * n);
#pragma unroll
        for (int ai = 0; ai < 2; ++ai)
#pragma unroll
            for (int m = 0; m < 4; ++m) {
                const int r = u.pm * 256 + ai * 128 + wr * 64 + m * 16 + fr; const float sa = SA[r];
                float* d = PS + ((size_t)(u.kq >= 0 ? u.kq : 0) * MS + (r - MP)) * DM; bf16_t* db = XB + (size_t)r * DM;
#pragma unroll
                for (int bj = 0; bj < 2; ++bj) { const int c = u.pn * 256 + bj * 128 + wc * 32 + 8 * fq;
                    const f32x4 v0 = cvt_i32x4(acc[ai][bj][m][0]) * sb[bj][0] * sa, v1 = cvt_i32x4(acc[ai][bj][m][1]) * sb[bj][1] * sa;
                    if (u.kq >= 0) { *(f32x4*)(d + c) = v0; *(f32x4*)(d + c + 4) = v1; }
                    else { const u32x4 x = *(const u32x4*)(db + c);
                        *(u32x4*)(db + c) = pack8((f32x4){bf_lo(x.x), bf_hi(x.x), bf_lo(x.y), bf_hi(x.y)} + v0, (f32x4){bf_lo(x.z), bf_hi(x.z), bf_lo(x.w), bf_hi(x.w)} + v1); } }
            }
    }
};
struct Epi3 {
    static constexpr bool PERM = true;
    unsigned char* ws; float* out;
    __device__ __forceinline__ void operator()(const f32x4 (&acc)[2][2][4][2], const pg8::Unit& u, int wr, int wc, int fr, int fq) const {
        const int pn = u.pn; const float* ROWF = (const float*)(ws + WS_ROWF); const float* SB2 = (const float*)(ws + WS_SB2);
#pragma unroll
        for (int ai = 0; ai < 2; ++ai)
#pragma unroll
            for (int m = 0; m < 4; ++m) {
                const int r = u.pm * 256 + ai * 128 + wr * 64 + m * 16 + fr;
                const float rowf = ROWF[r];
                float* po = nullptr;
                if (r < MP) { const int t = r & 4095; if (t >= SEQ - 15) po = out + O_POOLP + ((size_t)(r >> 12) * 15 + (t - (SEQ - 15))) * DM; }
                else { const int rs = r - MP, t = rs & 31; if (t >= DSQ - 15) po = out + O_POOLS + ((size_t)(rs >> 5) * 15 + (t - (DSQ - 15))) * DM; }
#pragma unroll
                for (int bj = 0; bj < 2; ++bj) {
                    const int lc = bj * 128 + wc * 32 + 8 * fq;
                    const f32x4 s0 = *(const f32x4*)(SB2 + pn * 256 + lc), s1 = *(const f32x4*)(SB2 + pn * 256 + lc + 4);
                    const i32x4 i0 = __builtin_bit_cast(i32x4, acc[ai][bj][m][0]), i1 = __builtin_bit_cast(i32x4, acc[ai][bj][m][1]);
                    const f32x4 v0 = (f32x4){(float)i0[0], (float)i0[1], (float)i0[2], (float)i0[3]} * s0 * rowf, v1 = (f32x4){(float)i1[0], (float)i1[1], (float)i1[2], (float)i1[3]} * s1 * rowf;
                    if (pn < 16) {
                        const int c = pn * 256 + lc;
                        *(u32x4*)((bf16_t*)(ws + WS_U) + (size_t)u_row(r) * DM + c) = pack8(v0, v1);
                        if (po) { *(f32x4*)(po + c) = v0; *(f32x4*)(po + c + 4) = v1; }
                    } else {
                        *(u32x4*)((bf16_t*)(ws + WS_SG2) + (size_t)r * DM + (pn - 16) * 256 + lc) = pack8(silu4(v0), silu4(v1));
                    }
                }
            }
    }
};
struct Epi4 {
    static constexpr bool PERM = true;
    unsigned char* ws; const float* scale;
    __device__ __forceinline__ void operator()(const f32x4 (&acc)[2][2][4][2], const pg8::Unit& u, int wr, int wc, int fr, int fq) const {
#pragma unroll
        for (int bj = 0; bj < 2; ++bj) {
            const int c = u.pn * 256 + bj * 128 + wc * 32 + 8 * fq;
            const f32x4 s0 = *(const f32x4*)(scale + c), s1 = *(const f32x4*)(scale + c + 4);
#pragma unroll
            for (int ai = 0; ai < 2; ++ai)
#pragma unroll
                for (int m = 0; m < 4; ++m) {
                    const int r = u.pm * 256 + ai * 128 + wr * 64 + m * 16 + fr;
                    const u32x4 gw = *(const u32x4*)((const bf16_t*)(ws + WS_SG2) + (size_t)r * DM + c);
                    const f32x4 g0 = (f32x4){bf_lo(gw.x), bf_hi(gw.x), bf_lo(gw.y), bf_hi(gw.y)}, g1 = (f32x4){bf_lo(gw.z), bf_hi(gw.z), bf_lo(gw.w), bf_hi(gw.w)};
                    *(u32x4*)((bf16_t*)(ws + WS_ZG) + (size_t)r * DM + c) = pack8(acc[ai][bj][m][0] * s0 * g0, acc[ai][bj][m][1] * s1 * g1);
                }
        }
    }
};

__device__ __forceinline__ void transpose_item(const float* W, int N, int k0, int n0, bf16_t* WT, int K, int drow0, int nvalid, LAS float* scr, int lane) {
    const int cq = lane & 15, rq = lane >> 4;
    const float* src = W + (size_t)(k0 + 4 * rq) * N + n0 + 4 * cq;
    f32x4 a[16];
#pragma unroll
    for (int g = 0; g < 4; ++g)
#pragma unroll
        for (int i = 0; i < 4; ++i) a[g * 4 + i] = *(const f32x4*)(src + (size_t)(16 * g + i) * N);
    LAS unsigned char* T = (LAS unsigned char*)scr;
#pragma unroll
    for (int g = 0; g < 4; ++g)
#pragma unroll
        for (int c = 0; c < 4; ++c) { u32x2 o; o.x = cvt_pk_bf16(a[g * 4 + 0][c], a[g * 4 + 1][c]); o.y = cvt_pk_bf16(a[g * 4 + 2][c], a[g * 4 + 3][c]);
            *(LAS u32x2*)(T + (4 * cq + c) * 136 + 32 * g + 8 * rq) = o; }
    LDS_WAIT(); asm volatile("" ::: "memory");
    const int kc = lane & 7;
#pragma unroll
    for (int sI = 0; sI < 8; ++sI) { const int n = 8 * sI + (lane >> 3);
        const u32x2 lo = *(const LAS u32x2*)(T + n * 136 + 16 * kc), hi = *(const LAS u32x2*)(T + n * 136 + 16 * kc + 8);
        if (n < nvalid) *(u32x4*)(WT + (size_t)(drow0 + n) * K + k0 + 8 * kc) = (u32x4){lo.x, lo.y, hi.x, hi.y}; }
    LDS_WAIT(); asm volatile("" ::: "memory");
}
__device__ __forceinline__ unsigned q8(float v) { return (unsigned)(int)__builtin_rintf(v) & 0xffu; }
__device__ __forceinline__ unsigned q8x4(float a, float b, float c, float d) { return q8(a) | (q8(b) << 8) | (q8(c) << 16) | (q8(d) << 24); }
__device__ __forceinline__ void transpose_item_i8(const float* W, int N, int k0, int n0, signed char* WT, int K, int drow0, LAS float* scr, int lane, const unsigned* camax, float* sbout, const float* kscale = nullptr) {
    const int cq = lane & 15, rq = lane >> 4;
    const float* src = W + (size_t)(k0 + 4 * rq) * N + n0 + 4 * cq;
    f32x4 ks[8];
    if (kscale) {
#pragma unroll
        for (int g = 0; g < 8; ++g) ks[g] = *(const f32x4*)(kscale + k0 + 16 * g + 4 * rq); }
    const u32x4 cm = *(const u32x4*)(camax + drow0 + 4 * cq);
    f32x4 a[32];
#pragma unroll
    for (int g = 0; g < 8; ++g)
#pragma unroll
        for (int i = 0; i < 4; ++i) a[g * 4 + i] = *(const f32x4*)(src + (size_t)(16 * g + i) * N);
    f32x4 inv;
#pragma unroll
    for (int c = 0; c < 4; ++c) { const float am = __uint_as_float(cm[c]); inv[c] = am > 0.f ? 127.0f / am : 0.f; }
    LAS unsigned char* T = (LAS unsigned char*)scr;
#pragma unroll
    for (int g = 0; g < 8; ++g) {
        f32x4 r0 = a[g * 4 + 0] * inv, r1 = a[g * 4 + 1] * inv, r2 = a[g * 4 + 2] * inv, r3 = a[g * 4 + 3] * inv;
        if (kscale) { r0 = r0 * ks[g][0]; r1 = r1 * ks[g][1]; r2 = r2 * ks[g][2]; r3 = r3 * ks[g][3]; }
#pragma unroll
        for (int c = 0; c < 4; ++c) *(LAS unsigned*)(T + (4 * cq + c) * 132 + 16 * g + 4 * rq) = q8x4(r0[c], r1[c], r2[c], r3[c]);
    }
    LDS_WAIT(); asm volatile("" ::: "memory");
    const int kc = lane & 7;
#pragma unroll
    for (int sI = 0; sI < 8; ++sI) { const int n = 8 * sI + (lane >> 3); const LAS unsigned* tp = (const LAS unsigned*)(T + n * 132 + 16 * kc);
        *(u32x4*)(WT + (size_t)(drow0 + n) * K + k0 + 16 * kc) = (u32x4){tp[0], tp[1], tp[2], tp[3]}; }
    if (k0 == 0) sbout[drow0 + lane] = __uint_as_float(camax[drow0 + lane]) * (1.0f / 127.0f);
    LDS_WAIT(); asm volatile("" ::: "memory");
}
template <bool KS>
__device__ __forceinline__ f32x4 col_amax64(const float* wp, size_t stride, const float* nw) {
    f32x4 m = (f32x4){0.f, 0.f, 0.f, 0.f}; f32x4 a[8], b[8];
#define CA_LD(dst) do { _Pragma("unroll") for (int i = 0; i < 8; ++i) dst[i] = *(const f32x4*)(wp + (size_t)i * stride); wp += 8 * stride; asm volatile("" ::: "memory"); } while (0)
#define CA_USE(src) do { _Pragma("unroll") for (int i = 0; i < 8; ++i) { f32x4 x = src[i]; if (KS) x = x * nw[i]; \
        m.x = fmaxf(m.x, fabsf(x.x)); m.y = fmaxf(m.y, fabsf(x.y)); m.z = fmaxf(m.z, fabsf(x.z)); m.w = fmaxf(m.w, fabsf(x.w)); } if (KS) nw += 8; } while (0)
    CA_LD(a);
#pragma unroll 1
    for (int kb = 0; kb < 4; ++kb) {
        CA_LD(b);
        CA_USE(a);
        if (kb < 3) CA_LD(a);
        CA_USE(b);
    }
#undef CA_LD
#undef CA_USE
    return m;
}
__device__ __forceinline__ void rms_row_q(f32x4 (&v)[16], const LAS f32x4* w, bf16_t* orow, signed char* qrow, float* sa, int lane) {
    const LAS f32x4* wr = w + lane;
    float s = 0.f;
#pragma unroll
    for (int j = 0; j < 16; ++j) s += (v[j].x * v[j].x + v[j].y * v[j].y) + (v[j].z * v[j].z + v[j].w * v[j].w);
    const float rstd = 1.0f / sqrtf(wave_sum(s) * (1.0f / DM) + EPS);
    float am = 0.f;
#pragma unroll
    for (int j = 0; j < 16; ++j) { v[j] = v[j] * rstd * wr[64 * j]; am = fmaxf(am, fmaxf(fmaxf(fabsf(v[j].x), fabsf(v[j].y)), fmaxf(fabsf(v[j].z), fabsf(v[j].w))));
        u32x2 o; o.x = cvt_pk_bf16(v[j].x, v[j].y); o.y = cvt_pk_bf16(v[j].z, v[j].w); ((u32x2*)orow + lane)[64 * j] = o;
        if ((j & 3) == 3) asm volatile("" ::: "memory"); }
#pragma unroll
    for (int o = 1; o < 64; o <<= 1) am = fmaxf(am, __shfl_xor(am, o));
    const float inv = am > 0.f ? 127.0f / am : 0.f;
#pragma unroll
    for (int j = 0; j < 16; ++j) ((unsigned*)qrow + lane)[64 * j] = q8x4(v[j].x * inv, v[j].y * inv, v[j].z * inv, v[j].w * inv);
    if (lane == 0) *sa = am * (1.0f / 127.0f);
}
template <class F>
__device__ __forceinline__ void quant_rows_bf16(const bf16_t* src, signed char* dst, int M, int gw, int NGW, int lane, F fin) {
    u32x4 x[8], xn[8];
    if (gw < M) {
#pragma unroll
        for (int j = 0; j < 8; ++j) x[j] = ((const u32x4*)(src + (size_t)gw * DM) + lane)[64 * j]; }
#pragma unroll 1
    for (int m = gw; m < M; m += NGW) {
        if (m + NGW < M) {
#pragma unroll
            for (int j = 0; j < 8; ++j) xn[j] = ((const u32x4*)(src + (size_t)(m + NGW) * DM) + lane)[64 * j]; }
        float am = 0.f, ss = 0.f;
#pragma unroll
        for (int j = 0; j < 8; ++j) {
            const float f[8] = {bf_lo(x[j].x), bf_hi(x[j].x), bf_lo(x[j].y), bf_hi(x[j].y), bf_lo(x[j].z), bf_hi(x[j].z), bf_lo(x[j].w), bf_hi(x[j].w)};
#pragma unroll
            for (int e = 0; e < 8; ++e) { am = fmaxf(am, fabsf(f[e])); ss = fmaf(f[e], f[e], ss); } }
#pragma unroll
        for (int o = 1; o < 64; o <<= 1) am = fmaxf(am, __shfl_xor(am, o));
        ss = wave_sum(ss);
        const float inv = am > 0.f ? 127.0f / am : 0.f;
        u32x2* q = (u32x2*)(dst + (size_t)m * DM) + lane;
#pragma unroll
        for (int j = 0; j < 8; ++j) { u32x2 o; o.x = q8x4(bf_lo(x[j].x) * inv, bf_hi(x[j].x) * inv, bf_lo(x[j].y) * inv, bf_hi(x[j].y) * inv);
            o.y = q8x4(bf_lo(x[j].z) * inv, bf_hi(x[j].z) * inv, bf_lo(x[j].w) * inv, bf_hi(x[j].w) * inv); q[64 * j] = o; }
        fin(m, am, ss);
#pragma unroll
        for (int j = 0; j < 8; ++j) x[j] = xn[j];
    }
}
template <bool F32OUT>
__device__ __forceinline__ void rms_row(const float* xrow, const float* w, void* orow, int lane) {
    const f32x4* xr = (const f32x4*)xrow + lane; const f32x4* wr = (const f32x4*)w + lane;
    f32x4 v[16]; float s = 0.f;
#pragma unroll
    for (int j = 0; j < 16; ++j) { v[j] = xr[64 * j]; s += (v[j].x * v[j].x + v[j].y * v[j].y) + (v[j].z * v[j].z + v[j].w * v[j].w); }
    const float rstd = 1.0f / sqrtf(wave_sum(s) * (1.0f / DM) + EPS);
#pragma unroll
    for (int j = 0; j < 16; ++j) { const f32x4 g = wr[64 * j]; const f32x4 y = v[j] * rstd * g;
        if (F32OUT) ((f32x4*)orow + lane)[64 * j] = y;
        else { u32x2 o; o.x = cvt_pk_bf16(y.x, y.y); o.y = cvt_pk_bf16(y.z, y.w); ((u32x2*)orow + lane)[64 * j] = o; } }
}

__device__ __forceinline__ unsigned ord_key(float f) { const unsigned b = __float_as_uint(f); return (b & 0x80000000u) ? ~b : (b | 0x80000000u); }
constexpr int NVJ = 65;
constexpr int SC_WT_OFF = RING_BYTES + 1024;
constexpr int SC_QB_OFF = SC_WT_OFF + 4096;
__device__ __forceinline__ void score_tiles(const bf16_t* __restrict__ qif, const float* __restrict__ wi, const bf16_t* __restrict__ kif, float* __restrict__ sc,
                                            int kt0, int step, int count, LAS unsigned char* lds) {
    int tid = threadIdx.x; asm volatile("" : "+v"(tid));
    const int wid = __builtin_amdgcn_readfirstlane(tid >> 6), lane = tid & 63, r32 = lane & 31, hi = lane >> 5;
    constexpr float WSC = 0.5f * 0.125f * 0.17677669529663687f;
    __syncthreads();
    {   const u32x4* src = (const u32x4*)qif; LAS u32x4* dst = (LAS u32x4*)lds;
        u32x4 t[16];
#pragma unroll
        for (int i = 0; i < 16; ++i) t[i] = src[tid + 512 * i];
#pragma unroll
        for (int i = 0; i < 16; ++i) dst[tid + 512 * i] = t[i];
        LAS float* wt = (LAS float*)(lds + SC_WT_OFF);
#pragma unroll
        for (int e = tid; e < 1024; e += NTHREADS) { const int h = e >> 5, hh = (e >> 4) & 1, r = e & 15, q = (r & 3) + 8 * (r >> 2) + 4 * hh;
            wt[e] = wi[q * HIDX + h] * WSC; }
    }
    __syncthreads();
    if (tid < 256) {
        const int q = tid >> 3, ch = tid & 7; float acc[8] = {0.f, 0.f, 0.f, 0.f, 0.f, 0.f, 0.f, 0.f};
        const LAS u32x4* Af = (const LAS u32x4*)lds + ch * 32 + q;
        const LAS float* wtq = (const LAS float*)(lds + SC_WT_OFF) + ((q >> 2) & 1) * 16 + (q & 3) + 4 * (q >> 3);
#pragma unroll 4
        for (int h = 0; h < 32; ++h) { const float w = wtq[h * 32]; const u32x4 x = Af[h * 256];
            acc[0] = fmaf(w, bf_lo(x.x), acc[0]); acc[1] = fmaf(w, bf_hi(x.x), acc[1]); acc[2] = fmaf(w, bf_lo(x.y), acc[2]); acc[3] = fmaf(w, bf_hi(x.y), acc[3]);
            acc[4] = fmaf(w, bf_lo(x.z), acc[4]); acc[5] = fmaf(w, bf_hi(x.z), acc[5]); acc[6] = fmaf(w, bf_lo(x.w), acc[6]); acc[7] = fmaf(w, bf_hi(x.w), acc[7]); }
        u32x4 vh, vl;
        vh.x = cvt_pk_bf16(acc[0], acc[1]); vh.y = cvt_pk_bf16(acc[2], acc[3]); vh.z = cvt_pk_bf16(acc[4], acc[5]); vh.w = cvt_pk_bf16(acc[6], acc[7]);
        vl.x = cvt_pk_bf16(acc[0] - bf_lo(vh.x), acc[1] - bf_hi(vh.x)); vl.y = cvt_pk_bf16(acc[2] - bf_lo(vh.y), acc[3] - bf_hi(vh.y));
        vl.z = cvt_pk_bf16(acc[4] - bf_lo(vh.z), acc[5] - bf_hi(vh.z)); vl.w = cvt_pk_bf16(acc[6] - bf_lo(vh.w), acc[7] - bf_hi(vh.w));
        LAS u32x4* qb = (LAS u32x4*)(lds + SC_QB_OFF);
        qb[ch * 32 + q] = vh; qb[256 + ch * 32 + q] = vl;
    }
    __syncthreads();
    const LAS bf16x8* A = (const LAS bf16x8*)lds + lane;
    const LAS bf16x8* QBF = (const LAS bf16x8*)(lds + SC_QB_OFF) + lane;
    const LAS f32x4* W4 = (const LAS f32x4*)(lds + SC_WT_OFF) + hi * 4;
#define FMA8(NOP, S, W, C, B, X) asm volatile(NOP "v_fma_f32 %0, %8, |%16|, %0\n\tv_fma_f32 %1, %9, |%17|, %1\n\tv_fma_f32 %2, %10, |%18|, %2\n\tv_fma_f32 %3, %11, |%19|, %3\n\t" \
        "v_fma_f32 %4, %12, |%20|, %4\n\tv_fma_f32 %5, %13, |%21|, %5\n\tv_fma_f32 %6, %14, |%22|, %6\n\tv_fma_f32 %7, %15, |%23|, %7" \
        : "+v"(S[B + 0]), "+v"(S[B + 1]), "+v"(S[B + 2]), "+v"(S[B + 3]), "+v"(S[B + 4]), "+v"(S[B + 5]), "+v"(S[B + 6]), "+v"(S[B + 7]) \
        : "v"(W[B + 0]), "v"(W[B + 1]), "v"(W[B + 2]), "v"(W[B + 3]), "v"(W[B + 4]), "v"(W[B + 5]), "v"(W[B + 6]), "v"(W[B + 7]), \
          "v"(C[B + 0]), "v"(C[B + 1]), "v"(C[B + 2]), "v"(C[B + 3]), "v"(C[B + 4]), "v"(C[B + 5]), "v"(C[B + 6]), "v"(C[B + 7]), "v"(X))
#define SC_LDA(dst, h) do { _Pragma("unroll") for (int ks = 0; ks < 4; ++ks) dst[ks] = A[((h) * 4 + ks) * 64]; } while (0)
#define SC_STEP(a, h) do { const f32x4 w0 = W4[(h) * 8 + 0], w1 = W4[(h) * 8 + 1], w2 = W4[(h) * 8 + 2], w3 = W4[(h) * 8 + 3]; \
        const float w[16] = {w0.x, w0.y, w0.z, w0.w, w1.x, w1.y, w1.z, w1.w, w2.x, w2.y, w2.z, w2.w, w3.x, w3.y, w3.z, w3.w}; \
        f32x16 c0 = {}, c1 = {}; \
        _Pragma("unroll") for (int ks = 0; ks < 4; ++ks) { c0 = __builtin_amdgcn_mfma_f32_32x32x16_bf16(a[ks], b0[ks], c0, 0, 0, 0); c1 = __builtin_amdgcn_mfma_f32_32x32x16_bf16(a[ks], b1[ks], c1, 0, 0, 0); } \
        FMA8("s_nop 11\n\t", s0, w, c0, 0, c1[15]); FMA8("", s0, w, c0, 8, c1[15]); FMA8("", s1, w, c1, 0, c1[15]); FMA8("", s1, w, c1, 8, c1[15]); } while (0)
    for (int idx = wid; idx < count; idx += NWAVES) {
        const int kt = kt0 + step * idx;
        const bf16x8* kb = (const bf16x8*)kif + (size_t)kt * 512 + lane;
        bf16x8 b0[4], b1[4];
#pragma unroll
        for (int ks = 0; ks < 4; ++ks) { b0[ks] = kb[ks * 64]; b1[ks] = kb[(4 + ks) * 64]; }
        f32x16 s0 = {}, s1 = {};
#pragma unroll
        for (int ks = 0; ks < 4; ++ks) { const bf16x8 qh = QBF[ks * 64], ql = QBF[256 + ks * 64];
            s0 = __builtin_amdgcn_mfma_f32_32x32x16_bf16(qh, b0[ks], s0, 0, 0, 0); s1 = __builtin_amdgcn_mfma_f32_32x32x16_bf16(qh, b1[ks], s1, 0, 0, 0);
            s0 = __builtin_amdgcn_mfma_f32_32x32x16_bf16(ql, b0[ks], s0, 0, 0, 0); s1 = __builtin_amdgcn_mfma_f32_32x32x16_bf16(ql, b1[ks], s1, 0, 0, 0); }
        bf16x8 aA[4], aB[4];
        SC_LDA(aA, 0);
#pragma unroll 1
        for (int h = 0; h < 32; h += 2) {
            SC_LDA(aB, h + 1);
            { bf16x8 (&a)[4] = aA; SC_STEP(a, h); }
            if (h + 2 < 32) SC_LDA(aA, h + 2);
            { bf16x8 (&a)[4] = aB; SC_STEP(a, h + 1); }
        }
        float* o = sc + (size_t)kt * 64 + r32;
#pragma unroll
        for (int r = 0; r < 16; ++r) { const int q = (r & 3) + 8 * (r >> 2) + 4 * hi; o[(size_t)q * SCW] = s0[r]; o[(size_t)q * SCW + 32] = s1[r]; }
    }
#undef SC_LDA
#undef SC_STEP
#undef FMA8
}
__device__ __forceinline__ void sel_load(const float* __restrict__ sc, int nt, float (&vv)[NVJ], int lane) {
    if (nt <= 4) return;
    const int ng = (nt + 3) >> 2;
#pragma unroll
    for (int g = 0; g < 16; ++g) if (g < ng) {
#pragma unroll
        for (int i = 0; i < 4; ++i) vv[4 * g + i] = sc[(4 * g + i) * 64 + lane]; }
    if (ng > 16) vv[64] = sc[64 * 64 + lane];
}
__device__ __forceinline__ void select_row(float (&vv)[NVJ], int nt, int nvalid, u64* __restrict__ rm, const float* __restrict__ sc_next, int nt_next, int lane) {
    if (nt <= 4) { if (lane < nt) rm[lane] = ~0ull; sel_load(sc_next, nt_next, vv, lane); return; }
    unsigned uk[NVJ];
    { const int ng = (nt + 3) >> 2;
#pragma unroll
      for (int j = 0; j < NVJ; ++j) uk[j] = ((j >> 2) < ng && j * 64 + lane < nvalid) ? ord_key(vv[j]) : 0u; }
    sel_load(sc_next, nt_next, vv, lane);
#define CNTV(cnt, thr, x) asm volatile("v_cmp_le_u32 vcc, %1, %2\n\tv_addc_co_u32 %0, vcc, 0, %0, vcc" : "+v"(cnt) : "v"(thr), "v"(x) : "vcc")
    const int ng = (nt + 3) >> 2;
    unsigned T = 0u; int cT = 0;
    for (int bit = 31; bit >= 0; --bit) {
        const unsigned cand = T | (1u << bit); int cl = 0;
#pragma unroll
        for (int g = 0; g < 16; ++g) if (g < ng) { CNTV(cl, cand, uk[4 * g]); CNTV(cl, cand, uk[4 * g + 1]); CNTV(cl, cand, uk[4 * g + 2]); CNTV(cl, cand, uk[4 * g + 3]); }
        if (ng > 16) CNTV(cl, cand, uk[64]);
        cl += __builtin_amdgcn_update_dpp(0, cl, 0xB1, 0xf, 0xf, false);
        cl += __builtin_amdgcn_update_dpp(0, cl, 0x4E, 0xf, 0xf, false);
        cl += __builtin_amdgcn_update_dpp(0, cl, 0x141, 0xf, 0xf, false);
        cl += __builtin_amdgcn_update_dpp(0, cl, 0x140, 0xf, 0xf, false);
        const int cnt = (__builtin_amdgcn_readlane(cl, 0) + __builtin_amdgcn_readlane(cl, 16)) + (__builtin_amdgcn_readlane(cl, 32) + __builtin_amdgcn_readlane(cl, 48));
        if (cnt >= 256) { T = cand; cT = cnt; if (cnt == 256) break; }
    }
#undef CNTV
    if (cT == 256) {
        unsigned wlo = 0u, whi = 0u;
#pragma unroll
        for (int j = 0; j < 64; ++j)
            asm volatile("v_cmp_le_u32 vcc, %2, %3\n\ts_nop 4\n\tv_writelane_b32 %0, vcc_lo, %4\n\tv_writelane_b32 %1, vcc_hi, %4" : "+v"(wlo), "+v"(whi) : "s"(T), "v"(uk[j]), "i"(j) : "vcc");
        u64 mk64; asm volatile("v_cmp_le_u32 %0, %1, %2" : "=s"(mk64) : "s"(T), "v"(uk[64]));
        rm[lane] = ((u64)whi << 32) | wlo;
        if (lane == 0) rm[64] = mk64;
    } else {
        int cgt = 0;
#pragma unroll
        for (int j = 0; j < NVJ; ++j) { u64 t0_; asm volatile("v_cmp_lt_u32 %0, %1, %2" : "=&s"(t0_) : "s"(T), "v"(uk[j])); cgt += __builtin_popcountll(t0_); }
        int need = 256 - cgt;
#pragma unroll
        for (int j = 0; j < NVJ; ++j) {
            u64 gt, eq; asm volatile("v_cmp_lt_u32 %0, %1, %2" : "=s"(gt) : "s"(T), "v"(uk[j])); asm volatile("v_cmp_eq_u32 %0, %1, %2" : "=s"(eq) : "s"(T), "v"(uk[j]));
            const int below = __builtin_popcountll(eq & ((1ull << lane) - 1ull));
            const u64 take = __ballot(((eq >> lane) & 1ull) && below < need);
            need -= __builtin_popcountll(take);
            if (lane == 0) rm[j] = gt | take;
        }
    }
}

namespace att {
constexpr int D = 128, KVBLK = 64;
constexpr float SCALE = 0.088388347648318440f;
constexpr float THR = 8.f;
constexpr float NEG = -1e30f, MINIT = -1e20f;
constexpr size_t SHM_V = KVBLK * D * 2, SHM_K = KVBLK * D * 2;
constexpr size_t OFF_WS = 2 * SHM_V + 2 * SHM_K, OFF_TB = OFF_WS + 8 * 64 * 4, OFF_MK = OFF_TB + 4 * 256 * 4, LDS_ATTN = OFF_MK + 64 * 65 * 8;
static_assert(LDS_ATTN <= 131072, "attention LDS");
#define KSWZ(row, colB) ((row) * 256 + ((colB) ^ (((row) & 7) << 4)))
#define SBAR() __builtin_amdgcn_sched_barrier(0)
__device__ __forceinline__ int crow(int r, int hi) { return (r & 3) + 8 * (r >> 2) + 4 * hi; }
__device__ __forceinline__ void partialSM(f32x16& p0, f32x16& p1, float& m_reg, float& mn, float& alpha) {
    constexpr float C = SCALE * 1.4426950408889634f;
    float pmax = p0[0];
#pragma unroll
    for (int r = 1; r < 16; ++r) pmax = fmaxf(pmax, p0[r]);
#pragma unroll
    for (int r = 0; r < 16; ++r) pmax = fmaxf(pmax, p1[r]);
    { auto rr = __builtin_amdgcn_permlane32_swap(__float_as_uint(pmax), __float_as_uint(pmax), false, false);
      pmax = fmaxf(__uint_as_float(rr[0]), __uint_as_float(rr[1])); }
    if (__builtin_expect(__all(pmax - m_reg <= THR / SCALE), 1)) { mn = m_reg; alpha = 1.f; }
    else { mn = fmaxf(m_reg, pmax); alpha = __builtin_amdgcn_exp2f((m_reg - mn) * C); m_reg = mn; }
    const float mnC = -mn * C;
#pragma unroll
    for (int r = 0; r < 16; ++r) p0[r] = fmaf(p0[r], C, mnC);
#pragma unroll
    for (int r = 0; r < 16; ++r) p1[r] = fmaf(p1[r], C, mnC);
#pragma unroll
    for (int r = 0; r < 16; ++r) p0[r] = __builtin_amdgcn_exp2f(p0[r]);
}
__device__ __forceinline__ void finishSM(f32x16& p0, f32x16& p1, float alpha, float& l_reg, bf16x8& pa0, bf16x8& pa1, bf16x8& pa2, bf16x8& pa3) {
#pragma unroll
    for (int r = 0; r < 16; ++r) p1[r] = __builtin_amdgcn_exp2f(p1[r]);
    float ps = 0;
#pragma unroll
    for (int r = 0; r < 16; ++r) ps += p0[r];
#pragma unroll
    for (int r = 0; r < 16; ++r) ps += p1[r];
    { auto rr = __builtin_amdgcn_permlane32_swap(__float_as_uint(ps), __float_as_uint(ps), false, false);
      ps = __uint_as_float(rr[0]) + __uint_as_float(rr[1]); }
    l_reg = l_reg * alpha + ps;
#define PK4(P, BASE, OUT) do { unsigned a0 = cvt_pk_bf16(P[BASE + 0], P[BASE + 1]), a1 = cvt_pk_bf16(P[BASE + 2], P[BASE + 3]);   \
    unsigned b0 = cvt_pk_bf16(P[BASE + 4], P[BASE + 5]), b1 = cvt_pk_bf16(P[BASE + 6], P[BASE + 7]);                              \
    auto r0 = __builtin_amdgcn_permlane32_swap(a0, b0, false, false); auto r1 = __builtin_amdgcn_permlane32_swap(a1, b1, false, false); \
    u32x4 w = {r0[0], r1[0], r0[1], r1[1]}; OUT = *reinterpret_cast<bf16x8*>(&w); } while (0)
    PK4(p0, 0, pa0); PK4(p0, 8, pa1); PK4(p1, 0, pa2); PK4(p1, 8, pa3);
#undef PK4
}
__device__ __forceinline__ void qkt(f32x16& p0, f32x16& p1, const LAS char* Ks, const bf16x8* qr, int r32, int hi) {
    p0 = f32x16{}; p1 = f32x16{};
#pragma unroll
    for (int d0 = 0; d0 < 8; ++d0) { const int cb = (d0 * 16 + hi * 8) * 2;
        const bf16x8 b0 = *(const LAS bf16x8*)(Ks + KSWZ(r32, cb));
        const bf16x8 b1 = *(const LAS bf16x8*)(Ks + KSWZ(32 + r32, cb));
        p0 = __builtin_amdgcn_mfma_f32_32x32x16_bf16(b0, qr[d0], p0, 0, 0, 0);
        p1 = __builtin_amdgcn_mfma_f32_32x32x16_bf16(b1, qr[d0], p1, 0, 0, 0); }
}
__device__ __forceinline__ int v_st(int k, int c) { const int kk = (k & ~0xC) | ((k & 4) << 1) | ((k & 8) >> 1); return ((kk >> 3) * 4 + (c >> 5)) * 512 + ((kk & 7) * 32 + (c & 31)) * 2; }
__device__ __forceinline__ int v_rd_base(int lane) { return ((lane & 3) << 3) | (((lane >> 2) & 3) << 6) | (((lane >> 4) & 1) << 5) | (((lane >> 5) & 1) << 8); }
constexpr int v_rd_off(int d0, int ks, int half) { return d0 * 512 + ks * 4096 + half * 2048; }
template <int OFF> __device__ __forceinline__ s16x4 tr_read(int vb) {
    s16x4 r; asm volatile("ds_read_b64_tr_b16 %0, %1 offset:%2" : "=&v"(r) : "v"(vb), "i"(OFF) : "memory"); return r;
}
template <int D0> __device__ __forceinline__ void pv_one(f32x16& od, int vb, bf16x8 pa0, bf16x8 pa1, bf16x8 pa2, bf16x8 pa3) {
    const s16x4 l0 = tr_read<v_rd_off(D0, 0, 0)>(vb), h0 = tr_read<v_rd_off(D0, 0, 1)>(vb), l1 = tr_read<v_rd_off(D0, 1, 0)>(vb), h1 = tr_read<v_rd_off(D0, 1, 1)>(vb);
    const s16x4 l2 = tr_read<v_rd_off(D0, 2, 0)>(vb), h2 = tr_read<v_rd_off(D0, 2, 1)>(vb), l3 = tr_read<v_rd_off(D0, 3, 0)>(vb), h3 = tr_read<v_rd_off(D0, 3, 1)>(vb);
    asm volatile("s_waitcnt lgkmcnt(0)" ::: "memory"); SBAR();
#define PK(L, H) (bf16x8){L[0], L[1], L[2], L[3], H[0], H[1], H[2], H[3]}
    od = __builtin_amdgcn_mfma_f32_32x32x16_bf16(pa0, PK(l0, h0), od, 0, 0, 0);
    od = __builtin_amdgcn_mfma_f32_32x32x16_bf16(pa1, PK(l1, h1), od, 0, 0, 0);
    od = __builtin_amdgcn_mfma_f32_32x32x16_bf16(pa2, PK(l2, h2), od, 0, 0, 0);
    od = __builtin_amdgcn_mfma_f32_32x32x16_bf16(pa3, PK(l3, h3), od, 0, 0, 0);
#undef PK
}
__device__ __forceinline__ void pv_d0(f32x16* o, int vb, bf16x8 pa0, bf16x8 pa1, bf16x8 pa2, bf16x8 pa3) {
    pv_one<0>(o[0], vb, pa0, pa1, pa2, pa3); pv_one<1>(o[1], vb, pa0, pa1, pa2, pa3); pv_one<2>(o[2], vb, pa0, pa1, pa2, pa3); pv_one<3>(o[3], vb, pa0, pa1, pa2, pa3);
}
__device__ __forceinline__ void mask_bias(f32x16& p0, f32x16& p1, u64 mw, bool near, const LAS float* tbk, int hi) {
    if (near) {
#pragma unroll
        for (int r = 0; r < 16; ++r) { const int b = (r & 3) + 8 * (r >> 2); p0[r] += tbk[b]; p1[r] += tbk[32 + b]; }
    }
    const unsigned lo = (unsigned)mw >> (4 * hi), hh = (unsigned)(mw >> 32) >> (4 * hi);
#pragma unroll
    for (int r = 0; r < 16; ++r) { const int b = (r & 3) + 8 * (r >> 2);
        const unsigned m0 = (unsigned)__builtin_amdgcn_sbfe((int)lo, b, 1), m1 = (unsigned)__builtin_amdgcn_sbfe((int)hh, b, 1);
        p0[r] = __uint_as_float((m0 & __float_as_uint(p0[r])) | (~m0 & __float_as_uint(NEG)));
        p1[r] = __uint_as_float((m1 & __float_as_uint(p1[r])) | (~m1 & __float_as_uint(NEG))); }
}

__device__ __forceinline__ void og_store_rows(const LAS char* st, const bf16_t* __restrict__ SGg, bf16_t* __restrict__ OGg, int kvh, int nrows, int tid) {
    for (int c = tid; c < nrows * 64; c += NTHREADS) { const int row = c >> 6, ch = c & 63;
        const u32x4 ov = *(const LAS u32x4*)(st + row * 1024 + ch * 16);
        const size_t off = (size_t)row * DM + kvh * 512 + ch * 8;
        const u32x4 gv = *(const u32x4*)(SGg + off);
        u32x4 w; w.x = cvt_pk_bf16(bf_lo(ov.x) * bf_lo(gv.x), bf_hi(ov.x) * bf_hi(gv.x)); w.y = cvt_pk_bf16(bf_lo(ov.y) * bf_lo(gv.y), bf_hi(ov.y) * bf_hi(gv.y));
        w.z = cvt_pk_bf16(bf_lo(ov.z) * bf_lo(gv.z), bf_hi(ov.z) * bf_hi(gv.z)); w.w = cvt_pk_bf16(bf_lo(ov.w) * bf_lo(gv.w), bf_hi(ov.w) * bf_hi(gv.w));
        *(u32x4*)(OGg + off) = w; }
}
__device__ __forceinline__ void attn_block(const bf16_t* __restrict__ Qg, const bf16_t* __restrict__ Kh, const bf16_t* __restrict__ Vh, const u64* __restrict__ rmq,
                                           const bf16_t* __restrict__ SGg, bf16_t* __restrict__ OGg, int NT, int qpos0, int kvh, const float* __restrict__ rel_bias, LAS char* lds) {
    int tid = threadIdx.x; asm volatile("" : "+v"(tid));
    const int wid = __builtin_amdgcn_readfirstlane(tid >> 6), lane = tid & 63, r32 = lane & 31, hi = lane >> 5;
    const int hl = wid & 3, qs = wid >> 2, head = kvh * 4 + hl;
    LAS char* V_lds = lds; LAS char* K_lds = lds + 2 * SHM_V;
    LAS float* ws = (LAS float*)(lds + OFF_WS) + wid * 64; LAS float* li_l = ws; LAS float* al_l = ws + 32;
    LAS float* tb = (LAS float*)(lds + OFF_TB);
    for (int e = tid; e < 1024; e += NTHREADS) {
        const int h = e >> 8, rel = (e & 255) - 192, n = rel < 0 ? -rel : rel;
        int bk = n < 8 ? n : (n < 12 ? 8 : n < 16 ? 9 : n < 23 ? 10 : n < 32 ? 11 : n < 46 ? 12 : n < 64 ? 13 : n < 91 ? 14 : 15);
        if (rel > 0) bk += 16;
        tb[e] = (rel_bias[bk * 32 + kvh * 4 + h] - rel_bias[15 * 32 + kvh * 4 + h]) * (1.0f / SCALE);
    }
    {
        const u32x4* src = (const u32x4*)rmq; LAS u32x4* dst = (LAS u32x4*)(lds + OFF_MK);
        constexpr int NCH = 64 * RMS * 8 / 16;
        for (int e = tid; e < NCH; e += NTHREADS) dst[e] = src[e];
    }
    float m_reg = MINIT, l_reg = 0; f32x16 o[4] = {}; bf16x8 qr[8];
    const int qrow = qs * 32 + r32;
    const bf16_t* Qw = Qg + (size_t)qrow * DM + head * D + hi * 8;
#pragma unroll
    for (int d0 = 0; d0 < 8; ++d0) qr[d0] = *(const bf16x8*)(Qw + d0 * 16);
    const LAS u64* rml = (const LAS u64*)(lds + OFF_MK) + qrow * RMS;
    const int vb0 = (int)(uintptr_t)V_lds + v_rd_base(lane);
    const int tboff = hl * 256 + 192 - (qpos0 + qrow) + 4 * hi;
    constexpr int LDK = KVW;
    unsigned koff[2], voff[2];
#pragma unroll
    for (int i = 0; i < 2; ++i) { const int off = (wid * 2 + i) * 1024 + lane * 16;
        { const int row = off >> 8, cB = (off & 255) ^ ((row & 7) << 4); koff[i] = (unsigned)(row * LDK * 2 + cB); }
        { const int sub = off >> 9, kk = (sub >> 2) * 8 + ((off & 511) >> 6), k = (kk & ~0xC) | ((kk & 4) << 1) | ((kk & 8) >> 1), c = (sub & 3) * 32 + ((off & 63) >> 1); voff[i] = (unsigned)(k * LDK * 2 + c * 2); } }
#define DMA_K(t, slot) do { _Pragma("unroll") for (int i_ = 0; i_ < 2; ++i_) __builtin_amdgcn_global_load_lds((const unsigned*)((const char*)Kh + (size_t)(t) * (KVBLK * LDK * 2) + koff[i_]), \
        (LAS unsigned*)(K_lds + (slot) * SHM_K + (wid * 2 + i_) * 1024), 16, 0, 0); } while (0)
#define DMA_V(t, slot) do { _Pragma("unroll") for (int i_ = 0; i_ < 2; ++i_) __builtin_amdgcn_global_load_lds((const unsigned*)((const char*)Vh + (size_t)(t) * (KVBLK * LDK * 2) + voff[i_]), \
        (LAS unsigned*)(V_lds + (slot) * SHM_V + (wid * 2 + i_) * 1024), 16, 0, 0); } while (0)
#define STEPBAR() do { asm volatile("s_waitcnt vmcnt(0) lgkmcnt(0)" ::: "memory"); __builtin_amdgcn_s_barrier(); asm volatile("" ::: "memory"); } while (0)
#define RESC(a) do { if (__any((a) < 1.f)) { if (hi == 0) al_l[r32] = (a); asm volatile("s_waitcnt lgkmcnt(0)" ::: "memory"); \
    _Pragma("unroll") for (int d = 0; d < 4; ++d) _Pragma("unroll") for (int r = 0; r < 16; ++r) o[d][r] *= al_l[crow(r, hi)]; } } while (0)
#define MB(P0, P1, t) mask_bias(P0, P1, rml[t], (t) >= NT - 3, tb + tboff + (t) * KVBLK, hi)
    f32x16 pA0, pA1, pB0, pB1; float mnA, mnB, alA, alB; bf16x8 pa0, pa1, pa2, pa3;
    DMA_K(0, 0);
    STEPBAR();
    if (NT > 1) DMA_K(1, 1);
    DMA_V(0, 0);
    qkt(pA0, pA1, K_lds, qr, r32, hi); MB(pA0, pA1, 0); partialSM(pA0, pA1, m_reg, mnA, alA);
    int j = 1;
    for (; j + 1 < NT; j += 2) {
        STEPBAR();
        DMA_K(j + 1, 0); DMA_V(j, 1);
        SBAR(); qkt(pB0, pB1, K_lds + SHM_K, qr, r32, hi);
        finishSM(pA0, pA1, alA, l_reg, pa0, pa1, pa2, pa3); SBAR();
        pv_d0(o, vb0, pa0, pa1, pa2, pa3); MB(pB0, pB1, j); partialSM(pB0, pB1, m_reg, mnB, alB);
        RESC(alB);
        STEPBAR();
        if (j + 2 < NT) DMA_K(j + 2, 1);
        DMA_V(j + 1, 0);
        SBAR(); qkt(pA0, pA1, K_lds, qr, r32, hi);
        finishSM(pB0, pB1, alB, l_reg, pa0, pa1, pa2, pa3); SBAR();
        pv_d0(o, vb0 + (int)SHM_V, pa0, pa1, pa2, pa3); MB(pA0, pA1, j + 1); partialSM(pA0, pA1, m_reg, mnA, alA);
        RESC(alA);
    }
    if (j < NT) {
        STEPBAR();
        DMA_V(j, 1);
        SBAR(); qkt(pB0, pB1, K_lds + SHM_K, qr, r32, hi);
        finishSM(pA0, pA1, alA, l_reg, pa0, pa1, pa2, pa3); SBAR();
        pv_d0(o, vb0, pa0, pa1, pa2, pa3); MB(pB0, pB1, j); partialSM(pB0, pB1, m_reg, mnB, alB);
        RESC(alB);
        STEPBAR();
        finishSM(pB0, pB1, alB, l_reg, pa0, pa1, pa2, pa3); SBAR();
        pv_d0(o, vb0 + (int)SHM_V, pa0, pa1, pa2, pa3);
    } else {
        STEPBAR();
        finishSM(pA0, pA1, alA, l_reg, pa0, pa1, pa2, pa3); SBAR();
        pv_d0(o, vb0, pa0, pa1, pa2, pa3);
    }
    asm volatile("s_waitcnt vmcnt(0)" ::: "memory");
    if (hi == 0) li_l[r32] = l_reg;
    __syncthreads();
    {
        LAS bf16_t* st = (LAS bf16_t*)lds;
#pragma unroll
        for (int r = 0; r < 16; ++r) { const int orow = qs * 32 + crow(r, hi); const float rl = __builtin_amdgcn_rcpf(li_l[crow(r, hi)]);
#pragma unroll
            for (int d0 = 0; d0 < 4; ++d0) st[orow * 512 + hl * 128 + d0 * 32 + r32] = (bf16_t)(cvt_pk_bf16(o[d0][r] * rl, 0.f) & 0xffffu); }
    }
    __syncthreads();
    og_store_rows(lds, SGg, OGg, kvh, 64, tid);
    __syncthreads();
#undef DMA_K
#undef DMA_V
#undef STEPBAR
#undef RESC
#undef MB
}

#define WGBAR() do { asm volatile("s_waitcnt lgkmcnt(0)" ::: "memory"); __builtin_amdgcn_s_barrier(); asm volatile("" ::: "memory"); } while (0)
__device__ __forceinline__ void attn_sample_block(const bf16_t* __restrict__ Qg, const float* __restrict__ ck, const float* __restrict__ cv, const bf16_t* __restrict__ kn, const bf16_t* __restrict__ vn,
                                                  const u64* __restrict__ rmq, const bf16_t* __restrict__ SGg, bf16_t* __restrict__ OGg, int kvh, const float* __restrict__ rel_bias, LAS char* lds) {
    int tid = threadIdx.x; asm volatile("" : "+v"(tid));
    const int wid = __builtin_amdgcn_readfirstlane(tid >> 6), lane = tid & 63, r32 = lane & 31, hi = lane >> 5;
    constexpr int NT = 65;
    LAS char* V_lds = lds; LAS char* K_lds = lds + 2 * SHM_V;
    LAS float* tb = (LAS float*)(lds + OFF_TB);
    for (int e = tid; e < 1024; e += NTHREADS) {
        const int h = e >> 8, rel = (e & 255) - 192, n = rel < 0 ? -rel : rel;
        int bk = n < 8 ? n : (n < 12 ? 8 : n < 16 ? 9 : n < 23 ? 10 : n < 32 ? 11 : n < 46 ? 12 : n < 64 ? 13 : n < 91 ? 14 : 15);
        if (rel > 0) bk += 16;
        tb[e] = (rel_bias[bk * 32 + kvh * 4 + h] - rel_bias[15 * 32 + kvh * 4 + h]) * (1.0f / SCALE);
    }
    {   const u32x4* src = (const u32x4*)rmq; LAS u32x4* dst = (LAS u32x4*)(lds + OFF_MK);
        for (int e = tid; e < 32 * RMS * 8 / 16; e += NTHREADS) dst[e] = src[e]; }
    if (wid >= 4) {
        const int lt = tid - 256;
        f32x4 krA[4][2], vrA[4][2], krB[4][2], vrB[4][2];
        const int row0 = lt >> 4, c8 = (lt & 15) * 8;
#define LD_TILE(kr, vr, t) do { if ((t) < 64) { _Pragma("unroll") for (int i = 0; i < 4; ++i) { const size_t o_ = ((size_t)(t) * 64 + row0 + 16 * i) * KVW + c8; \
            kr[i][0] = *(const f32x4*)(ck + o_); kr[i][1] = *(const f32x4*)(ck + o_ + 4); vr[i][0] = *(const f32x4*)(cv + o_); vr[i][1] = *(const f32x4*)(cv + o_ + 4); } } } while (0)
#define WR_TILE(kr, vr, t, b) do { if ((t) < 64) { _Pragma("unroll") for (int i = 0; i < 4; ++i) { const int r_ = row0 + 16 * i; \
            *(LAS u32x4*)(K_lds + (b) * SHM_K + KSWZ(r_, c8 * 2)) = pack8(kr[i][0], kr[i][1]); *(LAS u32x4*)(V_lds + (b) * SHM_V + v_st(r_, c8)) = pack8(vr[i][0], vr[i][1]); } } \
        else if ((t) == 64) { _Pragma("unroll") for (int i = 0; i < 4; ++i) { const int r_ = row0 + 16 * i; u32x4 kx = (u32x4){0u, 0u, 0u, 0u}, vx = kx; \
            if (r_ < 32) { kx = *(const u32x4*)(kn + (size_t)r_ * KVW + c8); vx = *(const u32x4*)(vn + (size_t)r_ * KVW + c8); } \
            *(LAS u32x4*)(K_lds + (b) * SHM_K + KSWZ(r_, c8 * 2)) = kx; *(LAS u32x4*)(V_lds + (b) * SHM_V + v_st(r_, c8)) = vx; } } } while (0)
        LD_TILE(krA, vrA, 0); WR_TILE(krA, vrA, 0, 0); LD_TILE(krA, vrA, 1); LD_TILE(krB, vrB, 2);
        WGBAR();
        WR_TILE(krA, vrA, 1, 1); LD_TILE(krA, vrA, 3);
        WGBAR();
        for (int j = 1; j + 1 < NT; j += 2) {
            WGBAR();
            WR_TILE(krB, vrB, j + 1, 0);
            WGBAR();
            LD_TILE(krB, vrB, j + 3);
            WGBAR();
            WR_TILE(krA, vrA, j + 2, 1);
            WGBAR();
            LD_TILE(krA, vrA, j + 4);
        }
#undef LD_TILE
#undef WR_TILE
    } else {
        LAS float* ws = (LAS float*)(lds + OFF_WS) + wid * 64; LAS float* li_l = ws; LAS float* al_l = ws + 32;
        const int head = kvh * 4 + wid;
        float m_reg = MINIT, l_reg = 0; f32x16 o[4] = {}; bf16x8 qr[8];
        const bf16_t* Qw = Qg + (size_t)r32 * DM + head * D + hi * 8;
#pragma unroll
        for (int d0 = 0; d0 < 8; ++d0) qr[d0] = *(const bf16x8*)(Qw + d0 * 16);
        const LAS u64* rml = (const LAS u64*)(lds + OFF_MK) + r32 * RMS;
        const int vb0 = (int)(uintptr_t)V_lds + v_rd_base(lane);
        const int tboff = wid * 256 + 192 - (PAST + r32) + 4 * hi;
#define RESC(a) do { if (__any((a) < 1.f)) { if (hi == 0) al_l[r32] = (a); asm volatile("s_waitcnt lgkmcnt(0)" ::: "memory"); \
    _Pragma("unroll") for (int d = 0; d < 4; ++d) _Pragma("unroll") for (int r = 0; r < 16; ++r) o[d][r] *= al_l[crow(r, hi)]; } } while (0)
#define MB(P0, P1, t) mask_bias(P0, P1, rml[t], (t) >= NT - 3, tb + tboff + (t) * KVBLK, hi)
        f32x16 pA0, pA1, pB0, pB1; float mnA, mnB, alA, alB; bf16x8 pa0, pa1, pa2, pa3;
        WGBAR();
        qkt(pA0, pA1, K_lds, qr, r32, hi); MB(pA0, pA1, 0); partialSM(pA0, pA1, m_reg, mnA, alA);
        WGBAR();
        for (int j = 1; j + 1 < NT; j += 2) {
            SBAR(); qkt(pB0, pB1, K_lds + SHM_K, qr, r32, hi);
            finishSM(pA0, pA1, alA, l_reg, pa0, pa1, pa2, pa3); SBAR();
            pv_d0(o, vb0, pa0, pa1, pa2, pa3); MB(pB0, pB1, j); partialSM(pB0, pB1, m_reg, mnB, alB);
            WGBAR();
            RESC(alB);
            WGBAR();
            SBAR(); qkt(pA0, pA1, K_lds, qr, r32, hi);
            finishSM(pB0, pB1, alB, l_reg, pa0, pa1, pa2, pa3); SBAR();
            pv_d0(o, vb0 + (int)SHM_V, pa0, pa1, pa2, pa3); MB(pA0, pA1, j + 1); partialSM(pA0, pA1, m_reg, mnA, alA);
            WGBAR();
            RESC(alA);
            WGBAR();
        }
        finishSM(pA0, pA1, alA, l_reg, pa0, pa1, pa2, pa3); SBAR();
        pv_d0(o, vb0, pa0, pa1, pa2, pa3);
        if (hi == 0) li_l[r32] = l_reg;
        WGBAR();
        {
            LAS bf16_t* st = (LAS bf16_t*)lds;
#pragma unroll
            for (int r = 0; r < 16; ++r) { const int orow = crow(r, hi); const float rl = __builtin_amdgcn_rcpf(li_l[orow]);
#pragma unroll
                for (int d0 = 0; d0 < 4; ++d0) st[orow * 512 + wid * 128 + d0 * 32 + r32] = (bf16_t)(cvt_pk_bf16(o[d0][r] * rl, 0.f) & 0xffffu); }
        }
#undef RESC
#undef MB
    }
    if (wid >= 4) WGBAR();
    __syncthreads();
    og_store_rows(lds, SGg, OGg, kvh, 32, tid);
    __syncthreads();
}
}

__global__ void __launch_bounds__(NTHREADS, 2) mega(Params p) {
    extern __shared__ __attribute__((aligned(16))) unsigned char lds_raw[];
    LAS unsigned char* lds = (LAS unsigned char*)lds_raw;
    volatile LAS unsigned* MISC = (volatile LAS unsigned*)(lds + MISC_OFF);
    const int G = gridDim.x; const int bx = blockIdx.x;
    const int vcu = (G % 8 == 0) ? (bx % 8) * (G / 8) + bx / 8 : bx;
    const int NGW = G * NWAVES;
#define PHASE_IDS() int tid = threadIdx.x; asm volatile("" : "+v"(tid)); const int lane = tid & 63, wave = __builtin_amdgcn_readfirstlane(tid >> 6), gw = vcu * NWAVES + wave; (void)lane; (void)gw
    unsigned char* ws = p.ws; float* out = p.out;
    const int lo = p.ph_lo, hi_ph = p.ph_hi;
    for (int u = threadIdx.x; u < (LDS_BYTES - RING_BYTES) / 4; u += NTHREADS) ((LAS unsigned*)(lds + RING_BYTES))[u] = 0u;
    __syncthreads();
    XcdBarrier bar; bar.bar = (unsigned*)(ws + WS_CTL) + CW_BAR; bar.x = 0; bar.st = nullptr;
    if (hi_ph - lo > 1) bar = xcd_barrier_post((unsigned*)(ws + WS_CTL) + CW_BAR, MISC + 8);
#ifndef PH_MASK
#define PH_MASK 0x7fff
#endif
#define IN(k) (((PH_MASK >> (k)) & 1) && lo <= (k) && (k) < hi_ph)
#ifdef TPROBE
    unsigned long long tp0 = __builtin_amdgcn_s_memrealtime(), tp1 = 0;
#define TP_MARK(k) do { if ((k) == TPROBE - 1) tp0 = __builtin_amdgcn_s_memrealtime(); if ((k) == TPROBE) tp1 = __builtin_amdgcn_s_memrealtime(); } while (0)
#else
#define TP_MARK(k) do { } while (0)
#endif
#define SEAM(k) do { if (IN(k) && IN((k) + 1)) xcd_barrier(bar); TP_MARK(k); } while (0)

    if (IN(0)) {
        PHASE_IDS();
        {
            for (int i = tid; i < DM / 4; i += NTHREADS) ((LAS f32x4*)lds)[i] = ((const f32x4*)p.norm_w)[i];
            __syncthreads();
            f32x4 v[16], vn[16];
            if (gw < MT) { const f32x4* xr = (const f32x4*)(gw < MP ? p.x_prompt + (size_t)gw * DM : p.x_sample + (size_t)(gw - MP) * DM) + lane;
#pragma unroll
                for (int j = 0; j < 16; ++j) v[j] = xr[64 * j]; }
#pragma unroll 1
            for (int m = gw; m < MT; m += NGW) {
                const int mn = m + NGW;
                if (mn < MT) { const f32x4* xr = (const f32x4*)(mn < MP ? p.x_prompt + (size_t)mn * DM : p.x_sample + (size_t)(mn - MP) * DM) + lane;
#pragma unroll
                    for (int j = 0; j < 16; ++j) vn[j] = xr[64 * j]; }
                rms_row_q(v, (const LAS f32x4*)lds, (bf16_t*)(ws + WS_H) + (size_t)m * DM, (signed char*)(ws + WS_H8) + (size_t)m * DM, (float*)(ws + WS_SA) + m, lane);
#pragma unroll
                for (int j = 0; j < 16; ++j) v[j] = vn[j];
            }
        }
        {
            const size_t gt = (size_t)gw * 64 + lane, GT = (size_t)NGW * 64;
            constexpr size_t NK8 = (size_t)DB * SKV * DIDX / 8;
            for (size_t i = gt; i < NK8; i += GT) {
                const size_t row = i / 8, c8 = i % 8, bb = row / SKV, s = row % SKV;
                if (s >= (size_t)PAST && s < (size_t)PAST + DSQ) continue;
                u32x4 w = (u32x4){0u, 0u, 0u, 0u};
                if (s < (size_t)PAST) { const float* src = p.cache_kidx + (bb * PAST + s) * DIDX + c8 * 8; w = pack8(*(const f32x4*)src, *(const f32x4*)(src + 4)); }
                *(u32x4*)((bf16_t*)(ws + WS_KIS) + bb * SKV * DIDX + kif_off((int)s, (int)c8 * 8)) = w;
            }
        }
        {
            u32x4* z = (u32x4*)((bf16_t*)(ws + WS_WT_IN) + (size_t)2144 * DM);
            for (size_t i = (size_t)gw * 64 + lane; i < (size_t)160 * DM * 2 / 16; i += (size_t)NGW * 64) z[i] = (u32x4){0u, 0u, 0u, 0u};
        }
        __syncthreads();
        LAS float* scr = (LAS float*)(lds + wave * 16384);
        constexpr int I_IN = 64 * 34, I_GRP = 4 * 16 * 16, I_AMX = 64 * 40, I_AMX2 = 64 * 32, I_AMX3 = 64 * 16;
        constexpr int NITEMS = I_IN + I_GRP + I_AMX + I_AMX2 + 2 * I_AMX3;
        for (int it = gw; it < NITEMS; it += NGW) {
            int r = it;
            if (r < I_IN) { const int kb = r / 34, nb = r % 34, n0 = 6144 + nb * 64;
                transpose_item(p.attn_w_in, 12384, kb * 64, n0, (bf16_t*)(ws + WS_WT_IN), DM, nb * 64, nb == 33 ? 32 : 64, scr, lane); continue; } r -= I_IN;
            if (r < I_GRP) { const int g = r / 256, q = r % 256;
                transpose_item(p.pool_group_w + (size_t)g * 1024 * 1024, 1024, (q / 16) * 64, (q % 16) * 64, (bf16_t*)(ws + WS_WT_GRP), 1024, g * 1024 + (q % 16) * 64, 64, scr, lane); continue; } r -= I_GRP;
            if (r >= I_AMX + I_AMX2) {
                r -= I_AMX + I_AMX2; const bool second = r >= I_AMX3; if (second) r -= I_AMX3;
                const int kb = r >> 4, cb = r & 15, n0 = cb * 256 + lane * 4;
                const f32x4 m = col_amax64<false>((second ? p.pool_w_out : p.attn_w_out) + (size_t)kb * 64 * DM + n0, DM, nullptr);
                unsigned* cm = (unsigned*)(ws + (second ? WS_CAMAX4 : WS_CAMAX3)) + n0;
                atomicMax(cm, __float_as_uint(m.x)); atomicMax(cm + 1, __float_as_uint(m.y)); atomicMax(cm + 2, __float_as_uint(m.z)); atomicMax(cm + 3, __float_as_uint(m.w));
                continue;
            }
            if (r >= I_AMX) {
                r -= I_AMX; const int kb = r >> 5, cb = r & 31, n0 = cb * 256 + lane * 4;
                const f32x4 m = col_amax64<true>(p.pool_w_in + (size_t)kb * 64 * 8192 + n0, 8192, p.norm_w + DM + kb * 64);
                unsigned* cm = (unsigned*)(ws + WS_CAMAX2) + cb * 256 + lane * 4;
                atomicMax(cm, __float_as_uint(m.x)); atomicMax(cm + 1, __float_as_uint(m.y)); atomicMax(cm + 2, __float_as_uint(m.z)); atomicMax(cm + 3, __float_as_uint(m.w));
                continue;
            }
            {
                const int kb = r / 40, cb = r % 40, n0 = (cb < 24 ? cb * 256 : 8288 + (cb - 24) * 256) + lane * 4;
                const f32x4 m = col_amax64<false>(p.attn_w_in + (size_t)kb * 64 * 12384 + n0, 12384, nullptr);
                unsigned* cm = (unsigned*)(ws + WS_CAMAX) + cb * 256 + lane * 4;
                atomicMax(cm, __float_as_uint(m.x)); atomicMax(cm + 1, __float_as_uint(m.y)); atomicMax(cm + 2, __float_as_uint(m.z)); atomicMax(cm + 3, __float_as_uint(m.w));
            }
        }
    }
    SEAM(0);
    if (IN(1)) {
        PHASE_IDS();
        LAS float* scr = (LAS float*)(lds + wave * 16384);
        for (int it = gw; it < 2 * 32 * 64; it += NGW) { const bool second = it < 32 * 64; const int r = second ? it : it - 32 * 64, kb = r >> 6, nb = r & 63;
            transpose_item_i8(second ? p.pool_w_out : p.attn_w_out, DM, kb * 128, nb * 64, (signed char*)(ws + (second ? WS_WPO8 : WS_WO8)), DM, nb * 64, scr, lane,
                              (const unsigned*)(ws + (second ? WS_CAMAX4 : WS_CAMAX3)), (float*)(ws + (second ? WS_SB4 : WS_SB3))); }
        for (int it = gw; it < 32 * 128; it += NGW) { const int kb = it >> 7, nb = it & 127;
            transpose_item_i8(p.pool_w_in, 8192, kb * 128, nb * 64, (signed char*)(ws + WS_WP8), DM, nb * 64, scr, lane, (const unsigned*)(ws + WS_CAMAX2), (float*)(ws + WS_SB2), p.norm_w + DM); }
        for (int it = gw; it < 32 * 160; it += NGW) { const int kb = it / 160, nb = it % 160, n0 = nb < 96 ? nb * 64 : 8288 + (nb - 96) * 64;
            transpose_item_i8(p.attn_w_in, 12384, kb * 128, n0, (signed char*)(ws + WS_WT8), DM, nb * 64, scr, lane, (const unsigned*)(ws + WS_CAMAX), (float*)(ws + WS_SB)); }
    }
    SEAM(1);
    if (IN(2)) {
        {
            pg8::Gemm g{(const bf16_t*)(ws + WS_H8), (const bf16_t*)(ws + WS_WT8), MT, NI8, DM / 2, DM / 2, DM / 2, 0};
            pg8::Order S; S.init(MT / 256, 40, 0, 0, G, bx);
            Epi1a E{ws, out};
            pg8::gemm_phase<Epi1a, false, true>(lds, g, S, E);
        }
        {
            pg8::Gemm g{(const bf16_t*)(ws + WS_H), (const bf16_t*)(ws + WS_WT_IN), MT, NB16, DM, DM, DM, 0};
            int G2 = G; asm volatile("" : "+s"(G2));
            pg8::Order S; S.init(MT / 256, 8, MT / 256, 1, G2, G2 - 1 - bx);
            Epi1b E{ws, out};
            pg8::gemm_phase<Epi1b, true>(lds, g, S, E);
        }
    }
    SEAM(2);
    if (IN(3)) {
        const bf16_t* QIF = (const bf16_t*)(ws + WS_QIB); const float* WI = (const float*)(ws + WS_WIB); float* SC = (float*)(ws + WS_SC);
        for (int it = vcu; it < 512; it += G) {
            if (it < 256) {
#pragma unroll 1
                for (int hh = 0; hh < 2; ++hh) { const int g = hh ? 511 - it : it, b = g >> 7, nt = ((g & 127) >> 1) + 1;
                    if (nt > 4) score_tiles(QIF + (size_t)g * 65536, WI + (size_t)g * 32 * HIDX, (const bf16_t*)(ws + WS_KIP) + (size_t)b * SEQ * DIDX, SC + (size_t)g * 32 * SCW, 0, 1, nt, lds); }
            } else {
                const int sb = (it - 256) >> 3, kr = (it - 256) & 7, g = 512 + sb;
                score_tiles(QIF + (size_t)g * 65536, WI + (size_t)g * 32 * HIDX, (const bf16_t*)(ws + WS_KIS) + (size_t)sb * SKV * DIDX, SC + (size_t)g * 32 * SCW, kr, 8, kr == 0 ? 9 : 8, lds);
            }
        }
    }
    SEAM(3);
    if (IN(4)) {
        PHASE_IDS();
        u64* RM = (u64*)(ws + WS_RM); const float* SC = (const float*)(ws + WS_SC);
        for (int pi = gw; pi < 2048; pi += NGW) {
            const int nq = (pi & 1) == 0 ? 9 : 8;
            float vv[NVJ];
#pragma unroll
            for (int j = 0; j < NVJ; ++j) vv[j] = 0.f;
            sel_load(SC + (size_t)pi * SCW, (pi >> 6) + 1, vv, lane);
#pragma unroll 1
            for (int k = 0; k < nq; ++k) {
                int m, nt, nv;
                if (k < 8) { const int b = k >> 1, t = (k & 1) ? 4095 - pi : pi; m = b * SEQ + t; nt = (t >> 6) + 1; nv = nt * 64; } else { m = MP + (pi >> 1); nt = 65; nv = PAST + DSQ; }
                int m2 = 0, nt2 = 0;
                if (k + 1 < 8) { const int b = (k + 1) >> 1, t = ((k + 1) & 1) ? 4095 - pi : pi; m2 = b * SEQ + t; nt2 = (t >> 6) + 1; } else if (k + 1 < nq) { m2 = MP + (pi >> 1); nt2 = 65; }
                select_row(vv, nt, nv, RM + (size_t)m * RMS, SC + (size_t)m2 * SCW, nt2, lane);
            }
        }
    }
    SEAM(4);
    if (IN(5)) {
        const u64* RM = (const u64*)(ws + WS_RM);
        const bf16_t* QB = (const bf16_t*)(ws + WS_QB); const bf16_t* SG = (const bf16_t*)(ws + WS_SG); bf16_t* OG = (bf16_t*)(ws + WS_OG);
        for (int sl = vcu; sl < 1280; sl += G) {
            const int v = sl & 255, k = sl >> 8, ks = v % 5;
            if (k != ks) {
                const int it = v + 256 * (k - (k > ks ? 1 : 0));
                const int b = it >> 8, kvh = (it >> 5) & 7, pr = it & 31;
                const bf16_t* Kh = (const bf16_t*)(ws + WS_KP) + (size_t)b * SEQ * KVW + kvh * 128; const bf16_t* Vh = (const bf16_t*)(ws + WS_VP) + (size_t)b * SEQ * KVW + kvh * 128;
#pragma unroll 1
                for (int half = 0; half < 2; ++half) {
                    const int c = half ? 63 - pr : pr; const size_t m0 = (size_t)b * SEQ + c * 64;
                    att::attn_block(QB + m0 * DM, Kh, Vh, RM + m0 * RMS, SG + m0 * DM, OG + m0 * DM, c + 1, c * 64, kvh, p.rel_bias, (LAS char*)lds);
                }
            } else {
                const int b = v >> 3, kvh = v & 7; const size_t m0 = (size_t)MP + b * 32;
                att::attn_sample_block(QB + m0 * DM, p.cache_k + ((size_t)b * PAST * NKVH + kvh) * 128, p.cache_v + ((size_t)b * PAST * NKVH + kvh) * 128,
                                       (const bf16_t*)(ws + WS_KSN) + (size_t)b * 32 * KVW + kvh * 128, (const bf16_t*)(ws + WS_VSN) + (size_t)b * 32 * KVW + kvh * 128,
                                       RM + m0 * RMS, SG + m0 * DM, OG + m0 * DM, kvh, p.rel_bias, (LAS char*)lds);
            }
        }
    }
    SEAM(5);
    if (IN(6)) {
        PHASE_IDS();
        float* SAo = (float*)(ws + WS_SA);
        quant_rows_bf16((const bf16_t*)(ws + WS_OG), (signed char*)(ws + WS_H8), MT, gw, NGW, lane, [&](int m, float am, float) { if (lane == 0) SAo[m] = am * (1.0f / 127.0f); });
    }
    SEAM(6);
    if (IN(7)) {
        pg8::Gemm g{(const bf16_t*)(ws + WS_H8), (const bf16_t*)(ws + WS_WO8), MT, DM, DM / 2, DM / 2, DM / 2, 0};
        pg8::Order S; S.init(MP / 256, 16, 256, 2, G, bx);
        EpiX1 E{p.x_prompt, nullptr, (bf16_t*)(ws + WS_H), (float*)(ws + WS_PS), (const float*)(ws + WS_SA), (const float*)(ws + WS_SB3)};
        pg8::gemm_phase<EpiX1, false, true>(lds, g, S, E);
    }
    SEAM(7);
    if (IN(8)) {
        signed char* X8 = (signed char*)(ws + WS_H8); float* ROWF = (float*)(ws + WS_ROWF);
        {
        PHASE_IDS();
        for (int m = MP + gw; m < MT; m += NGW) {
            const f32x4* xr = (const f32x4*)(p.x_sample + (size_t)(m - MP) * DM) + lane; const f32x4* ps = (const f32x4*)((const float*)(ws + WS_PS) + (size_t)(m - MP) * DM) + lane;
            f32x4* x1 = (f32x4*)((float*)(ws + WS_X1) + (size_t)m * DM) + lane; float ss = 0.f, am = 0.f; f32x4 v[16];
#pragma unroll
            for (int jb = 0; jb < 4; ++jb) {
                const f32x4* q0 = xr + 256 * jb; const f32x4* q1 = ps + 256 * jb; const f32x4* q2 = q1 + (size_t)MS * DM / 4; const f32x4* q3 = q2 + (size_t)MS * DM / 4; const f32x4* q4 = q3 + (size_t)MS * DM / 4;
                asm volatile("" : "+v"(q0), "+v"(q1), "+v"(q2), "+v"(q3), "+v"(q4) :: "memory");
#pragma unroll
                for (int jj = 0; jj < 4; ++jj) v[jb * 4 + jj] = q0[64 * jj] + ((q1[64 * jj] + q2[64 * jj]) + (q3[64 * jj] + q4[64 * jj]));
            }
#pragma unroll
            for (int j = 0; j < 16; ++j) { x1[64 * j] = v[j]; ss += (v[j].x * v[j].x + v[j].y * v[j].y) + (v[j].z * v[j].z + v[j].w * v[j].w);
                am = fmaxf(am, fmaxf(fmaxf(fabsf(v[j].x), fabsf(v[j].y)), fmaxf(fabsf(v[j].z), fabsf(v[j].w)))); }
#pragma unroll
            for (int o = 1; o < 64; o <<= 1) am = fmaxf(am, __shfl_xor(am, o));
            ss = wave_sum(ss);
            const float inv = am > 0.f ? 127.0f / am : 0.f;
            unsigned* q = (unsigned*)(X8 + (size_t)m * DM) + lane;
#pragma unroll
            for (int j = 0; j < 16; ++j) q[64 * j] = q8x4(v[j].x * inv, v[j].y * inv, v[j].z * inv, v[j].w * inv);
            if (lane == 0) ROWF[m] = am * (1.0f / 127.0f) / sqrtf(ss * (1.0f / DM) + EPS);
        }
        }
        {
            PHASE_IDS();
            quant_rows_bf16((const bf16_t*)(ws + WS_H), X8, MP, gw, NGW, lane, [&](int m, float am, float ss) { if (lane == 0) ROWF[m] = am * (1.0f / 127.0f) / sqrtf(ss * (1.0f / DM) + EPS); });
        }
        {
            PHASE_IDS();
            bf16_t* U = (bf16_t*)(ws + WS_U);
            constexpr int NPAD = (NBATCH + DB) * 16 * 512;
            for (int i = gw * 64 + lane; i < NPAD; i += NGW * 64) {
                const int c = (i & 511) * 8, rr = i >> 9, sq = rr >> 4, k = rr & 15;
                u32x4 o = (u32x4){0u, 0u, 0u, 0u}; size_t row;
                if (sq < NBATCH) row = (size_t)sq * UP_SEQ + k;
                else { const int b = sq - NBATCH; row = (size_t)UP_ROWS + (size_t)b * US_SEQ + k;
                    if (k >= 1) { const float* hp = p.state_pool + ((size_t)b * 15 + (k - 1)) * DM + c; o = pack8(*(const f32x4*)hp, *(const f32x4*)(hp + 4)); } }
                *(u32x4*)(U + row * DM + c) = o;
            }
        }
    }
    SEAM(8);
    if (IN(9)) {
        pg8::Gemm g{(const bf16_t*)(ws + WS_H8), (const bf16_t*)(ws + WS_WP8), MT, 8192, DM / 2, DM / 2, DM / 2, 0};
        pg8::Order S; S.init(MT / 256, 32, 0, 0, G, bx);
        Epi3 E{ws, out};
        pg8::gemm_phase<Epi3, false, true>(lds, g, S, E);
    }
    SEAM(9);
    if (IN(10)) {
        PHASE_IDS();
        const bf16_t* __restrict__ U = (const bf16_t*)(ws + WS_U); bf16_t* __restrict__ MX = (bf16_t*)(ws + WS_MX);
        const int gt = gw * 64 + lane, GT = NGW * 64;
#define ACC8(S, X, SGN) do { S[0] += SGN bf_lo(X.x); S[1] += SGN bf_hi(X.x); S[2] += SGN bf_lo(X.y); S[3] += SGN bf_hi(X.y); S[4] += SGN bf_lo(X.z); S[5] += SGN bf_hi(X.z); S[6] += SGN bf_lo(X.w); S[7] += SGN bf_hi(X.w); } while (0)
        for (int i = gt; i < 256 * 512; i += GT) {
            const int rg = i >> 9, c = (i & 511) * 8, w = 2 << (c >> 10);
            const float icw = 1.0f / (float)w;
            const int pm0 = rg < 224 ? rg * 68 : 224 * 68 + (rg - 224) * 36, pn = rg < 224 ? 68 : 36;
            const int cut = ((pm0 + pn - 1) >> 12) != (pm0 >> 12) ? (((pm0 >> 12) + 1) << 12) - pm0 : pn;
#pragma unroll 1
            for (int sg = 0; sg < 3; ++sg) {
                int m0, n;
                if (sg == 0) { m0 = pm0; n = cut; } else if (sg == 1) { m0 = pm0 + cut; n = pn - cut; } else { m0 = MP + (rg - 224) * 32; n = rg < 224 ? 0 : 32; }
                if (n <= 0) continue;
                const bool samp = m0 >= MP;
                const int t0 = samp ? 0 : (m0 & 4095);
                const bf16_t* up = U + (size_t)u_row(m0) * DM + c;
                float s[8] = {0.f, 0.f, 0.f, 0.f, 0.f, 0.f, 0.f, 0.f};
                for (int k = 1; k <= w; ++k) { const u32x4 x = *(const u32x4*)(up - (size_t)k * DM); ACC8(s, x, +); }
#pragma unroll 1
                for (int tb = 0; tb < n; tb += 4) {
                    u32x4 cur[4], old[4];
#pragma unroll
                    for (int q = 0; q < 4; ++q) { cur[q] = *(const u32x4*)(up + (size_t)(tb + q) * DM); old[q] = *(const u32x4*)(up + ((ptrdiff_t)(tb + q) - w) * DM); }
#pragma unroll
                    for (int q = 0; q < 4; ++q) {
                        const int t = t0 + tb + q;
                        ACC8(s, cur[q], +); ACC8(s, old[q], -);
                        const float ic = (samp || t + 1 >= w) ? icw : 1.0f / (float)(t + 1);
                        const float f[8] = {bf_lo(cur[q].x), bf_hi(cur[q].x), bf_lo(cur[q].y), bf_hi(cur[q].y), bf_lo(cur[q].z), bf_hi(cur[q].z), bf_lo(cur[q].w), bf_hi(cur[q].w)};
                        u32x4 o;
                        o.x = cvt_pk_bf16(s[0] * ic - f[0], s[1] * ic - f[1]); o.y = cvt_pk_bf16(s[2] * ic - f[2], s[3] * ic - f[3]);
                        o.z = cvt_pk_bf16(s[4] * ic - f[4], s[5] * ic - f[5]); o.w = cvt_pk_bf16(s[6] * ic - f[6], s[7] * ic - f[7]);
                        *(u32x4*)(MX + (size_t)(m0 + tb + q) * DM + c) = o;
                    }
                }
            }
        }
#undef ACC8
    }
    SEAM(10);
    if (IN(11)) {
        pg8::Gemm g{(const bf16_t*)(ws + WS_MX), (const bf16_t*)(ws + WS_WT_GRP), MT, DM, 1024, DM, 1024, 1};
        pg8::Order S; S.init(MT / 256, 16, 0, 0, G, bx);
        Epi4 E{ws, p.pool_scale};
        pg8::gemm_phase<Epi4>(lds, g, S, E);
    }
    SEAM(11);
    if (IN(12)) {
        PHASE_IDS();
        float* SAo = (float*)(ws + WS_SA);
        quant_rows_bf16((const bf16_t*)(ws + WS_ZG), (signed char*)(ws + WS_H8), MT, gw, NGW, lane, [&](int m, float am, float) { if (lane == 0) SAo[m] = am * (1.0f / 127.0f); });
    }
    SEAM(12);
    if (IN(13)) {
        pg8::Gemm g{(const bf16_t*)(ws + WS_H8), (const bf16_t*)(ws + WS_WPO8), MT, DM, DM / 2, DM / 2, DM / 2, 0};
        pg8::Order S; S.init(MP / 256, 16, 256, 2, G, bx);
        EpiX2 E{(bf16_t*)(ws + WS_H), (float*)(ws + WS_PS), (const float*)(ws + WS_SA), (const float*)(ws + WS_SB4)};
        pg8::gemm_phase<EpiX2, false, true>(lds, g, S, E);
    }
    SEAM(13);
    if (IN(14)) {
        PHASE_IDS();
        for (int m = MP + gw; m < MT; m += NGW) {
            const f32x4* xr = (const f32x4*)((const float*)(ws + WS_X1) + (size_t)m * DM) + lane; const f32x4* ps = (const f32x4*)((const float*)(ws + WS_PS) + (size_t)(m - MP) * DM) + lane;
            const f32x4* wr = (const f32x4*)p.final_norm_w + lane; f32x4* yo = (f32x4*)(out + O_YS + (size_t)(m - MP) * DM) + lane;
            float ss = 0.f; f32x4 v[16];
#pragma unroll
            for (int jb = 0; jb < 4; ++jb) {
                const f32x4* q0 = xr + 256 * jb; const f32x4* q1 = ps + 256 * jb; const f32x4* q2 = q1 + (size_t)MS * DM / 4; const f32x4* q3 = q2 + (size_t)MS * DM / 4; const f32x4* q4 = q3 + (size_t)MS * DM / 4;
                asm volatile("" : "+v"(q0), "+v"(q1), "+v"(q2), "+v"(q3), "+v"(q4) :: "memory");
#pragma unroll
                for (int jj = 0; jj < 4; ++jj) v[jb * 4 + jj] = q0[64 * jj] + ((q1[64 * jj] + q2[64 * jj]) + (q3[64 * jj] + q4[64 * jj]));
            }
#pragma unroll
            for (int j = 0; j < 16; ++j) ss += (v[j].x * v[j].x + v[j].y * v[j].y) + (v[j].z * v[j].z + v[j].w * v[j].w);
            const float rstd = 1.0f / sqrtf(wave_sum(ss) * (1.0f / DM) + EPS);
#pragma unroll
            for (int j = 0; j < 16; ++j) yo[64 * j] = v[j] * rstd * wr[64 * j];
        }
        {
            const f32x4* wr = (const f32x4*)p.final_norm_w + lane; f32x4 w[16];
#pragma unroll
            for (int j = 0; j < 16; ++j) w[j] = wr[64 * j];
            const bf16_t* XB = (const bf16_t*)(ws + WS_H);
            u32x2 x[16], xn[16];
            if (gw < MP) {
#pragma unroll
                for (int j = 0; j < 16; ++j) x[j] = ((const u32x2*)(XB + (size_t)gw * DM) + lane)[64 * j]; }
#pragma unroll 1
            for (int m = gw; m < MP; m += NGW) {
                if (m + NGW < MP) {
#pragma unroll
                    for (int j = 0; j < 16; ++j) xn[j] = ((const u32x2*)(XB + (size_t)(m + NGW) * DM) + lane)[64 * j]; }
                float ss = 0.f;
#pragma unroll
                for (int j = 0; j < 16; ++j) { const float a = bf_lo(x[j].x), b = bf_hi(x[j].x), c = bf_lo(x[j].y), d = bf_hi(x[j].y); ss += (a * a + b * b) + (c * c + d * d); }
                const float rstd = 1.0f / sqrtf(wave_sum(ss) * (1.0f / DM) + EPS);
                f32x4* yo = (f32x4*)(out + O_YP + (size_t)m * DM) + lane;
#pragma unroll
                for (int j = 0; j < 16; ++j) yo[64 * j] = (f32x4){bf_lo(x[j].x), bf_hi(x[j].x), bf_lo(x[j].y), bf_hi(x[j].y)} * rstd * w[j];
#pragma unroll
                for (int j = 0; j < 16; ++j) x[j] = xn[j];
            }
        }
    }
#ifdef TPROBE
    if (TPROBE == NPHASE - 1) tp1 = __builtin_amdgcn_s_memrealtime();
    if (bx == 0) { const unsigned long long t = __builtin_amdgcn_s_memrealtime(), dt = (tp1 - tp0) * TPMUL; while (__builtin_amdgcn_s_memrealtime() - t < dt) __builtin_amdgcn_s_sleep(8); }
#endif
#undef IN
#undef SEAM
}

#ifndef MK_N_LAUNCHES
#define MK_N_LAUNCHES 1
#endif
extern "C" void kernel_launch(void* const* d_in, const int* in_sizes, int n_in, void* d_out, int out_size, void* d_ws, size_t ws_size, hipStream_t stream) {
    static int grid = 0;
    if (grid == 0) {
        if (n_in != 15 || (size_t)out_size != O_END || ws_size < WS_END) { fprintf(stderr, "kernel_launch: unexpected shapes: n_in %d out %d ws %zu (need >= %zu)\n", n_in, out_size, ws_size, (size_t)WS_END); grid = -1; return; }
        int dev = 0, cus = 0, per_cu = 0;
        if (hipGetDevice(&dev) != hipSuccess || hipDeviceGetAttribute(&cus, hipDeviceAttributeMultiprocessorCount, dev) != hipSuccess) { grid = -1; return; }
        if (hipFuncSetAttribute((const void*)mega, hipFuncAttributeMaxDynamicSharedMemorySize, LDS_BYTES) != hipSuccess) { fprintf(stderr, "kernel_launch: hipFuncSetAttribute failed\n"); grid = -1; return; }
        if (hipOccupancyMaxActiveBlocksPerMultiprocessor(&per_cu, (const void*)mega, NTHREADS, LDS_BYTES) != hipSuccess || per_cu < 1) { fprintf(stderr, "kernel_launch: occupancy query says %d\n", per_cu); }
        (void)hipGetLastError();
        grid = cus;
    }
    if (grid < 0) return;
    if (hipMemsetAsync((char*)d_ws + WS_CTL, 0, CTL_ZERO_BYTES, stream) != hipSuccess) return;
    Params p{};
    p.x_prompt = (const float*)d_in[0]; p.x_sample = (const float*)d_in[1]; p.cache_k = (const float*)d_in[2]; p.cache_v = (const float*)d_in[3];
    p.cache_kidx = (const float*)d_in[4]; p.state_pool = (const float*)d_in[5]; p.norm_w = (const float*)d_in[6]; p.final_norm_w = (const float*)d_in[7];
    p.attn_w_in = (const float*)d_in[8]; p.attn_w_out = (const float*)d_in[9]; p.rel_bias = (const float*)d_in[10]; p.pool_w_in = (const float*)d_in[11];
    p.pool_group_w = (const float*)d_in[12]; p.pool_scale = (const float*)d_in[13]; p.pool_w_out = (const float*)d_in[14];
    p.out = (float*)d_out; p.ws = (unsigned char*)d_ws;
    if (MK_N_LAUNCHES == 1) { p.ph_lo = 0; p.ph_hi = NPHASE; hipLaunchKernelGGL(mega, dim3(grid), dim3(NTHREADS), LDS_BYTES, stream, p); }
    else for (int k = 0; k < NPHASE; ++k) { p.ph_lo = k; p.ph_hi = k + 1; hipLaunchKernelGGL(mega, dim3(grid), dim3(NTHREADS), LDS_BYTES, stream, p); }
#ifdef PROBE_PHASE
    { p.ph_lo = PROBE_PHASE; p.ph_hi = PROBE_PHASE + 1; hipLaunchKernelGGL(mega, dim3(grid), dim3(NTHREADS), LDS_BYTES, stream, p); }
#endif
    const hipError_t le = hipPeekAtLastError();
    if (le != hipSuccess) fprintf(stderr, "kernel_launch: launch failed: %s\n", hipGetErrorName(le));
}
```
